# Optimizing an MI355X kernel written in HIP

```python
import math
import jax, jax.numpy as jnp
from jax import lax
import numpy as np

D_MODEL = 1024
BATCH = 2
SEQ = 8192
DEPTH = 2

BLOCK = 128
EPS = 1e-6
ML_HEADS = 4
ML_HEAD_DIM = 128
ML_WIDTH = ML_HEADS * ML_HEAD_DIM
ML_CONV = 4
SG_GROUPS = 4
SG_GROUP_DIM = 128
SG_WIDTH = SG_GROUPS * SG_GROUP_DIM
FOX_HEADS = 4
FOX_HEAD_DIM = 128
FOX_WIDTH = FOX_HEADS * FOX_HEAD_DIM
DIFF_HEADS = 4
DIFF_QK_DIM = 64
DIFF_V_DIM = 128
DIFF_WIDTH = DIFF_HEADS * DIFF_V_DIM
ROPE_THETA = 500000.0
ROPE_DIMS = DIFF_QK_DIM // 4
D_FF = 2816
N_EXPERTS = 8
TOP_K = 2
D_FF_EXPERT = 3584

EVEN_SPLITS = (ML_WIDTH, ML_WIDTH, ML_WIDTH, ML_WIDTH, 2 * ML_HEADS, SG_WIDTH, SG_WIDTH)
ODD_SPLITS = (FOX_WIDTH, FOX_WIDTH, FOX_WIDTH, FOX_HEADS,
              DIFF_HEADS * 2 * DIFF_QK_DIM, DIFF_HEADS * 2 * DIFF_QK_DIM, DIFF_WIDTH)
EVEN_PROJ = sum(EVEN_SPLITS)
ODD_PROJ = sum(ODD_SPLITS)

kernel_name = "hybrid_mlstm_gmlp_fox_diff_moe"


def split_cols(z, sizes):
    idx = np.cumsum(sizes)[:-1].tolist()
    return jnp.split(z, idx, axis=-1)


def rms_norm(x, g):
    xf = x.astype(jnp.float32)
    y = xf * lax.rsqrt(jnp.mean(xf * xf, axis=-1, keepdims=True) + EPS)
    return (y * g.astype(jnp.float32)).astype(x.dtype)


def causal_dwconv(x, w, b):
    C = x.shape[-1]
    y = lax.conv_general_dilated(x, w[:, None, :].astype(x.dtype), window_strides=(1,),
                                 padding=((w.shape[0] - 1, 0),),
                                 dimension_numbers=("NWC", "WIO", "NWC"),
                                 feature_group_count=C)
    return y + b


def swiglu(t, w_gate_up, w_down):
    g, u = jnp.split(t @ w_gate_up, 2, axis=-1)
    return (jax.nn.silu(g) * u) @ w_down


def partial_rope(x):
    S = x.shape[-2]
    half = ROPE_DIMS // 2
    inv = ROPE_THETA ** (-jnp.arange(half, dtype=jnp.float32) / half)
    ang = jnp.arange(S, dtype=jnp.float32)[:, None] * inv[None, :]
    cos, sin = jnp.cos(ang), jnp.sin(ang)
    xf = x[..., :ROPE_DIMS].astype(jnp.float32)
    x1, x2 = xf[..., :half], xf[..., half:]
    rot = jnp.concatenate([x1 * cos - x2 * sin, x2 * cos + x1 * sin], axis=-1)
    return jnp.concatenate([rot.astype(x.dtype), x[..., ROPE_DIMS:]], axis=-1)


def mlstm_chunkwise(q, k, v, i_pre, f_pre):
    B, H, S, D = q.shape
    L = BLOCK
    NC = S // L
    out_dtype = v.dtype
    f32 = jnp.float32
    q = q.astype(f32) * (D ** -0.5)
    k = k.astype(f32)
    v = v.astype(f32)
    log_f = jax.nn.log_sigmoid(f_pre.astype(f32))
    log_i = i_pre.astype(f32)

    def to_chunks(a):
        return jnp.moveaxis(a.reshape(B, H, NC, L, *a.shape[3:]), 2, 0)

    causal = jnp.tril(jnp.ones((L, L), dtype=bool))

    def step(carry, inp):
        C, n, m = carry
        qb, kb, vb, lfb, lib = inp
        b = jnp.cumsum(lfb, axis=-1)
        dmat = jnp.where(causal, b[..., :, None] - b[..., None, :] + lib[..., None, :], -jnp.inf)
        inter = b + m[..., None]
        m_row = jnp.maximum(inter, jnp.max(dmat, axis=-1))
        w_intra = jnp.exp(dmat - m_row[..., None])
        w_inter = jnp.exp(inter - m_row)
        s = jnp.einsum('bhtd,bhsd->bhts', qb, kb) * w_intra
        num = jnp.einsum('bhts,bhsd->bhtd', s, vb) + w_inter[..., None] * jnp.einsum('bhed,bhtd->bhte', C, qb)
        den = jnp.sum(s, axis=-1) + w_inter * jnp.einsum('bhd,bhtd->bht', n, qb)
        h = num / jnp.maximum(jnp.abs(den), jnp.exp(-m_row))[..., None]
        b_last = b[..., -1]
        g = b_last[..., None] - b + lib
        m_new = jnp.maximum(b_last + m, jnp.max(g, axis=-1))
        w_s = jnp.exp(g - m_new[..., None])
        decay = jnp.exp(b_last + m - m_new)
        C_new = decay[..., None, None] * C + jnp.einsum('bhs,bhse,bhsd->bhed', w_s, vb, kb)
        n_new = decay[..., None] * n + jnp.einsum('bhs,bhsd->bhd', w_s, kb)
        return (C_new, n_new, m_new), h

    init = (jnp.zeros((B, H, D, D), f32), jnp.zeros((B, H, D), f32), jnp.zeros((B, H), f32))
    _, hs = lax.scan(step, init, (to_chunks(q), to_chunks(k), to_chunks(v),
                                  to_chunks(log_f), to_chunks(log_i)))
    return jnp.moveaxis(hs, 0, 2).reshape(B, H, S, D).astype(out_dtype)


def spatial_gating(u, v, w_s, b_s):
    B, S, G, Dg = v.shape
    L = BLOCK
    NC = S // L
    tril = jnp.tril(jnp.ones((L, L), dtype=bool))
    w = jnp.where(tril, w_s, jnp.zeros_like(w_s))
    mixed = jnp.einsum('gts,bnsgc->bntgc', w, v.reshape(B, NC, L, G, Dg)) + b_s.T[None, None, :, :, None]
    return u * mixed.reshape(B, S, G, Dg)


def blocked_causal_attention(q, k, v, scale, log_fcum=None):
    B, H, G, S, Dk = q.shape
    Dv = v.shape[-1]
    NB = S // BLOCK
    q_blocks = jnp.moveaxis(q.reshape(B, H, G, NB, BLOCK, Dk), 3, 0)
    k_pos = jnp.arange(S)
    xs = (q_blocks, jnp.arange(NB))
    if log_fcum is not None:
        xs = xs + (jnp.moveaxis(log_fcum.reshape(B, H, NB, BLOCK), 2, 0),)

    def one_block(args):
        q_blk, idx = args[0], args[1]
        q_pos = idx * BLOCK + jnp.arange(BLOCK)
        logits = jnp.einsum('bhgqd,bhgkd->bhgqk', q_blk, k).astype(jnp.float32) * scale
        if log_fcum is not None:
            fq = args[2]
            logits = logits + (fq[..., :, None] - log_fcum[..., None, :])[:, :, None]
        mask = k_pos[None, :] <= q_pos[:, None]
        logits = jnp.where(mask, logits, -jnp.inf)
        p = jax.nn.softmax(logits, axis=-1)
        return jnp.einsum('bhgqk,bhkv->bhgqv', p.astype(v.dtype), v)

    out = lax.map(one_block, xs)
    return jnp.moveaxis(out, 0, 3).reshape(B, H, G, S, Dv)


def even_mixer(h, w_in, ml_conv_w, ml_conv_b, ml_gate_b, ml_norm_g, sg_norm_g, sg_w, sg_b, w_out):
    B, S, _ = h.shape
    q, k, v, o, gates, u, vs = split_cols(h @ w_in, EVEN_SPLITS)
    qk = jax.nn.silu(causal_dwconv(jnp.concatenate([q, k], axis=-1), ml_conv_w, ml_conv_b))
    q, k = jnp.split(qk, 2, axis=-1)

    def heads(t):
        return t.reshape(B, S, ML_HEADS, ML_HEAD_DIM).transpose(0, 2, 1, 3)

    i_pre = (gates[..., :ML_HEADS] + ml_gate_b[0]).transpose(0, 2, 1)
    f_pre = (gates[..., ML_HEADS:] + ml_gate_b[1]).transpose(0, 2, 1)
    hm = mlstm_chunkwise(heads(q), heads(k), heads(v), i_pre, f_pre).transpose(0, 2, 1, 3)
    hm = rms_norm(hm, ml_norm_g.reshape(ML_HEADS, ML_HEAD_DIM))
    y_ml = jax.nn.sigmoid(o) * hm.reshape(B, S, ML_WIDTH)
    u = jax.nn.gelu(u)
    vs = rms_norm(jax.nn.gelu(vs), sg_norm_g)
    y_sg = spatial_gating(u.reshape(B, S, SG_GROUPS, SG_GROUP_DIM),
                          vs.reshape(B, S, SG_GROUPS, SG_GROUP_DIM), sg_w, sg_b).reshape(B, S, SG_WIDTH)
    return jnp.concatenate([y_ml, y_sg], axis=-1) @ w_out


def odd_mixer(h, w_in, fox_f_b, diff_lambda, diff_norm_g, w_out, lambda_init):
    B, S, _ = h.shape
    fq, fk, fv, ff, dq, dk, dv = split_cols(h @ w_in, ODD_SPLITS)
    log_f = jax.nn.log_sigmoid(ff.astype(jnp.float32) + fox_f_b.astype(jnp.float32))
    F = jnp.cumsum(log_f, axis=1).transpose(0, 2, 1)

    def fheads(t):
        return t.reshape(B, S, FOX_HEADS, FOX_HEAD_DIM).transpose(0, 2, 1, 3)

    y_fox = blocked_causal_attention(fheads(fq)[:, :, None], fheads(fk)[:, :, None], fheads(fv),
                                     FOX_HEAD_DIM ** -0.5, F)[:, :, 0]
    y_fox = y_fox.transpose(0, 2, 1, 3).reshape(B, S, FOX_WIDTH)
    def dheads(t):
        return t.reshape(B, S, DIFF_HEADS, 2, DIFF_QK_DIM).transpose(0, 2, 3, 1, 4)

    qd = partial_rope(dheads(dq))
    kd = partial_rope(dheads(dk))
    vd = dv.reshape(B, S, DIFF_HEADS, DIFF_V_DIM).transpose(0, 2, 1, 3)
    a = blocked_causal_attention(qd, kd, vd, DIFF_QK_DIM ** -0.5)
    lam_f = diff_lambda.astype(jnp.float32)
    lam = (jnp.exp(jnp.sum(lam_f[0] * lam_f[1])) - jnp.exp(jnp.sum(lam_f[2] * lam_f[3])) + lambda_init)
    y_d = a[:, :, 0] - lam.astype(a.dtype) * a[:, :, 1]
    y_d = rms_norm(y_d, diff_norm_g) * (1.0 - lambda_init)
    y_d = y_d.transpose(0, 2, 1, 3).reshape(B, S, DIFF_WIDTH)
    return jnp.concatenate([y_fox, y_d], axis=-1) @ w_out


def moe_swiglu(h, w_router, w_gate_up, w_down):
    B, S, D = h.shape
    t = h.reshape(B * S, D)
    logits = (t @ w_router).astype(jnp.float32)
    top_v, top_i = lax.top_k(logits, TOP_K)
    top_w = jax.nn.softmax(top_v, axis=-1)
    gates = jnp.sum(jax.nn.one_hot(top_i, N_EXPERTS, dtype=jnp.float32) * top_w[..., None], axis=1)
    out = jnp.zeros_like(t)
    for e in range(N_EXPERTS):
        out = out + gates[:, e:e + 1].astype(t.dtype) * swiglu(t, w_gate_up[e], w_down[e])
    return out.reshape(B, S, D)


def setup_inputs(seed: int = 0) -> dict:
    key = jax.random.key(seed)
    ks = iter(jax.random.split(key, 40))
    NE = (DEPTH + 1) // 2
    NO = DEPTH // 2
    D = D_MODEL

    def nrm(shape, scale):
        return jax.random.normal(next(ks), shape, jnp.float32) * scale

    def gain(shape):
        return 1.0 + nrm(shape, 0.02)

    x = nrm((BATCH, SEQ, D), 1.0)
    ml_gate_b = jnp.concatenate([
        nrm((NE, 1, ML_HEADS), 0.1),
        jnp.linspace(3.0, 6.0, ML_HEADS, dtype=jnp.float32)[None, None, :] + nrm((NE, 1, ML_HEADS), 0.1)], axis=1)
    return {
        "x": x,
        "even_norm_mix": gain((NE, D)),
        "even_w_in": nrm((NE, D, EVEN_PROJ), D ** -0.5),
        "even_ml_conv_w": nrm((NE, ML_CONV, 2 * ML_WIDTH), ML_CONV ** -0.5),
        "even_ml_conv_b": nrm((NE, 2 * ML_WIDTH), 0.02),
        "even_ml_gate_b": ml_gate_b,
        "even_ml_norm_g": gain((NE, ML_WIDTH)),
        "even_sg_norm_g": gain((NE, SG_WIDTH)),
        "even_sg_w": nrm((NE, SG_GROUPS, BLOCK, BLOCK), BLOCK ** -0.5),
        "even_sg_b": 1.0 + nrm((NE, SG_GROUPS, BLOCK), 0.02),
        "even_w_out": nrm((NE, ML_WIDTH + SG_WIDTH, D), (ML_WIDTH + SG_WIDTH) ** -0.5),
        "even_norm_ffn": gain((NE, D)),
        "ffn_w_gate_up": nrm((NE, D, 2 * D_FF), D ** -0.5),
        "ffn_w_down": nrm((NE, D_FF, D), D_FF ** -0.5),
        "odd_norm_mix": gain((NO, D)),
        "odd_w_in": nrm((NO, D, ODD_PROJ), D ** -0.5),
        "odd_fox_f_b": jnp.linspace(2.0, 5.0, FOX_HEADS, dtype=jnp.float32)[None, :] + nrm((NO, FOX_HEADS), 0.1),
        "odd_diff_lambda": nrm((NO, 4, DIFF_QK_DIM), 0.1),
        "odd_diff_norm_g": gain((NO, DIFF_V_DIM)),
        "odd_w_out": nrm((NO, FOX_WIDTH + DIFF_WIDTH, D), (FOX_WIDTH + DIFF_WIDTH) ** -0.5),
        "odd_norm_ffn": gain((NO, D)),
        "moe_w_router": nrm((NO, D, N_EXPERTS), D ** -0.5),
        "moe_w_gate_up": nrm((NO, N_EXPERTS, D, 2 * D_FF_EXPERT), D ** -0.5),
        "moe_w_down": nrm((NO, N_EXPERTS, D_FF_EXPERT, D), D_FF_EXPERT ** -0.5),
        "final_norm": gain((D,)),
    }


def reference(x, even_norm_mix, even_w_in, even_ml_conv_w, even_ml_conv_b, even_ml_gate_b,
              even_ml_norm_g, even_sg_norm_g, even_sg_w, even_sg_b, even_w_out, even_norm_ffn,
              ffn_w_gate_up, ffn_w_down, odd_norm_mix, odd_w_in, odd_fox_f_b, odd_diff_lambda,
              odd_diff_norm_g, odd_w_out, odd_norm_ffn, moe_w_router, moe_w_gate_up, moe_w_down,
              final_norm):
    for layer in range(DEPTH):
        p = layer // 2
        if layer % 2 == 0:
            x = x + even_mixer(rms_norm(x, even_norm_mix[p]), even_w_in[p], even_ml_conv_w[p],
                               even_ml_conv_b[p], even_ml_gate_b[p], even_ml_norm_g[p],
                               even_sg_norm_g[p], even_sg_w[p], even_sg_b[p], even_w_out[p])
            x = x + swiglu(rms_norm(x, even_norm_ffn[p]), ffn_w_gate_up[p], ffn_w_down[p])
        else:
            lambda_init = 0.8 - 0.6 * math.exp(-0.3 * layer)
            x = x + odd_mixer(rms_norm(x, odd_norm_mix[p]), odd_w_in[p], odd_fox_f_b[p],
                              odd_diff_lambda[p], odd_diff_norm_g[p], odd_w_out[p], lambda_init)
            x = x + moe_swiglu(rms_norm(x, odd_norm_ffn[p]), moe_w_router[p], moe_w_gate_up[p], moe_w_down[p])
    return rms_norm(x, final_norm)
```

```cpp
#include <hip/hip_runtime.h>
#include <cstdio>
#include <cstdint>

#define LAS __attribute__((address_space(3)))
#define GAS __attribute__((address_space(1)))
typedef unsigned short bf16;
typedef unsigned short bf16_t;
typedef short bf16x8 __attribute__((ext_vector_type(8)));
typedef short s16x4 __attribute__((ext_vector_type(4)));
typedef float f32x2 __attribute__((ext_vector_type(2)));
typedef float f32x4 __attribute__((ext_vector_type(4)));
typedef float f32x16 __attribute__((ext_vector_type(16)));
typedef unsigned u32x2 __attribute__((ext_vector_type(2)));
typedef unsigned u32x4 __attribute__((ext_vector_type(4)));
typedef GAS unsigned gu32;
#define RLX_AGENT __ATOMIC_RELAXED, __HIP_MEMORY_SCOPE_AGENT
#define LDS_WAIT() asm volatile("s_waitcnt lgkmcnt(0)" ::: "memory")
#define VM_WAIT() asm volatile("s_waitcnt vmcnt(0)" ::: "memory")

typedef __bf16 bf16x2_t __attribute__((ext_vector_type(2)));
__device__ __forceinline__ unsigned pk2(float lo, float hi) { const f32x2 v = {lo, hi}; return __builtin_bit_cast(unsigned, __builtin_convertvector(v, bf16x2_t)); }
__device__ __forceinline__ unsigned f2bf(float f) { return pk2(f, 0.f) & 0xffffu; }
__device__ __forceinline__ float bf2f(unsigned b) { return __builtin_bit_cast(float, b << 16); }
__device__ __forceinline__ float bflo(unsigned w) { return __builtin_bit_cast(float, w << 16); }
__device__ __forceinline__ float bfhi(unsigned w) { return __builtin_bit_cast(float, w & 0xffff0000u); }
__device__ __forceinline__ float ldf(const float* p) { return __builtin_bit_cast(float, __hip_atomic_load((const unsigned*)p, RLX_AGENT)); }
__device__ __forceinline__ int ldi(const int* p) { return __hip_atomic_load(p, RLX_AGENT); }
__device__ __forceinline__ float wave_sum(float v) {
#define DPPF(x, ctrl, rmask) __builtin_bit_cast(float, __builtin_amdgcn_update_dpp(0, __builtin_bit_cast(int, x), ctrl, rmask, 0xF, true))
    v += DPPF(v, 0xB1, 0xF);
    v += DPPF(v, 0x4E, 0xF);
    v += DPPF(v, 0x141, 0xF);
    v += DPPF(v, 0x140, 0xF);
    v += DPPF(v, 0x142, 0xA);
    v += DPPF(v, 0x143, 0xC);
#undef DPPF
    return __builtin_bit_cast(float, __builtin_amdgcn_readlane(__builtin_bit_cast(int, v), 63));
}
__device__ __forceinline__ float wave_max(float v) {
#pragma unroll
    for (int o = 1; o < 64; o <<= 1) v = fmaxf(v, __shfl_xor(v, o));
    return v;
}
__device__ __forceinline__ float shfl_up_l(float v, int o, int lane) { const int src = (lane >= o) ? lane - o : lane; return __builtin_bit_cast(float, __builtin_amdgcn_ds_bpermute(src << 2, __builtin_bit_cast(int, v))); }
__device__ __forceinline__ float shfl_idx_l(float v, int src) { return __builtin_bit_cast(float, __builtin_amdgcn_ds_bpermute(src << 2, __builtin_bit_cast(int, v))); }
__device__ __forceinline__ float shfl_xor_l(float v, int o, int lane) { return __builtin_bit_cast(float, __builtin_amdgcn_ds_bpermute((lane ^ o) << 2, __builtin_bit_cast(int, v))); }
__device__ __forceinline__ float quad_xor1(float v) { return __builtin_bit_cast(float, __builtin_amdgcn_update_dpp(0, __builtin_bit_cast(int, v), 0xB1, 0xF, 0xF, true)); }
__device__ __forceinline__ float quad_xor2(float v) { return __builtin_bit_cast(float, __builtin_amdgcn_update_dpp(0, __builtin_bit_cast(int, v), 0x4E, 0xF, 0xF, true)); }
__device__ __forceinline__ float quad_sum(float v) { v += quad_xor1(v); v += quad_xor2(v); return v; }
__device__ __forceinline__ float fast_exp(float x) { return __builtin_amdgcn_exp2f(x * 1.4426950408889634f); }
__device__ __forceinline__ float sigmoidf_(float x) { return __builtin_amdgcn_rcpf(1.0f + fast_exp(-x)); }
__device__ __forceinline__ float siluf_(float x) { return x * sigmoidf_(x); }
__device__ __forceinline__ float gelu_tanh(float x) {
    const float x2 = x * x, t = fmaf(x2, -2.3022082299f * 0.044715f, -2.3022082299f);
    return x * __builtin_amdgcn_rcpf(1.0f + __builtin_amdgcn_exp2f(x * t));
}
__device__ __forceinline__ float log_sigmoid_acc(float x) { return fminf(x, 0.f) - log1pf(expf(-fabsf(x))); }

namespace pg8 {
#define PG8_LAS __attribute__((address_space(3)))
constexpr int BM = 256, BK = 64, HALF = 128, HTB = HALF * BK * 2, STAGE_BYTES = 8 * HTB, NXCD = 8, WGM = 8;
__host__ __device__ __forceinline__ int lds_byte(int r, int c) { const int st = (r >> 4) * 2 + (c >> 5), rr = r & 15, cc = c & 31, ob = rr * 64 + cc * 2; return st * 1024 + (ob ^ (((ob >> 9) & 1) << 5)); }
__host__ __device__ __forceinline__ void stage_rc(int b, int& R, int& C) { const int st = b / 1024, sb = b % 1024, swz = sb ^ (((sb >> 9) & 1) << 5); R = (st >> 1) * 16 + swz / 64; C = (st & 1) * 32 + (swz % 64) / 2; }
__host__ __device__ __forceinline__ int perm32(int rho) { const int n = rho >> 4, i = rho & 15; return 8 * (i >> 2) + 4 * n + (i & 3); }

struct Unit { int pm, pn, pb, kt0, nkt; };
struct Gemm { const bf16_t* A; const bf16_t* Bt; int M, N, K; };

struct StaticOrder {
    int nM, nN, nwg, G, c; int wgm = WGM;
    __host__ __device__ void init(int M, int N, int G_, int c_) { nM = M / BM; nN = N / BM; nwg = nM * nN; G = G_; c = c_; }
    __host__ __device__ __forceinline__ bool next(int i, Unit& u) const {
        const long L = (long)i * G + c; if (L >= nwg) return false;
        int wgid = (int)L; { const int q = nwg / NXCD, r = nwg % NXCD, xcd = wgid % NXCD, off = wgid / NXCD; wgid = (xcd < r ? xcd * (q + 1) : r * (q + 1) + (xcd - r) * q) + off; }
        const int nig = wgm * nN, gid = wgid / nig, fm = gid * wgm, gsz = (nM - fm) < wgm ? (nM - fm) : wgm;
        u.pm = fm + ((wgid % nig) % gsz); u.pn = (wgid % nig) / gsz; u.pb = u.pn; return true;
    }
    static constexpr bool KRANGE = false;
    __device__ __forceinline__ void a_ready(const Unit&) const {}
    __device__ __forceinline__ void done(const Unit&) const {}
};
struct MoeOrder {
    int nM, nN, nwg, G, c; int ts[9]; int wgm = WGM;
    __device__ __forceinline__ bool next(int i, Unit& u) const {
        const long L = (long)i * G + c; if (L >= nwg) return false;
        int wgid = (int)L; { const int q = nwg / NXCD, r = nwg % NXCD, xcd = wgid % NXCD, off = wgid / NXCD; wgid = (xcd < r ? xcd * (q + 1) : r * (q + 1) + (xcd - r) * q) + off; }
        const int nig = wgm * nN, gid = wgid / nig, fm = gid * wgm, gsz = (nM - fm) < wgm ? (nM - fm) : wgm;
        u.pm = fm + ((wgid % nig) % gsz); u.pn = (wgid % nig) / gsz;
        int e = 0;
#pragma unroll
        for (int k = 1; k < 8; ++k) e += (u.pm >= ts[k]) ? 1 : 0;
        u.pb = e * nN + u.pn; return true;
    }
    static constexpr bool KRANGE = false;
    __device__ __forceinline__ void a_ready(const Unit&) const {}
    __device__ __forceinline__ void done(const Unit&) const {}
};
__host__ __device__ __forceinline__ int hyb_SL(int R) { return R <= 9 ? 28 : (R <= 18 ? 14 : (R <= 36 ? 7 : 4)); }
struct HybridOrder {
    int U, c, nN, NKT, G; int ts[9];
    __device__ __forceinline__ bool next(int i, Unit& u) const {
        const bool full = i < 2; const int R = U - 512, SL = hyb_SL(R), ui = c / SL, sl = c - ui * SL;
        if (!full && (i > 2 || R <= 0 || ui >= R)) return false;
        int wgid = i * G + c; { const int q = 512 / NXCD, xcd = wgid % NXCD, off = wgid / NXCD; wgid = xcd * q + off; }
        const int nig = WGM * nN, fm = (wgid / nig) * WGM, pm_f = fm + ((wgid % nig) % WGM), pn_f = (wgid % nig) / WGM;
        const int unit = 512 + ui, pm_s = unit / nN, pn_s = unit - pm_s * nN, nk_s = NKT / SL;
        const int pm = full ? pm_f : pm_s, pn = full ? pn_f : pn_s, nkt = full ? NKT : nk_s, kt0 = full ? 0 : sl * nk_s;
        int e = 0;
#pragma unroll
        for (int k = 1; k < 8; ++k) e += (pm >= ts[k]) ? 1 : 0;
        u.pm = pm; u.pn = pn; u.pb = e * nN + pn; u.kt0 = kt0; u.nkt = nkt; return true;
    }
    static constexpr bool KRANGE = true;
    __device__ __forceinline__ void a_ready(const Unit&) const {}
    __device__ __forceinline__ void done(const Unit&) const {}
};

__device__ __forceinline__ unsigned cvt_pk_bf16(float lo, float hi) { unsigned r; asm volatile("v_cvt_pk_bf16_f32 %0, %1, %2" : "=v"(r) : "v"(lo), "v"(hi)); return r; }

struct EpiBf16 {
    static constexpr bool PERM = true, AFTER_DRAIN = false;
    bf16_t* O; int ldc; const float* cs; int rope_pn0, rope_pn1; float* norm2; int sig_pn0, gelu_pn0, gelu_pn1;
    __device__ __forceinline__ void operator()(const f32x4 (&acc)[2][2][4][2], const Unit& u, int wr, int wc, int fr, int fq) const {
        const int row0 = u.pm * BM + wr * 64 + fr; const int col0 = u.pn * BM + wc * 32 + 8 * fq;
        if (norm2 != nullptr && u.pn < 4) {
#pragma unroll
            for (int ai = 0; ai < 2; ++ai)
#pragma unroll
                for (int m = 0; m < 4; ++m)
#pragma unroll
                    for (int bj = 0; bj < 2; ++bj) { const f32x4 a0 = acc[ai][bj][m][0], a1 = acc[ai][bj][m][1];
                        float s = (a0[0] * a0[0] + a0[1] * a0[1]) + (a0[2] * a0[2] + a0[3] * a0[3]) + (a1[0] * a1[0] + a1[1] * a1[1]) + (a1[2] * a1[2] + a1[3] * a1[3]);
                        s += __shfl_xor(s, 16); s += __shfl_xor(s, 32);
                        if (fq == 0) norm2[((size_t)(row0 + ai * HALF + m * 16) * 8 + (u.pn >> 1) * 4 + (u.pn & 1) * 2 + bj) * 4 + wc] = s; }
        }
        const bool rope = (u.pn >= rope_pn0) && (u.pn < rope_pn1) && ((wc & 1) == 0);
        const float sgn = (fq == 0) ? -1.f : 1.f;
#pragma unroll
        for (int ai = 0; ai < 2; ++ai)
#pragma unroll
            for (int m = 0; m < 4; ++m) { const int row = row0 + ai * HALF + m * 16; bf16_t* rowp = O + (size_t)row * ldc + col0;
                f32x4 c0 = {1.f, 1.f, 1.f, 1.f}, c1 = c0, s0 = {0.f, 0.f, 0.f, 0.f}, s1 = s0;
                if (rope) {
                    const float pos = (float)(row & 8191);
                    constexpr float IR[8] = {0.15915494309189535f, 0.03086376340470123f, 0.0059851857127137054f, 0.001160663641240061f, 0.00022507907903927653f, 4.3647952792802891e-05f, 8.4643308082414014e-06f, 1.6414262627950345e-06f};
#pragma unroll
                    for (int k = 0; k < 4; ++k) { const float r0 = __builtin_amdgcn_fractf(pos * IR[k]), r1 = __builtin_amdgcn_fractf(pos * IR[4 + k]);
                        c0[k] = __builtin_amdgcn_cosf(r0); s0[k] = __builtin_amdgcn_sinf(r0); c1[k] = __builtin_amdgcn_cosf(r1); s1[k] = __builtin_amdgcn_sinf(r1); } }
#pragma unroll
                for (int bj = 0; bj < 2; ++bj) { f32x4 v0 = acc[ai][bj][m][0], v1 = acc[ai][bj][m][1];
                    if (u.pn >= gelu_pn0 && u.pn < gelu_pn1) {
#pragma unroll
                        for (int i = 0; i < 4; ++i) { v0[i] = gelu_tanh(v0[i]); v1[i] = gelu_tanh(v1[i]); } }
                    else if (u.pn >= sig_pn0 && u.pn < gelu_pn0) {
#pragma unroll
                        for (int i = 0; i < 4; ++i) { v0[i] = sigmoidf_(v0[i]); v1[i] = sigmoidf_(v1[i]); } }
                    if (rope) { f32x4 p0, p1;
#pragma unroll
                        for (int i = 0; i < 4; ++i) { p0[i] = __shfl_xor(v0[i], 16); p1[i] = __shfl_xor(v1[i], 16); }
                        if (fq < 2) { v0 = v0 * c0 + (p0 * s0) * sgn; v1 = v1 * c1 + (p1 * s1) * sgn; } }
                    u32x4 w; w.x = cvt_pk_bf16(v0[0], v0[1]); w.y = cvt_pk_bf16(v0[2], v0[3]); w.z = cvt_pk_bf16(v1[0], v1[1]); w.w = cvt_pk_bf16(v1[2], v1[3]);
                    *(u32x4*)(rowp + bj * HALF) = w; } }
    }
};
struct EpiResF32 {
    static constexpr bool PERM = false, AFTER_DRAIN = false;
    const float* base; float* out; int ldc;
    __device__ __forceinline__ void operator()(const f32x4 (&acc)[2][2][4][2], const Unit& u, int wr, int wc, int fr, int fq) const {
        const int row0 = u.pm * BM + wr * 64 + fr, col0 = u.pn * BM + wc * 32 + 4 * fq;
#pragma unroll
        for (int ai = 0; ai < 2; ++ai) {
            f32x4 b[4][2][2];
#pragma unroll
            for (int m = 0; m < 4; ++m) { const size_t off = (size_t)(row0 + ai * HALF + m * 16) * ldc + col0;
#pragma unroll
                for (int bj = 0; bj < 2; ++bj)
#pragma unroll
                    for (int n = 0; n < 2; ++n) b[m][bj][n] = *(const f32x4*)(base + off + bj * HALF + n * 16); }
#pragma unroll
            for (int m = 0; m < 4; ++m) { const size_t off = (size_t)(row0 + ai * HALF + m * 16) * ldc + col0;
#pragma unroll
                for (int bj = 0; bj < 2; ++bj)
#pragma unroll
                    for (int n = 0; n < 2; ++n) *(f32x4*)(out + off + bj * HALF + n * 16) = b[m][bj][n] + acc[ai][bj][m][n]; }
            asm volatile("" ::: "memory"); }
    }
};
struct EpiSwiglu {
    static constexpr bool PERM = true, AFTER_DRAIN = false;
    bf16_t* O; int ldc;
    __device__ __forceinline__ void operator()(const f32x4 (&acc)[2][2][4][2], const Unit& u, int wr, int wc, int fr, int fq) const {
        const int row0 = u.pm * BM + wr * 64 + fr; const int col0 = u.pn * HALF + wc * 32 + 8 * fq;
#pragma unroll
        for (int ai = 0; ai < 2; ++ai)
#pragma unroll
            for (int m = 0; m < 4; ++m) { bf16_t* rowp = O + (size_t)(row0 + ai * HALF + m * 16) * ldc + col0;
                f32x4 h0, h1;
#pragma unroll
                for (int i = 0; i < 4; ++i) { h0[i] = siluf_(acc[ai][0][m][0][i]) * acc[ai][1][m][0][i]; h1[i] = siluf_(acc[ai][0][m][1][i]) * acc[ai][1][m][1][i]; }
                u32x4 w; w.x = cvt_pk_bf16(h0[0], h0[1]); w.y = cvt_pk_bf16(h0[2], h0[3]); w.z = cvt_pk_bf16(h1[0], h1[1]); w.w = cvt_pk_bf16(h1[2], h1[3]);
                *(u32x4*)rowp = w; }
    }
};
#if defined(PROBE_EPI)
struct EpiNone { static constexpr bool PERM = true, AFTER_DRAIN = false; bf16_t* O; int ldc;
    __device__ __forceinline__ void operator()(const f32x4 (&acc)[2][2][4][2], const Unit& u, int wr, int wc, int fr, int fq) const {
        float s = 0.f;
#pragma unroll
        for (int ai = 0; ai < 2; ++ai)
#pragma unroll
            for (int bj = 0; bj < 2; ++bj)
#pragma unroll
                for (int m = 0; m < 4; ++m)
#pragma unroll
                    for (int n = 0; n < 2; ++n) s += acc[ai][bj][m][n][0];
        if (s == 12345.678f) O[0] = 1; } };
struct EpiSwigluCheap {
    static constexpr bool PERM = true, AFTER_DRAIN = false;
    bf16_t* O; int ldc;
    __device__ __forceinline__ void operator()(const f32x4 (&acc)[2][2][4][2], const Unit& u, int wr, int wc, int fr, int fq) const {
        const int row0 = u.pm * BM + wr * 64 + fr; const int col0 = u.pn * HALF + wc * 32 + 8 * fq;
#pragma unroll
        for (int ai = 0; ai < 2; ++ai)
#pragma unroll
            for (int m = 0; m < 4; ++m) { bf16_t* rowp = O + (size_t)(row0 + ai * HALF + m * 16) * ldc + col0;
                const f32x4 h0 = acc[ai][0][m][0] * acc[ai][1][m][0], h1 = acc[ai][0][m][1] * acc[ai][1][m][1];
                u32x4 w; w.x = cvt_pk_bf16(h0[0], h0[1]); w.y = cvt_pk_bf16(h0[2], h0[3]); w.z = cvt_pk_bf16(h1[0], h1[1]); w.w = cvt_pk_bf16(h1[2], h1[3]);
                *(u32x4*)rowp = w; }
    }
};
#endif
struct EpiMoeDown {
    static constexpr bool PERM = false, AFTER_DRAIN = false;
    float* Y; int ldc; const float* rw;
    __device__ __forceinline__ void operator()(const f32x4 (&acc)[2][2][4][2], const Unit& u, int wr, int wc, int fr, int fq) const {
        const int row0 = u.pm * BM + wr * 64 + fr, col0 = u.pn * BM + wc * 32 + 4 * fq;
#pragma unroll
        for (int ai = 0; ai < 2; ++ai)
#pragma unroll
            for (int m = 0; m < 4; ++m) { const int row = row0 + ai * HALF + m * 16; const float w = ldf(rw + row); const size_t off = (size_t)row * ldc + col0;
#pragma unroll
                for (int bj = 0; bj < 2; ++bj)
#pragma unroll
                    for (int n = 0; n < 2; ++n) *(f32x4*)(Y + off + bj * HALF + n * 16) = acc[ai][bj][m][n] * w; }
    }
};

struct EpiMoeDownSK {
    static constexpr bool PERM = true, AFTER_DRAIN = false;
    bf16_t* Y; int ldc; const float* rw; float* slab; int SL;
    __device__ __forceinline__ void operator()(const f32x4 (&acc)[2][2][4][2], const Unit& u, int wr, int wc, int fr, int fq) const {
        const int r0 = wr * 64 + fr, c0 = wc * 32 + 8 * fq; const bool second = u.kt0 != 0;
        const int sidx = second ? (u.pm * 4 + u.pn - 512) * (SL - 1) + u.kt0 / u.nkt - 1 : 0;
        float* sb = slab + (size_t)sidx * 65536 + c0; bf16_t* yb = Y + (size_t)(u.pm * BM) * ldc + u.pn * BM + c0;
        float wv[2][4];
#pragma unroll
        for (int ai = 0; ai < 2; ++ai)
#pragma unroll
            for (int m = 0; m < 4; ++m) wv[ai][m] = rw[u.pm * BM + r0 + ai * HALF + m * 16];
#pragma unroll
        for (int ai = 0; ai < 2; ++ai)
#pragma unroll
            for (int m = 0; m < 4; ++m) { const int r = r0 + ai * HALF + m * 16; const float w = wv[ai][m];
#pragma unroll
                for (int bj = 0; bj < 2; ++bj) { const f32x4 v0 = acc[ai][bj][m][0] * w, v1 = acc[ai][bj][m][1] * w;
                    if (second) { *(f32x4*)(sb + (size_t)r * 256 + bj * HALF) = v0; *(f32x4*)(sb + (size_t)r * 256 + bj * HALF + 4) = v1; }
                    else { u32x4 o; o.x = cvt_pk_bf16(v0[0], v0[1]); o.y = cvt_pk_bf16(v0[2], v0[3]); o.z = cvt_pk_bf16(v1[0], v1[1]); o.w = cvt_pk_bf16(v1[2], v1[3]); *(u32x4*)(yb + (size_t)r * ldc + bj * HALF) = o; } } }
    }
};

template <class Epi, class Sched, bool ALIGN_EPI = false, bool SP2 = false>
__device__ __forceinline__ void gemm_phase(PG8_LAS unsigned char* lds, const Gemm g, const Sched& S, const Epi& E, const int tid) {
    const int wid = __builtin_amdgcn_readfirstlane(tid >> 6), lane = tid & 63, wr = wid >> 2, wc = wid & 3, fr = lane & 15, fq = lane >> 4;
    const int K = g.K; int nt = K / BK;
    unsigned voffA[2], voffB[2];
#pragma unroll
    for (int i = 0; i < 2; ++i) { int R, C; stage_rc(tid * 16 + i * 8192, R, C); const int Rb = Epi::PERM ? ((R & ~31) + perm32(R & 31)) : R;
        voffA[i] = (unsigned)(R * K + C) * 2u; voffB[i] = (unsigned)(Rb * K + C) * 2u; }
    const size_t kstep = (size_t)(BK * 2);
    const size_t hstep = (size_t)HALF * K * 2;
    const size_t tstep = 2 * hstep;
    const unsigned ldsw = (unsigned)wid * 1024u;
    const int aoff = lds_byte(wr * 64 + fr, fq * 8), boff = lds_byte(wc * 32 + fr, fq * 8);
#define PG8_SA(b, h) (((b) * 2 + (h)) * HTB)
#define PG8_SB(b, h) ((4 + (b) * 2 + (h)) * HTB)
#define PG8_STAGE(bufoff, gbase, voff) do { _Pragma("unroll") for (int _i = 0; _i < 2; ++_i) \
        __builtin_amdgcn_global_load_lds((const unsigned*)((const char*)(gbase) + (voff)[_i]), (PG8_LAS unsigned*)(lds + (bufoff) + ldsw + _i * 8192), 16, 0, 0); } while (0)
#define PG8_LDA(dst, b, h) do { _Pragma("unroll") for (int m = 0; m < 4; ++m) _Pragma("unroll") for (int k = 0; k < 2; ++k) dst[m][k] = *(const PG8_LAS bf16x8*)(lds + PG8_SA(b, h) + aoff + m * 2048 + k * 1024); } while (0)
#define PG8_LDB(dst, b, h) do { _Pragma("unroll") for (int n = 0; n < 2; ++n) _Pragma("unroll") for (int k = 0; k < 2; ++k) dst[n][k] = *(const PG8_LAS bf16x8*)(lds + PG8_SB(b, h) + boff + n * 2048 + k * 1024); } while (0)
#define PG8_MMA(ai, bj, At, Bt) do { __builtin_amdgcn_s_setprio(1); _Pragma("unroll") for (int m = 0; m < 4; ++m) _Pragma("unroll") for (int n = 0; n < 2; ++n) _Pragma("unroll") for (int k = 0; k < 2; ++k) \
        acc[ai][bj][m][n] = __builtin_amdgcn_mfma_f32_16x16x32_bf16(Bt[n][k], At[m][k], acc[ai][bj][m][n], 0, 0, 0); __builtin_amdgcn_s_setprio(0); } while (0)
#define PG8_WAIT_V(n) asm volatile("s_waitcnt vmcnt(" #n ")" ::: "memory")
#define PG8_WAIT_L(n) asm volatile("s_waitcnt lgkmcnt(" #n ")" ::: "memory")
#define PG8_BAR __builtin_amdgcn_s_barrier()
#define PG8_SCHED __builtin_amdgcn_sched_barrier(0)
    Unit cur, nxt; int ui = 0;
    if (!S.next(0, cur)) return;
    f32x4 acc[2][2][4][2];
#pragma unroll
    for (int a = 0; a < 2; ++a)
#pragma unroll
        for (int b = 0; b < 2; ++b)
#pragma unroll
            for (int m = 0; m < 4; ++m)
#pragma unroll
                for (int n = 0; n < 2; ++n) acc[a][b][m][n] = (f32x4){0.f, 0.f, 0.f, 0.f};
    bf16x8 At[4][2], B0[2][2], B1[2][2];
    const char* cA = (const char*)g.A + (size_t)cur.pm * tstep; const char* cB = (const char*)g.Bt + (size_t)cur.pb * tstep;
    if constexpr (Sched::KRANGE) { cA += (size_t)cur.kt0 * kstep; cB += (size_t)cur.kt0 * kstep; nt = cur.nkt; }
    S.a_ready(cur);
    if constexpr (SP2) {
        PG8_STAGE(PG8_SB(0, 0), cB, voffB); PG8_STAGE(PG8_SB(0, 1), cB + hstep, voffB); PG8_STAGE(PG8_SA(0, 0), cA, voffA); PG8_STAGE(PG8_SA(0, 1), cA + hstep, voffA);
        if (wr == 1) PG8_BAR;
        PG8_WAIT_V(2); PG8_BAR;
        PG8_STAGE(PG8_SB(1, 0), cB + kstep, voffB); PG8_STAGE(PG8_SA(1, 0), cA + kstep, voffA); PG8_STAGE(PG8_SB(1, 1), cB + hstep + kstep, voffB);
        PG8_WAIT_V(6); PG8_BAR;
    } else {
        PG8_STAGE(PG8_SB(0, 0), cB, voffB); PG8_STAGE(PG8_SA(0, 0), cA, voffA); PG8_STAGE(PG8_SB(0, 1), cB + hstep, voffB); PG8_STAGE(PG8_SA(0, 1), cA + hstep, voffA);
        if (wr == 1) PG8_BAR;
        PG8_WAIT_V(4); PG8_BAR;
        PG8_STAGE(PG8_SB(1, 0), cB + kstep, voffB); PG8_STAGE(PG8_SA(1, 0), cA + kstep, voffA); PG8_STAGE(PG8_SB(1, 1), cB + hstep + kstep, voffB);
        PG8_WAIT_V(6); PG8_BAR;
    }
    for (;;) {
        const bool has_next = S.next(ui + 1, nxt);
        const char* nA = has_next ? (const char*)g.A + (size_t)nxt.pm * tstep : cA; const char* nB = has_next ? (const char*)g.Bt + (size_t)nxt.pb * tstep : cB;
        if constexpr (Sched::KRANGE) { if (has_next) { nA += (size_t)nxt.kt0 * kstep; nB += (size_t)nxt.kt0 * kstep; } }
        for (int t = 0; t < nt; t += 2) {
            const bool last = (t == nt - 2);
            const char* a1 = cA + (size_t)(t + 1) * kstep;
            const char* a2 = last ? nA : cA + (size_t)(t + 2) * kstep; const char* b2 = last ? nB : cB + (size_t)(t + 2) * kstep;
            const char* a3 = a2 + kstep; const char* b3 = b2 + kstep;
            if (last && has_next) S.a_ready(nxt);
            if constexpr (SP2) {
            PG8_LDB(B0, 0, 0); PG8_LDB(B1, 0, 1); PG8_SCHED; PG8_LDA(At, 0, 0); PG8_STAGE(PG8_SA(1, 1), a1 + hstep, voffA);
            PG8_WAIT_V(8); PG8_WAIT_L(0); PG8_BAR; PG8_MMA(0, 0, At, B0); PG8_MMA(0, 1, At, B1); PG8_BAR; PG8_SCHED;
            PG8_LDA(At, 0, 1); PG8_STAGE(PG8_SB(0, 0), b2, voffB); PG8_STAGE(PG8_SB(0, 1), b2 + hstep, voffB); PG8_STAGE(PG8_SA(0, 0), a2, voffA);
            PG8_WAIT_V(8); PG8_WAIT_L(0); PG8_BAR; PG8_MMA(1, 0, At, B0); PG8_MMA(1, 1, At, B1); PG8_BAR; PG8_SCHED;
            PG8_LDB(B0, 1, 0); PG8_LDB(B1, 1, 1); PG8_SCHED; PG8_LDA(At, 1, 0); PG8_STAGE(PG8_SA(0, 1), a2 + hstep, voffA);
            PG8_WAIT_V(8); PG8_WAIT_L(0); PG8_BAR; PG8_MMA(0, 0, At, B0); PG8_MMA(0, 1, At, B1); PG8_BAR; PG8_SCHED;
            PG8_LDA(At, 1, 1); PG8_STAGE(PG8_SB(1, 0), b3, voffB); PG8_STAGE(PG8_SB(1, 1), b3 + hstep, voffB); PG8_STAGE(PG8_SA(1, 0), a3, voffA);
            PG8_WAIT_V(8); PG8_WAIT_L(0); PG8_BAR; PG8_MMA(1, 0, At, B0); PG8_MMA(1, 1, At, B1); PG8_BAR; PG8_SCHED;
            } else {
            PG8_LDB(B0, 0, 0); PG8_SCHED; PG8_LDA(At, 0, 0); PG8_STAGE(PG8_SA(1, 1), a1 + hstep, voffA);
            PG8_WAIT_L(8); PG8_BAR; PG8_WAIT_L(0); PG8_MMA(0, 0, At, B0); PG8_BAR; PG8_SCHED;
            PG8_LDB(B1, 0, 1); PG8_STAGE(PG8_SB(0, 0), b2, voffB);
            PG8_BAR; PG8_WAIT_L(0); PG8_MMA(0, 1, At, B1); PG8_BAR;
            PG8_LDA(At, 0, 1); PG8_STAGE(PG8_SA(0, 0), a2, voffA);
            PG8_BAR; PG8_WAIT_L(0); PG8_MMA(1, 0, At, B0); PG8_BAR; PG8_SCHED;
            PG8_STAGE(PG8_SB(0, 1), b2 + hstep, voffB);
            PG8_WAIT_V(6); PG8_BAR; PG8_MMA(1, 1, At, B1); PG8_BAR;
            PG8_LDB(B0, 1, 0); PG8_SCHED; PG8_LDA(At, 1, 0); PG8_STAGE(PG8_SA(0, 1), a2 + hstep, voffA);
            PG8_WAIT_L(8); PG8_BAR; PG8_WAIT_L(0); PG8_MMA(0, 0, At, B0); PG8_BAR; PG8_SCHED;
            PG8_LDB(B1, 1, 1); PG8_STAGE(PG8_SB(1, 0), b3, voffB);
            PG8_BAR; PG8_WAIT_L(0); PG8_MMA(0, 1, At, B1); PG8_BAR;
            PG8_LDA(At, 1, 1); PG8_STAGE(PG8_SA(1, 0), a3, voffA);
            PG8_BAR; PG8_WAIT_L(0); PG8_MMA(1, 0, At, B0); PG8_BAR; PG8_SCHED;
            PG8_STAGE(PG8_SB(1, 1), b3 + hstep, voffB);
            PG8_WAIT_V(6); PG8_BAR; PG8_MMA(1, 1, At, B1); PG8_BAR;
            }
        }
        if constexpr (ALIGN_EPI) { if (wr == 0) PG8_BAR; }
        if constexpr (!Epi::AFTER_DRAIN) { E(acc, cur, wr, wc, fr, fq); S.done(cur); }
        if (!has_next) break;
#pragma unroll
        for (int a = 0; a < 2; ++a)
#pragma unroll
            for (int b = 0; b < 2; ++b)
#pragma unroll
                for (int m = 0; m < 4; ++m)
#pragma unroll
                    for (int n = 0; n < 2; ++n) acc[a][b][m][n] = (f32x4){0.f, 0.f, 0.f, 0.f};
        cur = nxt; cA = nA; cB = nB; ++ui;
        if constexpr (Sched::KRANGE) nt = cur.nkt;
        if constexpr (ALIGN_EPI) { if (wr == 1) PG8_BAR; }
    }
    PG8_WAIT_V(0);
    if constexpr (!ALIGN_EPI) { if (wr == 0) PG8_BAR; }
    PG8_BAR;
#undef PG8_SA
#undef PG8_SB
#undef PG8_STAGE
#undef PG8_LDA
#undef PG8_LDB
#undef PG8_MMA
#undef PG8_WAIT_V
#undef PG8_WAIT_L
#undef PG8_BAR
#undef PG8_SCHED
}
}
namespace att {
constexpr int NW = 8, QBLK = 32, KVBLK = 64, QB = NW * QBLK, PITCH = 3072, DV = 128;
constexpr int SHM_V = KVBLK * DV * 2;
constexpr int LDS_V = 0, LDS_K = 2 * SHM_V, LDS_WS = 65536, LDS_BYTES = LDS_WS + NW * 64 * 4;
constexpr float THR = 8.f;
template <int DK> struct Cfg { static constexpr int SHM_K = KVBLK * DK * 2; static constexpr float SCALE = (DK == 128) ? 0.08838834764831845f : 0.125f; };

#define KSWZ(row, colB) ((row) * 256 + ((colB) ^ (((row) & 7) << 4)))
#define KSWZ64(row, ch) ((row) * 128 + ((((ch) ^ (((row) >> 1) & 7))) << 4))
#define SBAR() __builtin_amdgcn_sched_barrier(0)
__device__ __forceinline__ int v_st(int k, int c) { const int kk = (k & ~0xC) | ((k & 4) << 1) | ((k & 8) >> 1); return ((kk >> 3) * 4 + (c >> 5)) * 512 + ((kk & 7) * 32 + (c & 31)) * 2; }
__device__ __forceinline__ int v_rd_base(int lane) { return ((lane & 3) << 3) | (((lane >> 2) & 3) << 6) | (((lane >> 4) & 1) << 5) | (((lane >> 5) & 1) << 8); }
constexpr int v_rd_off(int d0, int ks, int half) { return d0 * 512 + ks * 4096 + half * 2048; }
__device__ __forceinline__ int crow(int r, int hi) { return (r & 3) + 8 * (r >> 2) + 4 * hi; }
__device__ __forceinline__ unsigned cvtpk(float lo, float hi) { unsigned r; asm volatile("v_cvt_pk_bf16_f32 %0, %1, %2" : "=v"(r) : "v"(lo), "v"(hi)); return r; }
__device__ __forceinline__ bf16x8 load8(const bf16* p) { return *reinterpret_cast<const bf16x8*>(p); }
__device__ __forceinline__ void mask_tile(f32x16& p0, f32x16& p1, int dq) {
    const float NEG = -__builtin_inff();
#pragma unroll
    for (int r = 0; r < 16; ++r) {
        const int c = (r & 3) + 8 * (r >> 2);
        if (dq - c < 0) p0[r] = NEG;
        if (dq - c - 32 < 0) p1[r] = NEG;
    }
}
template <int DK>
__device__ __forceinline__ void partialSM(f32x16& p0, f32x16& p1, float& m_reg, float& mn, float& alpha) {
    constexpr float SCALE = Cfg<DK>::SCALE;
    float pmax = p0[0]; for (int r = 1; r < 16; ++r) pmax = fmaxf(pmax, p0[r]); for (int r = 0; r < 16; ++r) pmax = fmaxf(pmax, p1[r]);
    { auto rr = __builtin_amdgcn_permlane32_swap(__float_as_uint(pmax), __float_as_uint(pmax), false, false);
      pmax = fmaxf(__uint_as_float(rr[0]), __uint_as_float(rr[1])); }
    constexpr float C2 = 1.4426950408889634f * SCALE;
    if (__builtin_expect(__all((pmax - m_reg) * SCALE <= THR), 1)) { mn = m_reg; alpha = 1.f; }
    else { mn = fmaxf(m_reg, pmax); alpha = __builtin_amdgcn_exp2f((m_reg - mn) * C2); m_reg = mn; }
    const float mnL = -mn * C2;
    for (int r = 0; r < 16; ++r) p0[r] = fmaf(p0[r], C2, mnL); for (int r = 0; r < 16; ++r) p1[r] = fmaf(p1[r], C2, mnL);
    for (int r = 0; r < 16; ++r) p0[r] = __builtin_amdgcn_exp2f(p0[r]);
}
__device__ __forceinline__ void finishSM(f32x16& p0, f32x16& p1, float alpha, float& l_reg, bf16x8& pa0, bf16x8& pa1, bf16x8& pa2, bf16x8& pa3) {
    for (int r = 0; r < 16; ++r) p1[r] = __builtin_amdgcn_exp2f(p1[r]);
    float ps = 0; for (int r = 0; r < 16; ++r) ps += p0[r]; for (int r = 0; r < 16; ++r) ps += p1[r];
    { auto rr = __builtin_amdgcn_permlane32_swap(__float_as_uint(ps), __float_as_uint(ps), false, false);
      ps = __uint_as_float(rr[0]) + __uint_as_float(rr[1]); }
    l_reg = l_reg * alpha + ps;
#define PK4(P, B_, OUT) do { unsigned a0 = cvtpk(P[B_+0], P[B_+1]), a1 = cvtpk(P[B_+2], P[B_+3]);                          \
        unsigned b0 = cvtpk(P[B_+4], P[B_+5]), b1 = cvtpk(P[B_+6], P[B_+7]);                                             \
        auto r0 = __builtin_amdgcn_permlane32_swap(a0, b0, false, false); auto r1 = __builtin_amdgcn_permlane32_swap(a1, b1, false, false); \
        u32x4 w = {r0[0], r1[0], r0[1], r1[1]}; OUT = *reinterpret_cast<bf16x8*>(&w); } while (0)
    PK4(p0, 0, pa0); PK4(p0, 8, pa1); PK4(p1, 0, pa2); PK4(p1, 8, pa3);
#undef PK4
}
__device__ __forceinline__ bf16x8 bias_frag(u32x2 kb, int hi) { u32x4 w = {hi ? 0u : kb.x, hi ? 0u : kb.y, 0u, 0u}; return *reinterpret_cast<bf16x8*>(&w); }
template <int KB, int DK, bool BIAS>
__device__ __forceinline__ void qkt(f32x16& p0, f32x16& p1, const char* K_lds, int r32, int hi, const bf16x8* qr, u32x2 kb0, u32x2 kb1) {
    constexpr int SHM_K = Cfg<DK>::SHM_K;
    p0 = f32x16{}; p1 = f32x16{};
    if constexpr (DK == 128) {
        const char* kb[4];
#pragma unroll
        for (int dd = 0; dd < 4; ++dd) kb[dd] = K_lds + KB * SHM_K + KSWZ(r32, (dd * 16 + hi * 8) * 2);
#pragma unroll
        for (int d0 = 0; d0 < 8; ++d0) { const char* a = kb[d0 & 3] + (d0 >> 2) * 128;
            bf16x8 b0 = *reinterpret_cast<const bf16x8*>(a);
            bf16x8 b1 = *reinterpret_cast<const bf16x8*>(a + 32 * 256);
            p0 = __builtin_amdgcn_mfma_f32_32x32x16_bf16(b0, qr[d0], p0, 0, 0, 0);
            p1 = __builtin_amdgcn_mfma_f32_32x32x16_bf16(b1, qr[d0], p1, 0, 0, 0); }
    } else {
#pragma unroll
        for (int d0 = 0; d0 < 4; ++d0) { const char* a = K_lds + KB * SHM_K + KSWZ64(r32, 2 * d0 + hi);
            bf16x8 b0 = *reinterpret_cast<const bf16x8*>(a);
            bf16x8 b1 = *reinterpret_cast<const bf16x8*>(a + 32 * 128);
            p0 = __builtin_amdgcn_mfma_f32_32x32x16_bf16(b0, qr[d0], p0, 0, 0, 0);
            p1 = __builtin_amdgcn_mfma_f32_32x32x16_bf16(b1, qr[d0], p1, 0, 0, 0); }
    }
    if constexpr (BIAS) {
        u32x4 ow = {hi ? 0u : 0x3f803f80u, hi ? 0u : 0x00003f80u, 0u, 0u}; const bf16x8 qone = *reinterpret_cast<bf16x8*>(&ow);
        p0 = __builtin_amdgcn_mfma_f32_32x32x16_bf16(bias_frag(kb0, hi), qone, p0, 0, 0, 0);
        p1 = __builtin_amdgcn_mfma_f32_32x32x16_bf16(bias_frag(kb1, hi), qone, p1, 0, 0, 0);
    }
}
template <int VB>
__device__ __forceinline__ void pv_tile(f32x16* o, int vb0, bf16x8 pa0, bf16x8 pa1, bf16x8 pa2, bf16x8 pa3) {
#define TRRD(dst, off) asm volatile("ds_read_b64_tr_b16 %0, %1 offset:%2" : "=&v"(dst) : "v"(vb0), "i"(off) : "memory")
#define PV_D0(d0) do { s16x4 l0, l1, l2, l3, h0, h1, h2, h3; constexpr int b_ = VB * SHM_V + v_rd_off(d0, 0, 0); \
        TRRD(l0, b_); TRRD(h0, b_ + 2048); TRRD(l1, b_ + 4096); TRRD(h1, b_ + 6144); TRRD(l2, b_ + 8192); TRRD(h2, b_ + 10240); TRRD(l3, b_ + 12288); TRRD(h3, b_ + 14336); \
        asm volatile("s_waitcnt lgkmcnt(0)" ::: "memory"); SBAR();   \
        o[d0] = __builtin_amdgcn_mfma_f32_32x32x16_bf16(pa0, (bf16x8){l0[0], l0[1], l0[2], l0[3], h0[0], h0[1], h0[2], h0[3]}, o[d0], 0, 0, 0);   \
        o[d0] = __builtin_amdgcn_mfma_f32_32x32x16_bf16(pa1, (bf16x8){l1[0], l1[1], l1[2], l1[3], h1[0], h1[1], h1[2], h1[3]}, o[d0], 0, 0, 0);   \
        o[d0] = __builtin_amdgcn_mfma_f32_32x32x16_bf16(pa2, (bf16x8){l2[0], l2[1], l2[2], l2[3], h2[0], h2[1], h2[2], h2[3]}, o[d0], 0, 0, 0);   \
        o[d0] = __builtin_amdgcn_mfma_f32_32x32x16_bf16(pa3, (bf16x8){l3[0], l3[1], l3[2], l3[3], h3[0], h3[1], h3[2], h3[3]}, o[d0], 0, 0, 0); } while (0)
    PV_D0(0); PV_D0(1); PV_D0(2); PV_D0(3);
#undef PV_D0
#undef TRRD
}

struct BlockRef { const bf16* Q; const bf16* K; const bf16* V; const u32x2* KB; int P0, JLO; };
template <int DK> struct Seam { bf16x8 qr[DK / 16]; bf16x8 st_v0, st_v1, st_k0, st_k1; u32x2 kbn0, kbn1; };
#define AROW(p, k0, rr) ((p) + (size_t)((k0) + (rr)) * PITCH + sc)
#define VMW() asm volatile("s_waitcnt vmcnt(0)" ::: "memory")
#define VMWN(n) asm volatile("s_waitcnt vmcnt(%0)" :: "i"(n) : "memory")
#define SLOAD_H(R_, k0) do { S.st_v0 = load8(AROW((R_).V, k0, sr)); S.st_v1 = load8(AROW((R_).V, k0, 32 + sr));                                   \
        if constexpr (DK == 128) { S.st_k0 = load8(AROW((R_).K, k0, sr)); S.st_k1 = load8(AROW((R_).K, k0, 32 + sr)); }                            \
        else { S.st_k0 = load8((R_).K + (size_t)((k0) + (tid >> 3)) * PITCH + (tid & 7) * 8); }                                                    \
        if constexpr (BIAS) { S.kbn0 = (R_).KB[(k0) + r32]; S.kbn1 = (R_).KB[(k0) + 32 + r32]; } } while (0)
#define SWRITE_HK(bf) do { if constexpr (DK == 128) { *(bf16x8*)(K_lds + (bf) * SHM_K + kws) = S.st_k0; *(bf16x8*)(K_lds + (bf) * SHM_K + kws + 32 * 256) = S.st_k1; } \
        else { *(bf16x8*)(K_lds + (bf) * SHM_K + kws) = S.st_k0; } } while (0)
#define SWRITE_HV(bf) do { *(bf16x8*)(V_lds + (bf) * SHM_V + vst0) = S.st_v0; *(bf16x8*)(V_lds + (bf) * SHM_V + vst1) = S.st_v1; } while (0)
#define SWRITE_H(bf) do { SWRITE_HV(bf); SWRITE_HK(bf); } while (0)
template <int DK, bool BIAS>
__device__ __forceinline__ void causal_prime(const BlockRef& cur, char* lds, Seam<DK>& S, int tid) {
    constexpr int SHM_K = Cfg<DK>::SHM_K;
    const int wid = __builtin_amdgcn_readfirstlane(tid >> 6), lane = tid & 63, r32 = lane & 31, hi = lane >> 5;
    const int sr = tid >> 4, sc = (tid & 15) * 8; const int kws = (DK == 128) ? KSWZ(sr, sc * 2) : KSWZ64(tid >> 3, tid & 7); char* K_lds = lds + LDS_K;
#pragma unroll
    for (int d0 = 0; d0 < DK / 16; ++d0) S.qr[d0] = load8(cur.Q + (size_t)(wid * QBLK + r32) * PITCH + d0 * 16 + hi * 8);
    SLOAD_H(cur, cur.JLO * KVBLK); VMW(); SWRITE_HK(0);
    __syncthreads();
}
template <int DK, bool BIAS, int OUT>
__device__ __forceinline__ void causal_block(const BlockRef& cur, const BlockRef& nxt, char* lds, Seam<DK>& S, void* Oblk, int opitch, int tid) {
    constexpr int SHM_K = Cfg<DK>::SHM_K;
    const int wid = __builtin_amdgcn_readfirstlane(tid >> 6), lane = tid & 63, r32 = lane & 31, hi = lane >> 5;
    const int NT = (cur.P0 + QB) / KVBLK - cur.JLO;
    const int qlo = cur.P0 + wid * QBLK, qm = qlo + r32 - 4 * hi;
    char* V_lds = lds + LDS_V; char* K_lds = lds + LDS_K;
    float* ws = (float*)(lds + LDS_WS) + wid * 64; float* li_l = ws, * al_l = ws + 32;
    float m_reg = -1e30f, l_reg = 0; f32x16 o[4] = {};
    const int sr = tid >> 4, sc = (tid & 15) * 8, vst0 = v_st(sr, sc), vst1 = v_st(32 + sr, sc);
    const int kws = (DK == 128) ? KSWZ(sr, sc * 2) : KSWZ64(tid >> 3, tid & 7);
    const int vb0 = (int)(uintptr_t)V_lds + v_rd_base(lane);
#define RESC(a) do { if (__any((a) < 1.f)) { if (hi == 0) al_l[r32] = (a); asm volatile("s_waitcnt lgkmcnt(0)" ::: "memory");              \
                     for (int d_ = 0; d_ < 4; ++d_) for (int r = 0; r < 16; ++r) o[d_][r] *= al_l[crow(r, hi)]; } } while (0)
#define KBASE(t) ((cur.JLO + (t)) * KVBLK)
#define MASKT(P0_, P1_, t) do { const int kb_ = KBASE(t); if (kb_ + KVBLK - 1 > qlo) mask_tile(P0_, P1_, qm - kb_); } while (0)
    constexpr int NQL = DK / 16;
#define SEAM_K0() do { VMWN(NQL); SWRITE_HK(0); SBAR(); } while (0)
    f32x16 pA0, pA1, pB0, pB1; float mnA, mnB, alA, alB; bf16x8 pa0, pa1, pa2, pa3;
    SWRITE_HV(0); SBAR();
    qkt<0, DK, BIAS>(pA0, pA1, K_lds, r32, hi, S.qr, S.kbn0, S.kbn1); SBAR();
    if (NT > 1) { SLOAD_H(cur, KBASE(1)); }
    SBAR();
    MASKT(pA0, pA1, 0); partialSM<DK>(pA0, pA1, m_reg, mnA, alA);
    if (NT > 1) { VMW(); SWRITE_H(1); }
    __syncthreads();
#define HALF_STEP(PX0, PX1, mnX, alX, PY0, PY1, alY, t, KB, VB, SB) do {                                                      \
        SBAR(); qkt<KB, DK, BIAS>(PX0, PX1, K_lds, r32, hi, S.qr, S.kbn0, S.kbn1);                                            \
        finishSM(PY0, PY1, alY, l_reg, pa0, pa1, pa2, pa3); SBAR();                                                           \
        if ((t) + 1 < NT) { SLOAD_H(cur, KBASE((t) + 1)); SBAR(); }                                                           \
        pv_tile<VB>(o, vb0, pa0, pa1, pa2, pa3); MASKT(PX0, PX1, (t)); partialSM<DK>(PX0, PX1, m_reg, mnX, alX);              \
        __syncthreads();                                                                                                      \
        if ((t) + 1 < NT) { VMW(); SWRITE_H(SB); }                                                                            \
        RESC(alX); __syncthreads(); } while (0)
    for (int t = 1; t + 1 < NT; t += 2) {
        HALF_STEP(pB0, pB1, mnB, alB, pA0, pA1, alA, t, 1, 0, 0);
        HALF_STEP(pA0, pA1, mnA, alA, pB0, pB1, alB, t + 1, 0, 1, 1);
    }
    const bool even = (NT & 1) == 0;
    if (even) { SBAR(); qkt<1, DK, BIAS>(pB0, pB1, K_lds, r32, hi, S.qr, S.kbn0, S.kbn1); SBAR(); }
    SLOAD_H(nxt, nxt.JLO * KVBLK); SBAR();
#pragma unroll
    for (int d0 = 0; d0 < DK / 16; ++d0) S.qr[d0] = load8(nxt.Q + (size_t)(wid * QBLK + r32) * PITCH + d0 * 16 + hi * 8);
    SBAR();
    finishSM(pA0, pA1, alA, l_reg, pa0, pa1, pa2, pa3); SBAR();
    pv_tile<0>(o, vb0, pa0, pa1, pa2, pa3);
    if (even) { MASKT(pB0, pB1, NT - 1); partialSM<DK>(pB0, pB1, m_reg, mnB, alB); __syncthreads(); RESC(alB);
        finishSM(pB0, pB1, alB, l_reg, pa0, pa1, pa2, pa3); SBAR(); pv_tile<1>(o, vb0, pa0, pa1, pa2, pa3); }
    SBAR(); SEAM_K0();
    if (hi == 0) li_l[r32] = l_reg; asm volatile("s_waitcnt lgkmcnt(0)" ::: "memory");
    float rli[16];
#pragma unroll
    for (int r = 0; r < 16; ++r) rli[r] = __builtin_amdgcn_rcpf(li_l[crow(r, hi)]);
#pragma unroll
    for (int r = 0; r < 16; ++r) { const int orow = wid * QBLK + crow(r, hi);
#pragma unroll
        for (int d0 = 0; d0 < 4; ++d0) { const float v = o[d0][r] * rli[r];
            if constexpr (OUT == 1) { ((float*)Oblk)[(size_t)orow * opitch + d0 * 32 + r32] = v; }
            else { const float vn = __shfl_xor(v, 1);
                   if ((r32 & 1) == 0) *(unsigned*)((bf16*)Oblk + (size_t)orow * opitch + d0 * 32 + r32) = cvtpk(v, vn); } } }
    __syncthreads();
#undef RESC
#undef KBASE
#undef MASKT
#undef SEAM_K0
#undef HALF_STEP
}
#undef AROW
#undef VMW
#undef VMWN
#undef SLOAD_H
#undef SWRITE_HK
#undef SWRITE_HV
#undef SWRITE_H
}
constexpr int T = 16384, DM = 1024, SEQ = 8192, NWAVES = 8, NTHR = 512, GRID = 256;
constexpr float EPS = 1e-6f;
constexpr int ZP = 3072;
constexpr int FF = 2816, FFE = 3584, NEXP = 8;
constexpr int XP_ROWS = 34816;
constexpr size_t MiB = 1u << 20, KiB = 1024;
constexpr size_t WS_CTL = 0, CTL_ZERO_BYTES = 65536;
constexpr size_t WS_SLOT = 1 * MiB, SLOT = 256 * KiB;
constexpr size_t WS_ROPE = WS_SLOT + 0 * SLOT;
constexpr size_t WS_LI = WS_SLOT + 2 * SLOT;
constexpr size_t WS_LF = WS_SLOT + 3 * SLOT;
constexpr size_t WS_LFX = WS_SLOT + 4 * SLOT;
constexpr size_t WS_KB = WS_SLOT + 14 * SLOT;
constexpr size_t WS_RTE = WS_SLOT + 6 * SLOT;
constexpr size_t WS_RTW = WS_SLOT + 7 * SLOT;
constexpr size_t WS_PPOS = WS_SLOT + 8 * SLOT;
constexpr size_t WS_RW = WS_SLOT + 9 * SLOT;
constexpr size_t WS_MISC = WS_SLOT + 10 * SLOT;
constexpr size_t WS_NH = WS_SLOT + 11 * SLOT;
constexpr size_t WS_NP = WS_SLOT + 12 * SLOT;
constexpr size_t WS_SGW = WS_SLOT + 13 * SLOT;
constexpr size_t WS_NORM2 = 5 * MiB;
constexpr size_t MISC_CNT = 0, MISC_MG = 8192, MISC_BL = 10240, MISC_MP = 12288, MISC_LAM = 14336, MISC_TS = 14400;
constexpr size_t WS_W_EIN = 8 * MiB, WS_W_EOUT = 14 * MiB, WS_W_FGU = 16 * MiB, WS_W_FDN = 27 * MiB, WS_W_OIN = 33 * MiB, WS_W_OOUT = 39 * MiB, WS_W_MGU = 41 * MiB, WS_W_MDN = 153 * MiB;
constexpr size_t WS_XR = 210 * MiB;
constexpr size_t WS_XN = 274 * MiB;
constexpr size_t WS_CAT = 306 * MiB;
constexpr size_t WS_ARENA = 338 * MiB;
constexpr size_t WS_CH = 576 * MiB;
constexpr size_t WS_CP = 608 * MiB;
constexpr size_t WS_DO = 576 * MiB;
constexpr size_t WS_XP = 640 * MiB;
constexpr size_t WS_Y = 708 * MiB;
constexpr size_t WS_END = 844 * MiB;
static_assert(WS_W_MDN + (size_t)NEXP * DM * FFE * 2 <= WS_XR && WS_ARENA + (size_t)XP_ROWS * FFE * 2 <= WS_CH && WS_XP + (size_t)XP_ROWS * DM * 2 <= WS_Y && WS_Y + (size_t)XP_ROWS * DM * 4 <= WS_END, "ws map");
constexpr int CW_BAR = 4096, CW_QUEUE = 8192;
constexpr int LDS_BYTES = 155648, LDSCTL_OFF = 151552;
constexpr int TS_ = 136;
constexpr int TILE_B = 128 * TS_ * 2;

#define XB_TMO      128
#define XB_XCNT(j)  (256  + 64 * (j))
#define XB_XSUB(j)  (1280 + 64 * (j))
#define XB_XGEN(j)  (2304 + 64 * (j))
#define XB_TOP      3328
#define XB_TOPGEN   3392
#define XCD_BAR_WORDS 3456
#define XB_SPIN_CAP (1u << 18)
__device__ __forceinline__ unsigned xb_ld(unsigned* p)              { return __hip_atomic_load(p, __ATOMIC_RELAXED, __HIP_MEMORY_SCOPE_AGENT); }
__device__ __forceinline__ unsigned xb_add(unsigned* p, unsigned v) { return __hip_atomic_fetch_add(p, v, __ATOMIC_RELAXED, __HIP_MEMORY_SCOPE_AGENT); }
__device__ __forceinline__ unsigned xb_xcc_id() { return (unsigned)__builtin_amdgcn_s_getreg((3 << 11) | 20) & 0xFu; }
#define XB_SPIN(cond, bar) do { unsigned _sp = 0; while (cond) { __builtin_amdgcn_s_sleep(1); \
    if ((++_sp & 255u) == 0u) { if (xb_ld(&(bar)[XB_TMO])) break; if (_sp > XB_SPIN_CAP) { atomicAdd(&(bar)[XB_TMO], 1u); break; } } } } while (0)
struct XcdBarrier { unsigned* bar; unsigned x; volatile LAS unsigned* st; };
__device__ __forceinline__ XcdBarrier xcd_barrier_post(unsigned* bar, volatile LAS unsigned* st) {
    XcdBarrier b; b.bar = bar; b.x = xb_xcc_id(); b.st = st;
    if (threadIdx.x == 0) (void)xb_add(&bar[XB_XCNT(b.x)], 1u);
    return b;
}
__device__ __forceinline__ void xcd_barrier_complete(unsigned* bar, unsigned x, unsigned& nloc, unsigned& nx) {
    const unsigned G = gridDim.x * gridDim.y * gridDim.z;
    unsigned sum, cnt, mine, sp = 0u;
    for (;;) {
        sum = 0u; cnt = 0u; mine = 0u;
#pragma unroll
        for (unsigned j = 0; j < 16; ++j) { const unsigned c = xb_ld(&bar[XB_XCNT(j)]); sum += c; cnt += (c > 0u) ? 1u : 0u; mine = (j == x) ? c : mine; }
        if (sum == G) break;
        __builtin_amdgcn_s_sleep(1);
        if ((++sp & 255u) == 0u) { if (xb_ld(&bar[XB_TMO])) break; if (sp > XB_SPIN_CAP) { atomicAdd(&bar[XB_TMO], 1u); break; } }
    }
    nloc = mine > 0u ? mine : 1u; nx = cnt > 0u ? cnt : 1u;
}
__device__ __forceinline__ void xcd_barrier(const XcdBarrier& b) {
    asm volatile("s_waitcnt vmcnt(0)" ::: "memory");
    __syncthreads();
    if (threadIdx.x == 0) {
        unsigned* bar = b.bar;
        __builtin_amdgcn_s_waitcnt(0);
        unsigned nloc = b.st[0], nx = b.st[1];
        if (nloc == 0u) { xcd_barrier_complete(bar, b.x, nloc, nx); b.st[0] = nloc; b.st[1] = nx; }
        const unsigned old = xb_add(&bar[XB_XSUB(b.x)], 1u);
        const unsigned gen = old / nloc;
        if (old + 1u == (gen + 1u) * nloc) {
            __builtin_amdgcn_fence(__ATOMIC_RELEASE, "agent");
            asm volatile("s_waitcnt vmcnt(0)" ::: "memory");
            const unsigned og = xb_add(&bar[XB_TOP], 1u);
            const unsigned tg = og / nx;
            if (og + 1u == (tg + 1u) * nx) xb_add(&bar[XB_TOPGEN], 1u);
            else XB_SPIN(xb_ld(&bar[XB_TOPGEN]) == tg, bar);
            __builtin_amdgcn_fence(__ATOMIC_ACQUIRE, "agent");
            xb_add(&bar[XB_XGEN(b.x)], 1u);
            asm volatile("s_waitcnt vmcnt(0)" ::: "memory");
        } else {
            XB_SPIN(xb_ld(&bar[XB_XGEN(b.x)]) == gen, bar);
            __builtin_amdgcn_fence(__ATOMIC_ACQUIRE, "agent");
            asm volatile("s_waitcnt vmcnt(0)" ::: "memory");
        }
    }
    __syncthreads();
}

struct Args { const float* in[25]; float* out; unsigned char* ws; int ph_lo, ph_hi; };
#define KARGS const __attribute__((address_space(4))) Args
__device__ __forceinline__ const float* ain(KARGS& a, int k) { return (const float*)(const GAS float*)a.in[k]; }
struct Ctx { LAS unsigned char* lds; unsigned char* ws; int tid, lane, wave, bid; };

struct ConvItem { const float* src; bf16* dst; int ldw, K; };
__device__ __forceinline__ int src_col(int type, int n0, int ffh) {
    const int pn = n0 >> 8, j = n0 & 255;
    const int t3 = j < 128 ? 128 * pn + j : ffh + 128 * pn + (j - 128);
    return type == 1 ? (n0 < 2048 ? n0 : n0 + 8) : (type == 2 ? (n0 < 1536 ? n0 : n0 + 4) : (type == 3 ? t3 : n0));
}
__device__ __forceinline__ ConvItem conv_decode(KARGS& a, unsigned char* ws, int it) {
    constexpr int I_EIN = 16 * 96, I_EOUT = 16 * 32, I_FGU = 16 * 176, I_FDN = 44 * 32, I_OIN = 16 * 96, I_OOUT = 16 * 32, I_MGU = 16 * 224, I_MDN = 56 * 32;
    constexpr int C1 = I_EIN, C2 = C1 + I_EOUT, C3 = C2 + I_FGU, C4 = C3 + I_FDN, C5 = C4 + I_OIN, C6 = C5 + I_OOUT, C7 = C6 + NEXP * I_MGU;
    const int kind = (it >= C1) + (it >= C2) + (it >= C3) + (it >= C4) + (it >= C5) + (it >= C6) + (it >= C7);
#define SEL8(v0, v1, v2, v3, v4, v5, v6, v7) (kind == 0 ? (v0) : kind == 1 ? (v1) : kind == 2 ? (v2) : kind == 3 ? (v3) : kind == 4 ? (v4) : kind == 5 ? (v5) : kind == 6 ? (v6) : (v7))
    const int base = SEL8(0, C1, C2, C3, C4, C5, C6, C7), per = SEL8(I_EIN, I_EOUT, I_FGU, I_FDN, I_OIN, I_OOUT, I_MGU, I_MDN);
    int r = it - base; const int e = r / per; r -= e * per;
    const int ldw = SEL8(3080, 1024, 2 * FF, 1024, 3076, 1024, 2 * FFE, 1024), K = SEL8(1024, 1024, 1024, FF, 1024, 1024, 1024, FFE), N = SEL8(3072, 1024, 2 * FF, 1024, 3072, 1024, 2 * FFE, 1024);
    const int type = SEL8(1, 0, 3, 0, 2, 0, 3, 0), ffh = SEL8(0, 0, FF, 0, 0, 0, FFE, 0);
    const float* W = SEL8(ain(a, 2), ain(a, 10), ain(a, 12), ain(a, 13), ain(a, 15), ain(a, 19), ain(a, 22), ain(a, 23));
    const size_t wso = SEL8(WS_W_EIN, WS_W_EOUT, WS_W_FGU, WS_W_FDN, WS_W_OIN, WS_W_OOUT, WS_W_MGU, WS_W_MDN);
#undef SEL8
    const int nblk = N / 32, kb = r / nblk, nb = r - kb * nblk, k0 = 64 * kb, n0 = 32 * nb;
    ConvItem c; c.ldw = ldw; c.K = K;
    c.src = W + (size_t)e * K * ldw + (size_t)k0 * ldw + src_col(type, n0, ffh);
    c.dst = (bf16*)(ws + wso) + (size_t)e * N * K + (size_t)n0 * K + k0;
    return c;
}
__device__ __forceinline__ void conv_load(const ConvItem& c, int lane, f32x4 (&v)[8]) {
    const int kl = lane >> 3, n4 = (lane & 7) * 4;
#pragma unroll
    for (int i = 0; i < 8; ++i) v[i] = __builtin_nontemporal_load((const f32x4*)(c.src + (size_t)(kl + 8 * i) * c.ldw + n4));
}
__device__ __forceinline__ void conv_finish(const ConvItem& c, int lane, const f32x4 (&v)[8], LAS float* scr) {
    const int kl = lane >> 3, n4 = (lane & 7) * 4;
#pragma unroll
    for (int i = 0; i < 8; ++i) { LAS float* d = scr + (kl + 8 * i) * 33 + n4; d[0] = v[i].x; d[1] = v[i].y; d[2] = v[i].z; d[3] = v[i].w; }
    LDS_WAIT(); asm volatile("" ::: "memory");
    const int cc = lane & 7;
#pragma unroll
    for (int j = 0; j < 4; ++j) { const int n = (lane >> 3) + 8 * j; const LAS float* s = scr + (8 * cc) * 33 + n;
        u32x4 o; o.x = pk2(s[0 * 33], s[1 * 33]); o.y = pk2(s[2 * 33], s[3 * 33]); o.z = pk2(s[4 * 33], s[5 * 33]); o.w = pk2(s[6 * 33], s[7 * 33]);
        *(u32x4*)(c.dst + (size_t)n * c.K + 8 * cc) = o; }
    LDS_WAIT(); asm volatile("" ::: "memory");
}
__device__ __forceinline__ void prologue_weights(KARGS& a, const Ctx& c) {
    LAS float* scr = (LAS float*)(c.lds + c.wave * 16384);
    const int gw = c.bid * NWAVES + c.wave, NGW = GRID * NWAVES;
    constexpr int NITEMS = 16 * 96 + 16 * 32 + 16 * 176 + 44 * 32 + 16 * 96 + 16 * 32 + NEXP * (16 * 224 + 56 * 32);
    int it = gw; if (it >= NITEMS) return;
    f32x4 va[8], vb[8]; ConvItem d0 = conv_decode(a, c.ws, it), d1 = d0; conv_load(d0, c.lane, va);
    for (;;) {
        const int it1 = it + NGW; const bool has1 = it1 < NITEMS;
        if (has1) { d1 = conv_decode(a, c.ws, it1); conv_load(d1, c.lane, vb); }
        conv_finish(d0, c.lane, va, scr);
        if (!has1) break;
        it = it1 + NGW; const bool has0 = it < NITEMS;
        if (has0) { d0 = conv_decode(a, c.ws, it); conv_load(d0, c.lane, va); }
        conv_finish(d1, c.lane, vb, scr);
        if (!has0) break;
    }
}
__device__ __forceinline__ void prologue_tables(KARGS& a, const Ctx& c) {
    const int gt = c.bid * NTHR + c.tid, NGT = GRID * NTHR;
    bf16* sgw = (bf16*)(c.ws + WS_SGW); const float* w = ain(a, 8);
    for (int i = gt; i < 4 * 128 * 128; i += NGT) { const int tt = (i >> 7) & 127, ss = i & 127; sgw[i] = (bf16)(ss <= tt ? f2bf(w[i]) : 0u); }
    if (c.bid == 0 && c.wave == 0) { const float* l = ain(a, 17); const float p0 = wave_sum(l[c.lane] * l[64 + c.lane]), p1 = wave_sum(l[128 + c.lane] * l[192 + c.lane]);
        const float lambda_init = 0.8f - 0.6f * expf(-0.3f);
        if (c.lane == 0) *(float*)(c.ws + WS_MISC + MISC_LAM) = expf(p0) - expf(p1) + lambda_init; }
}

template <int NC> __device__ __forceinline__ void stage_wxt(const Ctx& c, const float* W, int ldw, int col0) {
    LAS float* wxt = (LAS float*)c.lds;
    for (int i = c.tid; i < NC * 1024; i += NTHR) { const int cc = i >> 10, k = i & 1023; wxt[i] = W[(size_t)k * ldw + col0 + cc]; }
    __syncthreads();
}
template <int MODE> __device__ __forceinline__ void row_phase(KARGS& a, const Ctx& c, const float* xin, const float* gain) {
    constexpr int NC = (MODE == 0 || MODE == 3) ? 8 : (MODE == 2 ? 4 : 0);
    unsigned char* ws = c.ws;
    LAS float* wxt = (LAS float*)c.lds; LAS int* lcnt = (LAS int*)(c.lds + 32768);
    if (MODE == 0) stage_wxt<8>(c, ain(a, 2), 3080, 2048);
    if (MODE == 2) stage_wxt<4>(c, ain(a, 15), 3076, 1536);
    if (MODE == 3) { if (c.tid < 8) lcnt[c.tid] = 0; stage_wxt<8>(c, ain(a, 21), 8, 0); }
    f32x4 g[4];
#pragma unroll
    for (int j = 0; j < 4; ++j) g[j] = *((const f32x4*)gain + c.lane + 64 * j);
    bf16* XN = (bf16*)(ws + WS_XN);
    int skSL = 2;
    if (MODE == 4) skSL = pg8::hyb_SL(__builtin_amdgcn_readfirstlane(ldi((const int*)(ws + WS_MISC + MISC_TS) + 8)) * 4 - 512);
#define ROW_INDEX(r) ((MODE == 4) ? (r) * (GRID * NWAVES) + c.bid * NWAVES + c.wave : 64 * c.bid + c.wave * 8 + (r))
#define ROW_LOAD(r, V, Y0, Y1, P0, P1) do { const int m_ = ROW_INDEX(r); const f32x4* xr_ = (const f32x4*)(xin + (size_t)m_ * DM) + c.lane; \
        _Pragma("unroll") for (int j = 0; j < 4; ++j) V[j] = xr_[64 * j]; \
        if (MODE == 4) { P0 = ldi((const int*)(ws + WS_PPOS) + 2 * m_); P1 = ldi((const int*)(ws + WS_PPOS) + 2 * m_ + 1); \
            const u32x2* y0_ = (const u32x2*)((const bf16*)(ws + WS_Y) + (size_t)P0 * DM) + c.lane; const u32x2* y1_ = (const u32x2*)((const bf16*)(ws + WS_Y) + (size_t)P1 * DM) + c.lane; \
            _Pragma("unroll") for (int j = 0; j < 4; ++j) { Y0[j] = y0_[64 * j]; Y1[j] = y1_[64 * j]; } } } while (0)
    f32x4 vn[4]; u32x2 yn0[4], yn1[4]; int pn0 = 0, pn1 = 0;
    ROW_LOAD(0, vn, yn0, yn1, pn0, pn1);
#pragma unroll
    for (int r = 0; r < 8; ++r) {
        const int m = ROW_INDEX(r);
        f32x4 v[4]; const int p0 = pn0, p1 = pn1;
#pragma unroll
        for (int j = 0; j < 4; ++j) { v[j] = vn[j]; if (MODE == 4) { v[j].x += bflo(yn0[j].x) + bflo(yn1[j].x); v[j].y += bfhi(yn0[j].x) + bfhi(yn1[j].x); v[j].z += bflo(yn0[j].y) + bflo(yn1[j].y); v[j].w += bfhi(yn0[j].y) + bfhi(yn1[j].y); } }
        if (r + 1 < 8) ROW_LOAD(r + 1, vn, yn0, yn1, pn0, pn1);
        if (MODE == 4) {
            const float* slab = (const float*)(ws + WS_XP);
            if (p0 >= 32768 || p1 >= 32768) {
#pragma unroll 1
                for (int q = 0; q < 2; ++q) { const int p = q ? p1 : p0; if (p < 32768) continue;
#pragma unroll
                    for (int j = 0; j < 4; ++j) { const float* sp = slab + ((size_t)(((p >> 8) * 4 + j - 512) * (skSL - 1)) * 256 + (p & 255)) * 256;
#pragma unroll 4
                        for (int s2 = 0; s2 < skSL - 1; ++s2) v[j] = v[j] + *((const f32x4*)(sp + (size_t)s2 * 65536) + c.lane); } } } }
        float s = 0.f;
#pragma unroll
        for (int j = 0; j < 4; ++j) s += (v[j].x * v[j].x + v[j].y * v[j].y) + (v[j].z * v[j].z + v[j].w * v[j].w);
#pragma unroll
        for (int j = 0; j < 4; ++j) v[j] = v[j] * g[j];
        float z[NC > 0 ? NC : 1];
        if constexpr (NC > 0) {
#pragma unroll
            for (int cc = 0; cc < NC; ++cc) { float pp = 0.f;
#pragma unroll
                for (int j = 0; j < 4; ++j) { const f32x4 w = *((const LAS f32x4*)(wxt + cc * 1024) + c.lane + 64 * j); pp += (v[j].x * w.x + v[j].y * w.y) + (v[j].z * w.z + v[j].w * w.w); }
                z[cc] = pp; }
#pragma unroll
            for (int cc = 0; cc < NC; ++cc) z[cc] = wave_sum(z[cc]);
        }
        const float rstd = 1.0f / sqrtf(wave_sum(s) * (1.0f / DM) + EPS);
#pragma unroll
        for (int j = 0; j < 4; ++j) v[j] = v[j] * rstd;
        if (MODE == 4) { f32x4* o = (f32x4*)((float*)(GAS float*)a.out + (size_t)m * DM) + c.lane;
#pragma unroll
            for (int j = 0; j < 4; ++j) o[64 * j] = v[j]; }
        else { u32x2* o = (u32x2*)(XN + (size_t)m * DM) + c.lane;
#pragma unroll
            for (int j = 0; j < 4; ++j) { u32x2 w; w.x = pk2(v[j].x, v[j].y); w.y = pk2(v[j].z, v[j].w); o[64 * j] = w; } }
        if constexpr (NC > 0) {
#pragma unroll
            for (int cc = 0; cc < NC; ++cc) z[cc] *= rstd;
            if (MODE == 0) { if (c.lane < 8) { float zz = z[0];
#pragma unroll
                    for (int cc = 1; cc < 8; ++cc) zz = (c.lane == cc) ? z[cc] : zz;
                    const float gb = ain(a, 5)[c.lane];
                    if (c.lane < 4) ((float*)(ws + WS_LI))[m * 4 + c.lane] = zz + gb; else ((float*)(ws + WS_LF))[m * 4 + c.lane - 4] = log_sigmoid_acc(zz + gb); } }
            if (MODE == 2) {
                if (c.lane < 4) { float zz = z[0];
#pragma unroll
                    for (int cc = 1; cc < 4; ++cc) zz = (c.lane == cc) ? z[cc] : zz;
                    ((float*)(ws + WS_LFX))[m * 4 + c.lane] = log_sigmoid_acc(zz + ain(a, 16)[c.lane]); } }
            if (MODE == 3) { if (c.lane == 0) {
                    int e1 = 0; float v1 = z[0];
#pragma unroll
                    for (int cc = 1; cc < 8; ++cc) if (z[cc] > v1) { v1 = z[cc]; e1 = cc; }
                    int e2 = -1; float v2 = -__builtin_inff();
#pragma unroll
                    for (int cc = 0; cc < 8; ++cc) if (cc != e1 && z[cc] > v2) { v2 = z[cc]; e2 = cc; }
                    const float w2 = 1.0f / (1.0f + expf(v1 - v2)), w1 = 1.0f - w2;
                    ((int*)(ws + WS_RTE))[2 * m] = e1; ((int*)(ws + WS_RTE))[2 * m + 1] = e2;
                    ((float*)(ws + WS_RTW))[2 * m] = w1; ((float*)(ws + WS_RTW))[2 * m + 1] = w2;
                    __hip_atomic_fetch_add(&lcnt[e1], 1, __ATOMIC_RELAXED, __HIP_MEMORY_SCOPE_WORKGROUP); __hip_atomic_fetch_add(&lcnt[e2], 1, __ATOMIC_RELAXED, __HIP_MEMORY_SCOPE_WORKGROUP); } }
        }
    }
#undef ROW_LOAD
#undef ROW_INDEX
    if (MODE == 3) { __syncthreads(); if (c.tid < 8) ((int*)(ws + WS_MISC + MISC_CNT))[c.bid * 8 + c.tid] = lcnt[c.tid]; }
    __syncthreads();
}

__device__ __forceinline__ int crow_(int r, int hi) { return (r & 3) + 8 * (r >> 2) + 4 * hi; }
__device__ __forceinline__ void wg_mma128(f32x16 (&acc)[2], const LAS bf16* A, const LAS bf16* Bt, int wave, int lane) {
    const int r32 = lane & 31, hi = lane >> 5, mblk = (wave >> 1) * 32, nblk = (wave & 1) * 64;
    const LAS bf16* ap = A + (mblk + r32) * TS_ + hi * 8; const LAS bf16* bp0 = Bt + (nblk + r32) * TS_ + hi * 8; const LAS bf16* bp1 = bp0 + 32 * TS_;
#pragma unroll
    for (int ks = 0; ks < 8; ++ks) {
        const bf16x8 av = *(const LAS bf16x8*)(ap + ks * 16), b0 = *(const LAS bf16x8*)(bp0 + ks * 16), b1 = *(const LAS bf16x8*)(bp1 + ks * 16);
        acc[0] = __builtin_amdgcn_mfma_f32_32x32x16_bf16(av, b0, acc[0], 0, 0, 0);
        acc[1] = __builtin_amdgcn_mfma_f32_32x32x16_bf16(av, b1, acc[1], 0, 0, 0);
    }
}
__device__ __forceinline__ void unpack8(const u32x4 w, float (&f)[8]) { f[0] = bflo(w.x); f[1] = bfhi(w.x); f[2] = bflo(w.y); f[3] = bfhi(w.y); f[4] = bflo(w.z); f[5] = bfhi(w.z); f[6] = bflo(w.w); f[7] = bfhi(w.w); }
__device__ __forceinline__ void stage_raw(const Ctx& c, const bf16* Z, int tok0, bool first, int col0, LAS bf16* raw) {
    for (int i = c.tid; i < 131 * 16; i += NTHR) { const int r = i >> 4, ch = i & 15;
        u32x4 v = {0u, 0u, 0u, 0u}; if (!(first && r < 3)) v = *(const u32x4*)(Z + (size_t)(tok0 - 3 + r) * ZP + col0 + ch * 8);
        *(LAS u32x4*)(raw + r * TS_ + ch * 8) = v; }
}
template <bool TRANSPOSE> __device__ __forceinline__ void conv_tile(const Ctx& c, const LAS bf16* raw, const float* cw  , const float* cb, float scale, LAS bf16* tile) {
    float w0[4][8], b0[8];
    if (!TRANSPOSE) { const int d0 = (c.tid & 15) * 8;
#pragma unroll
        for (int j = 0; j < 4; ++j)
#pragma unroll
            for (int i = 0; i < 8; ++i) w0[j][i] = cw[j * 1024 + d0 + i];
#pragma unroll
        for (int i = 0; i < 8; ++i) b0[i] = cb[d0 + i]; }
#pragma unroll 4
    for (int it = 0; it < 4; ++it) {
        const int ch = TRANSPOSE ? (c.tid >> 7) * 4 + it : (c.tid & 15), s = TRANSPOSE ? (c.tid & 127) : (c.tid >> 4) + 32 * it, d0 = ch * 8;
        float acc[8];
#pragma unroll
        for (int i = 0; i < 8; ++i) acc[i] = TRANSPOSE ? cb[d0 + i] : b0[i];
#pragma unroll
        for (int j = 0; j < 4; ++j) { float x[8]; unpack8(*(const LAS u32x4*)(raw + (s + j) * TS_ + d0), x);
#pragma unroll
            for (int i = 0; i < 8; ++i) acc[i] += (TRANSPOSE ? cw[j * 1024 + d0 + i] : w0[j][i]) * x[i]; }
#pragma unroll
        for (int i = 0; i < 8; ++i) acc[i] = siluf_(acc[i]) * scale;
        if (TRANSPOSE) {
#pragma unroll
            for (int i = 0; i < 8; ++i) tile[(d0 + i) * TS_ + s] = (bf16)f2bf(acc[i]);
        } else { u32x4 o; o.x = pk2(acc[0], acc[1]); o.y = pk2(acc[2], acc[3]); o.z = pk2(acc[4], acc[5]); o.w = pk2(acc[6], acc[7]); *(LAS u32x4*)(tile + s * TS_ + d0) = o; }
    }
}
struct RawRegs { u32x4 v[5]; };
__device__ __forceinline__ void raw_load(const Ctx& c, const bf16* Z, int tok0, bool first, int col0, RawRegs& R) {
#pragma unroll
    for (int n = 0; n < 5; ++n) { const int i = c.tid + NTHR * n, r = i >> 4, ch = i & 15; R.v[n] = (u32x4){0u, 0u, 0u, 0u};
        if (i < 131 * 16 && !(first && r < 3)) R.v[n] = *(const u32x4*)(Z + (size_t)(tok0 - 3 + r) * ZP + col0 + ch * 8); }
}
__device__ __forceinline__ void raw_store(const Ctx& c, const RawRegs& R, LAS bf16* raw) {
#pragma unroll
    for (int n = 0; n < 5; ++n) { const int i = c.tid + NTHR * n, r = i >> 4, ch = i & 15; if (i < 131 * 16) *(LAS u32x4*)(raw + r * TS_ + ch * 8) = R.v[n]; }
}
struct TRegs { u32x4 v[4]; };
__device__ __forceinline__ void tr_load(const Ctx& c, const bf16* src, TRegs& R) {
    const int s = c.tid & 127, chq = c.tid >> 7;
#pragma unroll
    for (int it = 0; it < 4; ++it) R.v[it] = *(const u32x4*)(src + (size_t)s * ZP + (chq * 4 + it) * 8);
}
template <class F> __device__ __forceinline__ void tr_store(const Ctx& c, const TRegs& R, LAS bf16* tile, const F& f) {
    const int s = c.tid & 127, chq = c.tid >> 7;
#pragma unroll
    for (int it = 0; it < 4; ++it) { const int e0 = (chq * 4 + it) * 8; float x[8]; unpack8(R.v[it], x);
#pragma unroll
        for (int i = 0; i < 8; ++i) tile[(e0 + i) * TS_ + s] = (bf16)f2bf(f(x[i], s, e0 + i)); }
}
struct CRegs { u32x4 v[4]; };
__device__ __forceinline__ void rows_load(const Ctx& c, const bf16* src  , CRegs& R) {
#pragma unroll
    for (int n = 0; n < 4; ++n) { const int i = c.tid + NTHR * n; R.v[n] = *(const u32x4*)(src + (i >> 4) * 128 + (i & 15) * 8); }
}
__device__ __forceinline__ void rows_store(const Ctx& c, const CRegs& R, LAS bf16* tile) {
#pragma unroll
    for (int n = 0; n < 4; ++n) { const int i = c.tid + NTHR * n; *(LAS u32x4*)(tile + (i >> 4) * TS_ + (i & 15) * 8) = R.v[n]; }
}
template <class F> __device__ __forceinline__ void stage_transposed(const Ctx& c, const bf16* src, LAS bf16* tile, const F& f) {
    const int s = c.tid & 127, chq = c.tid >> 7;
#pragma unroll
    for (int it = 0; it < 4; ++it) { const int e0 = (chq * 4 + it) * 8; float x[8]; unpack8(*(const u32x4*)(src + (size_t)s * ZP + e0), x);
#pragma unroll
        for (int i = 0; i < 8; ++i) tile[(e0 + i) * TS_ + s] = (bf16)f2bf(f(x[i], s, e0 + i)); }
}
constexpr int L_T0 = 0, L_T1 = TILE_B, L_T2 = 2 * TILE_B, L_T3 = 3 * TILE_B, L_TAB = 4 * TILE_B + 2048;
static_assert(L_TAB + 4096 <= LDSCTL_OFF, "LDS map");

__device__ __forceinline__ void ml_state_unit(KARGS& a, const Ctx& c0, int bhc) {
    Ctx c = c0; { int t_ = c0.wave * 64 + (int)__builtin_amdgcn_mbcnt_hi(~0u, __builtin_amdgcn_mbcnt_lo(~0u, 0u)); asm volatile("" : "+v"(t_)); c.tid = t_; c.lane = t_ & 63; c.wave = __builtin_amdgcn_readfirstlane(t_ >> 6); }
    unsigned char* ws = c.ws;
    const int bh = bhc >> 6, ck = bhc & 63, b = bh >> 2, h = bh & 3, tok0 = b * SEQ + ck * 128;
    const bf16* Z = (const bf16*)(ws + WS_ARENA);
    LAS bf16* KT = (LAS bf16*)(c.lds + L_T0); LAS bf16* VT = (LAS bf16*)(c.lds + L_T1); LAS bf16* RAW = (LAS bf16*)(c.lds + L_T2);
    LAS float* wt = (LAS float*)(c.lds + L_TAB);
    RawRegs rk; TRegs rv;
    raw_load(c, Z, tok0, ck == 0, 512 + h * 128, rk); tr_load(c, Z + (size_t)tok0 * ZP + 1024 + h * 128, rv);
    if (c.wave == 0) {
        const float* LF = (const float*)(ws + WS_LF); const float* LI = (const float*)(ws + WS_LI);
        const int s0 = 2 * c.lane;
        const float lf0 = ldf(LF + (size_t)(tok0 + s0) * 4 + h), lf1 = ldf(LF + (size_t)(tok0 + s0 + 1) * 4 + h);
        const float li0 = ldf(LI + (size_t)(tok0 + s0) * 4 + h), li1 = ldf(LI + (size_t)(tok0 + s0 + 1) * 4 + h);
        float sc = lf0 + lf1;
#pragma unroll
        for (int o = 1; o < 64; o <<= 1) { const float t = shfl_up_l(sc, o, c.lane); if (c.lane >= o) sc += t; }
        const float b1 = sc, b0 = sc - lf1, blast = shfl_idx_l(sc, 63);
        const float g0 = blast - b0 + li0, g1 = blast - b1 + li1;
        float mg = fmaxf(g0, g1);
#pragma unroll
        for (int o = 1; o < 64; o <<= 1) mg = fmaxf(mg, shfl_xor_l(mg, o, c.lane));
        wt[s0] = fast_exp(g0 - mg); wt[s0 + 1] = fast_exp(g1 - mg);
        if (c.lane == 0) { ((float*)(ws + WS_MISC + MISC_MG))[bhc] = mg; ((float*)(ws + WS_MISC + MISC_BL))[bhc] = blast; }
    }
    raw_store(c, rk, RAW);
    __syncthreads();
    conv_tile<true>(c, RAW, ain(a, 3) + 512 + h * 128, ain(a, 4) + 512 + h * 128, 1.0f, KT);
    tr_store(c, rv, VT, [&](float x, int s, int) { return x * wt[s]; });
    __syncthreads();
    f32x16 acc[2] = {};
    wg_mma128(acc, VT, KT, c.wave, c.lane);
    { const int r32 = c.lane & 31, hi = c.lane >> 5, mblk = (c.wave >> 1) * 32, nblk = (c.wave & 1) * 64; float* CH = (float*)(ws + WS_CH) + (size_t)bhc * 16384;
#pragma unroll
      for (int j = 0; j < 2; ++j)
#pragma unroll
        for (int i = 0; i < 16; ++i) CH[(mblk + crow_(i, hi)) * 128 + nblk + 32 * j + r32] = acc[j][i]; }
    { const int d = c.tid >> 2, part = c.tid & 3; float s = 0.f;
#pragma unroll
      for (int k = 0; k < 4; ++k) { float x[8]; unpack8(*(const LAS u32x4*)(KT + d * TS_ + part * 32 + 8 * k), x);
#pragma unroll
        for (int i = 0; i < 8; ++i) s += wt[part * 32 + 8 * k + i] * x[i]; }
      s = quad_sum(s);
      if (part == 0) ((float*)(ws + WS_NH))[(size_t)bhc * 128 + d] = s; }
    __syncthreads();
}
__device__ __forceinline__ void sg_unit(KARGS& a, const Ctx& c0, int idx) {
    Ctx c = c0; { int t_ = c0.wave * 64 + (int)__builtin_amdgcn_mbcnt_hi(~0u, __builtin_amdgcn_mbcnt_lo(~0u, 0u)); asm volatile("" : "+v"(t_)); c.tid = t_; c.lane = t_ & 63; c.wave = __builtin_amdgcn_readfirstlane(t_ >> 6); }
    unsigned char* ws = c.ws;
    const int bn = idx >> 2, g = idx & 3, tok0 = (bn >> 6) * SEQ + (bn & 63) * 128;
    const bf16* Z = (const bf16*)(ws + WS_ARENA);
    LAS bf16* WG = (LAS bf16*)(c.lds + L_T0); LAS bf16* VN = (LAS bf16*)(c.lds + L_T1); LAS float* rs = (LAS float*)(c.lds + L_TAB);
    const int r32 = c.lane & 31, hi = c.lane >> 5, mblk = (c.wave >> 1) * 32, nblk = (c.wave & 1) * 64, ch = c.tid & 15, c0e = ch * 8, chq = c.tid >> 7;
    TRegs rv; CRegs rw; u32x4 xv[16], uv[4]; f32x4 gv[4][2], bv[4];
    tr_load(c, Z + (size_t)tok0 * ZP + 2560 + g * 128, rv); rows_load(c, (const bf16*)(ws + WS_SGW) + (size_t)g * 16384, rw);
    { const bf16* p = Z + (size_t)(tok0 + (c.tid >> 2)) * ZP + 2560 + (c.tid & 3) * 128;
#pragma unroll
      for (int k = 0; k < 16; ++k) xv[k] = *(const u32x4*)(p + 8 * k); }
#pragma unroll
    for (int it = 0; it < 4; ++it) { uv[it] = *(const u32x4*)(Z + (size_t)(tok0 + (c.tid >> 4) + 32 * it) * ZP + 2048 + g * 128 + c0e);
        const float* gp = ain(a, 7) + g * 128 + (chq * 4 + it) * 8; gv[it][0] = *(const f32x4*)gp; gv[it][1] = *(const f32x4*)(gp + 4);
        bv[it] = *(const f32x4*)(ain(a, 9) + g * 128 + mblk + 8 * it + 4 * hi); }
    { const int s = c.tid >> 2, part = c.tid & 3; float ss = 0.f;
#pragma unroll
      for (int k = 0; k < 16; ++k) { float x[8]; unpack8(xv[k], x);
#pragma unroll
        for (int i = 0; i < 8; ++i) ss += x[i] * x[i]; }
      ss = quad_sum(ss);
      if (part == 0) rs[s] = 1.0f / sqrtf(ss * (1.0f / 512.0f) + EPS); }
    rows_store(c, rw, WG);
    __syncthreads();
    { const int s = c.tid & 127; const float r = rs[s];
#pragma unroll
      for (int it = 0; it < 4; ++it) { const int e0 = (chq * 4 + it) * 8; float x[8]; unpack8(rv.v[it], x);
#pragma unroll
        for (int i = 0; i < 8; ++i) VN[(e0 + i) * TS_ + s] = (bf16)f2bf(x[i] * r * gv[it][i >> 2][i & 3]); } }
    __syncthreads();
    f32x16 acc[2] = {};
    wg_mma128(acc, WG, VN, c.wave, c.lane);
    __syncthreads();
    LAS float* HT = (LAS float*)(c.lds + L_T0);
#pragma unroll
    for (int i = 0; i < 16; ++i) { const int t = mblk + crow_(i, hi); const float bs = bv[i >> 2][i & 3];
        HT[t * 132 + nblk + r32] = acc[0][i] + bs; HT[t * 132 + nblk + 32 + r32] = acc[1][i] + bs; }
    __syncthreads();
    { bf16* CAT = (bf16*)(ws + WS_CAT);
#pragma unroll
      for (int it = 0; it < 4; ++it) { const int t = (c.tid >> 4) + 32 * it; float u[8]; unpack8(uv[it], u);
          const f32x4 x0 = *(const LAS f32x4*)(HT + t * 132 + c0e), x1 = *(const LAS f32x4*)(HT + t * 132 + c0e + 4);
          u32x4 o; o.x = pk2(u[0] * x0.x, u[1] * x0.y); o.y = pk2(u[2] * x0.z, u[3] * x0.w);
          o.z = pk2(u[4] * x1.x, u[5] * x1.y); o.w = pk2(u[6] * x1.z, u[7] * x1.w);
          *(u32x4*)(CAT + (size_t)(tok0 + t) * DM + 512 + g * 128 + c0e) = o; } }
    __syncthreads();
}
__device__ __forceinline__ void ml_scan_phase(const Ctx& c) {
    unsigned char* ws = c.ws;
    const int gid = c.bid * NTHR + c.tid, bh = gid >> 14, idx = gid & 16383;
    LAS float* sdec = (LAS float*)c.lds; LAS float* ssc = sdec + 64; LAS float* smp = ssc + 64;
    if (c.wave == 0) {
        const float bl = ldf((const float*)(ws + WS_MISC + MISC_BL) + bh * 64 + c.lane), mg = ldf((const float*)(ws + WS_MISC + MISC_MG) + bh * 64 + c.lane);
        float m = 0.f, mprev = 0.f, mnew = 0.f;
        for (int k = 0; k < 64; ++k) { const float blk = __shfl(bl, k), mgk = __shfl(mg, k); const float mn = fmaxf(blk + m, mgk);
            if (c.lane == k) { mprev = m; mnew = mn; } m = mn; }
        smp[c.lane] = mprev; sdec[c.lane] = fast_exp(bl + mprev - mnew); ssc[c.lane] = fast_exp(mg - mnew);
    }
    __syncthreads();
    const float* CH = (const float*)(ws + WS_CH) + (size_t)bh * 64 * 16384 + idx; bf16* CP = (bf16*)(ws + WS_CP) + (size_t)bh * 64 * 16384 + idx;
    float C = 0.f;
#pragma unroll 1
    for (int k0 = 0; k0 < 64; k0 += 32) { float chv[32];
#pragma unroll
        for (int k = 0; k < 32; ++k) chv[k] = CH[(size_t)(k0 + k) * 16384];
#pragma unroll
        for (int k = 0; k < 32; ++k) { CP[(size_t)(k0 + k) * 16384] = (bf16)f2bf(C); C = sdec[k0 + k] * C + ssc[k0 + k] * chv[k]; } }
    if (idx < 128) { const float* NH = (const float*)(ws + WS_NH) + (size_t)bh * 64 * 128 + idx; float* NP = (float*)(ws + WS_NP) + (size_t)bh * 64 * 128 + idx; float n = 0.f;
#pragma unroll 8
        for (int k = 0; k < 64; ++k) { const float nh = NH[k * 128]; NP[k * 128] = n; n = sdec[k] * n + ssc[k] * nh; } }
    if (idx < 64) ((float*)(ws + WS_MISC + MISC_MP))[bh * 64 + idx] = smp[idx];
    __syncthreads();
}
template <int SKIP = 0> __device__ __forceinline__ void ml_out_unit(KARGS& a, const Ctx& c0, int bhc) {
    Ctx c = c0; { int t_ = c0.wave * 64 + (int)__builtin_amdgcn_mbcnt_hi(~0u, __builtin_amdgcn_mbcnt_lo(~0u, 0u)); asm volatile("" : "+v"(t_)); c.tid = t_; c.lane = t_ & 63; c.wave = __builtin_amdgcn_readfirstlane(t_ >> 6); }
    unsigned char* ws = c.ws;
    const int bh = bhc >> 6, ck = bhc & 63, b = bh >> 2, h = bh & 3, tok0 = b * SEQ + ck * 128;
    const bf16* Z = (const bf16*)(ws + WS_ARENA);
    LAS bf16* QT = (LAS bf16*)(c.lds + L_T0); LAS bf16* KT = (LAS bf16*)(c.lds + L_T1); LAS bf16* VT = (LAS bf16*)(c.lds + L_T2); LAS bf16* CT = (LAS bf16*)(c.lds + L_T3);
    LAS bf16* SW = KT; LAS bf16* RAW = (LAS bf16*)(c.lds + L_T3 + 1024); LAS bf16* RAWK = VT;
    RawRegs rq, rk; TRegs rv; CRegs rc;
    raw_load(c, Z, tok0, ck == 0, h * 128, rq); raw_load(c, Z, tok0, ck == 0, 512 + h * 128, rk);
    tr_load(c, Z + (size_t)tok0 * ZP + 1024 + h * 128, rv); rows_load(c, (const bf16*)(ws + WS_CP) + (size_t)bhc * 16384, rc);
    LAS float* t_a = (LAS float*)(c.lds + L_TAB); LAS float* t_mu = t_a + 128; LAS float* t_wi = t_a + 256; LAS float* t_emr = t_a + 384; LAS float* t_rden = t_a + 512; LAS float* t_np = t_a + 640; LAS float* t_ssq = t_a + 768;
    if (c.wave == 0) {
        const float* LF = (const float*)(ws + WS_LF); const float* LI = (const float*)(ws + WS_LI);
        const int s0 = 2 * c.lane;
        const float lf0 = ldf(LF + (size_t)(tok0 + s0) * 4 + h), lf1 = ldf(LF + (size_t)(tok0 + s0 + 1) * 4 + h);
        const float li0 = ldf(LI + (size_t)(tok0 + s0) * 4 + h), li1 = ldf(LI + (size_t)(tok0 + s0 + 1) * 4 + h);
        float sc = lf0 + lf1;
#pragma unroll
        for (int o = 1; o < 64; o <<= 1) { const float t = shfl_up_l(sc, o, c.lane); if (c.lane >= o) sc += t; }
        const float b1 = sc, b0 = sc - lf1;
        const float a0 = li0 - b0, a1 = li1 - b1;
        float pm = fmaxf(a0, a1);
#pragma unroll
        for (int o = 1; o < 64; o <<= 1) { const float t = shfl_up_l(pm, o, c.lane); if (c.lane >= o) pm = fmaxf(pm, t); }
        float pprev = shfl_up_l(pm, 1, c.lane); if (c.lane == 0) pprev = -__builtin_inff();
        const float pm0 = fmaxf(pprev, a0), pm1 = pm;
        const float mprev = ldf((const float*)(ws + WS_MISC + MISC_MP) + bhc);
        const float mu0 = fmaxf(mprev, pm0), mu1 = fmaxf(mprev, pm1);
        t_a[s0] = a0; t_a[s0 + 1] = a1; t_mu[s0] = mu0; t_mu[s0 + 1] = mu1;
        t_wi[s0] = fast_exp(mprev - mu0); t_wi[s0 + 1] = fast_exp(mprev - mu1);
        t_emr[s0] = fast_exp(-b0 - mu0); t_emr[s0 + 1] = fast_exp(-b1 - mu1);
    }
    if (c.wave == 1) { const float* NP = (const float*)(ws + WS_NP) + (size_t)bhc * 128; t_np[c.lane] = ldf(NP + c.lane); t_np[64 + c.lane] = ldf(NP + 64 + c.lane); }
    raw_store(c, rq, RAW); raw_store(c, rk, RAWK);
    __syncthreads();
    if (!(SKIP & 1)) { conv_tile<false>(c, RAW, ain(a, 3) + h * 128, ain(a, 4) + h * 128, 0.08838834764831845f, QT);
    conv_tile<false>(c, RAWK, ain(a, 3) + 512 + h * 128, ain(a, 4) + 512 + h * 128, 1.0f, KT); }
    __syncthreads();
    if (!(SKIP & 2)) tr_store(c, rv, VT, [](float x, int, int) { return x; });
    rows_store(c, rc, CT);
    __syncthreads();
    const int r32 = c.lane & 31, hi = c.lane >> 5, mblk = (c.wave >> 1) * 32, nblk = (c.wave & 1) * 64;
    f32x16 sa[2] = {};
    if (!(SKIP & 4)) wg_mma128(sa, QT, KT, c.wave, c.lane);
    __syncthreads();
    { const float as0 = t_a[nblk + r32], as1 = t_a[nblk + 32 + r32];
#pragma unroll
      for (int i = 0; i < 16; ++i) { const int t = mblk + crow_(i, hi); const float mu = t_mu[t];
          const int s0 = nblk + r32, s1 = s0 + 32;
          const float w0 = (s0 <= t) ? fast_exp(as0 - mu) : 0.f, w1 = (s1 <= t) ? fast_exp(as1 - mu) : 0.f;
          SW[t * TS_ + s0] = (bf16)f2bf(sa[0][i] * w0); SW[t * TS_ + s1] = (bf16)f2bf(sa[1][i] * w1); } }
    __syncthreads();
    f32x16 n1[2] = {}, n2[2] = {};
    if (!(SKIP & 4)) { wg_mma128(n1, SW, VT, c.wave, c.lane);
    wg_mma128(n2, QT, CT, c.wave, c.lane); }
    { const int t = c.tid >> 2, part = c.tid & 3; float ds = 0.f, dq = 0.f;
#pragma unroll
      for (int k = 0; k < 4; ++k) { float x[8], q[8]; unpack8(*(const LAS u32x4*)(SW + t * TS_ + part * 32 + 8 * k), x); unpack8(*(const LAS u32x4*)(QT + t * TS_ + part * 32 + 8 * k), q);
#pragma unroll
        for (int i = 0; i < 8; ++i) { ds += x[i]; dq += q[i] * t_np[part * 32 + 8 * k + i]; } }
      ds = quad_sum(ds); dq = quad_sum(dq);
      if (part == 0) { const float den = ds + t_wi[t] * dq; t_rden[t] = 1.0f / fmaxf(fabsf(den), t_emr[t]); } }
    __syncthreads();
    LAS float* HT = (LAS float*)(c.lds + L_T0);
#pragma unroll
    for (int i = 0; i < 16; ++i) { const int t = mblk + crow_(i, hi); const float wi = t_wi[t], rd = t_rden[t];
        HT[t * 132 + nblk + r32] = (n1[0][i] + wi * n2[0][i]) * rd; HT[t * 132 + nblk + 32 + r32] = (n1[1][i] + wi * n2[1][i]) * rd; }
    __syncthreads();
    { const int t = c.tid >> 2, part = c.tid & 3; float q = 0.f;
#pragma unroll
      for (int k = 0; k < 8; ++k) { const f32x4 x = *(const LAS f32x4*)(HT + t * 132 + part * 32 + 4 * k); q += (x.x * x.x + x.y * x.y) + (x.z * x.z + x.w * x.w); }
      q = quad_sum(q);
      if (part == 0) t_ssq[t] = 1.0f / sqrtf(q * (1.0f / 128.0f) + EPS); }
    __syncthreads();
    { int tt = c.tid; asm volatile("" : "+v"(tt));
      bf16* CAT = (bf16*)(ws + WS_CAT); const int ch = tt & 15, e0 = ch * 8; float gn[8];
#pragma unroll
      for (int i = 0; i < 8; ++i) gn[i] = ain(a, 6)[h * 128 + e0 + i];
#pragma unroll
      for (int it = 0; it < 4; ++it) { const int t = (tt >> 4) + 32 * it; float og[8]; unpack8(*(const u32x4*)(Z + (size_t)(tok0 + t) * ZP + 1536 + h * 128 + e0), og);
          const float rstd = t_ssq[t]; const f32x4 x0 = *(const LAS f32x4*)(HT + t * 132 + e0), x1 = *(const LAS f32x4*)(HT + t * 132 + e0 + 4);
          u32x4 o; o.x = pk2(x0.x * rstd * gn[0] * og[0], x0.y * rstd * gn[1] * og[1]); o.y = pk2(x0.z * rstd * gn[2] * og[2], x0.w * rstd * gn[3] * og[3]);
          o.z = pk2(x1.x * rstd * gn[4] * og[4], x1.y * rstd * gn[5] * og[5]); o.w = pk2(x1.z * rstd * gn[6] * og[6], x1.w * rstd * gn[7] * og[7]);
          *(u32x4*)(CAT + (size_t)(tok0 + t) * DM + h * 128 + e0) = o; } }
    __syncthreads();
}

__device__ __forceinline__ void fox_cumsum(const Ctx& c) {
    if (c.bid >= 8) return;
    unsigned char* ws = c.ws; const int bh = c.bid, b = bh >> 2, h = bh & 3;
    const float* LFX = (const float*)(ws + WS_LFX) + (size_t)b * SEQ * 4 + h; u32x2* KB = (u32x2*)(ws + WS_KB) + (size_t)bh * SEQ;
    LAS float* wsum = (LAS float*)c.lds;
    float v[16]; float tot = 0.f;
#pragma unroll
    for (int i = 0; i < 16; ++i) { v[i] = LFX[(size_t)(c.tid * 16 + i) * 4]; tot += v[i]; }
    float sc = tot;
#pragma unroll
    for (int o = 1; o < 64; o <<= 1) { const float t = shfl_up_l(sc, o, c.lane); if (c.lane >= o) sc += t; }
    if (c.lane == 63) wsum[c.wave] = sc;
    __syncthreads();
    float base = 0.f;
    for (int w = 0; w < c.wave; ++w) base += wsum[w];
    float run = base + sc - tot;
#pragma unroll
    for (int i = 0; i < 16; ++i) { run += v[i]; const float x = -run * 11.313708498984761f;
        const unsigned a = f2bf(x); const float r1 = x - bf2f(a); const unsigned b2 = f2bf(r1); const float r2 = r1 - bf2f(b2); const unsigned c2 = f2bf(r2);
        u32x2 w; w.x = a | (b2 << 16); w.y = c2; KB[c.tid * 16 + i] = w; }
}
#ifndef ATT_ONLY
#define ATT_ONLY 0
#endif
template <int ONLY = ATT_ONLY> __device__ __forceinline__ void attn_phase(KARGS& a, const Ctx& c, int qoff) {
    unsigned char* ws = c.ws; char* lds = (char*)c.lds;
    const bf16* Z = (const bf16*)(ws + WS_ARENA);
    LAS int* slot = (LAS int*)(c.lds + att::LDS_BYTES);
    unsigned* q = (unsigned*)(ws + WS_CTL) + CW_QUEUE + qoff;
    if (ONLY != 2) for (;;) {
        if (c.tid == 0) slot[0] = (int)__hip_atomic_fetch_add(q, 1u, RLX_AGENT);
        __syncthreads();
        const int it = slot[0];
        __syncthreads();
        if (it >= 256) break;
        const int qb = 31 - (it >> 3), bh = it & 7, b = bh >> 2, h = bh & 3; const size_t rb = (size_t)b * SEQ;
        att::BlockRef R; R.Q = Z + (rb + (size_t)qb * 256) * ZP + h * 128; R.K = Z + rb * ZP + 512 + h * 128; R.V = Z + rb * ZP + 1024 + h * 128;
        R.KB = (const u32x2*)(ws + WS_KB) + (size_t)bh * SEQ; R.P0 = qb * 256;
        int tl = c.tid; asm volatile("" : "+v"(tl));
        { const int ln = tl & 63, wv = __builtin_amdgcn_readfirstlane(tl >> 6);
          const f32x4* N2 = (const f32x4*)(ws + WS_NORM2) + rb * 8; LAS float* red = (LAS float*)(c.lds + att::LDS_BYTES + 64); LAS int* jl = (LAS int*)(c.lds + att::LDS_BYTES + 32);
          float km = 0.f, qm = 0.f; const int nk = R.P0 + 256;
          for (int s = tl; s < nk; s += NTHR) { const f32x4 pv = N2[(size_t)s * 8 + 4 + h]; km = fmaxf(km, (pv.x + pv.y) + (pv.z + pv.w)); }
          if (tl < 256) { const f32x4 pv = N2[(size_t)(R.P0 + tl) * 8 + h]; qm = (pv.x + pv.y) + (pv.z + pv.w); }
#pragma unroll
          for (int o = 1; o < 64; o <<= 1) { km = fmaxf(km, shfl_xor_l(km, o, ln)); qm = fmaxf(qm, shfl_xor_l(qm, o, ln)); }
          if (ln == 0) { red[wv] = km; red[8 + wv] = qm; }
          if (tl == 0) jl[0] = qb * 4;
          __syncthreads();
          float K2 = 0.f, Q2 = 0.f;
#pragma unroll
          for (int w = 0; w < 8; ++w) { K2 = fmaxf(K2, red[w]); Q2 = fmaxf(Q2, red[8 + w]); }
          const float B2 = 2.0f * 1.02f * sqrtf(K2 * Q2);
          if (tl < qb * 4) { const u32x2 w1 = R.KB[tl * 64 + 63], w0 = R.KB[R.P0];
              const float kb1 = bflo(w1.x) + bfhi(w1.x) + bflo(w1.y), kb0 = bflo(w0.x) + bfhi(w0.x) + bflo(w0.y);
              if (B2 + (kb1 - kb0) >= -30.0f * 11.313708498984761f) __hip_atomic_fetch_min(jl, tl, __ATOMIC_RELAXED, __HIP_MEMORY_SCOPE_WORKGROUP); }
          __syncthreads();
          R.JLO = jl[0];
          __syncthreads(); }
        att::Seam<128> S;
        att::causal_prime<128, true>(R, lds, S, tl);
        att::causal_block<128, true, 0>(R, R, lds, S, (void*)((bf16*)(ws + WS_CAT) + (rb + (size_t)qb * 256) * DM + h * 128), DM, tl);
    }
    if (ONLY != 1) for (;;) {
        if (c.tid == 0) slot[0] = (int)__hip_atomic_fetch_add(q + 64, 1u, RLX_AGENT);
        __syncthreads();
        const int it = slot[0];
        __syncthreads();
        if (it >= 512) break;
        const int qb = 31 - (it >> 4), d = it & 15, bh = d >> 1, mp = d & 1, b = bh >> 2, h = bh & 3; const size_t rb = (size_t)b * SEQ;
        att::BlockRef R; R.Q = Z + (rb + (size_t)qb * 256) * ZP + 1536 + h * 128 + mp * 64; R.K = Z + rb * ZP + 2048 + h * 128 + mp * 64; R.V = Z + rb * ZP + 2560 + h * 128;
        R.KB = nullptr; R.P0 = qb * 256; R.JLO = 0;
        att::Seam<64> S;
        int tl = c.tid; asm volatile("" : "+v"(tl));
        att::causal_prime<64, false>(R, lds, S, tl);
        att::causal_block<64, false, 1>(R, R, lds, S, (void*)((float*)(ws + WS_DO) + (size_t)mp * T * 512 + (rb + (size_t)qb * 256) * 512 + h * 128), 512, tl);
    }
}
__device__ __forceinline__ void diffnorm_phase(KARGS& a, const Ctx& c) {
    unsigned char* ws = c.ws;
    const float lam = ldf((const float*)(ws + WS_MISC + MISC_LAM)); const float post = 1.0f - (0.8f - 0.6f * expf(-0.3f));
    const float* D0 = (const float*)(ws + WS_DO); const float* D1 = D0 + (size_t)T * 512; bf16* CAT = (bf16*)(ws + WS_CAT);
    const int gw = c.bid * NWAVES + c.wave, NGW = GRID * NWAVES;
    const float g0 = ain(a, 18)[2 * c.lane] * post, g1 = ain(a, 18)[2 * c.lane + 1] * post;
    for (int p0 = gw * 8; p0 < T * 4; p0 += NGW * 8) {
        f32x2 x0[8], x1[8];
#pragma unroll
        for (int k = 0; k < 8; ++k) { const size_t o = (size_t)(p0 + k) * 128 + 2 * c.lane; x0[k] = *(const f32x2*)(D0 + o); x1[k] = *(const f32x2*)(D1 + o); }
#pragma unroll
        for (int k = 0; k < 8; ++k) { const int p = p0 + k, t = p >> 2, h = p & 3; const float y0 = x0[k].x - lam * x1[k].x, y1 = x0[k].y - lam * x1[k].y;
            const float rstd = 1.0f / sqrtf(wave_sum(y0 * y0 + y1 * y1) * (1.0f / 128.0f) + EPS);
            *(unsigned*)(CAT + (size_t)t * DM + 512 + h * 128 + 2 * c.lane) = pk2(y0 * rstd * g0, y1 * rstd * g1); } }
}

__device__ __forceinline__ void moe_scatter_phase(const Ctx& c) {
    unsigned char* ws = c.ws;
    LAS int* soff = (LAS int*)c.lds;
    LAS int* sts = soff + 8;
    LAS int* stot = soff + 32;
    LAS int* spos = soff + 64;
    const int* CNT = (const int*)(ws + WS_MISC + MISC_CNT);
    const bf16* XN = (const bf16*)(ws + WS_XN); bf16* XP = (bf16*)(ws + WS_XP);
    u32x4 rowv[8][2];
#pragma unroll
    for (int k = 0; k < 8; ++k) { const u32x4* src = (const u32x4*)(XN + (size_t)(64 * c.bid + c.wave * 8 + k) * DM); rowv[k][0] = src[c.lane]; rowv[k][1] = src[64 + c.lane]; }
    if (c.wave == 0) {
        typedef int i32x4 __attribute__((ext_vector_type(4)));
        i32x4 cv[8];
#pragma unroll
        for (int k = 0; k < 8; ++k) cv[k] = *((const i32x4*)(CNT + (size_t)c.lane * 32) + k);
        int tot[8], before[8];
#pragma unroll
        for (int e = 0; e < 8; ++e) { int s = 0, bf = 0;
#pragma unroll
            for (int k = 0; k < 4; ++k) { const int w = 4 * c.lane + k; const int v = cv[2 * k + (e >> 2)][e & 3]; s += v; if (w < c.bid) bf += v; }
            tot[e] = s; before[e] = bf; }
#pragma unroll
        for (int e = 0; e < 8; ++e) {
#pragma unroll
            for (int o = 1; o < 64; o <<= 1) { tot[e] += __shfl_xor(tot[e], o); before[e] += __shfl_xor(before[e], o); } }
        int ts = 0, so[8];
#pragma unroll
        for (int e = 0; e < 8; ++e) { if (c.lane == 0) { sts[e] = ts; stot[e] = tot[e]; } so[e] = ts * 256 + before[e]; ts += (tot[e] + 255) >> 8; }
        if (c.lane == 0) { sts[8] = ts; if (c.bid == 0) { int acc = 0; for (int e = 0; e < 8; ++e) { ((int*)(ws + WS_MISC + MISC_TS))[e] = acc; acc += (tot[e] + 255) >> 8; } ((int*)(ws + WS_MISC + MISC_TS))[8] = acc; } }
        const int m = 64 * c.bid + c.lane; const int e1 = ((const int*)(ws + WS_RTE))[2 * m], e2 = ((const int*)(ws + WS_RTE))[2 * m + 1];
        int p1 = 0, p2 = 0;
#pragma unroll
        for (int e = 0; e < 8; ++e) { const unsigned long long mask = __ballot(e1 == e || e2 == e); const int rank = __builtin_popcountll(mask & ((1ull << c.lane) - 1ull));
            if (e1 == e) p1 = so[e] + rank; if (e2 == e) p2 = so[e] + rank; }
        spos[2 * c.lane] = p1; spos[2 * c.lane + 1] = p2;
        ((int*)(ws + WS_PPOS))[2 * m] = p1; ((int*)(ws + WS_PPOS))[2 * m + 1] = p2;
        ((float*)(ws + WS_RW))[p1] = ((const float*)(ws + WS_RTW))[2 * m]; ((float*)(ws + WS_RW))[p2] = ((const float*)(ws + WS_RTW))[2 * m + 1];
    }
    __syncthreads();
#pragma unroll
    for (int k = 0; k < 8; ++k) { const int ti = c.wave * 8 + k;
#pragma unroll
        for (int sl = 0; sl < 2; ++sl) { u32x4* dst = (u32x4*)(XP + (size_t)spos[2 * ti + sl] * DM); dst[c.lane] = rowv[k][0]; dst[64 + c.lane] = rowv[k][1]; } }
    { const int gw = c.bid * NWAVES + c.wave;
      for (int e = 0; e < 8; ++e) { const int tot = stot[e], first = sts[e] * 256 + tot, npad = ((tot + 255) & ~255) - tot;
          for (int i = gw; i < npad; i += GRID * NWAVES) { u32x4* dst = (u32x4*)(XP + (size_t)(first + i) * DM); const u32x4 z = {0u, 0u, 0u, 0u}; dst[c.lane] = z; dst[64 + c.lane] = z;
              if (c.lane == 0) ((float*)(ws + WS_RW))[first + i] = 0.f; } } }
    __syncthreads();
}
#ifndef MK_PER_PHASE
#define MK_PER_PHASE 0
#endif
constexpr int NPHASE = 19;
__global__ void __launch_bounds__(NTHR, 2) fwd_kernel(Args args_by_value) {
    (void)args_by_value;
    extern __shared__ __attribute__((aligned(16))) unsigned char lds_raw[];
    KARGS* ap0 = (KARGS*)__builtin_amdgcn_kernarg_segment_ptr();
    Ctx c_; c_.lds = (LAS unsigned char*)lds_raw; c_.ws = (unsigned char*)(GAS unsigned char*)ap0->ws; c_.tid = threadIdx.x; c_.lane = c_.tid & 63; c_.wave = __builtin_amdgcn_readfirstlane(c_.tid >> 6); c_.bid = blockIdx.x;
    unsigned char* const ws0 = c_.ws;
    for (int u = c_.tid; u < (LDS_BYTES - LDSCTL_OFF) / 4; u += NTHR) ((LAS unsigned*)(c_.lds + LDSCTL_OFF))[u] = 0u;
    __syncthreads();
    XcdBarrier bar; bar.bar = (unsigned*)(ws0 + WS_CTL) + CW_BAR; bar.x = 0; bar.st = nullptr;
    if (!MK_PER_PHASE) bar = xcd_barrier_post((unsigned*)(ws0 + WS_CTL) + CW_BAR, (volatile LAS unsigned*)(c_.lds + LDSCTL_OFF));
    const int lo = ap0->ph_lo, hi = ap0->ph_hi; const int wave0 = c_.wave;
#ifndef PHASE_MASK
#define PHASE_MASK 0xFFFFFFFFu
#endif
#define IN(k) (((PHASE_MASK >> (k)) & 1u) && lo <= (k) && (k) < hi)
#define FRESH() Ctx c = c_; { int t_ = wave0 * 64 + (int)__builtin_amdgcn_mbcnt_hi(~0u, __builtin_amdgcn_mbcnt_lo(~0u, 0u)); asm volatile("" : "+v"(t_)); c.tid = t_; c.lane = t_ & 63; c.wave = __builtin_amdgcn_readfirstlane(t_ >> 6); KARGS* ap_ = (KARGS*)__builtin_amdgcn_kernarg_segment_ptr(); asm volatile("" : "+s"(ap_)); GAS unsigned char* w_ = (GAS unsigned char*)ap_->ws; c.ws = (unsigned char*)w_; } \
    KARGS& args = *(KARGS*)__builtin_amdgcn_kernarg_segment_ptr(); \
    unsigned char* const ws = c.ws; bf16* const XN = (bf16*)(ws + WS_XN); bf16* const CAT = (bf16*)(ws + WS_CAT); bf16* const ZA = (bf16*)(ws + WS_ARENA); float* const XR = (float*)(ws + WS_XR); (void)XN; (void)CAT; (void)ZA; (void)XR;
#define SEAM(k) do { if (IN(k) && IN((k) + 1)) xcd_barrier(bar); } while (0)
    PG8_LAS unsigned char* glds = (PG8_LAS unsigned char*)lds_raw;

#define QOFF 0
    if (IN(0)) { FRESH(); prologue_weights(args, c); prologue_tables(args, c); __syncthreads(); row_phase<0>(args, c, ain(args, 0), ain(args, 1)); }
    SEAM(0);
    if (IN(1)) { FRESH(); pg8::Gemm g{XN, (const bf16*)(ws + WS_W_EIN), T, 3072, 1024}; pg8::StaticOrder S; S.init(T, 3072, GRID, c.bid);
        pg8::EpiBf16 E{ZA, ZP, nullptr, 0, 0, nullptr, 6, 8, 12}; pg8::gemm_phase<pg8::EpiBf16, pg8::StaticOrder, true, true>(glds, g, S, E, c.tid); }
    SEAM(1);
    if (IN(2)) { FRESH(); for (int u = c.bid; u < 1024; u += GRID) { if (u < 512) ml_state_unit(args, c, u); else sg_unit(args, c, u - 512); } }
    SEAM(2);
    if (IN(3)) { FRESH(); ml_scan_phase(c); }
    SEAM(3);
    if (IN(4)) { FRESH(); for (int u = c.bid; u < 512; u += GRID) ml_out_unit(args, c, u); }
    SEAM(4);
    if (IN(5)) { FRESH(); pg8::Gemm g{CAT, (const bf16*)(ws + WS_W_EOUT), T, 1024, 1024}; pg8::StaticOrder S; S.init(T, 1024, GRID, c.bid);
        pg8::EpiResF32 E{ain(args, 0), XR, DM}; pg8::gemm_phase<pg8::EpiResF32, pg8::StaticOrder, false, true>(glds, g, S, E, c.tid); }
    SEAM(5);
    if (IN(6)) { FRESH(); row_phase<1>(args, c, XR, ain(args, 11)); }
    SEAM(6);
    if (IN(7)) { FRESH(); pg8::Gemm g{XN, (const bf16*)(ws + WS_W_FGU), T, 2 * FF, 1024}; pg8::StaticOrder S; S.init(T, 2 * FF, GRID, c.bid);
        pg8::EpiSwiglu E{ZA, FF}; pg8::gemm_phase<pg8::EpiSwiglu, pg8::StaticOrder, true, true>(glds, g, S, E, c.tid); }
    SEAM(7);
    if (IN(8)) { FRESH(); pg8::Gemm g{ZA, (const bf16*)(ws + WS_W_FDN), T, 1024, FF}; pg8::StaticOrder S; S.init(T, 1024, GRID, c.bid);
        pg8::EpiResF32 E{XR, XR, DM}; pg8::gemm_phase<pg8::EpiResF32, pg8::StaticOrder, false, true>(glds, g, S, E, c.tid); }
    SEAM(8);
    if (IN(9)) { FRESH(); row_phase<2>(args, c, XR, ain(args, 14)); }
    SEAM(9);
    if (IN(10)) { FRESH(); fox_cumsum(c); __syncthreads();
        pg8::Gemm g{XN, (const bf16*)(ws + WS_W_OIN), T, 3072, 1024}; pg8::StaticOrder S; S.init(T, 3072, GRID, c.bid);
        pg8::EpiBf16 E{ZA, ZP, (const float*)(ws + WS_ROPE), 6, 10, (float*)(ws + WS_NORM2), 99, 99, 99}; pg8::gemm_phase<pg8::EpiBf16, pg8::StaticOrder, true, true>(glds, g, S, E, c.tid); }
    SEAM(10);
    if (IN(11)) { FRESH(); attn_phase(args, c, QOFF); }
    SEAM(11);
    if (IN(12)) { FRESH(); diffnorm_phase(args, c); }
    SEAM(12);
    if (IN(13)) { FRESH(); pg8::Gemm g{CAT, (const bf16*)(ws + WS_W_OOUT), T, 1024, 1024}; pg8::StaticOrder S; S.init(T, 1024, GRID, c.bid);
        pg8::EpiResF32 E{XR, XR, DM}; pg8::gemm_phase<pg8::EpiResF32, pg8::StaticOrder, false, true>(glds, g, S, E, c.tid); }
    SEAM(13);
    if (IN(14)) { FRESH(); row_phase<3>(args, c, XR, ain(args, 20)); }
    SEAM(14);
    if (IN(15)) { FRESH(); moe_scatter_phase(c); }
    SEAM(15);
    if (IN(16)) { FRESH(); pg8::Gemm g{(const bf16*)(ws + WS_XP), (const bf16*)(ws + WS_W_MGU), 0, 2 * FFE, 1024}; pg8::MoeOrder S;
#pragma unroll
        for (int e = 0; e < 9; ++e) S.ts[e] = __builtin_amdgcn_readfirstlane(ldi((const int*)(ws + WS_MISC + MISC_TS) + e));
        S.nM = S.ts[8]; S.nN = 2 * FFE / 256; S.nwg = S.nM * S.nN; S.G = GRID; S.c = c.bid;
        pg8::EpiSwiglu E{ZA, FFE}; pg8::gemm_phase<pg8::EpiSwiglu, pg8::MoeOrder, true, true>(glds, g, S, E, c.tid); }
    SEAM(16);
    if (IN(17)) { FRESH(); pg8::Gemm g{ZA, (const bf16*)(ws + WS_W_MDN), 0, 1024, FFE}; pg8::HybridOrder S;
#pragma unroll
        for (int e = 0; e < 9; ++e) S.ts[e] = __builtin_amdgcn_readfirstlane(ldi((const int*)(ws + WS_MISC + MISC_TS) + e));
        S.nN = 4; S.NKT = FFE / 64; S.U = S.ts[8] * 4; S.G = GRID; S.c = c.bid;
        pg8::EpiMoeDownSK E{(bf16*)(ws + WS_Y), DM, (const float*)(ws + WS_RW), (float*)(ws + WS_XP), pg8::hyb_SL(S.U - 512)}; pg8::gemm_phase<pg8::EpiMoeDownSK, pg8::HybridOrder, true, true>(glds, g, S, E, c.tid); }
    SEAM(17);
    if (IN(18)) { FRESH(); row_phase<4>(args, c, XR, ain(args, 24)); }
#undef QOFF
#undef IN
#undef SEAM
}

extern "C" void kernel_launch(void* const* d_in, const int* in_sizes, int n_in, void* d_out, int out_size, void* d_ws, size_t ws_size, hipStream_t stream) {
    static int ready = 0;
    if (ready == 0) {
        if (n_in != 25 || in_sizes[0] != T * DM || out_size != T * DM || ws_size < WS_END) {
            fprintf(stderr, "kernel_launch: built for 25 inputs, x/out of %d floats, >= %zu bytes of workspace; got n_in %d in0 %d out %d ws %zu; nothing launched\n", T * DM, (size_t)WS_END, n_in, n_in > 0 ? in_sizes[0] : -1, out_size, ws_size);
            ready = -1; return; }
        if (hipFuncSetAttribute((const void*)fwd_kernel, hipFuncAttributeMaxDynamicSharedMemorySize, LDS_BYTES) != hipSuccess) { fprintf(stderr, "kernel_launch: hipFuncSetAttribute(%d) failed\n", LDS_BYTES); ready = -1; return; }
        int dev = 0, cus = 0, per_cu = 0; (void)hipGetDevice(&dev); (void)hipDeviceGetAttribute(&cus, hipDeviceAttributeMultiprocessorCount, dev);
        if (hipOccupancyMaxActiveBlocksPerMultiprocessor(&per_cu, (const void*)fwd_kernel, NTHR, LDS_BYTES) != hipSuccess) per_cu = -1;
        (void)hipGetLastError();
        if (cus < GRID || per_cu < 1) fprintf(stderr, "kernel_launch: note: %d CUs, occupancy query %d; the kernel needs %d co-resident workgroups (one per CU)\n", cus, per_cu, GRID);
        ready = 1;
    }
    if (ready < 0) return;
    (void)hipMemsetAsync((char*)d_ws + WS_CTL, 0, CTL_ZERO_BYTES, stream);
    Args a{};
    for (int i = 0; i < 25; ++i) a.in[i] = (const float*)d_in[i];
    a.out = (float*)d_out; a.ws = (unsigned char*)d_ws;
#if MK_PER_PHASE
    for (int p = 0; p < NPHASE; ++p) { a.ph_lo = p; a.ph_hi = p + 1; hipLaunchKernelGGL(fwd_kernel, dim3(GRID), dim3(NTHR), LDS_BYTES, stream, a); }
#else
    a.ph_lo = 0; a.ph_hi = NPHASE; hipLaunchKernelGGL(fwd_kernel, dim3(GRID), dim3(NTHR), LDS_BYTES, stream, a);
#endif
    const hipError_t le = hipPeekAtLastError();
    if (le != hipSuccess) fprintf(stderr, "kernel_launch: launch failed: %s\n", hipGetErrorName(le));
}
```

```cpp
#include <hip/hip_runtime.h>
#include <cstdio>
#include <cstdint>

#define LAS __attribute__((address_space(3)))
#define GAS __attribute__((address_space(1)))
typedef unsigned short bf16;
typedef unsigned short bf16_t;
typedef short bf16x8 __attribute__((ext_vector_type(8)));
typedef short s16x4 __attribute__((ext_vector_type(4)));
typedef float f32x2 __attribute__((ext_vector_type(2)));
typedef float f32x4 __attribute__((ext_vector_type(4)));
typedef float f32x16 __attribute__((ext_vector_type(16)));
typedef unsigned u32x2 __attribute__((ext_vector_type(2)));
typedef unsigned u32x4 __attribute__((ext_vector_type(4)));
typedef GAS unsigned gu32;
#define RLX_AGENT __ATOMIC_RELAXED, __HIP_MEMORY_SCOPE_AGENT
#define LDS_WAIT() asm volatile("s_waitcnt lgkmcnt(0)" ::: "memory")
#define VM_WAIT() asm volatile("s_waitcnt vmcnt(0)" ::: "memory")

typedef __bf16 bf16x2_t __attribute__((ext_vector_type(2)));
__device__ __forceinline__ unsigned pk2(float lo, float hi) { const f32x2 v = {lo, hi}; return __builtin_bit_cast(unsigned, __builtin_convertvector(v, bf16x2_t)); }
__device__ __forceinline__ unsigned f2bf(float f) { return pk2(f, 0.f) & 0xffffu; }
__device__ __forceinline__ float bf2f(unsigned b) { return __builtin_bit_cast(float, b << 16); }
__device__ __forceinline__ float bflo(unsigned w) { return __builtin_bit_cast(float, w << 16); }
__device__ __forceinline__ float bfhi(unsigned w) { return __builtin_bit_cast(float, w & 0xffff0000u); }
__device__ __forceinline__ float ldf(const float* p) { return __builtin_bit_cast(float, __hip_atomic_load((const unsigned*)p, RLX_AGENT)); }
__device__ __forceinline__ int ldi(const int* p) { return __hip_atomic_load(p, RLX_AGENT); }
__device__ __forceinline__ float wave_sum(float v) {
#define DPPF(x, ctrl, rmask) __builtin_bit_cast(float, __builtin_amdgcn_update_dpp(0, __builtin_bit_cast(int, x), ctrl, rmask, 0xF, true))
    v += DPPF(v, 0xB1, 0xF);
    v += DPPF(v, 0x4E, 0xF);
    v += DPPF(v, 0x141, 0xF);
    v += DPPF(v, 0x140, 0xF);
    v += DPPF(v, 0x142, 0xA);
    v += DPPF(v, 0x143, 0xC);
#undef DPPF
    return __builtin_bit_cast(float, __builtin_amdgcn_readlane(__builtin_bit_cast(int, v), 63));
}
__device__ __forceinline__ float wave_max(float v) {
#pragma unroll
    for (int o = 1; o < 64; o <<= 1) v = fmaxf(v, __shfl_xor(v, o));
    return v;
}
__device__ __forceinline__ float shfl_up_l(float v, int o, int lane) { const int src = (lane >= o) ? lane - o : lane; return __builtin_bit_cast(float, __builtin_amdgcn_ds_bpermute(src << 2, __builtin_bit_cast(int, v))); }
__device__ __forceinline__ float shfl_idx_l(float v, int src) { return __builtin_bit_cast(float, __builtin_amdgcn_ds_bpermute(src << 2, __builtin_bit_cast(int, v))); }
__device__ __forceinline__ float shfl_xor_l(float v, int o, int lane) { return __builtin_bit_cast(float, __builtin_amdgcn_ds_bpermute((lane ^ o) << 2, __builtin_bit_cast(int, v))); }
__device__ __forceinline__ float quad_xor1(float v) { return __builtin_bit_cast(float, __builtin_amdgcn_update_dpp(0, __builtin_bit_cast(int, v), 0xB1, 0xF, 0xF, true)); }
__device__ __forceinline__ float quad_xor2(float v) { return __builtin_bit_cast(float, __builtin_amdgcn_update_dpp(0, __builtin_bit_cast(int, v), 0x4E, 0xF, 0xF, true)); }
__device__ __forceinline__ float quad_sum(float v) { v += quad_xor1(v); v += quad_xor2(v); return v; }
__device__ __forceinline__ float fast_exp(float x) { return __builtin_amdgcn_exp2f(x * 1.4426950408889634f); }
__device__ __forceinline__ float sigmoidf_(float x) { return __builtin_amdgcn_rcpf(1.0f + fast_exp(-x)); }
__device__ __forceinline__ float siluf_(float x) { return x * sigmoidf_(x); }
__device__ __forceinline__ float gelu_tanh(float x) {
    const float x2 = x * x, t = fmaf(x2, -2.3022082299f * 0.044715f, -2.3022082299f);
    return x * __builtin_amdgcn_rcpf(1.0f + __builtin_amdgcn_exp2f(x * t));
}
__device__ __forceinline__ float log_sigmoid_acc(float x) { return fminf(x, 0.f) - log1pf(expf(-fabsf(x))); }

namespace pg8 {
#define PG8_LAS __attribute__((address_space(3)))
constexpr int BM = 256, BK = 64, HALF = 128, HTB = HALF * BK * 2, STAGE_BYTES = 8 * HTB, NXCD = 8, WGM = 8;
__host__ __device__ __forceinline__ int lds_byte(int r, int c) { const int st = (r >> 4) * 2 + (c >> 5), rr = r & 15, cc = c & 31, ob = rr * 64 + cc * 2; return st * 1024 + (ob ^ (((ob >> 9) & 1) << 5)); }
__host__ __device__ __forceinline__ void stage_rc(int b, int& R, int& C) { const int st = b / 1024, sb = b % 1024, swz = sb ^ (((sb >> 9) & 1) << 5); R = (st >> 1) * 16 + swz / 64; C = (st & 1) * 32 + (swz % 64) / 2; }
__host__ __device__ __forceinline__ int perm32(int rho) { const int n = rho >> 4, i = rho & 15; return 8 * (i >> 2) + 4 * n + (i & 3); }

struct Unit { int pm, pn, pb, kt0, nkt; };
struct Gemm { const bf16_t* A; const bf16_t* Bt; int M, N, K; };

struct StaticOrder {
    int nM, nN, nwg, G, c; int wgm = WGM;
    __host__ __device__ void init(int M, int N, int G_, int c_) { nM = M / BM; nN = N / BM; nwg = nM * nN; G = G_; c = c_; }
    __host__ __device__ __forceinline__ bool next(int i, Unit& u) const {
        const long L = (long)i * G + c; if (L >= nwg) return false;
        int wgid = (int)L; { const int q = nwg / NXCD, r = nwg % NXCD, xcd = wgid % NXCD, off = wgid / NXCD; wgid = (xcd < r ? xcd * (q + 1) : r * (q + 1) + (xcd - r) * q) + off; }
        const int nig = wgm * nN, gid = wgid / nig, fm = gid * wgm, gsz = (nM - fm) < wgm ? (nM - fm) : wgm;
        u.pm = fm + ((wgid % nig) % gsz); u.pn = (wgid % nig) / gsz; u.pb = u.pn; return true;
    }
    static constexpr bool KRANGE = false;
    __device__ __forceinline__ void a_ready(const Unit&) const {}
    __device__ __forceinline__ void done(const Unit&) const {}
};
struct MoeOrder {
    int nM, nN, nwg, G, c; int ts[9]; int wgm = WGM;
    __device__ __forceinline__ bool next(int i, Unit& u) const {
        const long L = (long)i * G + c; if (L >= nwg) return false;
        int wgid = (int)L; { const int q = nwg / NXCD, r = nwg % NXCD, xcd = wgid % NXCD, off = wgid / NXCD; wgid = (xcd < r ? xcd * (q + 1) : r * (q + 1) + (xcd - r) * q) + off; }
        const int nig = wgm * nN, gid = wgid / nig, fm = gid * wgm, gsz = (nM - fm) < wgm ? (nM - fm) : wgm;
        u.pm = fm + ((wgid % nig) % gsz); u.pn = (wgid % nig) / gsz;
        int e = 0;
#pragma unroll
        for (int k = 1; k < 8; ++k) e += (u.pm >= ts[k]) ? 1 : 0;
        u.pb = e * nN + u.pn; return true;
    }
    static constexpr bool KRANGE = false;
    __device__ __forceinline__ void a_ready(const Unit&) const {}
    __device__ __forceinline__ void done(const Unit&) const {}
};
__host__ __device__ __forceinline__ int hyb_SL(int R) { return R <= 9 ? 28 : (R <= 18 ? 14 : (R <= 36 ? 7 : 4)); }
struct HybridOrder {
    int U, c, nN, NKT, G; int ts[9];
    __device__ __forceinline__ bool next(int i, Unit& u) const {
        const bool full = i < 2; const int R = U - 512, SL = hyb_SL(R), ui = c / SL, sl = c - ui * SL;
        if (!full && (i > 2 || R <= 0 || ui >= R)) return false;
        int wgid = i * G + c; { const int q = 512 / NXCD, xcd = wgid % NXCD, off = wgid / NXCD; wgid = xcd * q + off; }
        const int nig = WGM * nN, fm = (wgid / nig) * WGM, pm_f = fm + ((wgid % nig) % WGM), pn_f = (wgid % nig) / WGM;
        const int unit = 512 + ui, pm_s = unit / nN, pn_s = unit - pm_s * nN, nk_s = NKT / SL;
        const int pm = full ? pm_f : pm_s, pn = full ? pn_f : pn_s, nkt = full ? NKT : nk_s, kt0 = full ? 0 : sl * nk_s;
        int e = 0;
#pragma unroll
        for (int k = 1; k < 8; ++k) e += (pm >= ts[k]) ? 1 : 0;
        u.pm = pm; u.pn = pn; u.pb = e * nN + pn; u.kt0 = kt0; u.nkt = nkt; return true;
    }
    static constexpr bool KRANGE = true;
    __device__ __forceinline__ void a_ready(const Unit&) const {}
    __device__ __forceinline__ void done(const Unit&) const {}
};

__device__ __forceinline__ unsigned cvt_pk_bf16(float lo, float hi) { unsigned r; asm volatile("v_cvt_pk_bf16_f32 %0, %1, %2" : "=v"(r) : "v"(lo), "v"(hi)); return r; }

struct EpiBf16 {
    static constexpr bool PERM = true, AFTER_DRAIN = false;
    bf16_t* O; int ldc; const float* cs; int rope_pn0, rope_pn1; float* norm2; int sig_pn0, gelu_pn0, gelu_pn1;
    __device__ __forceinline__ void operator()(const f32x4 (&acc)[2][2][4][2], const Unit& u, int wr, int wc, int fr, int fq) const {
        const int row0 = u.pm * BM + wr * 64 + fr; const int col0 = u.pn * BM + wc * 32 + 8 * fq;
        if (norm2 != nullptr && u.pn < 4) {
#pragma unroll
            for (int ai = 0; ai < 2; ++ai)
#pragma unroll
                for (int m = 0; m < 4; ++m)
#pragma unroll
                    for (int bj = 0; bj < 2; ++bj) { const f32x4 a0 = acc[ai][bj][m][0], a1 = acc[ai][bj][m][1];
                        float s = (a0[0] * a0[0] + a0[1] * a0[1]) + (a0[2] * a0[2] + a0[3] * a0[3]) + (a1[0] * a1[0] + a1[1] * a1[1]) + (a1[2] * a1[2] + a1[3] * a1[3]);
                        s += __shfl_xor(s, 16); s += __shfl_xor(s, 32);
                        if (fq == 0) norm2[((size_t)(row0 + ai * HALF + m * 16) * 8 + (u.pn >> 1) * 4 + (u.pn & 1) * 2 + bj) * 4 + wc] = s; }
        }
        const bool rope = (u.pn >= rope_pn0) && (u.pn < rope_pn1) && ((wc & 1) == 0);
        const float sgn = (fq == 0) ? -1.f : 1.f;
#pragma unroll
        for (int ai = 0; ai < 2; ++ai)
#pragma unroll
            for (int m = 0; m < 4; ++m) { const int row = row0 + ai * HALF + m * 16; bf16_t* rowp = O + (size_t)row * ldc + col0;
                f32x4 c0 = {1.f, 1.f, 1.f, 1.f}, c1 = c0, s0 = {0.f, 0.f, 0.f, 0.f}, s1 = s0;
                if (rope) {
                    const float pos = (float)(row & 8191);
                    constexpr float IR[8] = {0.15915494309189535f, 0.03086376340470123f, 0.0059851857127137054f, 0.001160663641240061f, 0.00022507907903927653f, 4.3647952792802891e-05f, 8.4643308082414014e-06f, 1.6414262627950345e-06f};
#pragma unroll
                    for (int k = 0; k < 4; ++k) { const float r0 = __builtin_amdgcn_fractf(pos * IR[k]), r1 = __builtin_amdgcn_fractf(pos * IR[4 + k]);
                        c0[k] = __builtin_amdgcn_cosf(r0); s0[k] = __builtin_amdgcn_sinf(r0); c1[k] = __builtin_amdgcn_cosf(r1); s1[k] = __builtin_amdgcn_sinf(r1); } }
#pragma unroll
                for (int bj = 0; bj < 2; ++bj) { f32x4 v0 = acc[ai][bj][m][0], v1 = acc[ai][bj][m][1];
                    if (u.pn >= gelu_pn0 && u.pn < gelu_pn1) {
#pragma unroll
                        for (int i = 0; i < 4; ++i) { v0[i] = gelu_tanh(v0[i]); v1[i] = gelu_tanh(v1[i]); } }
                    else if (u.pn >= sig_pn0 && u.pn < gelu_pn0) {
#pragma unroll
                        for (int i = 0; i < 4; ++i) { v0[i] = sigmoidf_(v0[i]); v1[i] = sigmoidf_(v1[i]); } }
                    if (rope) { f32x4 p0, p1;
#pragma unroll
                        for (int i = 0; i < 4; ++i) { p0[i] = __shfl_xor(v0[i], 16); p1[i] = __shfl_xor(v1[i], 16); }
                        if (fq < 2) { v0 = v0 * c0 + (p0 * s0) * sgn; v1 = v1 * c1 + (p1 * s1) * sgn; } }
                    u32x4 w; w.x = cvt_pk_bf16(v0[0], v0[1]); w.y = cvt_pk_bf16(v0[2], v0[3]); w.z = cvt_pk_bf16(v1[0], v1[1]); w.w = cvt_pk_bf16(v1[2], v1[3]);
                    *(u32x4*)(rowp + bj * HALF) = w; } }
    }
};
struct EpiResF32 {
    static constexpr bool PERM = false, AFTER_DRAIN = false;
    const float* base; float* out; int ldc;
    __device__ __forceinline__ void operator()(const f32x4 (&acc)[2][2][4][2], const Unit& u, int wr, int wc, int fr, int fq) const {
        const int row0 = u.pm * BM + wr * 64 + fr, col0 = u.pn * BM + wc * 32 + 4 * fq;
#pragma unroll
        for (int ai = 0; ai < 2; ++ai) {
            f32x4 b[4][2][2];
#pragma unroll
            for (int m = 0; m < 4; ++m) { const size_t off = (size_t)(row0 + ai * HALF + m * 16) * ldc + col0;
#pragma unroll
                for (int bj = 0; bj < 2; ++bj)
#pragma unroll
                    for (int n = 0; n < 2; ++n) b[m][bj][n] = *(const f32x4*)(base + off + bj * HALF + n * 16); }
#pragma unroll
            for (int m = 0; m < 4; ++m) { const size_t off = (size_t)(row0 + ai * HALF + m * 16) * ldc + col0;
#pragma unroll
                for (int bj = 0; bj < 2; ++bj)
#pragma unroll
                    for (int n = 0; n < 2; ++n) *(f32x4*)(out + off + bj * HALF + n * 16) = b[m][bj][n] + acc[ai][bj][m][n]; }
            asm volatile("" ::: "memory"); }
    }
};
struct EpiSwiglu {
    static constexpr bool PERM = true, AFTER_DRAIN = false;
    bf16_t* O; int ldc;
    __device__ __forceinline__ void operator()(const f32x4 (&acc)[2][2][4][2], const Unit& u, int wr, int wc, int fr, int fq) const {
        const int row0 = u.pm * BM + wr * 64 + fr; const int col0 = u.pn * HALF + wc * 32 + 8 * fq;
#pragma unroll
        for (int ai = 0; ai < 2; ++ai)
#pragma unroll
            for (int m = 0; m < 4; ++m) { bf16_t* rowp = O + (size_t)(row0 + ai * HALF + m * 16) * ldc + col0;
                f32x4 h0, h1;
#pragma unroll
                for (int i = 0; i < 4; ++i) { h0[i] = siluf_(acc[ai][0][m][0][i]) * acc[ai][1][m][0][i]; h1[i] = siluf_(acc[ai][0][m][1][i]) * acc[ai][1][m][1][i]; }
                u32x4 w; w.x = cvt_pk_bf16(h0[0], h0[1]); w.y = cvt_pk_bf16(h0[2], h0[3]); w.z = cvt_pk_bf16(h1[0], h1[1]); w.w = cvt_pk_bf16(h1[2], h1[3]);
                *(u32x4*)rowp = w; }
    }
};
#if defined(PROBE_EPI)
struct EpiNone { static constexpr bool PERM = true, AFTER_DRAIN = false; bf16_t* O; int ldc;
    __device__ __forceinline__ void operator()(const f32x4 (&acc)[2][2][4][2], const Unit& u, int wr, int wc, int fr, int fq) const {
        float s = 0.f;
#pragma unroll
        for (int ai = 0; ai < 2; ++ai)
#pragma unroll
            for (int bj = 0; bj < 2; ++bj)
#pragma unroll
                for (int m = 0; m < 4; ++m)
#pragma unroll
                    for (int n = 0; n < 2; ++n) s += acc[ai][bj][m][n][0];
        if (s == 12345.678f) O[0] = 1; } };
struct EpiSwigluCheap {
    static constexpr bool PERM = true, AFTER_DRAIN = false;
    bf16_t* O; int ldc;
    __device__ __forceinline__ void operator()(const f32x4 (&acc)[2][2][4][2], const Unit& u, int wr, int wc, int fr, int fq) const {
        const int row0 = u.pm * BM + wr * 64 + fr; const int col0 = u.pn * HALF + wc * 32 + 8 * fq;
#pragma unroll
        for (int ai = 0; ai < 2; ++ai)
#pragma unroll
            for (int m = 0; m < 4; ++m) { bf16_t* rowp = O + (size_t)(row0 + ai * HALF + m * 16) * ldc + col0;
                const f32x4 h0 = acc[ai][0][m][0] * acc[ai][1][m][0], h1 = acc[ai][0][m][1] * acc[ai][1][m][1];
                u32x4 w; w.x = cvt_pk_bf16(h0[0], h0[1]); w.y = cvt_pk_bf16(h0[2], h0[3]); w.z = cvt_pk_bf16(h1[0], h1[1]); w.w = cvt_pk_bf16(h1[2], h1[3]);
                *(u32x4*)rowp = w; }
    }
};
#endif
struct EpiMoeDown {
    static constexpr bool PERM = false, AFTER_DRAIN = false;
    float* Y; int ldc; const float* rw;
    __device__ __forceinline__ void operator()(const f32x4 (&acc)[2][2][4][2], const Unit& u, int wr, int wc, int fr, int fq) const {
        const int row0 = u.pm * BM + wr * 64 + fr, col0 = u.pn * BM + wc * 32 + 4 * fq;
#pragma unroll
        for (int ai = 0; ai < 2; ++ai)
#pragma unroll
            for (int m = 0; m < 4; ++m) { const int row = row0 + ai * HALF + m * 16; const float w = ldf(rw + row); const size_t off = (size_t)row * ldc + col0;
#pragma unroll
                for (int bj = 0; bj < 2; ++bj)
#pragma unroll
                    for (int n = 0; n < 2; ++n) *(f32x4*)(Y + off + bj * HALF + n * 16) = acc[ai][bj][m][n] * w; }
    }
};

struct EpiMoeDownSK {
    static constexpr bool PERM = true, AFTER_DRAIN = false;
    bf16_t* Y; int ldc; const float* rw; float* slab; int SL;
    __device__ __forceinline__ void operator()(const f32x4 (&acc)[2][2][4][2], const Unit& u, int wr, int wc, int fr, int fq) const {
        const int r0 = wr * 64 + fr, c0 = wc * 32 + 8 * fq; const bool second = u.kt0 != 0;
        const int sidx = second ? (u.pm * 4 + u.pn - 512) * (SL - 1) + u.kt0 / u.nkt - 1 : 0;
        float* sb = slab + (size_t)sidx * 65536 + c0; bf16_t* yb = Y + (size_t)(u.pm * BM) * ldc + u.pn * BM + c0;
        float wv[2][4];
#pragma unroll
        for (int ai = 0; ai < 2; ++ai)
#pragma unroll
            for (int m = 0; m < 4; ++m) wv[ai][m] = rw[u.pm * BM + r0 + ai * HALF + m * 16];
#pragma unroll
        for (int ai = 0; ai < 2; ++ai)
#pragma unroll
            for (int m = 0; m < 4; ++m) { const int r = r0 + ai * HALF + m * 16; const float w = wv[ai][m];
#pragma unroll
                for (int bj = 0; bj < 2; ++bj) { const f32x4 v0 = acc[ai][bj][m][0] * w, v1 = acc[ai][bj][m][1] * w;
                    if (second) { *(f32x4*)(sb + (size_t)r * 256 + bj * HALF) = v0; *(f32x4*)(sb + (size_t)r * 256 + bj * HALF + 4) = v1; }
                    else { u32x4 o; o.x = cvt_pk_bf16(v0[0], v0[1]); o.y = cvt_pk_bf16(v0[2], v0[3]); o.z = cvt_pk_bf16(v1[0], v1[1]); o.w = cvt_pk_bf16(v1[2], v1[3]); *(u32x4*)(yb + (size_t)r * ldc + bj * HALF) = o; } } }
    }
};

template <class Epi, class Sched, bool ALIGN_EPI = false, bool SP2 = false>
__device__ __forceinline__ void gemm_phase(PG8_LAS unsigned char* lds, const Gemm g, const Sched& S, const Epi& E, const int tid) {
    const int wid = __builtin_amdgcn_readfirstlane(tid >> 6), lane = tid & 63, wr = wid >> 2, wc = wid & 3, fr = lane & 15, fq = lane >> 4;
    const int K = g.K; int nt = K / BK;
    unsigned voffA[2], voffB[2];
#pragma unroll
    for (int i = 0; i < 2; ++i) { int R, C; stage_rc(tid * 16 + i * 8192, R, C); const int Rb = Epi::PERM ? ((R & ~31) + perm32(R & 31)) : R;
        voffA[i] = (unsigned)(R * K + C) * 2u; voffB[i] = (unsigned)(Rb * K + C) * 2u; }
    const size_t kstep = (size_t)(BK * 2);
    const size_t hstep = (size_t)HALF * K * 2;
    const size_t tstep = 2 * hstep;
    const unsigned ldsw = (unsigned)wid * 1024u;
    const int aoff = lds_byte(wr * 64 + fr, fq * 8), boff = lds_byte(wc * 32 + fr, fq * 8);
#define PG8_SA(b, h) (((b) * 2 + (h)) * HTB)
#define PG8_SB(b, h) ((4 + (b) * 2 + (h)) * HTB)
#define PG8_STAGE(bufoff, gbase, voff) do { _Pragma("unroll") for (int _i = 0; _i < 2; ++_i) \
        __builtin_amdgcn_global_load_lds((const unsigned*)((const char*)(gbase) + (voff)[_i]), (PG8_LAS unsigned*)(lds + (bufoff) + ldsw + _i * 8192), 16, 0, 0); } while (0)
#define PG8_LDA(dst, b, h) do { _Pragma("unroll") for (int m = 0; m < 4; ++m) _Pragma("unroll") for (int k = 0; k < 2; ++k) dst[m][k] = *(const PG8_LAS bf16x8*)(lds + PG8_SA(b, h) + aoff + m * 2048 + k * 1024); } while (0)
#define PG8_LDB(dst, b, h) do { _Pragma("unroll") for (int n = 0; n < 2; ++n) _Pragma("unroll") for (int k = 0; k < 2; ++k) dst[n][k] = *(const PG8_LAS bf16x8*)(lds + PG8_SB(b, h) + boff + n * 2048 + k * 1024); } while (0)
#define PG8_MMA(ai, bj, At, Bt) do { __builtin_amdgcn_s_setprio(1); _Pragma("unroll") for (int m = 0; m < 4; ++m) _Pragma("unroll") for (int n = 0; n < 2; ++n) _Pragma("unroll") for (int k = 0; k < 2; ++k) \
        acc[ai][bj][m][n] = __builtin_amdgcn_mfma_f32_16x16x32_bf16(Bt[n][k], At[m][k], acc[ai][bj][m][n], 0, 0, 0); __builtin_amdgcn_s_setprio(0); } while (0)
#define PG8_WAIT_V(n) asm volatile("s_waitcnt vmcnt(" #n ")" ::: "memory")
#define PG8_WAIT_L(n) asm volatile("s_waitcnt lgkmcnt(" #n ")" ::: "memory")
#define PG8_BAR __builtin_amdgcn_s_barrier()
#define PG8_SCHED __builtin_amdgcn_sched_barrier(0)
    Unit cur, nxt; int ui = 0;
    if (!S.next(0, cur)) return;
    f32x4 acc[2][2][4][2];
#pragma unroll
    for (int a = 0; a < 2; ++a)
#pragma unroll
        for (int b = 0; b < 2; ++b)
#pragma unroll
            for (int m = 0; m < 4; ++m)
#pragma unroll
                for (int n = 0; n < 2; ++n) acc[a][b][m][n] = (f32x4){0.f, 0.f, 0.f, 0.f};
    bf16x8 At[4][2], B0[2][2], B1[2][2];
    const char* cA = (const char*)g.A + (size_t)cur.pm * tstep; const char* cB = (const char*)g.Bt + (size_t)cur.pb * tstep;
    if constexpr (Sched::KRANGE) { cA += (size_t)cur.kt0 * kstep; cB += (size_t)cur.kt0 * kstep; nt = cur.nkt; }
    S.a_ready(cur);
    if constexpr (SP2) {
        PG8_STAGE(PG8_SB(0, 0), cB, voffB); PG8_STAGE(PG8_SB(0, 1), cB + hstep, voffB); PG8_STAGE(PG8_SA(0, 0), cA, voffA); PG8_STAGE(PG8_SA(0, 1), cA + hstep, voffA);
        if (wr == 1) PG8_BAR;
        PG8_WAIT_V(2); PG8_BAR;
        PG8_STAGE(PG8_SB(1, 0), cB + kstep, voffB); PG8_STAGE(PG8_SA(1, 0), cA + kstep, voffA); PG8_STAGE(PG8_SB(1, 1), cB + hstep + kstep, voffB);
        PG8_WAIT_V(6); PG8_BAR;
    } else {
        PG8_STAGE(PG8_SB(0, 0), cB, voffB); PG8_STAGE(PG8_SA(0, 0), cA, voffA); PG8_STAGE(PG8_SB(0, 1), cB + hstep, voffB); PG8_STAGE(PG8_SA(0, 1), cA + hstep, voffA);
        if (wr == 1) PG8_BAR;
        PG8_WAIT_V(4); PG8_BAR;
        PG8_STAGE(PG8_SB(1, 0), cB + kstep, voffB); PG8_STAGE(PG8_SA(1, 0), cA + kstep, voffA); PG8_STAGE(PG8_SB(1, 1), cB + hstep + kstep, voffB);
        PG8_WAIT_V(6); PG8_BAR;
    }
    for (;;) {
        const bool has_next = S.next(ui + 1, nxt);
        const char* nA = has_next ? (const char*)g.A + (size_t)nxt.pm * tstep : cA; const char* nB = has_next ? (const char*)g.Bt + (size_t)nxt.pb * tstep : cB;
        if constexpr (Sched::KRANGE) { if (has_next) { nA += (size_t)nxt.kt0 * kstep; nB += (size_t)nxt.kt0 * kstep; } }
        for (int t = 0; t < nt; t += 2) {
            const bool last = (t == nt - 2);
            const char* a1 = cA + (size_t)(t + 1) * kstep;
            const char* a2 = last ? nA : cA + (size_t)(t + 2) * kstep; const char* b2 = last ? nB : cB + (size_t)(t + 2) * kstep;
            const char* a3 = a2 + kstep; const char* b3 = b2 + kstep;
            if (last && has_next) S.a_ready(nxt);
            if constexpr (SP2) {
            PG8_LDB(B0, 0, 0); PG8_LDB(B1, 0, 1); PG8_SCHED; PG8_LDA(At, 0, 0); PG8_STAGE(PG8_SA(1, 1), a1 + hstep, voffA);
            PG8_WAIT_V(8); PG8_WAIT_L(0); PG8_BAR; PG8_MMA(0, 0, At, B0); PG8_MMA(0, 1, At, B1); PG8_BAR; PG8_SCHED;
            PG8_LDA(At, 0, 1); PG8_STAGE(PG8_SB(0, 0), b2, voffB); PG8_STAGE(PG8_SB(0, 1), b2 + hstep, voffB); PG8_STAGE(PG8_SA(0, 0), a2, voffA);
            PG8_WAIT_V(8); PG8_WAIT_L(0); PG8_BAR; PG8_MMA(1, 0, At, B0); PG8_MMA(1, 1, At, B1); PG8_BAR; PG8_SCHED;
            PG8_LDB(B0, 1, 0); PG8_LDB(B1, 1, 1); PG8_SCHED; PG8_LDA(At, 1, 0); PG8_STAGE(PG8_SA(0, 1), a2 + hstep, voffA);
            PG8_WAIT_V(8); PG8_WAIT_L(0); PG8_BAR; PG8_MMA(0, 0, At, B0); PG8_MMA(0, 1, At, B1); PG8_BAR; PG8_SCHED;
            PG8_LDA(At, 1, 1); PG8_STAGE(PG8_SB(1, 0), b3, voffB); PG8_STAGE(PG8_SB(1, 1), b3 + hstep, voffB); PG8_STAGE(PG8_SA(1, 0), a3, voffA);
            PG8_WAIT_V(8); PG8_WAIT_L(0); PG8_BAR; PG8_MMA(1, 0, At, B0); PG8_MMA(1, 1, At, B1); PG8_BAR; PG8_SCHED;
            } else {
            PG8_LDB(B0, 0, 0); PG8_SCHED; PG8_LDA(At, 0, 0); PG8_STAGE(PG8_SA(1, 1), a1 + hstep, voffA);
            PG8_WAIT_L(8); PG8_BAR; PG8_WAIT_L(0); PG8_MMA(0, 0, At, B0); PG8_BAR; PG8_SCHED;
            PG8_LDB(B1, 0, 1); PG8_STAGE(PG8_SB(0, 0), b2, voffB);
            PG8_BAR; PG8_WAIT_L(0); PG8_MMA(0, 1, At, B1); PG8_BAR;
            PG8_LDA(At, 0, 1); PG8_STAGE(PG8_SA(0, 0), a2, voffA);
            PG8_BAR; PG8_WAIT_L(0); PG8_MMA(1, 0, At, B0); PG8_BAR; PG8_SCHED;
            PG8_STAGE(PG8_SB(0, 1), b2 + hstep, voffB);
            PG8_WAIT_V(6); PG8_BAR; PG8_MMA(1, 1, At, B1); PG8_BAR;
            PG8_LDB(B0, 1, 0); PG8_SCHED; PG8_LDA(At, 1, 0); PG8_STAGE(PG8_SA(0, 1), a2 + hstep, voffA);
            PG8_WAIT_L(8); PG8_BAR; PG8_WAIT_L(0); PG8_MMA(0, 0, At, B0); PG8_BAR; PG8_SCHED;
            PG8_LDB(B1, 1, 1); PG8_STAGE(PG8_SB(1, 0), b3, voffB);
            PG8_BAR; PG8_WAIT_L(0); PG8_MMA(0, 1, At, B1); PG8_BAR;
            PG8_LDA(At, 1, 1); PG8_STAGE(PG8_SA(1, 0), a3, voffA);
            PG8_BAR; PG8_WAIT_L(0); PG8_MMA(1, 0, At, B0); PG8_BAR; PG8_SCHED;
            PG8_STAGE(PG8_SB(1, 1), b3 + hstep, voffB);
            PG8_WAIT_V(6); PG8_BAR; PG8_MMA(1, 1, At, B1); PG8_BAR;
            }
        }
        if constexpr (ALIGN_EPI) { if (wr == 0) PG8_BAR; }
        if constexpr (!Epi::AFTER_DRAIN) { E(acc, cur, wr, wc, fr, fq); S.done(cur); }
        if (!has_next) break;
#pragma unroll
        for (int a = 0; a < 2; ++a)
#pragma unroll
            for (int b = 0; b < 2; ++b)
#pragma unroll
                for (int m = 0; m < 4; ++m)
#pragma unroll
                    for (int n = 0; n < 2; ++n) acc[a][b][m][n] = (f32x4){0.f, 0.f, 0.f, 0.f};
        cur = nxt; cA = nA; cB = nB; ++ui;
        if constexpr (Sched::KRANGE) nt = cur.nkt;
        if constexpr (ALIGN_EPI) { if (wr == 1) PG8_BAR; }
    }
    PG8_WAIT_V(0);
    if constexpr (!ALIGN_EPI) { if (wr == 0) PG8_BAR; }
    PG8_BAR;
#undef PG8_SA
#undef PG8_SB
#undef PG8_STAGE
#undef PG8_LDA
#undef PG8_LDB
#undef PG8_MMA
#undef PG8_WAIT_V
#undef PG8_WAIT_L
#undef PG8_BAR
#undef PG8_SCHED
}
}
namespace att {
constexpr int NW = 8, QBLK = 32, KVBLK = 64, QB = NW * QBLK, PITCH = 3072, DV = 128;
constexpr int SHM_V = KVBLK * DV * 2;
constexpr int LDS_V = 0, LDS_K = 2 * SHM_V, LDS_WS = 65536, LDS_BYTES = LDS_WS + NW * 64 * 4;
constexpr float THR = 8.f;
template <int DK> struct Cfg { static constexpr int SHM_K = KVBLK * DK * 2; static constexpr float SCALE = (DK == 128) ? 0.08838834764831845f : 0.125f; };

#define KSWZ(row, colB) ((row) * 256 + ((colB) ^ (((row) & 7) << 4)))
#define KSWZ64(row, ch) ((row) * 128 + ((((ch) ^ (((row) >> 1) & 7))) << 4))
#define SBAR() __builtin_amdgcn_sched_barrier(0)
__device__ __forceinline__ int v_st(int k, int c) { const int kk = (k & ~0xC) | ((k & 4) << 1) | ((k & 8) >> 1); return ((kk >> 3) * 4 + (c >> 5)) * 512 + ((kk & 7) * 32 + (c & 31)) * 2; }
__device__ __forceinline__ int v_rd_base(int lane) { return ((lane & 3) << 3) | (((lane >> 2) & 3) << 6) | (((lane >> 4) & 1) << 5) | (((lane >> 5) & 1) << 8); }
constexpr int v_rd_off(int d0, int ks, int half) { return d0 * 512 + ks * 4096 + half * 2048; }
__device__ __forceinline__ int crow(int r, int hi) { return (r & 3) + 8 * (r >> 2) + 4 * hi; }
__device__ __forceinline__ unsigned cvtpk(float lo, float hi) { unsigned r; asm volatile("v_cvt_pk_bf16_f32 %0, %1, %2" : "=v"(r) : "v"(lo), "v"(hi)); return r; }
__device__ __forceinline__ bf16x8 load8(const bf16* p) { return *reinterpret_cast<const bf16x8*>(p); }
__device__ __forceinline__ void mask_tile(f32x16& p0, f32x16& p1, int dq) {
    const float NEG = -__builtin_inff();
#pragma unroll
    for (int r = 0; r < 16; ++r) {
        const int c = (r & 3) + 8 * (r >> 2);
        if (dq - c < 0) p0[r] = NEG;
        if (dq - c - 32 < 0) p1[r] = NEG;
    }
}
template <int DK>
__device__ __forceinline__ void partialSM(f32x16& p0, f32x16& p1, float& m_reg, float& mn, float& alpha) {
    constexpr float SCALE = Cfg<DK>::SCALE;
    float pmax = p0[0]; for (int r = 1; r < 16; ++r) pmax = fmaxf(pmax, p0[r]); for (int r = 0; r < 16; ++r) pmax = fmaxf(pmax, p1[r]);
    { auto rr = __builtin_amdgcn_permlane32_swap(__float_as_uint(pmax), __float_as_uint(pmax), false, false);
      pmax = fmaxf(__uint_as_float(rr[0]), __uint_as_float(rr[1])); }
    constexpr float C2 = 1.4426950408889634f * SCALE;
    if (__builtin_expect(__all((pmax - m_reg) * SCALE <= THR), 1)) { mn = m_reg; alpha = 1.f; }
    else { mn = fmaxf(m_reg, pmax); alpha = __builtin_amdgcn_exp2f((m_reg - mn) * C2); m_reg = mn; }
    const float mnL = -mn * C2;
    for (int r = 0; r < 16; ++r) p0[r] = fmaf(p0[r], C2, mnL); for (int r = 0; r < 16; ++r) p1[r] = fmaf(p1[r], C2, mnL);
    for (int r = 0; r < 16; ++r) p0[r] = __builtin_amdgcn_exp2f(p0[r]);
}
__device__ __forceinline__ void finishSM(f32x16& p0, f32x16& p1, float alpha, float& l_reg, bf16x8& pa0, bf16x8& pa1, bf16x8& pa2, bf16x8& pa3) {
    for (int r = 0; r < 16; ++r) p1[r] = __builtin_amdgcn_exp2f(p1[r]);
    float ps = 0; for (int r = 0; r < 16; ++r) ps += p0[r]; for (int r = 0; r < 16; ++r) ps += p1[r];
    { auto rr = __builtin_amdgcn_permlane32_swap(__float_as_uint(ps), __float_as_uint(ps), false, false);
      ps = __uint_as_float(rr[0]) + __uint_as_float(rr[1]); }
    l_reg = l_reg * alpha + ps;
#define PK4(P, B_, OUT) do { unsigned a0 = cvtpk(P[B_+0], P[B_+1]), a1 = cvtpk(P[B_+2], P[B_+3]);                          \
        unsigned b0 = cvtpk(P[B_+4], P[B_+5]), b1 = cvtpk(P[B_+6], P[B_+7]);                                             \
        auto r0 = __builtin_amdgcn_permlane32_swap(a0, b0, false, false); auto r1 = __builtin_amdgcn_permlane32_swap(a1, b1, false, false); \
        u32x4 w = {r0[0], r1[0], r0[1], r1[1]}; OUT = *reinterpret_cast<bf16x8*>(&w); } while (0)
    PK4(p0, 0, pa0); PK4(p0, 8, pa1); PK4(p1, 0, pa2); PK4(p1, 8, pa3);
#undef PK4
}
__device__ __forceinline__ bf16x8 bias_frag(u32x2 kb, int hi) { u32x4 w = {hi ? 0u : kb.x, hi ? 0u : kb.y, 0u, 0u}; return *reinterpret_cast<bf16x8*>(&w); }
template <int KB, int DK, bool BIAS>
__device__ __forceinline__ void qkt(f32x16& p0, f32x16& p1, const char* K_lds, int r32, int hi, const bf16x8* qr, u32x2 kb0, u32x2 kb1) {
    constexpr int SHM_K = Cfg<DK>::SHM_K;
    p0 = f32x16{}; p1 = f32x16{};
    if constexpr (DK == 128) {
        const char* kb[4];
#pragma unroll
        for (int dd = 0; dd < 4; ++dd) kb[dd] = K_lds + KB * SHM_K + KSWZ(r32, (dd * 16 + hi * 8) * 2);
#pragma unroll
        for (int d0 = 0; d0 < 8; ++d0) { const char* a = kb[d0 & 3] + (d0 >> 2) * 128;
            bf16x8 b0 = *reinterpret_cast<const bf16x8*>(a);
            bf16x8 b1 = *reinterpret_cast<const bf16x8*>(a + 32 * 256);
            p0 = __builtin_amdgcn_mfma_f32_32x32x16_bf16(b0, qr[d0], p0, 0, 0, 0);
            p1 = __builtin_amdgcn_mfma_f32_32x32x16_bf16(b1, qr[d0], p1, 0, 0, 0); }
    } else {
#pragma unroll
        for (int d0 = 0; d0 < 4; ++d0) { const char* a = K_lds + KB * SHM_K + KSWZ64(r32, 2 * d0 + hi);
            bf16x8 b0 = *reinterpret_cast<const bf16x8*>(a);
            bf16x8 b1 = *reinterpret_cast<const bf16x8*>(a + 32 * 128);
            p0 = __builtin_amdgcn_mfma_f32_32x32x16_bf16(b0, qr[d0], p0, 0, 0, 0);
            p1 = __builtin_amdgcn_mfma_f32_32x32x16_bf16(b1, qr[d0], p1, 0, 0, 0); }
    }
    if constexpr (BIAS) {
        u32x4 ow = {hi ? 0u : 0x3f803f80u, hi ? 0u : 0x00003f80u, 0u, 0u}; const bf16x8 qone = *reinterpret_cast<bf16x8*>(&ow);
        p0 = __builtin_amdgcn_mfma_f32_32x32x16_bf16(bias_frag(kb0, hi), qone, p0, 0, 0, 0);
        p1 = __builtin_amdgcn_mfma_f32_32x32x16_bf16(bias_frag(kb1, hi), qone, p1, 0, 0, 0);
    }
}
template <int VB>
__device__ __forceinline__ void pv_tile(f32x16* o, int vb0, bf16x8 pa0, bf16x8 pa1, bf16x8 pa2, bf16x8 pa3) {
#define TRRD(dst, off) asm volatile("ds_read_b64_tr_b16 %0, %1 offset:%2" : "=&v"(dst) : "v"(vb0), "i"(off) : "memory")
#define PV_D0(d0) do { s16x4 l0, l1, l2, l3, h0, h1, h2, h3; constexpr int b_ = VB * SHM_V + v_rd_off(d0, 0, 0); \
        TRRD(l0, b_); TRRD(h0, b_ + 2048); TRRD(l1, b_ + 4096); TRRD(h1, b_ + 6144); TRRD(l2, b_ + 8192); TRRD(h2, b_ + 10240); TRRD(l3, b_ + 12288); TRRD(h3, b_ + 14336); \
        asm volatile("s_waitcnt lgkmcnt(0)" ::: "memory"); SBAR();   \
        o[d0] = __builtin_amdgcn_mfma_f32_32x32x16_bf16(pa0, (bf16x8){l0[0], l0[1], l0[2], l0[3], h0[0], h0[1], h0[2], h0[3]}, o[d0], 0, 0, 0);   \
        o[d0] = __builtin_amdgcn_mfma_f32_32x32x16_bf16(pa1, (bf16x8){l1[0], l1[1], l1[2], l1[3], h1[0], h1[1], h1[2], h1[3]}, o[d0], 0, 0, 0);   \
        o[d0] = __builtin_amdgcn_mfma_f32_32x32x16_bf16(pa2, (bf16x8){l2[0], l2[1], l2[2], l2[3], h2[0], h2[1], h2[2], h2[3]}, o[d0], 0, 0, 0);   \
        o[d0] = __builtin_amdgcn_mfma_f32_32x32x16_bf16(pa3, (bf16x8){l3[0], l3[1], l3[2], l3[3], h3[0], h3[1], h3[2], h3[3]}, o[d0], 0, 0, 0); } while (0)
    PV_D0(0); PV_D0(1); PV_D0(2); PV_D0(3);
#undef PV_D0
#undef TRRD
}

struct BlockRef { const bf16* Q; const bf16* K; const bf16* V; const u32x2* KB; int P0, JLO; };
template <int DK> struct Seam { bf16x8 qr[DK / 16]; bf16x8 st_v0, st_v1, st_k0, st_k1; u32x2 kbn0, kbn1; };
#define AROW(p, k0, rr) ((p) + (size_t)((k0) + (rr)) * PITCH + sc)
#define VMW() asm volatile("s_waitcnt vmcnt(0)" ::: "memory")
#define VMWN(n) asm volatile("s_waitcnt vmcnt(%0)" :: "i"(n) : "memory")
#define SLOAD_H(R_, k0) do { S.st_v0 = load8(AROW((R_).V, k0, sr)); S.st_v1 = load8(AROW((R_).V, k0, 32 + sr));                                   \
        if constexpr (DK == 128) { S.st_k0 = load8(AROW((R_).K, k0, sr)); S.st_k1 = load8(AROW((R_).K, k0, 32 + sr)); }                            \
        else { S.st_k0 = load8((R_).K + (size_t)((k0) + (tid >> 3)) * PITCH + (tid & 7) * 8); }                                                    \
        if constexpr (BIAS) { S.kbn0 = (R_).KB[(k0) + r32]; S.kbn1 = (R_).KB[(k0) + 32 + r32]; } } while (0)
#define SWRITE_HK(bf) do { if constexpr (DK == 128) { *(bf16x8*)(K_lds + (bf) * SHM_K + kws) = S.st_k0; *(bf16x8*)(K_lds + (bf) * SHM_K + kws + 32 * 256) = S.st_k1; } \
        else { *(bf16x8*)(K_lds + (bf) * SHM_K + kws) = S.st_k0; } } while (0)
#define SWRITE_HV(bf) do { *(bf16x8*)(V_lds + (bf) * SHM_V + vst0) = S.st_v0; *(bf16x8*)(V_lds + (bf) * SHM_V + vst1) = S.st_v1; } while (0)
#define SWRITE_H(bf) do { SWRITE_HV(bf); SWRITE_HK(bf); } while (0)
template <int DK, bool BIAS>
__device__ __forceinline__ void causal_prime(const BlockRef& cur, char* lds, Seam<DK>& S, int tid) {
    constexpr int SHM_K = Cfg<DK>::SHM_K;
    const int wid = __builtin_amdgcn_readfirstlane(tid >> 6), lane = tid & 63, r32 = lane & 31, hi = lane >> 5;
    const int sr = tid >> 4, sc = (tid & 15) * 8; const int kws = (DK == 128) ? KSWZ(sr, sc * 2) : KSWZ64(tid >> 3, tid & 7); char* K_lds = lds + LDS_K;
#pragma unroll
    for (int d0 = 0; d0 < DK / 16; ++d0) S.qr[d0] = load8(cur.Q + (size_t)(wid * QBLK + r32) * PITCH + d0 * 16 + hi * 8);
    SLOAD_H(cur, cur.JLO * KVBLK); VMW(); SWRITE_HK(0);
    __syncthreads();
}
template <int DK, bool BIAS, int OUT>
__device__ __forceinline__ void causal_block(const BlockRef& cur, const BlockRef& nxt, char* lds, Seam<DK>& S, void* Oblk, int opitch, int tid) {
    constexpr int SHM_K = Cfg<DK>::SHM_K;
    const int wid = __builtin_amdgcn_readfirstlane(tid >> 6), lane = tid & 63, r32 = lane & 31, hi = lane >> 5;
    const int NT = (cur.P0 + QB) / KVBLK - cur.JLO;
    const int qlo = cur.P0 + wid * QBLK, qm = qlo + r32 - 4 * hi;
    char* V_lds = lds + LDS_V; char* K_lds = lds + LDS_K;
    float* ws = (float*)(lds + LDS_WS) + wid * 64; float* li_l = ws, * al_l = ws + 32;
    float m_reg = -1e30f, l_reg = 0; f32x16 o[4] = {};
    const int sr = tid >> 4, sc = (tid & 15) * 8, vst0 = v_st(sr, sc), vst1 = v_st(32 + sr, sc);
    const int kws = (DK == 128) ? KSWZ(sr, sc * 2) : KSWZ64(tid >> 3, tid & 7);
    const int vb0 = (int)(uintptr_t)V_lds + v_rd_base(lane);
#define RESC(a) do { if (__any((a) < 1.f)) { if (hi == 0) al_l[r32] = (a); asm volatile("s_waitcnt lgkmcnt(0)" ::: "memory");              \
                     for (int d_ = 0; d_ < 4; ++d_) for (int r = 0; r < 16; ++r) o[d_][r] *= al_l[crow(r, hi)]; } } while (0)
#define KBASE(t) ((cur.JLO + (t)) * KVBLK)
#define MASKT(P0_, P1_, t) do { const int kb_ = KBASE(t); if (kb_ + KVBLK - 1 > qlo) mask_tile(P0_, P1_, qm - kb_); } while (0)
    constexpr int NQL = DK / 16;
#define SEAM_K0() do { VMWN(NQL); SWRITE_HK(0); SBAR(); } while (0)
    f32x16 pA0, pA1, pB0, pB1; float mnA, mnB, alA, alB; bf16x8 pa0, pa1, pa2, pa3;
    SWRITE_HV(0); SBAR();
    qkt<0, DK, BIAS>(pA0, pA1, K_lds, r32, hi, S.qr, S.kbn0, S.kbn1); SBAR();
    if (NT > 1) { SLOAD_H(cur, KBASE(1)); }
    SBAR();
    MASKT(pA0, pA1, 0); partialSM<DK>(pA0, pA1, m_reg, mnA, alA);
    if (NT > 1) { VMW(); SWRITE_H(1); }
    __syncthreads();
#define HALF_STEP(PX0, PX1, mnX, alX, PY0, PY1, alY, t, KB, VB, SB) do {                                                      \
        SBAR(); qkt<KB, DK, BIAS>(PX0, PX1, K_lds, r32, hi, S.qr, S.kbn0, S.kbn1);                                            \
        finishSM(PY0, PY1, alY, l_reg, pa0, pa1, pa2, pa3); SBAR();                                                           \
        if ((t) + 1 < NT) { SLOAD_H(cur, KBASE((t) + 1)); SBAR(); }                                                           \
        pv_tile<VB>(o, vb0, pa0, pa1, pa2, pa3); MASKT(PX0, PX1, (t)); partialSM<DK>(PX0, PX1, m_reg, mnX, alX);              \
        __syncthreads();                                                                                                      \
        if ((t) + 1 < NT) { VMW(); SWRITE_H(SB); }                                                                            \
        RESC(alX); __syncthreads(); } while (0)
    for (int t = 1; t + 1 < NT; t += 2) {
        HALF_STEP(pB0, pB1, mnB, alB, pA0, pA1, alA, t, 1, 0, 0);
        HALF_STEP(pA0, pA1, mnA, alA, pB0, pB1, alB, t + 1, 0, 1, 1);
    }
    const bool even = (NT & 1) == 0;
    if (even) { SBAR(); qkt<1, DK, BIAS>(pB0, pB1, K_lds, r32, hi, S.qr, S.kbn0, S.kbn1); SBAR(); }
    SLOAD_H(nxt, nxt.JLO * KVBLK); SBAR();
#pragma unroll
    for (int d0 = 0; d0 < DK / 16; ++d0) S.qr[d0] = load8(nxt.Q + (size_t)(wid * QBLK + r32) * PITCH + d0 * 16 + hi * 8);
    SBAR();
    finishSM(pA0, pA1, alA, l_reg, pa0, pa1, pa2, pa3); SBAR();
    pv_tile<0>(o, vb0, pa0, pa1, pa2, pa3);
    if (even) { MASKT(pB0, pB1, NT - 1); partialSM<DK>(pB0, pB1, m_reg, mnB, alB); __syncthreads(); RESC(alB);
        finishSM(pB0, pB1, alB, l_reg, pa0, pa1, pa2, pa3); SBAR(); pv_tile<1>(o, vb0, pa0, pa1, pa2, pa3); }
    SBAR(); SEAM_K0();
    if (hi == 0) li_l[r32] = l_reg; asm volatile("s_waitcnt lgkmcnt(0)" ::: "memory");
    float rli[16];
#pragma unroll
    for (int r = 0; r < 16; ++r) rli[r] = __builtin_amdgcn_rcpf(li_l[crow(r, hi)]);
#pragma unroll
    for (int r = 0; r < 16; ++r) { const int orow = wid * QBLK + crow(r, hi);
#pragma unroll
        for (int d0 = 0; d0 < 4; ++d0) { const float v = o[d0][r] * rli[r];
            if constexpr (OUT == 1) { ((float*)Oblk)[(size_t)orow * opitch + d0 * 32 + r32] = v; }
            else { const float vn = __shfl_xor(v, 1);
                   if ((r32 & 1) == 0) *(unsigned*)((bf16*)Oblk + (size_t)orow * opitch + d0 * 32 + r32) = cvtpk(v, vn); } } }
    __syncthreads();
#undef RESC
#undef KBASE
#undef MASKT
#undef SEAM_K0
#undef HALF_STEP
}
#undef AROW
#undef VMW
#undef VMWN
#undef SLOAD_H
#undef SWRITE_HK
#undef SWRITE_HV
#undef SWRITE_H
}
constexpr int T = 16384, DM = 1024, SEQ = 8192, NWAVES = 8, NTHR = 512, GRID = 256;
constexpr float EPS = 1e-6f;
constexpr int ZP = 3072;
constexpr int FF = 2816, FFE = 3584, NEXP = 8;
constexpr int XP_ROWS = 34816;
constexpr size_t MiB = 1u << 20, KiB = 1024;
constexpr size_t WS_CTL = 0, CTL_ZERO_BYTES = 65536;
constexpr size_t WS_SLOT = 1 * MiB, SLOT = 256 * KiB;
constexpr size_t WS_ROPE = WS_SLOT + 0 * SLOT;
constexpr size_t WS_LI = WS_SLOT + 2 * SLOT;
constexpr size_t WS_LF = WS_SLOT + 3 * SLOT;
constexpr size_t WS_LFX = WS_SLOT + 4 * SLOT;
constexpr size_t WS_KB = WS_SLOT + 14 * SLOT;
constexpr size_t WS_RTE = WS_SLOT + 6 * SLOT;
constexpr size_t WS_RTW = WS_SLOT + 7 * SLOT;
constexpr size_t WS_PPOS = WS_SLOT + 8 * SLOT;
constexpr size_t WS_RW = WS_SLOT + 9 * SLOT;
constexpr size_t WS_MISC = WS_SLOT + 10 * SLOT;
constexpr size_t WS_NH = WS_SLOT + 11 * SLOT;
constexpr size_t WS_NP = WS_SLOT + 12 * SLOT;
constexpr size_t WS_SGW = WS_SLOT + 13 * SLOT;
constexpr size_t WS_NORM2 = 5 * MiB;
constexpr size_t MISC_CNT = 0, MISC_MG = 8192, MISC_BL = 10240, MISC_MP = 12288, MISC_LAM = 14336, MISC_TS = 14400;
constexpr size_t WS_W_EIN = 8 * MiB, WS_W_EOUT = 14 * MiB, WS_W_FGU = 16 * MiB, WS_W_FDN = 27 * MiB, WS_W_OIN = 33 * MiB, WS_W_OOUT = 39 * MiB, WS_W_MGU = 41 * MiB, WS_W_MDN = 153 * MiB;
constexpr size_t WS_XR = 210 * MiB;
constexpr size_t WS_XN = 274 * MiB;
constexpr size_t WS_CAT = 306 * MiB;
constexpr size_t WS_ARENA = 338 * MiB;
constexpr size_t WS_CH = 576 * MiB;
constexpr size_t WS_CP = 608 * MiB;
constexpr size_t WS_DO = 576 * MiB;
constexpr size_t WS_XP = 640 * MiB;
constexpr size_t WS_Y = 708 * MiB;
constexpr size_t WS_END = 844 * MiB;
static_assert(WS_W_MDN + (size_t)NEXP * DM * FFE * 2 <= WS_XR && WS_ARENA + (size_t)XP_ROWS * FFE * 2 <= WS_CH && WS_XP + (size_t)XP_ROWS * DM * 2 <= WS_Y && WS_Y + (size_t)XP_ROWS * DM * 4 <= WS_END, "ws map");
constexpr int CW_BAR = 4096, CW_QUEUE = 8192;
constexpr int LDS_BYTES = 155648, LDSCTL_OFF = 151552;
constexpr int TS_ = 136;
constexpr int TILE_B = 128 * TS_ * 2;

#define XB_TMO      128
#define XB_XCNT(j)  (256  + 64 * (j))
#define XB_XSUB(j)  (1280 + 64 * (j))
#define XB_XGEN(j)  (2304 + 64 * (j))
#define XB_TOP      3328
#define XB_TOPGEN   3392
#define XCD_BAR_WORDS 3456
#define XB_SPIN_CAP (1u << 18)
__device__ __forceinline__ unsigned xb_ld(unsigned* p)              { return __hip_atomic_load(p, __ATOMIC_RELAXED, __HIP_MEMORY_SCOPE_AGENT); }
__device__ __forceinline__ unsigned xb_add(unsigned* p, unsigned v) { return __hip_atomic_fetch_add(p, v, __ATOMIC_RELAXED, __HIP_MEMORY_SCOPE_AGENT); }
__device__ __forceinline__ unsigned xb_xcc_id() { return (unsigned)__builtin_amdgcn_s_getreg((3 << 11) | 20) & 0xFu; }
#define XB_SPIN(cond, bar) do { unsigned _sp = 0; while (cond) { __builtin_amdgcn_s_sleep(1); \
    if ((++_sp & 255u) == 0u) { if (xb_ld(&(bar)[XB_TMO])) break; if (_sp > XB_SPIN_CAP) { atomicAdd(&(bar)[XB_TMO], 1u); break; } } } } while (0)
struct XcdBarrier { unsigned* bar; unsigned x; volatile LAS unsigned* st; };
__device__ __forceinline__ XcdBarrier xcd_barrier_post(unsigned* bar, volatile LAS unsigned* st) {
    XcdBarrier b; b.bar = bar; b.x = xb_xcc_id(); b.st = st;
    if (threadIdx.x == 0) (void)xb_add(&bar[XB_XCNT(b.x)], 1u);
    return b;
}
__device__ __forceinline__ void xcd_barrier_complete(unsigned* bar, unsigned x, unsigned& nloc, unsigned& nx) {
    const unsigned G = gridDim.x * gridDim.y * gridDim.z;
    unsigned sum, cnt, mine, sp = 0u;
    for (;;) {
        sum = 0u; cnt = 0u; mine = 0u;
#pragma unroll
        for (unsigned j = 0; j < 16; ++j) { const unsigned c = xb_ld(&bar[XB_XCNT(j)]); sum += c; cnt += (c > 0u) ? 1u : 0u; mine = (j == x) ? c : mine; }
        if (sum == G) break;
        __builtin_amdgcn_s_sleep(1);
        if ((++sp & 255u) == 0u) { if (xb_ld(&bar[XB_TMO])) break; if (sp > XB_SPIN_CAP) { atomicAdd(&bar[XB_TMO], 1u); break; } }
    }
    nloc = mine > 0u ? mine : 1u; nx = cnt > 0u ? cnt : 1u;
}
__device__ __forceinline__ void xcd_barrier(const XcdBarrier& b) {
    asm volatile("s_waitcnt vmcnt(0)" ::: "memory");
    __syncthreads();
    if (threadIdx.x == 0) {
        unsigned* bar = b.bar;
        __builtin_amdgcn_s_waitcnt(0);
        unsigned nloc = b.st[0], nx = b.st[1];
        if (nloc == 0u) { xcd_barrier_complete(bar, b.x, nloc, nx); b.st[0] = nloc; b.st[1] = nx; }
        const unsigned old = xb_add(&bar[XB_XSUB(b.x)], 1u);
        const unsigned gen = old / nloc;
        if (old + 1u == (gen + 1u) * nloc) {
            __builtin_amdgcn_fence(__ATOMIC_RELEASE, "agent");
            asm volatile("s_waitcnt vmcnt(0)" ::: "memory");
            const unsigned og = xb_add(&bar[XB_TOP], 1u);
            const unsigned tg = og / nx;
            if (og + 1u == (tg + 1u) * nx) xb_add(&bar[XB_TOPGEN], 1u);
            else XB_SPIN(xb_ld(&bar[XB_TOPGEN]) == tg, bar);
            __builtin_amdgcn_fence(__ATOMIC_ACQUIRE, "agent");
            xb_add(&bar[XB_XGEN(b.x)], 1u);
            asm volatile("s_waitcnt vmcnt(0)" ::: "memory");
        } else {
            XB_SPIN(xb_ld(&bar[XB_XGEN(b.x)]) == gen, bar);
            __builtin_amdgcn_fence(__ATOMIC_ACQUIRE, "agent");
            asm volatile("s_waitcnt vmcnt(0)" ::: "memory");
        }
    }
    __syncthreads();
}

struct Args { const float* in[25]; float* out; unsigned char* ws; int ph_lo, ph_hi; };
#define KARGS const __attribute__((address_space(4))) Args
__device__ __forceinline__ const float* ain(KARGS& a, int k) { return (const float*)(const GAS float*)a.in[k]; }
struct Ctx { LAS unsigned char* lds; unsigned char* ws; int tid, lane, wave, bid; };

struct ConvItem { const float* src; bf16* dst; int ldw, K; };
__device__ __forceinline__ int src_col(int type, int n0, int ffh) {
    const int pn = n0 >> 8, j = n0 & 255;
    const int t3 = j < 128 ? 128 * pn + j : ffh + 128 * pn + (j - 128);
    return type == 1 ? (n0 < 2048 ? n0 : n0 + 8) : (type == 2 ? (n0 < 1536 ? n0 : n0 + 4) : (type == 3 ? t3 : n0));
}
__device__ __forceinline__ ConvItem conv_decode(KARGS& a, unsigned char* ws, int it) {
    constexpr int I_EIN = 16 * 96, I_EOUT = 16 * 32, I_FGU = 16 * 176, I_FDN = 44 * 32, I_OIN = 16 * 96, I_OOUT = 16 * 32, I_MGU = 16 * 224, I_MDN = 56 * 32;
    constexpr int C1 = I_EIN, C2 = C1 + I_EOUT, C3 = C2 + I_FGU, C4 = C3 + I_FDN, C5 = C4 + I_OIN, C6 = C5 + I_OOUT, C7 = C6 + NEXP * I_MGU;
    const int kind = (it >= C1) + (it >= C2) + (it >= C3) + (it >= C4) + (it >= C5) + (it >= C6) + (it >= C7);
#define SEL8(v0, v1, v2, v3, v4, v5, v6, v7) (kind == 0 ? (v0) : kind == 1 ? (v1) : kind == 2 ? (v2) : kind == 3 ? (v3) : kind == 4 ? (v4) : kind == 5 ? (v5) : kind == 6 ? (v6) : (v7))
    const int base = SEL8(0, C1, C2, C3, C4, C5, C6, C7), per = SEL8(I_EIN, I_EOUT, I_FGU, I_FDN, I_OIN, I_OOUT, I_MGU, I_MDN);
    int r = it - base; const int e = r / per; r -= e * per;
    const int ldw = SEL8(3080, 1024, 2 * FF, 1024, 3076, 1024, 2 * FFE, 1024), K = SEL8(1024, 1024, 1024, FF, 1024, 1024, 1024, FFE), N = SEL8(3072, 1024, 2 * FF, 1024, 3072, 1024, 2 * FFE, 1024);
    const int type = SEL8(1, 0, 3, 0, 2, 0, 3, 0), ffh = SEL8(0, 0, FF, 0, 0, 0, FFE, 0);
    const float* W = SEL8(ain(a, 2), ain(a, 10), ain(a, 12), ain(a, 13), ain(a, 15), ain(a, 19), ain(a, 22), ain(a, 23));
    const size_t wso = SEL8(WS_W_EIN, WS_W_EOUT, WS_W_FGU, WS_W_FDN, WS_W_OIN, WS_W_OOUT, WS_W_MGU, WS_W_MDN);
#undef SEL8
    const int nblk = N / 32, kb = r / nblk, nb = r - kb * nblk, k0 = 64 * kb, n0 = 32 * nb;
    ConvItem c; c.ldw = ldw; c.K = K;
    c.src = W + (size_t)e * K * ldw + (size_t)k0 * ldw + src_col(type, n0, ffh);
    c.dst = (bf16*)(ws + wso) + (size_t)e * N * K + (size_t)n0 * K + k0;
    return c;
}
__device__ __forceinline__ void conv_load(const ConvItem& c, int lane, f32x4 (&v)[8]) {
    const int kl = lane >> 3, n4 = (lane & 7) * 4;
#pragma unroll
    for (int i = 0; i < 8; ++i) v[i] = __builtin_nontemporal_load((const f32x4*)(c.src + (size_t)(kl + 8 * i) * c.ldw + n4));
}
__device__ __forceinline__ void conv_finish(const ConvItem& c, int lane, const f32x4 (&v)[8], LAS float* scr) {
    const int kl = lane >> 3, n4 = (lane & 7) * 4;
#pragma unroll
    for (int i = 0; i < 8; ++i) { LAS float* d = scr + (kl + 8 * i) * 33 + n4; d[0] = v[i].x; d[1] = v[i].y; d[2] = v[i].z; d[3] = v[i].w; }
    LDS_WAIT(); asm volatile("" ::: "memory");
    const int cc = lane & 7;
#pragma unroll
    for (int j = 0; j < 4; ++j) { const int n = (lane >> 3) + 8 * j; const LAS float* s = scr + (8 * cc) * 33 + n;
        u32x4 o; o.x = pk2(s[0 * 33], s[1 * 33]); o.y = pk2(s[2 * 33], s[3 * 33]); o.z = pk2(s[4 * 33], s[5 * 33]); o.w = pk2(s[6 * 33], s[7 * 33]);
        *(u32x4*)(c.dst + (size_t)n * c.K + 8 * cc) = o; }
    LDS_WAIT(); asm volatile("" ::: "memory");
}
constexpr int CONV_DENSE_ITEMS = 16 * 96 + 16 * 32 + 16 * 176 + 44 * 32 + 16 * 96 + 16 * 32, CONV_ALL_ITEMS = CONV_DENSE_ITEMS + NEXP * (16 * 224 + 56 * 32);
template <int LO, int HI, bool REV>
__device__ __forceinline__ void prologue_weights(KARGS& a, const Ctx& c) {
    LAS float* scr = (LAS float*)(c.lds + c.wave * 16384);
    const int gw = c.bid * NWAVES + c.wave, NGW = GRID * NWAVES;
    constexpr int NITEMS = HI - LO;
#define CONV_IT(i) (REV ? HI - 1 - (i) : LO + (i))
    int it = gw; if (it >= NITEMS) return;
    f32x4 va[8], vb[8]; ConvItem d0 = conv_decode(a, c.ws, CONV_IT(it)), d1 = d0; conv_load(d0, c.lane, va);
    for (;;) {
        const int it1 = it + NGW; const bool has1 = it1 < NITEMS;
        if (has1) { d1 = conv_decode(a, c.ws, CONV_IT(it1)); conv_load(d1, c.lane, vb); }
        conv_finish(d0, c.lane, va, scr);
        if (!has1) break;
        it = it1 + NGW; const bool has0 = it < NITEMS;
        if (has0) { d0 = conv_decode(a, c.ws, CONV_IT(it)); conv_load(d0, c.lane, va); }
        conv_finish(d1, c.lane, vb, scr);
        if (!has0) break;
    }
#undef CONV_IT
}
__device__ __forceinline__ void prologue_tables(KARGS& a, const Ctx& c) {
    const int gt = c.bid * NTHR + c.tid, NGT = GRID * NTHR;
    bf16* sgw = (bf16*)(c.ws + WS_SGW); const float* w = ain(a, 8);
    for (int i = gt; i < 4 * 128 * 128; i += NGT) { const int tt = (i >> 7) & 127, ss = i & 127; sgw[i] = (bf16)(ss <= tt ? f2bf(w[i]) : 0u); }
    if (c.bid == 0 && c.wave == 0) { const float* l = ain(a, 17); const float p0 = wave_sum(l[c.lane] * l[64 + c.lane]), p1 = wave_sum(l[128 + c.lane] * l[192 + c.lane]);
        const float lambda_init = 0.8f - 0.6f * expf(-0.3f);
        if (c.lane == 0) *(float*)(c.ws + WS_MISC + MISC_LAM) = expf(p0) - expf(p1) + lambda_init; }
}

template <int NC> __device__ __forceinline__ void stage_wxt(const Ctx& c, const float* W, int ldw, int col0) {
    LAS float* wxt = (LAS float*)c.lds;
    for (int i = c.tid; i < NC * 1024; i += NTHR) { const int cc = i >> 10, k = i & 1023; wxt[i] = W[(size_t)k * ldw + col0 + cc]; }
    __syncthreads();
}
template <int MODE> __device__ __forceinline__ void row_phase(KARGS& a, const Ctx& c, const float* xin, const float* gain) {
    constexpr int NC = (MODE == 0 || MODE == 3) ? 8 : (MODE == 2 ? 4 : 0);
    unsigned char* ws = c.ws;
    LAS float* wxt = (LAS float*)c.lds; LAS int* lcnt = (LAS int*)(c.lds + 32768);
    if (MODE == 0) stage_wxt<8>(c, ain(a, 2), 3080, 2048);
    if (MODE == 2) stage_wxt<4>(c, ain(a, 15), 3076, 1536);
    if (MODE == 3) { if (c.tid < 8) lcnt[c.tid] = 0; stage_wxt<8>(c, ain(a, 21), 8, 0); }
    f32x4 g[4];
#pragma unroll
    for (int j = 0; j < 4; ++j) g[j] = *((const f32x4*)gain + c.lane + 64 * j);
    bf16* XN = (bf16*)(ws + WS_XN);
    int skSL = 2;
    if (MODE == 4) skSL = pg8::hyb_SL(__builtin_amdgcn_readfirstlane(ldi((const int*)(ws + WS_MISC + MISC_TS) + 8)) * 4 - 512);
#define ROW_INDEX(r) ((MODE == 4) ? (r) * (GRID * NWAVES) + c.bid * NWAVES + c.wave : 64 * c.bid + c.wave * 8 + (r))
#define ROW_LOAD(r, V, Y0, Y1, P0, P1) do { const int m_ = ROW_INDEX(r); const f32x4* xr_ = (const f32x4*)(xin + (size_t)m_ * DM) + c.lane; \
        _Pragma("unroll") for (int j = 0; j < 4; ++j) V[j] = xr_[64 * j]; \
        if (MODE == 4) { P0 = ldi((const int*)(ws + WS_PPOS) + 2 * m_); P1 = ldi((const int*)(ws + WS_PPOS) + 2 * m_ + 1); \
            const u32x2* y0_ = (const u32x2*)((const bf16*)(ws + WS_Y) + (size_t)P0 * DM) + c.lane; const u32x2* y1_ = (const u32x2*)((const bf16*)(ws + WS_Y) + (size_t)P1 * DM) + c.lane; \
            _Pragma("unroll") for (int j = 0; j < 4; ++j) { Y0[j] = y0_[64 * j]; Y1[j] = y1_[64 * j]; } } } while (0)
    f32x4 vn[4]; u32x2 yn0[4], yn1[4]; int pn0 = 0, pn1 = 0;
    ROW_LOAD(0, vn, yn0, yn1, pn0, pn1);
#pragma unroll
    for (int r = 0; r < 8; ++r) {
        const int m = ROW_INDEX(r);
        f32x4 v[4]; const int p0 = pn0, p1 = pn1;
#pragma unroll
        for (int j = 0; j < 4; ++j) { v[j] = vn[j]; if (MODE == 4) { v[j].x += bflo(yn0[j].x) + bflo(yn1[j].x); v[j].y += bfhi(yn0[j].x) + bfhi(yn1[j].x); v[j].z += bflo(yn0[j].y) + bflo(yn1[j].y); v[j].w += bfhi(yn0[j].y) + bfhi(yn1[j].y); } }
        if (r + 1 < 8) ROW_LOAD(r + 1, vn, yn0, yn1, pn0, pn1);
        if (MODE == 4) {
            const float* slab = (const float*)(ws + WS_XP);
            if (p0 >= 32768 || p1 >= 32768) {
#pragma unroll 1
                for (int q = 0; q < 2; ++q) { const int p = q ? p1 : p0; if (p < 32768) continue;
#pragma unroll
                    for (int j = 0; j < 4; ++j) { const float* sp = slab + ((size_t)(((p >> 8) * 4 + j - 512) * (skSL - 1)) * 256 + (p & 255)) * 256;
#pragma unroll 4
                        for (int s2 = 0; s2 < skSL - 1; ++s2) v[j] = v[j] + *((const f32x4*)(sp + (size_t)s2 * 65536) + c.lane); } } } }
        float s = 0.f;
#pragma unroll
        for (int j = 0; j < 4; ++j) s += (v[j].x * v[j].x + v[j].y * v[j].y) + (v[j].z * v[j].z + v[j].w * v[j].w);
#pragma unroll
        for (int j = 0; j < 4; ++j) v[j] = v[j] * g[j];
        float z[NC > 0 ? NC : 1];
        if constexpr (NC > 0) {
#pragma unroll
            for (int cc = 0; cc < NC; ++cc) { float pp = 0.f;
#pragma unroll
                for (int j = 0; j < 4; ++j) { const f32x4 w = *((const LAS f32x4*)(wxt + cc * 1024) + c.lane + 64 * j); pp += (v[j].x * w.x + v[j].y * w.y) + (v[j].z * w.z + v[j].w * w.w); }
                z[cc] = pp; }
#pragma unroll
            for (int cc = 0; cc < NC; ++cc) z[cc] = wave_sum(z[cc]);
        }
        const float rstd = 1.0f / sqrtf(wave_sum(s) * (1.0f / DM) + EPS);
#pragma unroll
        for (int j = 0; j < 4; ++j) v[j] = v[j] * rstd;
        if (MODE == 4) { f32x4* o = (f32x4*)((float*)(GAS float*)a.out + (size_t)m * DM) + c.lane;
#pragma unroll
            for (int j = 0; j < 4; ++j) o[64 * j] = v[j]; }
        else { u32x2* o = (u32x2*)(XN + (size_t)m * DM) + c.lane;
#pragma unroll
            for (int j = 0; j < 4; ++j) { u32x2 w; w.x = pk2(v[j].x, v[j].y); w.y = pk2(v[j].z, v[j].w); o[64 * j] = w; } }
        if constexpr (NC > 0) {
#pragma unroll
            for (int cc = 0; cc < NC; ++cc) z[cc] *= rstd;
            if (MODE == 0) { if (c.lane < 8) { float zz = z[0];
#pragma unroll
                    for (int cc = 1; cc < 8; ++cc) zz = (c.lane == cc) ? z[cc] : zz;
                    const float gb = ain(a, 5)[c.lane];
                    if (c.lane < 4) ((float*)(ws + WS_LI))[m * 4 + c.lane] = zz + gb; else ((float*)(ws + WS_LF))[m * 4 + c.lane - 4] = log_sigmoid_acc(zz + gb); } }
            if (MODE == 2) {
                if (c.lane < 4) { float zz = z[0];
#pragma unroll
                    for (int cc = 1; cc < 4; ++cc) zz = (c.lane == cc) ? z[cc] : zz;
                    ((float*)(ws + WS_LFX))[m * 4 + c.lane] = log_sigmoid_acc(zz + ain(a, 16)[c.lane]); } }
            if (MODE == 3) { if (c.lane == 0) {
                    int e1 = 0; float v1 = z[0];
#pragma unroll
                    for (int cc = 1; cc < 8; ++cc) if (z[cc] > v1) { v1 = z[cc]; e1 = cc; }
                    int e2 = -1; float v2 = -__builtin_inff();
#pragma unroll
                    for (int cc = 0; cc < 8; ++cc) if (cc != e1 && z[cc] > v2) { v2 = z[cc]; e2 = cc; }
                    const float w2 = 1.0f / (1.0f + expf(v1 - v2)), w1 = 1.0f - w2;
                    ((int*)(ws + WS_RTE))[2 * m] = e1; ((int*)(ws + WS_RTE))[2 * m + 1] = e2;
                    ((float*)(ws + WS_RTW))[2 * m] = w1; ((float*)(ws + WS_RTW))[2 * m + 1] = w2;
                    __hip_atomic_fetch_add(&lcnt[e1], 1, __ATOMIC_RELAXED, __HIP_MEMORY_SCOPE_WORKGROUP); __hip_atomic_fetch_add(&lcnt[e2], 1, __ATOMIC_RELAXED, __HIP_MEMORY_SCOPE_WORKGROUP); } }
        }
    }
#undef ROW_LOAD
#undef ROW_INDEX
    if (MODE == 3) { __syncthreads(); if (c.tid < 8) ((int*)(ws + WS_MISC + MISC_CNT))[c.bid * 8 + c.tid] = lcnt[c.tid]; }
    __syncthreads();
}

__device__ __forceinline__ int crow_(int r, int hi) { return (r & 3) + 8 * (r >> 2) + 4 * hi; }
__device__ __forceinline__ void wg_mma128(f32x16 (&acc)[2], const LAS bf16* A, const LAS bf16* Bt, int wave, int lane) {
    const int r32 = lane & 31, hi = lane >> 5, mblk = (wave >> 1) * 32, nblk = (wave & 1) * 64;
    const LAS bf16* ap = A + (mblk + r32) * TS_ + hi * 8; const LAS bf16* bp0 = Bt + (nblk + r32) * TS_ + hi * 8; const LAS bf16* bp1 = bp0 + 32 * TS_;
#pragma unroll
    for (int ks = 0; ks < 8; ++ks) {
        const bf16x8 av = *(const LAS bf16x8*)(ap + ks * 16), b0 = *(const LAS bf16x8*)(bp0 + ks * 16), b1 = *(const LAS bf16x8*)(bp1 + ks * 16);
        acc[0] = __builtin_amdgcn_mfma_f32_32x32x16_bf16(av, b0, acc[0], 0, 0, 0);
        acc[1] = __builtin_amdgcn_mfma_f32_32x32x16_bf16(av, b1, acc[1], 0, 0, 0);
    }
}
__device__ __forceinline__ void unpack8(const u32x4 w, float (&f)[8]) { f[0] = bflo(w.x); f[1] = bfhi(w.x); f[2] = bflo(w.y); f[3] = bfhi(w.y); f[4] = bflo(w.z); f[5] = bfhi(w.z); f[6] = bflo(w.w); f[7] = bfhi(w.w); }
__device__ __forceinline__ void stage_raw(const Ctx& c, const bf16* Z, int tok0, bool first, int col0, LAS bf16* raw) {
    for (int i = c.tid; i < 131 * 16; i += NTHR) { const int r = i >> 4, ch = i & 15;
        u32x4 v = {0u, 0u, 0u, 0u}; if (!(first && r < 3)) v = *(const u32x4*)(Z + (size_t)(tok0 - 3 + r) * ZP + col0 + ch * 8);
        *(LAS u32x4*)(raw + r * TS_ + ch * 8) = v; }
}
template <bool TRANSPOSE> __device__ __forceinline__ void conv_tile(const Ctx& c, const LAS bf16* raw, const float* cw  , const float* cb, float scale, LAS bf16* tile) {
    float w0[4][8], b0[8];
    if (!TRANSPOSE) { const int d0 = (c.tid & 15) * 8;
#pragma unroll
        for (int j = 0; j < 4; ++j)
#pragma unroll
            for (int i = 0; i < 8; ++i) w0[j][i] = cw[j * 1024 + d0 + i];
#pragma unroll
        for (int i = 0; i < 8; ++i) b0[i] = cb[d0 + i]; }
#pragma unroll 4
    for (int it = 0; it < 4; ++it) {
        const int ch = TRANSPOSE ? (c.tid >> 7) * 4 + it : (c.tid & 15), s = TRANSPOSE ? (c.tid & 127) : (c.tid >> 4) + 32 * it, d0 = ch * 8;
        float acc[8];
#pragma unroll
        for (int i = 0; i < 8; ++i) acc[i] = TRANSPOSE ? cb[d0 + i] : b0[i];
#pragma unroll
        for (int j = 0; j < 4; ++j) { float x[8]; unpack8(*(const LAS u32x4*)(raw + (s + j) * TS_ + d0), x);
#pragma unroll
            for (int i = 0; i < 8; ++i) acc[i] += (TRANSPOSE ? cw[j * 1024 + d0 + i] : w0[j][i]) * x[i]; }
#pragma unroll
        for (int i = 0; i < 8; ++i) acc[i] = siluf_(acc[i]) * scale;
        if (TRANSPOSE) {
#pragma unroll
            for (int i = 0; i < 8; ++i) tile[(d0 + i) * TS_ + s] = (bf16)f2bf(acc[i]);
        } else { u32x4 o; o.x = pk2(acc[0], acc[1]); o.y = pk2(acc[2], acc[3]); o.z = pk2(acc[4], acc[5]); o.w = pk2(acc[6], acc[7]); *(LAS u32x4*)(tile + s * TS_ + d0) = o; }
    }
}
struct RawRegs { u32x4 v[5]; };
__device__ __forceinline__ void raw_load(const Ctx& c, const bf16* Z, int tok0, bool first, int col0, RawRegs& R) {
#pragma unroll
    for (int n = 0; n < 5; ++n) { const int i = c.tid + NTHR * n, r = i >> 4, ch = i & 15; R.v[n] = (u32x4){0u, 0u, 0u, 0u};
        if (i < 131 * 16 && !(first && r < 3)) R.v[n] = *(const u32x4*)(Z + (size_t)(tok0 - 3 + r) * ZP + col0 + ch * 8); }
}
__device__ __forceinline__ void raw_store(const Ctx& c, const RawRegs& R, LAS bf16* raw) {
#pragma unroll
    for (int n = 0; n < 5; ++n) { const int i = c.tid + NTHR * n, r = i >> 4, ch = i & 15; if (i < 131 * 16) *(LAS u32x4*)(raw + r * TS_ + ch * 8) = R.v[n]; }
}
struct TRegs { u32x4 v[4]; };
__device__ __forceinline__ void tr_load(const Ctx& c, const bf16* src, TRegs& R) {
    const int s = c.tid & 127, chq = c.tid >> 7;
#pragma unroll
    for (int it = 0; it < 4; ++it) R.v[it] = *(const u32x4*)(src + (size_t)s * ZP + (chq * 4 + it) * 8);
}
template <class F> __device__ __forceinline__ void tr_store(const Ctx& c, const TRegs& R, LAS bf16* tile, const F& f) {
    const int s = c.tid & 127, chq = c.tid >> 7;
#pragma unroll
    for (int it = 0; it < 4; ++it) { const int e0 = (chq * 4 + it) * 8; float x[8]; unpack8(R.v[it], x);
#pragma unroll
        for (int i = 0; i < 8; ++i) tile[(e0 + i) * TS_ + s] = (bf16)f2bf(f(x[i], s, e0 + i)); }
}
struct CRegs { u32x4 v[4]; };
__device__ __forceinline__ void rows_load(const Ctx& c, const bf16* src  , CRegs& R) {
#pragma unroll
    for (int n = 0; n < 4; ++n) { const int i = c.tid + NTHR * n; R.v[n] = *(const u32x4*)(src + (i >> 4) * 128 + (i & 15) * 8); }
}
__device__ __forceinline__ void rows_store(const Ctx& c, const CRegs& R, LAS bf16* tile) {
#pragma unroll
    for (int n = 0; n < 4; ++n) { const int i = c.tid + NTHR * n; *(LAS u32x4*)(tile + (i >> 4) * TS_ + (i & 15) * 8) = R.v[n]; }
}
template <class F> __device__ __forceinline__ void stage_transposed(const Ctx& c, const bf16* src, LAS bf16* tile, const F& f) {
    const int s = c.tid & 127, chq = c.tid >> 7;
#pragma unroll
    for (int it = 0; it < 4; ++it) { const int e0 = (chq * 4 + it) * 8; float x[8]; unpack8(*(const u32x4*)(src + (size_t)s * ZP + e0), x);
#pragma unroll
        for (int i = 0; i < 8; ++i) tile[(e0 + i) * TS_ + s] = (bf16)f2bf(f(x[i], s, e0 + i)); }
}
constexpr int L_T0 = 0, L_T1 = TILE_B, L_T2 = 2 * TILE_B, L_T3 = 3 * TILE_B, L_TAB = 4 * TILE_B + 2048;
static_assert(L_TAB + 4096 <= LDSCTL_OFF, "LDS map");

__device__ __forceinline__ void ml_state_unit(KARGS& a, const Ctx& c0, int bhc) {
    Ctx c = c0; { int t_ = c0.wave * 64 + (int)__builtin_amdgcn_mbcnt_hi(~0u, __builtin_amdgcn_mbcnt_lo(~0u, 0u)); asm volatile("" : "+v"(t_)); c.tid = t_; c.lane = t_ & 63; c.wave = __builtin_amdgcn_readfirstlane(t_ >> 6); }
    unsigned char* ws = c.ws;
    const int bh = bhc >> 6, ck = bhc & 63, b = bh >> 2, h = bh & 3, tok0 = b * SEQ + ck * 128;
    const bf16* Z = (const bf16*)(ws + WS_ARENA);
    LAS bf16* KT = (LAS bf16*)(c.lds + L_T0); LAS bf16* VT = (LAS bf16*)(c.lds + L_T1); LAS bf16* RAW = (LAS bf16*)(c.lds + L_T2);
    LAS float* wt = (LAS float*)(c.lds + L_TAB);
    RawRegs rk; TRegs rv;
    raw_load(c, Z, tok0, ck == 0, 512 + h * 128, rk); tr_load(c, Z + (size_t)tok0 * ZP + 1024 + h * 128, rv);
    if (c.wave == 0) {
        const float* LF = (const float*)(ws + WS_LF); const float* LI = (const float*)(ws + WS_LI);
        const int s0 = 2 * c.lane;
        const float lf0 = ldf(LF + (size_t)(tok0 + s0) * 4 + h), lf1 = ldf(LF + (size_t)(tok0 + s0 + 1) * 4 + h);
        const float li0 = ldf(LI + (size_t)(tok0 + s0) * 4 + h), li1 = ldf(LI + (size_t)(tok0 + s0 + 1) * 4 + h);
        float sc = lf0 + lf1;
#pragma unroll
        for (int o = 1; o < 64; o <<= 1) { const float t = shfl_up_l(sc, o, c.lane); if (c.lane >= o) sc += t; }
        const float b1 = sc, b0 = sc - lf1, blast = shfl_idx_l(sc, 63);
        const float g0 = blast - b0 + li0, g1 = blast - b1 + li1;
        float mg = fmaxf(g0, g1);
#pragma unroll
        for (int o = 1; o < 64; o <<= 1) mg = fmaxf(mg, shfl_xor_l(mg, o, c.lane));
        wt[s0] = fast_exp(g0 - mg); wt[s0 + 1] = fast_exp(g1 - mg);
        if (c.lane == 0) { ((float*)(ws + WS_MISC + MISC_MG))[bhc] = mg; ((float*)(ws + WS_MISC + MISC_BL))[bhc] = blast; }
    }
    raw_store(c, rk, RAW);
    __syncthreads();
    conv_tile<true>(c, RAW, ain(a, 3) + 512 + h * 128, ain(a, 4) + 512 + h * 128, 1.0f, KT);
    tr_store(c, rv, VT, [&](float x, int s, int) { return x * wt[s]; });
    __syncthreads();
    f32x16 acc[2] = {};
    wg_mma128(acc, VT, KT, c.wave, c.lane);
    { const int r32 = c.lane & 31, hi = c.lane >> 5, mblk = (c.wave >> 1) * 32, nblk = (c.wave & 1) * 64; float* CH = (float*)(ws + WS_CH) + (size_t)bhc * 16384;
#pragma unroll
      for (int j = 0; j < 2; ++j)
#pragma unroll
        for (int i = 0; i < 16; ++i) CH[(mblk + crow_(i, hi)) * 128 + nblk + 32 * j + r32] = acc[j][i]; }
    { const int d = c.tid >> 2, part = c.tid & 3; float s = 0.f;
#pragma unroll
      for (int k = 0; k < 4; ++k) { float x[8]; unpack8(*(const LAS u32x4*)(KT + d * TS_ + part * 32 + 8 * k), x);
#pragma unroll
        for (int i = 0; i < 8; ++i) s += wt[part * 32 + 8 * k + i] * x[i]; }
      s = quad_sum(s);
      if (part == 0) ((float*)(ws + WS_NH))[(size_t)bhc * 128 + d] = s; }
    __syncthreads();
}
__device__ __forceinline__ void sg_unit(KARGS& a, const Ctx& c0, int idx) {
    Ctx c = c0; { int t_ = c0.wave * 64 + (int)__builtin_amdgcn_mbcnt_hi(~0u, __builtin_amdgcn_mbcnt_lo(~0u, 0u)); asm volatile("" : "+v"(t_)); c.tid = t_; c.lane = t_ & 63; c.wave = __builtin_amdgcn_readfirstlane(t_ >> 6); }
    unsigned char* ws = c.ws;
    const int bn = idx >> 2, g = idx & 3, tok0 = (bn >> 6) * SEQ + (bn & 63) * 128;
    const bf16* Z = (const bf16*)(ws + WS_ARENA);
    LAS bf16* WG = (LAS bf16*)(c.lds + L_T0); LAS bf16* VN = (LAS bf16*)(c.lds + L_T1); LAS float* rs = (LAS float*)(c.lds + L_TAB);
    const int r32 = c.lane & 31, hi = c.lane >> 5, mblk = (c.wave >> 1) * 32, nblk = (c.wave & 1) * 64, ch = c.tid & 15, c0e = ch * 8, chq = c.tid >> 7;
    TRegs rv; CRegs rw; u32x4 xv[16], uv[4]; f32x4 gv[4][2], bv[4];
    tr_load(c, Z + (size_t)tok0 * ZP + 2560 + g * 128, rv); rows_load(c, (const bf16*)(ws + WS_SGW) + (size_t)g * 16384, rw);
    { const bf16* p = Z + (size_t)(tok0 + (c.tid >> 2)) * ZP + 2560 + (c.tid & 3) * 128;
#pragma unroll
      for (int k = 0; k < 16; ++k) xv[k] = *(const u32x4*)(p + 8 * k); }
#pragma unroll
    for (int it = 0; it < 4; ++it) { uv[it] = *(const u32x4*)(Z + (size_t)(tok0 + (c.tid >> 4) + 32 * it) * ZP + 2048 + g * 128 + c0e);
        const float* gp = ain(a, 7) + g * 128 + (chq * 4 + it) * 8; gv[it][0] = *(const f32x4*)gp; gv[it][1] = *(const f32x4*)(gp + 4);
        bv[it] = *(const f32x4*)(ain(a, 9) + g * 128 + mblk + 8 * it + 4 * hi); }
    { const int s = c.tid >> 2, part = c.tid & 3; float ss = 0.f;
#pragma unroll
      for (int k = 0; k < 16; ++k) { float x[8]; unpack8(xv[k], x);
#pragma unroll
        for (int i = 0; i < 8; ++i) ss += x[i] * x[i]; }
      ss = quad_sum(ss);
      if (part == 0) rs[s] = 1.0f / sqrtf(ss * (1.0f / 512.0f) + EPS); }
    rows_store(c, rw, WG);
    __syncthreads();
    { const int s = c.tid & 127; const float r = rs[s];
#pragma unroll
      for (int it = 0; it < 4; ++it) { const int e0 = (chq * 4 + it) * 8; float x[8]; unpack8(rv.v[it], x);
#pragma unroll
        for (int i = 0; i < 8; ++i) VN[(e0 + i) * TS_ + s] = (bf16)f2bf(x[i] * r * gv[it][i >> 2][i & 3]); } }
    __syncthreads();
    f32x16 acc[2] = {};
    wg_mma128(acc, WG, VN, c.wave, c.lane);
    __syncthreads();
    LAS float* HT = (LAS float*)(c.lds + L_T0);
#pragma unroll
    for (int i = 0; i < 16; ++i) { const int t = mblk + crow_(i, hi); const float bs = bv[i >> 2][i & 3];
        HT[t * 132 + nblk + r32] = acc[0][i] + bs; HT[t * 132 + nblk + 32 + r32] = acc[1][i] + bs; }
    __syncthreads();
    { bf16* CAT = (bf16*)(ws + WS_CAT);
#pragma unroll
      for (int it = 0; it < 4; ++it) { const int t = (c.tid >> 4) + 32 * it; float u[8]; unpack8(uv[it], u);
          const f32x4 x0 = *(const LAS f32x4*)(HT + t * 132 + c0e), x1 = *(const LAS f32x4*)(HT + t * 132 + c0e + 4);
          u32x4 o; o.x = pk2(u[0] * x0.x, u[1] * x0.y); o.y = pk2(u[2] * x0.z, u[3] * x0.w);
          o.z = pk2(u[4] * x1.x, u[5] * x1.y); o.w = pk2(u[6] * x1.z, u[7] * x1.w);
          *(u32x4*)(CAT + (size_t)(tok0 + t) * DM + 512 + g * 128 + c0e) = o; } }
    __syncthreads();
}
__device__ __forceinline__ void ml_scan_phase(const Ctx& c) {
    unsigned char* ws = c.ws;
    const int gid = c.bid * NTHR + c.tid, bh = gid >> 14, idx = gid & 16383;
    LAS float* sdec = (LAS float*)c.lds; LAS float* ssc = sdec + 64; LAS float* smp = ssc + 64;
    if (c.wave == 0) {
        const float bl = ldf((const float*)(ws + WS_MISC + MISC_BL) + bh * 64 + c.lane), mg = ldf((const float*)(ws + WS_MISC + MISC_MG) + bh * 64 + c.lane);
        float m = 0.f, mprev = 0.f, mnew = 0.f;
        for (int k = 0; k < 64; ++k) { const float blk = __shfl(bl, k), mgk = __shfl(mg, k); const float mn = fmaxf(blk + m, mgk);
            if (c.lane == k) { mprev = m; mnew = mn; } m = mn; }
        smp[c.lane] = mprev; sdec[c.lane] = fast_exp(bl + mprev - mnew); ssc[c.lane] = fast_exp(mg - mnew);
    }
    __syncthreads();
    const float* CH = (const float*)(ws + WS_CH) + (size_t)bh * 64 * 16384 + idx; bf16* CP = (bf16*)(ws + WS_CP) + (size_t)bh * 64 * 16384 + idx;
    float C = 0.f;
#pragma unroll 1
    for (int k0 = 0; k0 < 64; k0 += 32) { float chv[32];
#pragma unroll
        for (int k = 0; k < 32; ++k) chv[k] = CH[(size_t)(k0 + k) * 16384];
#pragma unroll
        for (int k = 0; k < 32; ++k) { CP[(size_t)(k0 + k) * 16384] = (bf16)f2bf(C); C = sdec[k0 + k] * C + ssc[k0 + k] * chv[k]; } }
    if (idx < 128) { const float* NH = (const float*)(ws + WS_NH) + (size_t)bh * 64 * 128 + idx; float* NP = (float*)(ws + WS_NP) + (size_t)bh * 64 * 128 + idx; float n = 0.f;
#pragma unroll 8
        for (int k = 0; k < 64; ++k) { const float nh = NH[k * 128]; NP[k * 128] = n; n = sdec[k] * n + ssc[k] * nh; } }
    if (idx < 64) ((float*)(ws + WS_MISC + MISC_MP))[bh * 64 + idx] = smp[idx];
    __syncthreads();
}
template <int SKIP = 0> __device__ __forceinline__ void ml_out_unit(KARGS& a, const Ctx& c0, int bhc) {
    Ctx c = c0; { int t_ = c0.wave * 64 + (int)__builtin_amdgcn_mbcnt_hi(~0u, __builtin_amdgcn_mbcnt_lo(~0u, 0u)); asm volatile("" : "+v"(t_)); c.tid = t_; c.lane = t_ & 63; c.wave = __builtin_amdgcn_readfirstlane(t_ >> 6); }
    unsigned char* ws = c.ws;
    const int bh = bhc >> 6, ck = bhc & 63, b = bh >> 2, h = bh & 3, tok0 = b * SEQ + ck * 128;
    const bf16* Z = (const bf16*)(ws + WS_ARENA);
    LAS bf16* QT = (LAS bf16*)(c.lds + L_T0); LAS bf16* KT = (LAS bf16*)(c.lds + L_T1); LAS bf16* VT = (LAS bf16*)(c.lds + L_T2); LAS bf16* CT = (LAS bf16*)(c.lds + L_T3);
    LAS bf16* SW = KT; LAS bf16* RAW = (LAS bf16*)(c.lds + L_T3 + 1024); LAS bf16* RAWK = VT;
    RawRegs rq, rk; TRegs rv; CRegs rc;
    raw_load(c, Z, tok0, ck == 0, h * 128, rq); raw_load(c, Z, tok0, ck == 0, 512 + h * 128, rk);
    tr_load(c, Z + (size_t)tok0 * ZP + 1024 + h * 128, rv); rows_load(c, (const bf16*)(ws + WS_CP) + (size_t)bhc * 16384, rc);
    LAS float* t_a = (LAS float*)(c.lds + L_TAB); LAS float* t_mu = t_a + 128; LAS float* t_wi = t_a + 256; LAS float* t_emr = t_a + 384; LAS float* t_rden = t_a + 512; LAS float* t_np = t_a + 640; LAS float* t_ssq = t_a + 768;
    if (c.wave == 0) {
        const float* LF = (const float*)(ws + WS_LF); const float* LI = (const float*)(ws + WS_LI);
        const int s0 = 2 * c.lane;
        const float lf0 = ldf(LF + (size_t)(tok0 + s0) * 4 + h), lf1 = ldf(LF + (size_t)(tok0 + s0 + 1) * 4 + h);
        const float li0 = ldf(LI + (size_t)(tok0 + s0) * 4 + h), li1 = ldf(LI + (size_t)(tok0 + s0 + 1) * 4 + h);
        float sc = lf0 + lf1;
#pragma unroll
        for (int o = 1; o < 64; o <<= 1) { const float t = shfl_up_l(sc, o, c.lane); if (c.lane >= o) sc += t; }
        const float b1 = sc, b0 = sc - lf1;
        const float a0 = li0 - b0, a1 = li1 - b1;
        float pm = fmaxf(a0, a1);
#pragma unroll
        for (int o = 1; o < 64; o <<= 1) { const float t = shfl_up_l(pm, o, c.lane); if (c.lane >= o) pm = fmaxf(pm, t); }
        float pprev = shfl_up_l(pm, 1, c.lane); if (c.lane == 0) pprev = -__builtin_inff();
        const float pm0 = fmaxf(pprev, a0), pm1 = pm;
        const float mprev = ldf((const float*)(ws + WS_MISC + MISC_MP) + bhc);
        const float mu0 = fmaxf(mprev, pm0), mu1 = fmaxf(mprev, pm1);
        t_a[s0] = a0; t_a[s0 + 1] = a1; t_mu[s0] = mu0; t_mu[s0 + 1] = mu1;
        t_wi[s0] = fast_exp(mprev - mu0); t_wi[s0 + 1] = fast_exp(mprev - mu1);
        t_emr[s0] = fast_exp(-b0 - mu0); t_emr[s0 + 1] = fast_exp(-b1 - mu1);
    }
    if (c.wave == 1) { const float* NP = (const float*)(ws + WS_NP) + (size_t)bhc * 128; t_np[c.lane] = ldf(NP + c.lane); t_np[64 + c.lane] = ldf(NP + 64 + c.lane); }
    raw_store(c, rq, RAW); raw_store(c, rk, RAWK);
    __syncthreads();
    if (!(SKIP & 1)) { conv_tile<false>(c, RAW, ain(a, 3) + h * 128, ain(a, 4) + h * 128, 0.08838834764831845f, QT);
    conv_tile<false>(c, RAWK, ain(a, 3) + 512 + h * 128, ain(a, 4) + 512 + h * 128, 1.0f, KT); }
    __syncthreads();
    if (!(SKIP & 2)) tr_store(c, rv, VT, [](float x, int, int) { return x; });
    rows_store(c, rc, CT);
    __syncthreads();
    const int r32 = c.lane & 31, hi = c.lane >> 5, mblk = (c.wave >> 1) * 32, nblk = (c.wave & 1) * 64;
    f32x16 sa[2] = {};
    if (!(SKIP & 4)) wg_mma128(sa, QT, KT, c.wave, c.lane);
    __syncthreads();
    { const float as0 = t_a[nblk + r32], as1 = t_a[nblk + 32 + r32];
#pragma unroll
      for (int i = 0; i < 16; ++i) { const int t = mblk + crow_(i, hi); const float mu = t_mu[t];
          const int s0 = nblk + r32, s1 = s0 + 32;
          const float w0 = (s0 <= t) ? fast_exp(as0 - mu) : 0.f, w1 = (s1 <= t) ? fast_exp(as1 - mu) : 0.f;
          SW[t * TS_ + s0] = (bf16)f2bf(sa[0][i] * w0); SW[t * TS_ + s1] = (bf16)f2bf(sa[1][i] * w1); } }
    __syncthreads();
    f32x16 n1[2] = {}, n2[2] = {};
    if (!(SKIP & 4)) { wg_mma128(n1, SW, VT, c.wave, c.lane);
    wg_mma128(n2, QT, CT, c.wave, c.lane); }
    { const int t = c.tid >> 2, part = c.tid & 3; float ds = 0.f, dq = 0.f;
#pragma unroll
      for (int k = 0; k < 4; ++k) { float x[8], q[8]; unpack8(*(const LAS u32x4*)(SW + t * TS_ + part * 32 + 8 * k), x); unpack8(*(const LAS u32x4*)(QT + t * TS_ + part * 32 + 8 * k), q);
#pragma unroll
        for (int i = 0; i < 8; ++i) { ds += x[i]; dq += q[i] * t_np[part * 32 + 8 * k + i]; } }
      ds = quad_sum(ds); dq = quad_sum(dq);
      if (part == 0) { const float den = ds + t_wi[t] * dq; t_rden[t] = 1.0f / fmaxf(fabsf(den), t_emr[t]); } }
    __syncthreads();
    LAS float* HT = (LAS float*)(c.lds + L_T0);
#pragma unroll
    for (int i = 0; i < 16; ++i) { const int t = mblk + crow_(i, hi); const float wi = t_wi[t], rd = t_rden[t];
        HT[t * 132 + nblk + r32] = (n1[0][i] + wi * n2[0][i]) * rd; HT[t * 132 + nblk + 32 + r32] = (n1[1][i] + wi * n2[1][i]) * rd; }
    __syncthreads();
    { const int t = c.tid >> 2, part = c.tid & 3; float q = 0.f;
#pragma unroll
      for (int k = 0; k < 8; ++k) { const f32x4 x = *(const LAS f32x4*)(HT + t * 132 + part * 32 + 4 * k); q += (x.x * x.x + x.y * x.y) + (x.z * x.z + x.w * x.w); }
      q = quad_sum(q);
      if (part == 0) t_ssq[t] = 1.0f / sqrtf(q * (1.0f / 128.0f) + EPS); }
    __syncthreads();
    { int tt = c.tid; asm volatile("" : "+v"(tt));
      bf16* CAT = (bf16*)(ws + WS_CAT); const int ch = tt & 15, e0 = ch * 8; float gn[8];
#pragma unroll
      for (int i = 0; i < 8; ++i) gn[i] = ain(a, 6)[h * 128 + e0 + i];
#pragma unroll
      for (int it = 0; it < 4; ++it) { const int t = (tt >> 4) + 32 * it; float og[8]; unpack8(*(const u32x4*)(Z + (size_t)(tok0 + t) * ZP + 1536 + h * 128 + e0), og);
          const float rstd = t_ssq[t]; const f32x4 x0 = *(const LAS f32x4*)(HT + t * 132 + e0), x1 = *(const LAS f32x4*)(HT + t * 132 + e0 + 4);
          u32x4 o; o.x = pk2(x0.x * rstd * gn[0] * og[0], x0.y * rstd * gn[1] * og[1]); o.y = pk2(x0.z * rstd * gn[2] * og[2], x0.w * rstd * gn[3] * og[3]);
          o.z = pk2(x1.x * rstd * gn[4] * og[4], x1.y * rstd * gn[5] * og[5]); o.w = pk2(x1.z * rstd * gn[6] * og[6], x1.w * rstd * gn[7] * og[7]);
          *(u32x4*)(CAT + (size_t)(tok0 + t) * DM + h * 128 + e0) = o; } }
    __syncthreads();
}

__device__ __forceinline__ void fox_cumsum(const Ctx& c) {
    if (c.bid >= 8) return;
    unsigned char* ws = c.ws; const int bh = c.bid, b = bh >> 2, h = bh & 3;
    const float* LFX = (const float*)(ws + WS_LFX) + (size_t)b * SEQ * 4 + h; u32x2* KB = (u32x2*)(ws + WS_KB) + (size_t)bh * SEQ;
    LAS float* wsum = (LAS float*)c.lds;
    float v[16]; float tot = 0.f;
#pragma unroll
    for (int i = 0; i < 16; ++i) { v[i] = LFX[(size_t)(c.tid * 16 + i) * 4]; tot += v[i]; }
    float sc = tot;
#pragma unroll
    for (int o = 1; o < 64; o <<= 1) { const float t = shfl_up_l(sc, o, c.lane); if (c.lane >= o) sc += t; }
    if (c.lane == 63) wsum[c.wave] = sc;
    __syncthreads();
    float base = 0.f;
    for (int w = 0; w < c.wave; ++w) base += wsum[w];
    float run = base + sc - tot;
#pragma unroll
    for (int i = 0; i < 16; ++i) { run += v[i]; const float x = -run * 11.313708498984761f;
        const unsigned a = f2bf(x); const float r1 = x - bf2f(a); const unsigned b2 = f2bf(r1); const float r2 = r1 - bf2f(b2); const unsigned c2 = f2bf(r2);
        u32x2 w; w.x = a | (b2 << 16); w.y = c2; KB[c.tid * 16 + i] = w; }
}
#ifndef ATT_ONLY
#define ATT_ONLY 0
#endif
template <int ONLY = ATT_ONLY> __device__ __forceinline__ void attn_phase(KARGS& a, const Ctx& c, int qoff) {
    unsigned char* ws = c.ws; char* lds = (char*)c.lds;
    const bf16* Z = (const bf16*)(ws + WS_ARENA);
    LAS int* slot = (LAS int*)(c.lds + att::LDS_BYTES);
    unsigned* q = (unsigned*)(ws + WS_CTL) + CW_QUEUE + qoff;
    if (ONLY != 2) for (;;) {
        if (c.tid == 0) slot[0] = (int)__hip_atomic_fetch_add(q, 1u, RLX_AGENT);
        __syncthreads();
        const int it = slot[0];
        __syncthreads();
        if (it >= 256) break;
        const int qb = 31 - (it >> 3), bh = it & 7, b = bh >> 2, h = bh & 3; const size_t rb = (size_t)b * SEQ;
        att::BlockRef R; R.Q = Z + (rb + (size_t)qb * 256) * ZP + h * 128; R.K = Z + rb * ZP + 512 + h * 128; R.V = Z + rb * ZP + 1024 + h * 128;
        R.KB = (const u32x2*)(ws + WS_KB) + (size_t)bh * SEQ; R.P0 = qb * 256;
        int tl = c.tid; asm volatile("" : "+v"(tl));
        { const int ln = tl & 63, wv = __builtin_amdgcn_readfirstlane(tl >> 6);
          const f32x4* N2 = (const f32x4*)(ws + WS_NORM2) + rb * 8; LAS float* red = (LAS float*)(c.lds + att::LDS_BYTES + 64); LAS int* jl = (LAS int*)(c.lds + att::LDS_BYTES + 32);
          float km = 0.f, qm = 0.f; const int nk = R.P0 + 256;
          for (int s = tl; s < nk; s += NTHR) { const f32x4 pv = N2[(size_t)s * 8 + 4 + h]; km = fmaxf(km, (pv.x + pv.y) + (pv.z + pv.w)); }
          if (tl < 256) { const f32x4 pv = N2[(size_t)(R.P0 + tl) * 8 + h]; qm = (pv.x + pv.y) + (pv.z + pv.w); }
#pragma unroll
          for (int o = 1; o < 64; o <<= 1) { km = fmaxf(km, shfl_xor_l(km, o, ln)); qm = fmaxf(qm, shfl_xor_l(qm, o, ln)); }
          if (ln == 0) { red[wv] = km; red[8 + wv] = qm; }
          if (tl == 0) jl[0] = qb * 4;
          __syncthreads();
          float K2 = 0.f, Q2 = 0.f;
#pragma unroll
          for (int w = 0; w < 8; ++w) { K2 = fmaxf(K2, red[w]); Q2 = fmaxf(Q2, red[8 + w]); }
          const float B2 = 2.0f * 1.02f * sqrtf(K2 * Q2);
          if (tl < qb * 4) { const u32x2 w1 = R.KB[tl * 64 + 63], w0 = R.KB[R.P0];
              const float kb1 = bflo(w1.x) + bfhi(w1.x) + bflo(w1.y), kb0 = bflo(w0.x) + bfhi(w0.x) + bflo(w0.y);
              if (B2 + (kb1 - kb0) >= -30.0f * 11.313708498984761f) __hip_atomic_fetch_min(jl, tl, __ATOMIC_RELAXED, __HIP_MEMORY_SCOPE_WORKGROUP); }
          __syncthreads();
          R.JLO = jl[0];
          __syncthreads(); }
        att::Seam<128> S;
        att::causal_prime<128, true>(R, lds, S, tl);
        att::causal_block<128, true, 0>(R, R, lds, S, (void*)((bf16*)(ws + WS_CAT) + (rb + (size_t)qb * 256) * DM + h * 128), DM, tl);
    }
    if (ONLY != 1) for (;;) {
        if (c.tid == 0) slot[0] = (int)__hip_atomic_fetch_add(q + 64, 1u, RLX_AGENT);
        __syncthreads();
        const int it = slot[0];
        __syncthreads();
        if (it >= 512) break;
        const int qb = 31 - (it >> 4), d = it & 15, bh = d >> 1, mp = d & 1, b = bh >> 2, h = bh & 3; const size_t rb = (size_t)b * SEQ;
        att::BlockRef R; R.Q = Z + (rb + (size_t)qb * 256) * ZP + 1536 + h * 128 + mp * 64; R.K = Z + rb * ZP + 2048 + h * 128 + mp * 64; R.V = Z + rb * ZP + 2560 + h * 128;
        R.KB = nullptr; R.P0 = qb * 256; R.JLO = 0;
        att::Seam<64> S;
        int tl = c.tid; asm volatile("" : "+v"(tl));
        att::causal_prime<64, false>(R, lds, S, tl);
        att::causal_block<64, false, 1>(R, R, lds, S, (void*)((float*)(ws + WS_DO) + (size_t)mp * T * 512 + (rb + (size_t)qb * 256) * 512 + h * 128), 512, tl);
    }
}
__device__ __forceinline__ void diffnorm_phase(KARGS& a, const Ctx& c) {
    unsigned char* ws = c.ws;
    const float lam = ldf((const float*)(ws + WS_MISC + MISC_LAM)); const float post = 1.0f - (0.8f - 0.6f * expf(-0.3f));
    const float* D0 = (const float*)(ws + WS_DO); const float* D1 = D0 + (size_t)T * 512; bf16* CAT = (bf16*)(ws + WS_CAT);
    const int gw = c.bid * NWAVES + c.wave, NGW = GRID * NWAVES;
    const float g0 = ain(a, 18)[2 * c.lane] * post, g1 = ain(a, 18)[2 * c.lane + 1] * post;
    for (int p0 = gw * 8; p0 < T * 4; p0 += NGW * 8) {
        f32x2 x0[8], x1[8];
#pragma unroll
        for (int k = 0; k < 8; ++k) { const size_t o = (size_t)(p0 + k) * 128 + 2 * c.lane; x0[k] = *(const f32x2*)(D0 + o); x1[k] = *(const f32x2*)(D1 + o); }
#pragma unroll
        for (int k = 0; k < 8; ++k) { const int p = p0 + k, t = p >> 2, h = p & 3; const float y0 = x0[k].x - lam * x1[k].x, y1 = x0[k].y - lam * x1[k].y;
            const float rstd = 1.0f / sqrtf(wave_sum(y0 * y0 + y1 * y1) * (1.0f / 128.0f) + EPS);
            *(unsigned*)(CAT + (size_t)t * DM + 512 + h * 128 + 2 * c.lane) = pk2(y0 * rstd * g0, y1 * rstd * g1); } }
}

__device__ __forceinline__ void moe_scatter_phase(const Ctx& c) {
    unsigned char* ws = c.ws;
    LAS int* soff = (LAS int*)c.lds;
    LAS int* sts = soff + 8;
    LAS int* stot = soff + 32;
    LAS int* spos = soff + 64;
    const int* CNT = (const int*)(ws + WS_MISC + MISC_CNT);
    const bf16* XN = (const bf16*)(ws + WS_XN); bf16* XP = (bf16*)(ws + WS_XP);
    u32x4 rowv[8][2];
#pragma unroll
    for (int k = 0; k < 8; ++k) { const u32x4* src = (const u32x4*)(XN + (size_t)(64 * c.bid + c.wave * 8 + k) * DM); rowv[k][0] = src[c.lane]; rowv[k][1] = src[64 + c.lane]; }
    if (c.wave == 0) {
        typedef int i32x4 __attribute__((ext_vector_type(4)));
        i32x4 cv[8];
#pragma unroll
        for (int k = 0; k < 8; ++k) cv[k] = *((const i32x4*)(CNT + (size_t)c.lane * 32) + k);
        int tot[8], before[8];
#pragma unroll
        for (int e = 0; e < 8; ++e) { int s = 0, bf = 0;
#pragma unroll
            for (int k = 0; k < 4; ++k) { const int w = 4 * c.lane + k; const int v = cv[2 * k + (e >> 2)][e & 3]; s += v; if (w < c.bid) bf += v; }
            tot[e] = s; before[e] = bf; }
#pragma unroll
        for (int e = 0; e < 8; ++e) {
#pragma unroll
            for (int o = 1; o < 64; o <<= 1) { tot[e] += __shfl_xor(tot[e], o); before[e] += __shfl_xor(before[e], o); } }
        int ts = 0, so[8];
#pragma unroll
        for (int e = 0; e < 8; ++e) { if (c.lane == 0) { sts[e] = ts; stot[e] = tot[e]; } so[e] = ts * 256 + before[e]; ts += (tot[e] + 255) >> 8; }
        if (c.lane == 0) { sts[8] = ts; if (c.bid == 0) { int acc = 0; for (int e = 0; e < 8; ++e) { ((int*)(ws + WS_MISC + MISC_TS))[e] = acc; acc += (tot[e] + 255) >> 8; } ((int*)(ws + WS_MISC + MISC_TS))[8] = acc; } }
        const int m = 64 * c.bid + c.lane; const int e1 = ((const int*)(ws + WS_RTE))[2 * m], e2 = ((const int*)(ws + WS_RTE))[2 * m + 1];
        int p1 = 0, p2 = 0;
#pragma unroll
        for (int e = 0; e < 8; ++e) { const unsigned long long mask = __ballot(e1 == e || e2 == e); const int rank = __builtin_popcountll(mask & ((1ull << c.lane) - 1ull));
            if (e1 == e) p1 = so[e] + rank; if (e2 == e) p2 = so[e] + rank; }
        spos[2 * c.lane] = p1; spos[2 * c.lane + 1] = p2;
        ((int*)(ws + WS_PPOS))[2 * m] = p1; ((int*)(ws + WS_PPOS))[2 * m + 1] = p2;
        ((float*)(ws + WS_RW))[p1] = ((const float*)(ws + WS_RTW))[2 * m]; ((float*)(ws + WS_RW))[p2] = ((const float*)(ws + WS_RTW))[2 * m + 1];
    }
    __syncthreads();
#pragma unroll
    for (int k = 0; k < 8; ++k) { const int ti = c.wave * 8 + k;
#pragma unroll
        for (int sl = 0; sl < 2; ++sl) { u32x4* dst = (u32x4*)(XP + (size_t)spos[2 * ti + sl] * DM); dst[c.lane] = rowv[k][0]; dst[64 + c.lane] = rowv[k][1]; } }
    { const int gw = c.bid * NWAVES + c.wave;
      for (int e = 0; e < 8; ++e) { const int tot = stot[e], first = sts[e] * 256 + tot, npad = ((tot + 255) & ~255) - tot;
          for (int i = gw; i < npad; i += GRID * NWAVES) { u32x4* dst = (u32x4*)(XP + (size_t)(first + i) * DM); const u32x4 z = {0u, 0u, 0u, 0u}; dst[c.lane] = z; dst[64 + c.lane] = z;
              if (c.lane == 0) ((float*)(ws + WS_RW))[first + i] = 0.f; } } }
    __syncthreads();
}
#ifndef MK_PER_PHASE
#define MK_PER_PHASE 0
#endif
constexpr int NPHASE = 19;
__global__ void __launch_bounds__(NTHR, 2) fwd_kernel(Args args_by_value) {
    (void)args_by_value;
    extern __shared__ __attribute__((aligned(16))) unsigned char lds_raw[];
    KARGS* ap0 = (KARGS*)__builtin_amdgcn_kernarg_segment_ptr();
    Ctx c_; c_.lds = (LAS unsigned char*)lds_raw; c_.ws = (unsigned char*)(GAS unsigned char*)ap0->ws; c_.tid = threadIdx.x; c_.lane = c_.tid & 63; c_.wave = __builtin_amdgcn_readfirstlane(c_.tid >> 6); c_.bid = blockIdx.x;
    unsigned char* const ws0 = c_.ws;
    for (int u = c_.tid; u < (LDS_BYTES - LDSCTL_OFF) / 4; u += NTHR) ((LAS unsigned*)(c_.lds + LDSCTL_OFF))[u] = 0u;
    __syncthreads();
    XcdBarrier bar; bar.bar = (unsigned*)(ws0 + WS_CTL) + CW_BAR; bar.x = 0; bar.st = nullptr;
    if (!MK_PER_PHASE) bar = xcd_barrier_post((unsigned*)(ws0 + WS_CTL) + CW_BAR, (volatile LAS unsigned*)(c_.lds + LDSCTL_OFF));
    const int lo = ap0->ph_lo, hi = ap0->ph_hi; const int wave0 = c_.wave;
#ifndef PHASE_MASK
#define PHASE_MASK 0xFFFFFFFFu
#endif
#define IN(k) (((PHASE_MASK >> (k)) & 1u) && lo <= (k) && (k) < hi)
#define FRESH() Ctx c = c_; { int t_ = wave0 * 64 + (int)__builtin_amdgcn_mbcnt_hi(~0u, __builtin_amdgcn_mbcnt_lo(~0u, 0u)); asm volatile("" : "+v"(t_)); c.tid = t_; c.lane = t_ & 63; c.wave = __builtin_amdgcn_readfirstlane(t_ >> 6); KARGS* ap_ = (KARGS*)__builtin_amdgcn_kernarg_segment_ptr(); asm volatile("" : "+s"(ap_)); GAS unsigned char* w_ = (GAS unsigned char*)ap_->ws; c.ws = (unsigned char*)w_; } \
    KARGS& args = *(KARGS*)__builtin_amdgcn_kernarg_segment_ptr(); \
    unsigned char* const ws = c.ws; bf16* const XN = (bf16*)(ws + WS_XN); bf16* const CAT = (bf16*)(ws + WS_CAT); bf16* const ZA = (bf16*)(ws + WS_ARENA); float* const XR = (float*)(ws + WS_XR); (void)XN; (void)CAT; (void)ZA; (void)XR;
#define SEAM(k) do { if (IN(k) && IN((k) + 1)) xcd_barrier(bar); } while (0)
    PG8_LAS unsigned char* glds = (PG8_LAS unsigned char*)lds_raw;

#define QOFF 0
    if (IN(0)) { FRESH(); prologue_weights<0, CONV_DENSE_ITEMS, false>(args, c); prologue_tables(args, c); __syncthreads(); row_phase<0>(args, c, ain(args, 0), ain(args, 1)); }
    SEAM(0);
    if (IN(1)) { FRESH(); pg8::Gemm g{XN, (const bf16*)(ws + WS_W_EIN), T, 3072, 1024}; pg8::StaticOrder S; S.init(T, 3072, GRID, c.bid);
        pg8::EpiBf16 E{ZA, ZP, nullptr, 0, 0, nullptr, 6, 8, 12}; pg8::gemm_phase<pg8::EpiBf16, pg8::StaticOrder, true, true>(glds, g, S, E, c.tid); }
    SEAM(1);
    if (IN(2)) { FRESH(); for (int u = c.bid; u < 1024; u += GRID) { if (u < 512) ml_state_unit(args, c, u); else sg_unit(args, c, u - 512); } }
    SEAM(2);
    if (IN(3)) { FRESH(); ml_scan_phase(c); }
    SEAM(3);
    if (IN(4)) { FRESH(); for (int u = c.bid; u < 512; u += GRID) ml_out_unit(args, c, u); }
    SEAM(4);
    if (IN(5)) { FRESH(); pg8::Gemm g{CAT, (const bf16*)(ws + WS_W_EOUT), T, 1024, 1024}; pg8::StaticOrder S; S.init(T, 1024, GRID, c.bid);
        pg8::EpiResF32 E{ain(args, 0), XR, DM}; pg8::gemm_phase<pg8::EpiResF32, pg8::StaticOrder, false, true>(glds, g, S, E, c.tid); }
    SEAM(5);
    if (IN(6)) { FRESH(); row_phase<1>(args, c, XR, ain(args, 11)); }
    SEAM(6);
    if (IN(7)) { FRESH(); pg8::Gemm g{XN, (const bf16*)(ws + WS_W_FGU), T, 2 * FF, 1024}; pg8::StaticOrder S; S.init(T, 2 * FF, GRID, c.bid);
        pg8::EpiSwiglu E{ZA, FF}; pg8::gemm_phase<pg8::EpiSwiglu, pg8::StaticOrder, true, true>(glds, g, S, E, c.tid); }
    SEAM(7);
    if (IN(8)) { FRESH(); pg8::Gemm g{ZA, (const bf16*)(ws + WS_W_FDN), T, 1024, FF}; pg8::StaticOrder S; S.init(T, 1024, GRID, c.bid);
        pg8::EpiResF32 E{XR, XR, DM}; pg8::gemm_phase<pg8::EpiResF32, pg8::StaticOrder, false, true>(glds, g, S, E, c.tid); }
    SEAM(8);
    if (IN(9)) { FRESH(); row_phase<2>(args, c, XR, ain(args, 14)); }
    SEAM(9);
    if (IN(10)) { FRESH(); fox_cumsum(c); __syncthreads();
        pg8::Gemm g{XN, (const bf16*)(ws + WS_W_OIN), T, 3072, 1024}; pg8::StaticOrder S; S.init(T, 3072, GRID, c.bid);
        pg8::EpiBf16 E{ZA, ZP, (const float*)(ws + WS_ROPE), 6, 10, (float*)(ws + WS_NORM2), 99, 99, 99}; pg8::gemm_phase<pg8::EpiBf16, pg8::StaticOrder, true, true>(glds, g, S, E, c.tid); }
    SEAM(10);
    if (IN(11)) { FRESH(); attn_phase(args, c, QOFF); }
    SEAM(11);
    if (IN(12)) { FRESH(); diffnorm_phase(args, c); }
    SEAM(12);
    if (IN(13)) { FRESH(); pg8::Gemm g{CAT, (const bf16*)(ws + WS_W_OOUT), T, 1024, 1024}; pg8::StaticOrder S; S.init(T, 1024, GRID, c.bid);
        pg8::EpiResF32 E{XR, XR, DM}; pg8::gemm_phase<pg8::EpiResF32, pg8::StaticOrder, false, true>(glds, g, S, E, c.tid); }
    SEAM(13);
    if (IN(14)) { FRESH(); row_phase<3>(args, c, XR, ain(args, 20)); }
    SEAM(14);
    if (IN(15)) { FRESH(); moe_scatter_phase(c); prologue_weights<CONV_DENSE_ITEMS, CONV_ALL_ITEMS, true>(args, c); }
    SEAM(15);
    if (IN(16)) { FRESH(); pg8::Gemm g{(const bf16*)(ws + WS_XP), (const bf16*)(ws + WS_W_MGU), 0, 2 * FFE, 1024}; pg8::MoeOrder S;
#pragma unroll
        for (int e = 0; e < 9; ++e) S.ts[e] = __builtin_amdgcn_readfirstlane(ldi((const int*)(ws + WS_MISC + MISC_TS) + e));
        S.nM = S.ts[8]; S.nN = 2 * FFE / 256; S.nwg = S.nM * S.nN; S.G = GRID; S.c = c.bid;
        pg8::EpiSwiglu E{ZA, FFE}; pg8::gemm_phase<pg8::EpiSwiglu, pg8::MoeOrder, true, true>(glds, g, S, E, c.tid); }
    SEAM(16);
    if (IN(17)) { FRESH(); pg8::Gemm g{ZA, (const bf16*)(ws + WS_W_MDN), 0, 1024, FFE}; pg8::HybridOrder S;
#pragma unroll
        for (int e = 0; e < 9; ++e) S.ts[e] = __builtin_amdgcn_readfirstlane(ldi((const int*)(ws + WS_MISC + MISC_TS) + e));
        S.nN = 4; S.NKT = FFE / 64; S.U = S.ts[8] * 4; S.G = GRID; S.c = c.bid;
        pg8::EpiMoeDownSK E{(bf16*)(ws + WS_Y), DM, (const float*)(ws + WS_RW), (float*)(ws + WS_XP), pg8::hyb_SL(S.U - 512)}; pg8::gemm_phase<pg8::EpiMoeDownSK, pg8::HybridOrder, true, true>(glds, g, S, E, c.tid); }
    SEAM(17);
    if (IN(18)) { FRESH(); row_phase<4>(args, c, XR, ain(args, 24)); }
#undef QOFF
#undef IN
#undef SEAM
}

extern "C" void kernel_launch(void* const* d_in, const int* in_sizes, int n_in, void* d_out, int out_size, void* d_ws, size_t ws_size, hipStream_t stream) {
    static int ready = 0;
    if (ready == 0) {
        if (n_in != 25 || in_sizes[0] != T * DM || out_size != T * DM || ws_size < WS_END) {
            fprintf(stderr, "kernel_launch: built for 25 inputs, x/out of %d floats, >= %zu bytes of workspace; got n_in %d in0 %d out %d ws %zu; nothing launched\n", T * DM, (size_t)WS_END, n_in, n_in > 0 ? in_sizes[0] : -1, out_size, ws_size);
            ready = -1; return; }
        if (hipFuncSetAttribute((const void*)fwd_kernel, hipFuncAttributeMaxDynamicSharedMemorySize, LDS_BYTES) != hipSuccess) { fprintf(stderr, "kernel_launch: hipFuncSetAttribute(%d) failed\n", LDS_BYTES); ready = -1; return; }
        int dev = 0, cus = 0, per_cu = 0; (void)hipGetDevice(&dev); (void)hipDeviceGetAttribute(&cus, hipDeviceAttributeMultiprocessorCount, dev);
        if (hipOccupancyMaxActiveBlocksPerMultiprocessor(&per_cu, (const void*)fwd_kernel, NTHR, LDS_BYTES) != hipSuccess) per_cu = -1;
        (void)hipGetLastError();
        if (cus < GRID || per_cu < 1) fprintf(stderr, "kernel_launch: note: %d CUs, occupancy query %d; the kernel needs %d co-resident workgroups (one per CU)\n", cus, per_cu, GRID);
        ready = 1;
    }
    if (ready < 0) return;
    (void)hipMemsetAsync((char*)d_ws + WS_CTL, 0, CTL_ZERO_BYTES, stream);
    Args a{};
    for (int i = 0; i < 25; ++i) a.in[i] = (const float*)d_in[i];
    a.out = (float*)d_out; a.ws = (unsigned char*)d_ws;
#if MK_PER_PHASE
    for (int p = 0; p < NPHASE; ++p) { a.ph_lo = p; a.ph_hi = p + 1; hipLaunchKernelGGL(fwd_kernel, dim3(GRID), dim3(NTHR), LDS_BYTES, stream, a); }
#else
    a.ph_lo = 0; a.ph_hi = NPHASE; hipLaunchKernelGGL(fwd_kernel, dim3(GRID), dim3(NTHR), LDS_BYTES, stream, a);
#endif
    const hipError_t le = hipPeekAtLastError();
    if (le != hipSuccess) fprintf(stderr, "kernel_launch: launch failed: %s\n", hipGetErrorName(le));
}
```

```cpp
#include <hip/hip_runtime.h>
#include <cstdio>
#include <cstdint>

#define LAS __attribute__((address_space(3)))
#define GAS __attribute__((address_space(1)))
typedef unsigned short bf16;
typedef unsigned short bf16_t;
typedef short bf16x8 __attribute__((ext_vector_type(8)));
typedef short s16x4 __attribute__((ext_vector_type(4)));
typedef float f32x2 __attribute__((ext_vector_type(2)));
typedef float f32x4 __attribute__((ext_vector_type(4)));
typedef float f32x16 __attribute__((ext_vector_type(16)));
typedef unsigned u32x2 __attribute__((ext_vector_type(2)));
typedef unsigned u32x4 __attribute__((ext_vector_type(4)));
typedef GAS unsigned gu32;
#define RLX_AGENT __ATOMIC_RELAXED, __HIP_MEMORY_SCOPE_AGENT
#define LDS_WAIT() asm volatile("s_waitcnt lgkmcnt(0)" ::: "memory")
#define VM_WAIT() asm volatile("s_waitcnt vmcnt(0)" ::: "memory")

typedef __bf16 bf16x2_t __attribute__((ext_vector_type(2)));
__device__ __forceinline__ unsigned pk2(float lo, float hi) { const f32x2 v = {lo, hi}; return __builtin_bit_cast(unsigned, __builtin_convertvector(v, bf16x2_t)); }
__device__ __forceinline__ unsigned f2bf(float f) { return pk2(f, 0.f) & 0xffffu; }
__device__ __forceinline__ float bf2f(unsigned b) { return __builtin_bit_cast(float, b << 16); }
__device__ __forceinline__ float bflo(unsigned w) { return __builtin_bit_cast(float, w << 16); }
__device__ __forceinline__ float bfhi(unsigned w) { return __builtin_bit_cast(float, w & 0xffff0000u); }
__device__ __forceinline__ float ldf(const float* p) { return __builtin_bit_cast(float, __hip_atomic_load((const unsigned*)p, RLX_AGENT)); }
__device__ __forceinline__ int ldi(const int* p) { return __hip_atomic_load(p, RLX_AGENT); }
__device__ __forceinline__ float wave_sum(float v) {
#define DPPF(x, ctrl, rmask) __builtin_bit_cast(float, __builtin_amdgcn_update_dpp(0, __builtin_bit_cast(int, x), ctrl, rmask, 0xF, true))
    v += DPPF(v, 0xB1, 0xF);
    v += DPPF(v, 0x4E, 0xF);
    v += DPPF(v, 0x141, 0xF);
    v += DPPF(v, 0x140, 0xF);
    v += DPPF(v, 0x142, 0xA);
    v += DPPF(v, 0x143, 0xC);
#undef DPPF
    return __builtin_bit_cast(float, __builtin_amdgcn_readlane(__builtin_bit_cast(int, v), 63));
}
__device__ __forceinline__ float wave_max(float v) {
#pragma unroll
    for (int o = 1; o < 64; o <<= 1) v = fmaxf(v, __shfl_xor(v, o));
    return v;
}
__device__ __forceinline__ float shfl_up_l(float v, int o, int lane) { const int src = (lane >= o) ? lane - o : lane; return __builtin_bit_cast(float, __builtin_amdgcn_ds_bpermute(src << 2, __builtin_bit_cast(int, v))); }
__device__ __forceinline__ float shfl_idx_l(float v, int src) { return __builtin_bit_cast(float, __builtin_amdgcn_ds_bpermute(src << 2, __builtin_bit_cast(int, v))); }
__device__ __forceinline__ float shfl_xor_l(float v, int o, int lane) { return __builtin_bit_cast(float, __builtin_amdgcn_ds_bpermute((lane ^ o) << 2, __builtin_bit_cast(int, v))); }
__device__ __forceinline__ float quad_xor1(float v) { return __builtin_bit_cast(float, __builtin_amdgcn_update_dpp(0, __builtin_bit_cast(int, v), 0xB1, 0xF, 0xF, true)); }
__device__ __forceinline__ float quad_xor2(float v) { return __builtin_bit_cast(float, __builtin_amdgcn_update_dpp(0, __builtin_bit_cast(int, v), 0x4E, 0xF, 0xF, true)); }
__device__ __forceinline__ float quad_sum(float v) { v += quad_xor1(v); v += quad_xor2(v); return v; }
__device__ __forceinline__ float fast_exp(float x) { return __builtin_amdgcn_exp2f(x * 1.4426950408889634f); }
__device__ __forceinline__ float sigmoidf_(float x) { return __builtin_amdgcn_rcpf(1.0f + fast_exp(-x)); }
__device__ __forceinline__ float siluf_(float x) { return x * sigmoidf_(x); }
__device__ __forceinline__ float gelu_tanh(float x) {
    const float x2 = x * x, t = fmaf(x2, -2.3022082299f * 0.044715f, -2.3022082299f);
    return x * __builtin_amdgcn_rcpf(1.0f + __builtin_amdgcn_exp2f(x * t));
}
__device__ __forceinline__ float log_sigmoid_acc(float x) { return fminf(x, 0.f) - log1pf(expf(-fabsf(x))); }

namespace pg8 {
#define PG8_LAS __attribute__((address_space(3)))
constexpr int BM = 256, BK = 64, HALF = 128, HTB = HALF * BK * 2, STAGE_BYTES = 8 * HTB, NXCD = 8, WGM = 8;
__host__ __device__ __forceinline__ int lds_byte(int r, int c) { const int st = (r >> 4) * 2 + (c >> 5), rr = r & 15, cc = c & 31, ob = rr * 64 + cc * 2; return st * 1024 + (ob ^ (((ob >> 9) & 1) << 5)); }
__host__ __device__ __forceinline__ void stage_rc(int b, int& R, int& C) { const int st = b / 1024, sb = b % 1024, swz = sb ^ (((sb >> 9) & 1) << 5); R = (st >> 1) * 16 + swz / 64; C = (st & 1) * 32 + (swz % 64) / 2; }
__host__ __device__ __forceinline__ int perm32(int rho) { const int n = rho >> 4, i = rho & 15; return 8 * (i >> 2) + 4 * n + (i & 3); }

struct Unit { int pm, pn, pb, kt0, nkt; };
struct Gemm { const bf16_t* A; const bf16_t* Bt; int M, N, K; };

struct StaticOrder {
    int nM, nN, nwg, G, c; int wgm = WGM;
    __host__ __device__ void init(int M, int N, int G_, int c_) { nM = M / BM; nN = N / BM; nwg = nM * nN; G = G_; c = c_; }
    __host__ __device__ __forceinline__ bool next(int i, Unit& u) const {
        const long L = (long)i * G + c; if (L >= nwg) return false;
        int wgid = (int)L; { const int q = nwg / NXCD, r = nwg % NXCD, xcd = wgid % NXCD, off = wgid / NXCD; wgid = (xcd < r ? xcd * (q + 1) : r * (q + 1) + (xcd - r) * q) + off; }
        const int nig = wgm * nN, gid = wgid / nig, fm = gid * wgm, gsz = (nM - fm) < wgm ? (nM - fm) : wgm;
        u.pm = fm + ((wgid % nig) % gsz); u.pn = (wgid % nig) / gsz; u.pb = u.pn; return true;
    }
    static constexpr bool KRANGE = false;
    __device__ __forceinline__ void a_ready(const Unit&) const {}
    __device__ __forceinline__ void done(const Unit&) const {}
};
struct MoeOrder {
    int nM, nN, nwg, G, c; int ts[9]; int wgm = WGM;
    __device__ __forceinline__ bool next(int i, Unit& u) const {
        const long L = (long)i * G + c; if (L >= nwg) return false;
        int wgid = (int)L; { const int q = nwg / NXCD, r = nwg % NXCD, xcd = wgid % NXCD, off = wgid / NXCD; wgid = (xcd < r ? xcd * (q + 1) : r * (q + 1) + (xcd - r) * q) + off; }
        const int nig = wgm * nN, gid = wgid / nig, fm = gid * wgm, gsz = (nM - fm) < wgm ? (nM - fm) : wgm;
        u.pm = fm + ((wgid % nig) % gsz); u.pn = (wgid % nig) / gsz;
        int e = 0;
#pragma unroll
        for (int k = 1; k < 8; ++k) e += (u.pm >= ts[k]) ? 1 : 0;
        u.pb = e * nN + u.pn; return true;
    }
    static constexpr bool KRANGE = false;
    __device__ __forceinline__ void a_ready(const Unit&) const {}
    __device__ __forceinline__ void done(const Unit&) const {}
};
__host__ __device__ __forceinline__ int hyb_SL(int R) { return R <= 9 ? 28 : (R <= 18 ? 14 : (R <= 36 ? 7 : 4)); }
struct HybridOrder {
    int U, c, nN, NKT, G; int ts[9];
    __device__ __forceinline__ bool next(int i, Unit& u) const {
        const bool full = i < 2; const int R = U - 512, SL = hyb_SL(R), ui = c / SL, sl = c - ui * SL;
        if (!full && (i > 2 || R <= 0 || ui >= R)) return false;
        int wgid = i * G + c; { const int q = 512 / NXCD, xcd = wgid % NXCD, off = wgid / NXCD; wgid = xcd * q + off; }
        const int nig = WGM * nN, fm = (wgid / nig) * WGM, pm_f = fm + ((wgid % nig) % WGM), pn_f = (wgid % nig) / WGM;
        const int unit = 512 + ui, pm_s = unit / nN, pn_s = unit - pm_s * nN, nk_s = NKT / SL;
        const int pm = full ? pm_f : pm_s, pn = full ? pn_f : pn_s, nkt = full ? NKT : nk_s, kt0 = full ? 0 : sl * nk_s;
        int e = 0;
#pragma unroll
        for (int k = 1; k < 8; ++k) e += (pm >= ts[k]) ? 1 : 0;
        u.pm = pm; u.pn = pn; u.pb = e * nN + pn; u.kt0 = kt0; u.nkt = nkt; return true;
    }
    static constexpr bool KRANGE = true;
    __device__ __forceinline__ void a_ready(const Unit&) const {}
    __device__ __forceinline__ void done(const Unit&) const {}
};

__device__ __forceinline__ unsigned cvt_pk_bf16(float lo, float hi) { unsigned r; asm volatile("v_cvt_pk_bf16_f32 %0, %1, %2" : "=v"(r) : "v"(lo), "v"(hi)); return r; }

struct EpiBf16 {
    static constexpr bool PERM = true, AFTER_DRAIN = false;
    bf16_t* O; int ldc; const float* cs; int rope_pn0, rope_pn1; float* norm2; int sig_pn0, gelu_pn0, gelu_pn1;
    __device__ __forceinline__ void operator()(const f32x4 (&acc)[2][2][4][2], const Unit& u, int wr, int wc, int fr, int fq) const {
        const int row0 = u.pm * BM + wr * 64 + fr; const int col0 = u.pn * BM + wc * 32 + 8 * fq;
        if (norm2 != nullptr && u.pn < 4) {
#pragma unroll
            for (int ai = 0; ai < 2; ++ai)
#pragma unroll
                for (int m = 0; m < 4; ++m)
#pragma unroll
                    for (int bj = 0; bj < 2; ++bj) { const f32x4 a0 = acc[ai][bj][m][0], a1 = acc[ai][bj][m][1];
                        float s = (a0[0] * a0[0] + a0[1] * a0[1]) + (a0[2] * a0[2] + a0[3] * a0[3]) + (a1[0] * a1[0] + a1[1] * a1[1]) + (a1[2] * a1[2] + a1[3] * a1[3]);
                        s += __shfl_xor(s, 16); s += __shfl_xor(s, 32);
                        if (fq == 0) norm2[((size_t)(row0 + ai * HALF + m * 16) * 8 + (u.pn >> 1) * 4 + (u.pn & 1) * 2 + bj) * 4 + wc] = s; }
        }
        const bool rope = (u.pn >= rope_pn0) && (u.pn < rope_pn1) && ((wc & 1) == 0);
        const float sgn = (fq == 0) ? -1.f : 1.f;
#pragma unroll
        for (int ai = 0; ai < 2; ++ai)
#pragma unroll
            for (int m = 0; m < 4; ++m) { const int row = row0 + ai * HALF + m * 16; bf16_t* rowp = O + (size_t)row * ldc + col0;
                f32x4 c0 = {1.f, 1.f, 1.f, 1.f}, c1 = c0, s0 = {0.f, 0.f, 0.f, 0.f}, s1 = s0;
                if (rope) {
                    const float pos = (float)(row & 8191);
                    constexpr float IR[8] = {0.15915494309189535f, 0.03086376340470123f, 0.0059851857127137054f, 0.001160663641240061f, 0.00022507907903927653f, 4.3647952792802891e-05f, 8.4643308082414014e-06f, 1.6414262627950345e-06f};
#pragma unroll
                    for (int k = 0; k < 4; ++k) { const float r0 = __builtin_amdgcn_fractf(pos * IR[k]), r1 = __builtin_amdgcn_fractf(pos * IR[4 + k]);
                        c0[k] = __builtin_amdgcn_cosf(r0); s0[k] = __builtin_amdgcn_sinf(r0); c1[k] = __builtin_amdgcn_cosf(r1); s1[k] = __builtin_amdgcn_sinf(r1); } }
#pragma unroll
                for (int bj = 0; bj < 2; ++bj) { f32x4 v0 = acc[ai][bj][m][0], v1 = acc[ai][bj][m][1];
                    if (u.pn >= gelu_pn0 && u.pn < gelu_pn1) {
#pragma unroll
                        for (int i = 0; i < 4; ++i) { v0[i] = gelu_tanh(v0[i]); v1[i] = gelu_tanh(v1[i]); } }
                    else if (u.pn >= sig_pn0 && u.pn < gelu_pn0) {
#pragma unroll
                        for (int i = 0; i < 4; ++i) { v0[i] = sigmoidf_(v0[i]); v1[i] = sigmoidf_(v1[i]); } }
                    if (rope) { f32x4 p0, p1;
#pragma unroll
                        for (int i = 0; i < 4; ++i) { p0[i] = __shfl_xor(v0[i], 16); p1[i] = __shfl_xor(v1[i], 16); }
                        if (fq < 2) { v0 = v0 * c0 + (p0 * s0) * sgn; v1 = v1 * c1 + (p1 * s1) * sgn; } }
                    u32x4 w; w.x = cvt_pk_bf16(v0[0], v0[1]); w.y = cvt_pk_bf16(v0[2], v0[3]); w.z = cvt_pk_bf16(v1[0], v1[1]); w.w = cvt_pk_bf16(v1[2], v1[3]);
                    *(u32x4*)(rowp + bj * HALF) = w; } }
    }
};
struct EpiResF32 {
    static constexpr bool PERM = false, AFTER_DRAIN = false;
    const float* base; float* out; int ldc;
    __device__ __forceinline__ void operator()(const f32x4 (&acc)[2][2][4][2], const Unit& u, int wr, int wc, int fr, int fq) const {
        const int row0 = u.pm * BM + wr * 64 + fr, col0 = u.pn * BM + wc * 32 + 4 * fq;
#pragma unroll
        for (int ai = 0; ai < 2; ++ai) {
            f32x4 b[4][2][2];
#pragma unroll
            for (int m = 0; m < 4; ++m) { const size_t off = (size_t)(row0 + ai * HALF + m * 16) * ldc + col0;
#pragma unroll
                for (int bj = 0; bj < 2; ++bj)
#pragma unroll
                    for (int n = 0; n < 2; ++n) b[m][bj][n] = *(const f32x4*)(base + off + bj * HALF + n * 16); }
#pragma unroll
            for (int m = 0; m < 4; ++m) { const size_t off = (size_t)(row0 + ai * HALF + m * 16) * ldc + col0;
#pragma unroll
                for (int bj = 0; bj < 2; ++bj)
#pragma unroll
                    for (int n = 0; n < 2; ++n) *(f32x4*)(out + off + bj * HALF + n * 16) = b[m][bj][n] + acc[ai][bj][m][n]; }
            asm volatile("" ::: "memory"); }
    }
};
struct EpiSwiglu {
    static constexpr bool PERM = true, AFTER_DRAIN = false;
    bf16_t* O; int ldc;
    __device__ __forceinline__ void operator()(const f32x4 (&acc)[2][2][4][2], const Unit& u, int wr, int wc, int fr, int fq) const {
        const int row0 = u.pm * BM + wr * 64 + fr; const int col0 = u.pn * HALF + wc * 32 + 8 * fq;
#pragma unroll
        for (int ai = 0; ai < 2; ++ai)
#pragma unroll
            for (int m = 0; m < 4; ++m) { bf16_t* rowp = O + (size_t)(row0 + ai * HALF + m * 16) * ldc + col0;
                f32x4 h0, h1;
#pragma unroll
                for (int i = 0; i < 4; ++i) { h0[i] = siluf_(acc[ai][0][m][0][i]) * acc[ai][1][m][0][i]; h1[i] = siluf_(acc[ai][0][m][1][i]) * acc[ai][1][m][1][i]; }
                u32x4 w; w.x = cvt_pk_bf16(h0[0], h0[1]); w.y = cvt_pk_bf16(h0[2], h0[3]); w.z = cvt_pk_bf16(h1[0], h1[1]); w.w = cvt_pk_bf16(h1[2], h1[3]);
                *(u32x4*)rowp = w; }
    }
};
#if defined(PROBE_EPI)
struct EpiNone { static constexpr bool PERM = true, AFTER_DRAIN = false; bf16_t* O; int ldc;
    __device__ __forceinline__ void operator()(const f32x4 (&acc)[2][2][4][2], const Unit& u, int wr, int wc, int fr, int fq) const {
        float s = 0.f;
#pragma unroll
        for (int ai = 0; ai < 2; ++ai)
#pragma unroll
            for (int bj = 0; bj < 2; ++bj)
#pragma unroll
                for (int m = 0; m < 4; ++m)
#pragma unroll
                    for (int n = 0; n < 2; ++n) s += acc[ai][bj][m][n][0];
        if (s == 12345.678f) O[0] = 1; } };
struct EpiSwigluCheap {
    static constexpr bool PERM = true, AFTER_DRAIN = false;
    bf16_t* O; int ldc;
    __device__ __forceinline__ void operator()(const f32x4 (&acc)[2][2][4][2], const Unit& u, int wr, int wc, int fr, int fq) const {
        const int row0 = u.pm * BM + wr * 64 + fr; const int col0 = u.pn * HALF + wc * 32 + 8 * fq;
#pragma unroll
        for (int ai = 0; ai < 2; ++ai)
#pragma unroll
            for (int m = 0; m < 4; ++m) { bf16_t* rowp = O + (size_t)(row0 + ai * HALF + m * 16) * ldc + col0;
                const f32x4 h0 = acc[ai][0][m][0] * acc[ai][1][m][0], h1 = acc[ai][0][m][1] * acc[ai][1][m][1];
                u32x4 w; w.x = cvt_pk_bf16(h0[0], h0[1]); w.y = cvt_pk_bf16(h0[2], h0[3]); w.z = cvt_pk_bf16(h1[0], h1[1]); w.w = cvt_pk_bf16(h1[2], h1[3]);
                *(u32x4*)rowp = w; }
    }
};
#endif
struct EpiMoeDown {
    static constexpr bool PERM = false, AFTER_DRAIN = false;
    float* Y; int ldc; const float* rw;
    __device__ __forceinline__ void operator()(const f32x4 (&acc)[2][2][4][2], const Unit& u, int wr, int wc, int fr, int fq) const {
        const int row0 = u.pm * BM + wr * 64 + fr, col0 = u.pn * BM + wc * 32 + 4 * fq;
#pragma unroll
        for (int ai = 0; ai < 2; ++ai)
#pragma unroll
            for (int m = 0; m < 4; ++m) { const int row = row0 + ai * HALF + m * 16; const float w = ldf(rw + row); const size_t off = (size_t)row * ldc + col0;
#pragma unroll
                for (int bj = 0; bj < 2; ++bj)
#pragma unroll
                    for (int n = 0; n < 2; ++n) *(f32x4*)(Y + off + bj * HALF + n * 16) = acc[ai][bj][m][n] * w; }
    }
};

struct EpiMoeDownSK {
    static constexpr bool PERM = true, AFTER_DRAIN = false;
    bf16_t* Y; int ldc; const float* rw; float* slab; int SL;
    __device__ __forceinline__ void operator()(const f32x4 (&acc)[2][2][4][2], const Unit& u, int wr, int wc, int fr, int fq) const {
        const int r0 = wr * 64 + fr, c0 = wc * 32 + 8 * fq; const bool second = u.kt0 != 0;
        const int sidx = second ? (u.pm * 4 + u.pn - 512) * (SL - 1) + u.kt0 / u.nkt - 1 : 0;
        float* sb = slab + (size_t)sidx * 65536 + c0; bf16_t* yb = Y + (size_t)(u.pm * BM) * ldc + u.pn * BM + c0;
        float wv[2][4];
#pragma unroll
        for (int ai = 0; ai < 2; ++ai)
#pragma unroll
            for (int m = 0; m < 4; ++m) wv[ai][m] = rw[u.pm * BM + r0 + ai * HALF + m * 16];
#pragma unroll
        for (int ai = 0; ai < 2; ++ai)
#pragma unroll
            for (int m = 0; m < 4; ++m) { const int r = r0 + ai * HALF + m * 16; const float w = wv[ai][m];
#pragma unroll
                for (int bj = 0; bj < 2; ++bj) { const f32x4 v0 = acc[ai][bj][m][0] * w, v1 = acc[ai][bj][m][1] * w;
                    if (second) { *(f32x4*)(sb + (size_t)r * 256 + bj * HALF) = v0; *(f32x4*)(sb + (size_t)r * 256 + bj * HALF + 4) = v1; }
                    else { u32x4 o; o.x = cvt_pk_bf16(v0[0], v0[1]); o.y = cvt_pk_bf16(v0[2], v0[3]); o.z = cvt_pk_bf16(v1[0], v1[1]); o.w = cvt_pk_bf16(v1[2], v1[3]); *(u32x4*)(yb + (size_t)r * ldc + bj * HALF) = o; } } }
    }
};

template <class Epi, class Sched, bool ALIGN_EPI = false, bool SP2 = false>
__device__ __forceinline__ void gemm_phase(PG8_LAS unsigned char* lds, const Gemm g, const Sched& S, const Epi& E, const int tid) {
    const int wid = __builtin_amdgcn_readfirstlane(tid >> 6), lane = tid & 63, wr = wid >> 2, wc = wid & 3, fr = lane & 15, fq = lane >> 4;
    const int K = g.K; int nt = K / BK;
    unsigned voffA[2], voffB[2];
#pragma unroll
    for (int i = 0; i < 2; ++i) { int R, C; stage_rc(tid * 16 + i * 8192, R, C); const int Rb = Epi::PERM ? ((R & ~31) + perm32(R & 31)) : R;
        voffA[i] = (unsigned)(R * K + C) * 2u; voffB[i] = (unsigned)(Rb * K + C) * 2u; }
    const size_t kstep = (size_t)(BK * 2);
    const size_t hstep = (size_t)HALF * K * 2;
    const size_t tstep = 2 * hstep;
    const unsigned ldsw = (unsigned)wid * 1024u;
    const int aoff = lds_byte(wr * 64 + fr, fq * 8), boff = lds_byte(wc * 32 + fr, fq * 8);
#define PG8_SA(b, h) (((b) * 2 + (h)) * HTB)
#define PG8_SB(b, h) ((4 + (b) * 2 + (h)) * HTB)
#define PG8_STAGE(bufoff, gbase, voff) do { _Pragma("unroll") for (int _i = 0; _i < 2; ++_i) \
        __builtin_amdgcn_global_load_lds((const unsigned*)((const char*)(gbase) + (voff)[_i]), (PG8_LAS unsigned*)(lds + (bufoff) + ldsw + _i * 8192), 16, 0, 0); } while (0)
#define PG8_LDA(dst, b, h) do { _Pragma("unroll") for (int m = 0; m < 4; ++m) _Pragma("unroll") for (int k = 0; k < 2; ++k) dst[m][k] = *(const PG8_LAS bf16x8*)(lds + PG8_SA(b, h) + aoff + m * 2048 + k * 1024); } while (0)
#define PG8_LDB(dst, b, h) do { _Pragma("unroll") for (int n = 0; n < 2; ++n) _Pragma("unroll") for (int k = 0; k < 2; ++k) dst[n][k] = *(const PG8_LAS bf16x8*)(lds + PG8_SB(b, h) + boff + n * 2048 + k * 1024); } while (0)
#define PG8_MMA(ai, bj, At, Bt) do { __builtin_amdgcn_s_setprio(1); _Pragma("unroll") for (int m = 0; m < 4; ++m) _Pragma("unroll") for (int n = 0; n < 2; ++n) _Pragma("unroll") for (int k = 0; k < 2; ++k) \
        acc[ai][bj][m][n] = __builtin_amdgcn_mfma_f32_16x16x32_bf16(Bt[n][k], At[m][k], acc[ai][bj][m][n], 0, 0, 0); __builtin_amdgcn_s_setprio(0); } while (0)
#define PG8_WAIT_V(n) asm volatile("s_waitcnt vmcnt(" #n ")" ::: "memory")
#define PG8_WAIT_L(n) asm volatile("s_waitcnt lgkmcnt(" #n ")" ::: "memory")
#define PG8_BAR __builtin_amdgcn_s_barrier()
#define PG8_SCHED __builtin_amdgcn_sched_barrier(0)
    Unit cur, nxt; int ui = 0;
    if (!S.next(0, cur)) return;
    f32x4 acc[2][2][4][2];
#pragma unroll
    for (int a = 0; a < 2; ++a)
#pragma unroll
        for (int b = 0; b < 2; ++b)
#pragma unroll
            for (int m = 0; m < 4; ++m)
#pragma unroll
                for (int n = 0; n < 2; ++n) acc[a][b][m][n] = (f32x4){0.f, 0.f, 0.f, 0.f};
    bf16x8 At[4][2], B0[2][2], B1[2][2];
    const char* cA = (const char*)g.A + (size_t)cur.pm * tstep; const char* cB = (const char*)g.Bt + (size_t)cur.pb * tstep;
    if constexpr (Sched::KRANGE) { cA += (size_t)cur.kt0 * kstep; cB += (size_t)cur.kt0 * kstep; nt = cur.nkt; }
    S.a_ready(cur);
    if constexpr (SP2) {
        PG8_STAGE(PG8_SB(0, 0), cB, voffB); PG8_STAGE(PG8_SB(0, 1), cB + hstep, voffB); PG8_STAGE(PG8_SA(0, 0), cA, voffA); PG8_STAGE(PG8_SA(0, 1), cA + hstep, voffA);
        if (wr == 1) PG8_BAR;
        PG8_WAIT_V(2); PG8_BAR;
        PG8_STAGE(PG8_SB(1, 0), cB + kstep, voffB); PG8_STAGE(PG8_SA(1, 0), cA + kstep, voffA); PG8_STAGE(PG8_SB(1, 1), cB + hstep + kstep, voffB);
        PG8_WAIT_V(6); PG8_BAR;
    } else {
        PG8_STAGE(PG8_SB(0, 0), cB, voffB); PG8_STAGE(PG8_SA(0, 0), cA, voffA); PG8_STAGE(PG8_SB(0, 1), cB + hstep, voffB); PG8_STAGE(PG8_SA(0, 1), cA + hstep, voffA);
        if (wr == 1) PG8_BAR;
        PG8_WAIT_V(4); PG8_BAR;
        PG8_STAGE(PG8_SB(1, 0), cB + kstep, voffB); PG8_STAGE(PG8_SA(1, 0), cA + kstep, voffA); PG8_STAGE(PG8_SB(1, 1), cB + hstep + kstep, voffB);
        PG8_WAIT_V(6); PG8_BAR;
    }
    for (;;) {
        const bool has_next = S.next(ui + 1, nxt);
        const char* nA = has_next ? (const char*)g.A + (size_t)nxt.pm * tstep : cA; const char* nB = has_next ? (const char*)g.Bt + (size_t)nxt.pb * tstep : cB;
        if constexpr (Sched::KRANGE) { if (has_next) { nA += (size_t)nxt.kt0 * kstep; nB += (size_t)nxt.kt0 * kstep; } }
        for (int t = 0; t < nt; t += 2) {
            const bool last = (t == nt - 2);
            const char* a1 = cA + (size_t)(t + 1) * kstep;
            const char* a2 = last ? nA : cA + (size_t)(t + 2) * kstep; const char* b2 = last ? nB : cB + (size_t)(t + 2) * kstep;
            const char* a3 = a2 + kstep; const char* b3 = b2 + kstep;
            if (last && has_next) S.a_ready(nxt);
            if constexpr (SP2) {
            PG8_LDB(B0, 0, 0); PG8_LDB(B1, 0, 1); PG8_SCHED; PG8_LDA(At, 0, 0); PG8_STAGE(PG8_SA(1, 1), a1 + hstep, voffA);
            PG8_WAIT_V(8); PG8_WAIT_L(0); PG8_BAR; PG8_MMA(0, 0, At, B0); PG8_MMA(0, 1, At, B1); PG8_BAR; PG8_SCHED;
            PG8_LDA(At, 0, 1); PG8_STAGE(PG8_SB(0, 0), b2, voffB); PG8_STAGE(PG8_SB(0, 1), b2 + hstep, voffB); PG8_STAGE(PG8_SA(0, 0), a2, voffA);
            PG8_WAIT_V(8); PG8_WAIT_L(0); PG8_BAR; PG8_MMA(1, 0, At, B0); PG8_MMA(1, 1, At, B1); PG8_BAR; PG8_SCHED;
            PG8_LDB(B0, 1, 0); PG8_LDB(B1, 1, 1); PG8_SCHED; PG8_LDA(At, 1, 0); PG8_STAGE(PG8_SA(0, 1), a2 + hstep, voffA);
            PG8_WAIT_V(8); PG8_WAIT_L(0); PG8_BAR; PG8_MMA(0, 0, At, B0); PG8_MMA(0, 1, At, B1); PG8_BAR; PG8_SCHED;
            PG8_LDA(At, 1, 1); PG8_STAGE(PG8_SB(1, 0), b3, voffB); PG8_STAGE(PG8_SB(1, 1), b3 + hstep, voffB); PG8_STAGE(PG8_SA(1, 0), a3, voffA);
            PG8_WAIT_V(8); PG8_WAIT_L(0); PG8_BAR; PG8_MMA(1, 0, At, B0); PG8_MMA(1, 1, At, B1); PG8_BAR; PG8_SCHED;
            } else {
            PG8_LDB(B0, 0, 0); PG8_SCHED; PG8_LDA(At, 0, 0); PG8_STAGE(PG8_SA(1, 1), a1 + hstep, voffA);
            PG8_WAIT_L(8); PG8_BAR; PG8_WAIT_L(0); PG8_MMA(0, 0, At, B0); PG8_BAR; PG8_SCHED;
            PG8_LDB(B1, 0, 1); PG8_STAGE(PG8_SB(0, 0), b2, voffB);
            PG8_BAR; PG8_WAIT_L(0); PG8_MMA(0, 1, At, B1); PG8_BAR;
            PG8_LDA(At, 0, 1); PG8_STAGE(PG8_SA(0, 0), a2, voffA);
            PG8_BAR; PG8_WAIT_L(0); PG8_MMA(1, 0, At, B0); PG8_BAR; PG8_SCHED;
            PG8_STAGE(PG8_SB(0, 1), b2 + hstep, voffB);
            PG8_WAIT_V(6); PG8_BAR; PG8_MMA(1, 1, At, B1); PG8_BAR;
            PG8_LDB(B0, 1, 0); PG8_SCHED; PG8_LDA(At, 1, 0); PG8_STAGE(PG8_SA(0, 1), a2 + hstep, voffA);
            PG8_WAIT_L(8); PG8_BAR; PG8_WAIT_L(0); PG8_MMA(0, 0, At, B0); PG8_BAR; PG8_SCHED;
            PG8_LDB(B1, 1, 1); PG8_STAGE(PG8_SB(1, 0), b3, voffB);
            PG8_BAR; PG8_WAIT_L(0); PG8_MMA(0, 1, At, B1); PG8_BAR;
            PG8_LDA(At, 1, 1); PG8_STAGE(PG8_SA(1, 0), a3, voffA);
            PG8_BAR; PG8_WAIT_L(0); PG8_MMA(1, 0, At, B0); PG8_BAR; PG8_SCHED;
            PG8_STAGE(PG8_SB(1, 1), b3 + hstep, voffB);
            PG8_WAIT_V(6); PG8_BAR; PG8_MMA(1, 1, At, B1); PG8_BAR;
            }
        }
        if constexpr (ALIGN_EPI) { if (wr == 0) PG8_BAR; }
        if constexpr (!Epi::AFTER_DRAIN) { E(acc, cur, wr, wc, fr, fq); S.done(cur); }
        if (!has_next) break;
#pragma unroll
        for (int a = 0; a < 2; ++a)
#pragma unroll
            for (int b = 0; b < 2; ++b)
#pragma unroll
                for (int m = 0; m < 4; ++m)
#pragma unroll
                    for (int n = 0; n < 2; ++n) acc[a][b][m][n] = (f32x4){0.f, 0.f, 0.f, 0.f};
        cur = nxt; cA = nA; cB = nB; ++ui;
        if constexpr (Sched::KRANGE) nt = cur.nkt;
        if constexpr (ALIGN_EPI) { if (wr == 1) PG8_BAR; }
    }
    PG8_WAIT_V(0);
    if constexpr (!ALIGN_EPI) { if (wr == 0) PG8_BAR; }
    PG8_BAR;
#undef PG8_SA
#undef PG8_SB
#undef PG8_STAGE
#undef PG8_LDA
#undef PG8_LDB
#undef PG8_MMA
#undef PG8_WAIT_V
#undef PG8_WAIT_L
#undef PG8_BAR
#undef PG8_SCHED
}
}
namespace att {
constexpr int NW = 8, QBLK = 32, KVBLK = 64, QB = NW * QBLK, PITCH = 3072, DV = 128;
constexpr int SHM_V = KVBLK * DV * 2;
constexpr int LDS_V = 0, LDS_K = 2 * SHM_V, LDS_WS = 65536, LDS_BYTES = LDS_WS + NW * 64 * 4;
constexpr float THR = 8.f;
template <int DK> struct Cfg { static constexpr int SHM_K = KVBLK * DK * 2; static constexpr float SCALE = (DK == 128) ? 0.08838834764831845f : 0.125f; };

#define KSWZ(row, colB) ((row) * 256 + ((colB) ^ (((row) & 7) << 4)))
#define KSWZ64(row, ch) ((row) * 128 + ((((ch) ^ (((row) >> 1) & 7))) << 4))
#define SBAR() __builtin_amdgcn_sched_barrier(0)
__device__ __forceinline__ int v_st(int k, int c) { const int kk = (k & ~0xC) | ((k & 4) << 1) | ((k & 8) >> 1); return ((kk >> 3) * 4 + (c >> 5)) * 512 + ((kk & 7) * 32 + (c & 31)) * 2; }
__device__ __forceinline__ int v_rd_base(int lane) { return ((lane & 3) << 3) | (((lane >> 2) & 3) << 6) | (((lane >> 4) & 1) << 5) | (((lane >> 5) & 1) << 8); }
constexpr int v_rd_off(int d0, int ks, int half) { return d0 * 512 + ks * 4096 + half * 2048; }
__device__ __forceinline__ int crow(int r, int hi) { return (r & 3) + 8 * (r >> 2) + 4 * hi; }
__device__ __forceinline__ unsigned cvtpk(float lo, float hi) { unsigned r; asm volatile("v_cvt_pk_bf16_f32 %0, %1, %2" : "=v"(r) : "v"(lo), "v"(hi)); return r; }
__device__ __forceinline__ bf16x8 load8(const bf16* p) { return *reinterpret_cast<const bf16x8*>(p); }
__device__ __forceinline__ void mask_tile(f32x16& p0, f32x16& p1, int dq) {
    const float NEG = -__builtin_inff();
#pragma unroll
    for (int r = 0; r < 16; ++r) {
        const int c = (r & 3) + 8 * (r >> 2);
        if (dq - c < 0) p0[r] = NEG;
        if (dq - c - 32 < 0) p1[r] = NEG;
    }
}
template <int DK>
__device__ __forceinline__ void partialSM(f32x16& p0, f32x16& p1, float& m_reg, float& mn, float& alpha) {
    constexpr float SCALE = Cfg<DK>::SCALE;
    float pmax = p0[0]; for (int r = 1; r < 16; ++r) pmax = fmaxf(pmax, p0[r]); for (int r = 0; r < 16; ++r) pmax = fmaxf(pmax, p1[r]);
    { auto rr = __builtin_amdgcn_permlane32_swap(__float_as_uint(pmax), __float_as_uint(pmax), false, false);
      pmax = fmaxf(__uint_as_float(rr[0]), __uint_as_float(rr[1])); }
    constexpr float C2 = 1.4426950408889634f * SCALE;
    if (__builtin_expect(__all((pmax - m_reg) * SCALE <= THR), 1)) { mn = m_reg; alpha = 1.f; }
    else { mn = fmaxf(m_reg, pmax); alpha = __builtin_amdgcn_exp2f((m_reg - mn) * C2); m_reg = mn; }
    const float mnL = -mn * C2;
    for (int r = 0; r < 16; ++r) p0[r] = fmaf(p0[r], C2, mnL); for (int r = 0; r < 16; ++r) p1[r] = fmaf(p1[r], C2, mnL);
    for (int r = 0; r < 16; ++r) p0[r] = __builtin_amdgcn_exp2f(p0[r]);
}
__device__ __forceinline__ void finishSM(f32x16& p0, f32x16& p1, float alpha, float& l_reg, bf16x8& pa0, bf16x8& pa1, bf16x8& pa2, bf16x8& pa3) {
    for (int r = 0; r < 16; ++r) p1[r] = __builtin_amdgcn_exp2f(p1[r]);
    float ps = 0; for (int r = 0; r < 16; ++r) ps += p0[r]; for (int r = 0; r < 16; ++r) ps += p1[r];
    { auto rr = __builtin_amdgcn_permlane32_swap(__float_as_uint(ps), __float_as_uint(ps), false, false);
      ps = __uint_as_float(rr[0]) + __uint_as_float(rr[1]); }
    l_reg = l_reg * alpha + ps;
#define PK4(P, B_, OUT) do { unsigned a0 = cvtpk(P[B_+0], P[B_+1]), a1 = cvtpk(P[B_+2], P[B_+3]);                          \
        unsigned b0 = cvtpk(P[B_+4], P[B_+5]), b1 = cvtpk(P[B_+6], P[B_+7]);                                             \
        auto r0 = __builtin_amdgcn_permlane32_swap(a0, b0, false, false); auto r1 = __builtin_amdgcn_permlane32_swap(a1, b1, false, false); \
        u32x4 w = {r0[0], r1[0], r0[1], r1[1]}; OUT = *reinterpret_cast<bf16x8*>(&w); } while (0)
    PK4(p0, 0, pa0); PK4(p0, 8, pa1); PK4(p1, 0, pa2); PK4(p1, 8, pa3);
#undef PK4
}
__device__ __forceinline__ bf16x8 bias_frag(u32x2 kb, int hi) { u32x4 w = {hi ? 0u : kb.x, hi ? 0u : kb.y, 0u, 0u}; return *reinterpret_cast<bf16x8*>(&w); }
template <int KB, int DK, bool BIAS>
__device__ __forceinline__ void qkt(f32x16& p0, f32x16& p1, const char* K_lds, int r32, int hi, const bf16x8* qr, u32x2 kb0, u32x2 kb1) {
    constexpr int SHM_K = Cfg<DK>::SHM_K;
    p0 = f32x16{}; p1 = f32x16{};
    if constexpr (DK == 128) {
        const char* kb[4];
#pragma unroll
        for (int dd = 0; dd < 4; ++dd) kb[dd] = K_lds + KB * SHM_K + KSWZ(r32, (dd * 16 + hi * 8) * 2);
#pragma unroll
        for (int d0 = 0; d0 < 8; ++d0) { const char* a = kb[d0 & 3] + (d0 >> 2) * 128;
            bf16x8 b0 = *reinterpret_cast<const bf16x8*>(a);
            bf16x8 b1 = *reinterpret_cast<const bf16x8*>(a + 32 * 256);
            p0 = __builtin_amdgcn_mfma_f32_32x32x16_bf16(b0, qr[d0], p0, 0, 0, 0);
            p1 = __builtin_amdgcn_mfma_f32_32x32x16_bf16(b1, qr[d0], p1, 0, 0, 0); }
    } else {
#pragma unroll
        for (int d0 = 0; d0 < 4; ++d0) { const char* a = K_lds + KB * SHM_K + KSWZ64(r32, 2 * d0 + hi);
            bf16x8 b0 = *reinterpret_cast<const bf16x8*>(a);
            bf16x8 b1 = *reinterpret_cast<const bf16x8*>(a + 32 * 128);
            p0 = __builtin_amdgcn_mfma_f32_32x32x16_bf16(b0, qr[d0], p0, 0, 0, 0);
            p1 = __builtin_amdgcn_mfma_f32_32x32x16_bf16(b1, qr[d0], p1, 0, 0, 0); }
    }
    if constexpr (BIAS) {
        u32x4 ow = {hi ? 0u : 0x3f803f80u, hi ? 0u : 0x00003f80u, 0u, 0u}; const bf16x8 qone = *reinterpret_cast<bf16x8*>(&ow);
        p0 = __builtin_amdgcn_mfma_f32_32x32x16_bf16(bias_frag(kb0, hi), qone, p0, 0, 0, 0);
        p1 = __builtin_amdgcn_mfma_f32_32x32x16_bf16(bias_frag(kb1, hi), qone, p1, 0, 0, 0);
    }
}
template <int VB>
__device__ __forceinline__ void pv_tile(f32x16* o, int vb0, bf16x8 pa0, bf16x8 pa1, bf16x8 pa2, bf16x8 pa3) {
#define TRRD(dst, off) asm volatile("ds_read_b64_tr_b16 %0, %1 offset:%2" : "=&v"(dst) : "v"(vb0), "i"(off) : "memory")
#define PV_D0(d0) do { s16x4 l0, l1, l2, l3, h0, h1, h2, h3; constexpr int b_ = VB * SHM_V + v_rd_off(d0, 0, 0); \
        TRRD(l0, b_); TRRD(h0, b_ + 2048); TRRD(l1, b_ + 4096); TRRD(h1, b_ + 6144); TRRD(l2, b_ + 8192); TRRD(h2, b_ + 10240); TRRD(l3, b_ + 12288); TRRD(h3, b_ + 14336); \
        asm volatile("s_waitcnt lgkmcnt(0)" ::: "memory"); SBAR();   \
        o[d0] = __builtin_amdgcn_mfma_f32_32x32x16_bf16(pa0, (bf16x8){l0[0], l0[1], l0[2], l0[3], h0[0], h0[1], h0[2], h0[3]}, o[d0], 0, 0, 0);   \
        o[d0] = __builtin_amdgcn_mfma_f32_32x32x16_bf16(pa1, (bf16x8){l1[0], l1[1], l1[2], l1[3], h1[0], h1[1], h1[2], h1[3]}, o[d0], 0, 0, 0);   \
        o[d0] = __builtin_amdgcn_mfma_f32_32x32x16_bf16(pa2, (bf16x8){l2[0], l2[1], l2[2], l2[3], h2[0], h2[1], h2[2], h2[3]}, o[d0], 0, 0, 0);   \
        o[d0] = __builtin_amdgcn_mfma_f32_32x32x16_bf16(pa3, (bf16x8){l3[0], l3[1], l3[2], l3[3], h3[0], h3[1], h3[2], h3[3]}, o[d0], 0, 0, 0); } while (0)
    PV_D0(0); PV_D0(1); PV_D0(2); PV_D0(3);
#undef PV_D0
#undef TRRD
}

struct BlockRef { const bf16* Q; const bf16* K; const bf16* V; const u32x2* KB; int P0, JLO; };
template <int DK> struct Seam { bf16x8 qr[DK / 16]; bf16x8 st_v0, st_v1, st_k0, st_k1; u32x2 kbn0, kbn1; };
#define AROW(p, k0, rr) ((p) + (size_t)((k0) + (rr)) * PITCH + sc)
#define VMW() asm volatile("s_waitcnt vmcnt(0)" ::: "memory")
#define VMWN(n) asm volatile("s_waitcnt vmcnt(%0)" :: "i"(n) : "memory")
#define SLOAD_H(R_, k0) do { S.st_v0 = load8(AROW((R_).V, k0, sr)); S.st_v1 = load8(AROW((R_).V, k0, 32 + sr));                                   \
        if constexpr (DK == 128) { S.st_k0 = load8(AROW((R_).K, k0, sr)); S.st_k1 = load8(AROW((R_).K, k0, 32 + sr)); }                            \
        else { S.st_k0 = load8((R_).K + (size_t)((k0) + (tid >> 3)) * PITCH + (tid & 7) * 8); }                                                    \
        if constexpr (BIAS) { S.kbn0 = (R_).KB[(k0) + r32]; S.kbn1 = (R_).KB[(k0) + 32 + r32]; } } while (0)
#define SWRITE_HK(bf) do { if constexpr (DK == 128) { *(bf16x8*)(K_lds + (bf) * SHM_K + kws) = S.st_k0; *(bf16x8*)(K_lds + (bf) * SHM_K + kws + 32 * 256) = S.st_k1; } \
        else { *(bf16x8*)(K_lds + (bf) * SHM_K + kws) = S.st_k0; } } while (0)
#define SWRITE_HV(bf) do { *(bf16x8*)(V_lds + (bf) * SHM_V + vst0) = S.st_v0; *(bf16x8*)(V_lds + (bf) * SHM_V + vst1) = S.st_v1; } while (0)
#define SWRITE_H(bf) do { SWRITE_HV(bf); SWRITE_HK(bf); } while (0)
template <int DK, bool BIAS>
__device__ __forceinline__ void causal_prime(const BlockRef& cur, char* lds, Seam<DK>& S, int tid) {
    constexpr int SHM_K = Cfg<DK>::SHM_K;
    const int wid = __builtin_amdgcn_readfirstlane(tid >> 6), lane = tid & 63, r32 = lane & 31, hi = lane >> 5;
    const int sr = tid >> 4, sc = (tid & 15) * 8; const int kws = (DK == 128) ? KSWZ(sr, sc * 2) : KSWZ64(tid >> 3, tid & 7); char* K_lds = lds + LDS_K;
#pragma unroll
    for (int d0 = 0; d0 < DK / 16; ++d0) S.qr[d0] = load8(cur.Q + (size_t)(wid * QBLK + r32) * PITCH + d0 * 16 + hi * 8);
    SLOAD_H(cur, cur.JLO * KVBLK); VMW(); SWRITE_HK(0);
    __syncthreads();
}
template <int DK, bool BIAS, int OUT>
__device__ __forceinline__ void causal_block(const BlockRef& cur, const BlockRef& nxt, char* lds, Seam<DK>& S, void* Oblk, int opitch, int tid) {
    constexpr int SHM_K = Cfg<DK>::SHM_K;
    const int wid = __builtin_amdgcn_readfirstlane(tid >> 6), lane = tid & 63, r32 = lane & 31, hi = lane >> 5;
    const int NT = (cur.P0 + QB) / KVBLK - cur.JLO;
    const int qlo = cur.P0 + wid * QBLK, qm = qlo + r32 - 4 * hi;
    char* V_lds = lds + LDS_V; char* K_lds = lds + LDS_K;
    float* ws = (float*)(lds + LDS_WS) + wid * 64; float* li_l = ws, * al_l = ws + 32;
    float m_reg = -1e30f, l_reg = 0; f32x16 o[4] = {};
    const int sr = tid >> 4, sc = (tid & 15) * 8, vst0 = v_st(sr, sc), vst1 = v_st(32 + sr, sc);
    const int kws = (DK == 128) ? KSWZ(sr, sc * 2) : KSWZ64(tid >> 3, tid & 7);
    const int vb0 = (int)(uintptr_t)V_lds + v_rd_base(lane);
#define RESC(a) do { if (__any((a) < 1.f)) { if (hi == 0) al_l[r32] = (a); asm volatile("s_waitcnt lgkmcnt(0)" ::: "memory");              \
                     for (int d_ = 0; d_ < 4; ++d_) for (int r = 0; r < 16; ++r) o[d_][r] *= al_l[crow(r, hi)]; } } while (0)
#define KBASE(t) ((cur.JLO + (t)) * KVBLK)
#define MASKT(P0_, P1_, t) do { const int kb_ = KBASE(t); if (kb_ + KVBLK - 1 > qlo) mask_tile(P0_, P1_, qm - kb_); } while (0)
    constexpr int NQL = DK / 16;
#define SEAM_K0() do { VMWN(NQL); SWRITE_HK(0); SBAR(); } while (0)
    f32x16 pA0, pA1, pB0, pB1; float mnA, mnB, alA, alB; bf16x8 pa0, pa1, pa2, pa3;
    SWRITE_HV(0); SBAR();
    qkt<0, DK, BIAS>(pA0, pA1, K_lds, r32, hi, S.qr, S.kbn0, S.kbn1); SBAR();
    if (NT > 1) { SLOAD_H(cur, KBASE(1)); }
    SBAR();
    MASKT(pA0, pA1, 0); partialSM<DK>(pA0, pA1, m_reg, mnA, alA);
    if (NT > 1) { VMW(); SWRITE_H(1); }
    __syncthreads();
#define HALF_STEP(PX0, PX1, mnX, alX, PY0, PY1, alY, t, KB, VB, SB) do {                                                      \
        SBAR(); qkt<KB, DK, BIAS>(PX0, PX1, K_lds, r32, hi, S.qr, S.kbn0, S.kbn1);                                            \
        finishSM(PY0, PY1, alY, l_reg, pa0, pa1, pa2, pa3); SBAR();                                                           \
        if ((t) + 1 < NT) { SLOAD_H(cur, KBASE((t) + 1)); SBAR(); }                                                           \
        pv_tile<VB>(o, vb0, pa0, pa1, pa2, pa3); MASKT(PX0, PX1, (t)); partialSM<DK>(PX0, PX1, m_reg, mnX, alX);              \
        __syncthreads();                                                                                                      \
        if ((t) + 1 < NT) { VMW(); SWRITE_H(SB); }                                                                            \
        RESC(alX); __syncthreads(); } while (0)
    for (int t = 1; t + 1 < NT; t += 2) {
        HALF_STEP(pB0, pB1, mnB, alB, pA0, pA1, alA, t, 1, 0, 0);
        HALF_STEP(pA0, pA1, mnA, alA, pB0, pB1, alB, t + 1, 0, 1, 1);
    }
    const bool even = (NT & 1) == 0;
    if (even) { SBAR(); qkt<1, DK, BIAS>(pB0, pB1, K_lds, r32, hi, S.qr, S.kbn0, S.kbn1); SBAR(); }
    SLOAD_H(nxt, nxt.JLO * KVBLK); SBAR();
#pragma unroll
    for (int d0 = 0; d0 < DK / 16; ++d0) S.qr[d0] = load8(nxt.Q + (size_t)(wid * QBLK + r32) * PITCH + d0 * 16 + hi * 8);
    SBAR();
    finishSM(pA0, pA1, alA, l_reg, pa0, pa1, pa2, pa3); SBAR();
    pv_tile<0>(o, vb0, pa0, pa1, pa2, pa3);
    if (even) { MASKT(pB0, pB1, NT - 1); partialSM<DK>(pB0, pB1, m_reg, mnB, alB); __syncthreads(); RESC(alB);
        finishSM(pB0, pB1, alB, l_reg, pa0, pa1, pa2, pa3); SBAR(); pv_tile<1>(o, vb0, pa0, pa1, pa2, pa3); }
    SBAR(); SEAM_K0();
    if (hi == 0) li_l[r32] = l_reg; asm volatile("s_waitcnt lgkmcnt(0)" ::: "memory");
    float rli[16];
#pragma unroll
    for (int r = 0; r < 16; ++r) rli[r] = __builtin_amdgcn_rcpf(li_l[crow(r, hi)]);
#pragma unroll
    for (int r = 0; r < 16; ++r) { const int orow = wid * QBLK + crow(r, hi);
#pragma unroll
        for (int d0 = 0; d0 < 4; ++d0) { const float v = o[d0][r] * rli[r];
            if constexpr (OUT == 1) { ((float*)Oblk)[(size_t)orow * opitch + d0 * 32 + r32] = v; }
            else { const float vn = __shfl_xor(v, 1);
                   if ((r32 & 1) == 0) *(unsigned*)((bf16*)Oblk + (size_t)orow * opitch + d0 * 32 + r32) = cvtpk(v, vn); } } }
    __syncthreads();
#undef RESC
#undef KBASE
#undef MASKT
#undef SEAM_K0
#undef HALF_STEP
}
#undef AROW
#undef VMW
#undef VMWN
#undef SLOAD_H
#undef SWRITE_HK
#undef SWRITE_HV
#undef SWRITE_H
}
constexpr int T = 16384, DM = 1024, SEQ = 8192, NWAVES = 8, NTHR = 512, GRID = 256;
constexpr float EPS = 1e-6f;
constexpr int ZP = 3072;
constexpr int FF = 2816, FFE = 3584, NEXP = 8;
constexpr int XP_ROWS = 34816;
constexpr size_t MiB = 1u << 20, KiB = 1024;
constexpr size_t WS_CTL = 0, CTL_ZERO_BYTES = 65536;
constexpr size_t WS_SLOT = 1 * MiB, SLOT = 256 * KiB;
constexpr size_t WS_ROPE = WS_SLOT + 0 * SLOT;
constexpr size_t WS_LI = WS_SLOT + 2 * SLOT;
constexpr size_t WS_LF = WS_SLOT + 3 * SLOT;
constexpr size_t WS_LFX = WS_SLOT + 4 * SLOT;
constexpr size_t WS_KB = WS_SLOT + 14 * SLOT;
constexpr size_t WS_RTE = WS_SLOT + 6 * SLOT;
constexpr size_t WS_RTW = WS_SLOT + 7 * SLOT;
constexpr size_t WS_PPOS = WS_SLOT + 8 * SLOT;
constexpr size_t WS_RW = WS_SLOT + 9 * SLOT;
constexpr size_t WS_MISC = WS_SLOT + 10 * SLOT;
constexpr size_t WS_NH = WS_SLOT + 11 * SLOT;
constexpr size_t WS_NP = WS_SLOT + 12 * SLOT;
constexpr size_t WS_SGW = WS_SLOT + 13 * SLOT;
constexpr size_t WS_NORM2 = 5 * MiB;
constexpr size_t MISC_CNT = 0, MISC_MG = 8192, MISC_BL = 10240, MISC_MP = 12288, MISC_LAM = 14336, MISC_TS = 14400;
constexpr size_t WS_W_EIN = 8 * MiB, WS_W_EOUT = 14 * MiB, WS_W_FGU = 16 * MiB, WS_W_FDN = 27 * MiB, WS_W_OIN = 33 * MiB, WS_W_OOUT = 39 * MiB, WS_W_MGU = 41 * MiB, WS_W_MDN = 153 * MiB;
constexpr size_t WS_XR = 210 * MiB;
constexpr size_t WS_XN = 274 * MiB;
constexpr size_t WS_CAT = 306 * MiB;
constexpr size_t WS_ARENA = 338 * MiB;
constexpr size_t WS_CH = 576 * MiB;
constexpr size_t WS_CP = 608 * MiB;
constexpr size_t WS_DO = 576 * MiB;
constexpr size_t WS_XP = 640 * MiB;
constexpr size_t WS_Y = 708 * MiB;
constexpr size_t WS_END = 844 * MiB;
static_assert(WS_W_MDN + (size_t)NEXP * DM * FFE * 2 <= WS_XR && WS_ARENA + (size_t)XP_ROWS * FFE * 2 <= WS_CH && WS_XP + (size_t)XP_ROWS * DM * 2 <= WS_Y && WS_Y + (size_t)XP_ROWS * DM * 4 <= WS_END, "ws map");
constexpr int CW_BAR = 4096, CW_QUEUE = 8192;
constexpr int LDS_BYTES = 155648, LDSCTL_OFF = 151552;
constexpr int TS_ = 136;
constexpr int TILE_B = 128 * TS_ * 2;

#define XB_TMO      128
#define XB_XCNT(j)  (256  + 64 * (j))
#define XB_XSUB(j)  (1280 + 64 * (j))
#define XB_XGEN(j)  (2304 + 64 * (j))
#define XB_TOP      3328
#define XB_TOPGEN   3392
#define XCD_BAR_WORDS 3456
#define XB_SPIN_CAP (1u << 18)
__device__ __forceinline__ unsigned xb_ld(unsigned* p)              { return __hip_atomic_load(p, __ATOMIC_RELAXED, __HIP_MEMORY_SCOPE_AGENT); }
__device__ __forceinline__ unsigned xb_add(unsigned* p, unsigned v) { return __hip_atomic_fetch_add(p, v, __ATOMIC_RELAXED, __HIP_MEMORY_SCOPE_AGENT); }
__device__ __forceinline__ unsigned xb_xcc_id() { return (unsigned)__builtin_amdgcn_s_getreg((3 << 11) | 20) & 0xFu; }
#define XB_SPIN(cond, bar) do { unsigned _sp = 0; while (cond) { __builtin_amdgcn_s_sleep(1); \
    if ((++_sp & 255u) == 0u) { if (xb_ld(&(bar)[XB_TMO])) break; if (_sp > XB_SPIN_CAP) { atomicAdd(&(bar)[XB_TMO], 1u); break; } } } } while (0)
struct XcdBarrier { unsigned* bar; unsigned x; volatile LAS unsigned* st; };
__device__ __forceinline__ XcdBarrier xcd_barrier_post(unsigned* bar, volatile LAS unsigned* st) {
    XcdBarrier b; b.bar = bar; b.x = xb_xcc_id(); b.st = st;
    if (threadIdx.x == 0) (void)xb_add(&bar[XB_XCNT(b.x)], 1u);
    return b;
}
__device__ __forceinline__ void xcd_barrier_complete(unsigned* bar, unsigned x, unsigned& nloc, unsigned& nx) {
    const unsigned G = gridDim.x * gridDim.y * gridDim.z;
    unsigned sum, cnt, mine, sp = 0u;
    for (;;) {
        sum = 0u; cnt = 0u; mine = 0u;
#pragma unroll
        for (unsigned j = 0; j < 16; ++j) { const unsigned c = xb_ld(&bar[XB_XCNT(j)]); sum += c; cnt += (c > 0u) ? 1u : 0u; mine = (j == x) ? c : mine; }
        if (sum == G) break;
        __builtin_amdgcn_s_sleep(1);
        if ((++sp & 255u) == 0u) { if (xb_ld(&bar[XB_TMO])) break; if (sp > XB_SPIN_CAP) { atomicAdd(&bar[XB_TMO], 1u); break; } }
    }
    nloc = mine > 0u ? mine : 1u; nx = cnt > 0u ? cnt : 1u;
}
__device__ __forceinline__ void xcd_barrier(const XcdBarrier& b) {
    asm volatile("s_waitcnt vmcnt(0)" ::: "memory");
    __syncthreads();
    if (threadIdx.x == 0) {
        unsigned* bar = b.bar;
        __builtin_amdgcn_s_waitcnt(0);
        unsigned nloc = b.st[0], nx = b.st[1];
        if (nloc == 0u) { xcd_barrier_complete(bar, b.x, nloc, nx); b.st[0] = nloc; b.st[1] = nx; }
        const unsigned old = xb_add(&bar[XB_XSUB(b.x)], 1u);
        const unsigned gen = old / nloc;
        if (old + 1u == (gen + 1u) * nloc) {
            __builtin_amdgcn_fence(__ATOMIC_RELEASE, "agent");
            asm volatile("s_waitcnt vmcnt(0)" ::: "memory");
            const unsigned og = xb_add(&bar[XB_TOP], 1u);
            const unsigned tg = og / nx;
            if (og + 1u == (tg + 1u) * nx) xb_add(&bar[XB_TOPGEN], 1u);
            else XB_SPIN(xb_ld(&bar[XB_TOPGEN]) == tg, bar);
            __builtin_amdgcn_fence(__ATOMIC_ACQUIRE, "agent");
            xb_add(&bar[XB_XGEN(b.x)], 1u);
            asm volatile("s_waitcnt vmcnt(0)" ::: "memory");
        } else {
            XB_SPIN(xb_ld(&bar[XB_XGEN(b.x)]) == gen, bar);
            __builtin_amdgcn_fence(__ATOMIC_ACQUIRE, "agent");
            asm volatile("s_waitcnt vmcnt(0)" ::: "memory");
        }
    }
    __syncthreads();
}

struct Args { const float* in[25]; float* out; unsigned char* ws; int ph_lo, ph_hi; };
#define KARGS const __attribute__((address_space(4))) Args
__device__ __forceinline__ const float* ain(KARGS& a, int k) { return (const float*)(const GAS float*)a.in[k]; }
struct Ctx { LAS unsigned char* lds; unsigned char* ws; int tid, lane, wave, bid; };

struct ConvItem { const float* src; bf16* dst; int ldw, K; };
__device__ __forceinline__ int src_col(int type, int n0, int ffh) {
    const int pn = n0 >> 8, j = n0 & 255;
    const int t3 = j < 128 ? 128 * pn + j : ffh + 128 * pn + (j - 128);
    return type == 1 ? (n0 < 2048 ? n0 : n0 + 8) : (type == 2 ? (n0 < 1536 ? n0 : n0 + 4) : (type == 3 ? t3 : n0));
}
__device__ __forceinline__ ConvItem conv_decode(KARGS& a, unsigned char* ws, int it) {
    constexpr int I_EIN = 16 * 96, I_EOUT = 16 * 32, I_FGU = 16 * 176, I_FDN = 44 * 32, I_OIN = 16 * 96, I_OOUT = 16 * 32, I_MGU = 16 * 224, I_MDN = 56 * 32;
    constexpr int C1 = I_EIN, C2 = C1 + I_EOUT, C3 = C2 + I_FGU, C4 = C3 + I_FDN, C5 = C4 + I_OIN, C6 = C5 + I_OOUT, C7 = C6 + NEXP * I_MGU;
    const int kind = (it >= C1) + (it >= C2) + (it >= C3) + (it >= C4) + (it >= C5) + (it >= C6) + (it >= C7);
#define SEL8(v0, v1, v2, v3, v4, v5, v6, v7) (kind == 0 ? (v0) : kind == 1 ? (v1) : kind == 2 ? (v2) : kind == 3 ? (v3) : kind == 4 ? (v4) : kind == 5 ? (v5) : kind == 6 ? (v6) : (v7))
    const int base = SEL8(0, C1, C2, C3, C4, C5, C6, C7), per = SEL8(I_EIN, I_EOUT, I_FGU, I_FDN, I_OIN, I_OOUT, I_MGU, I_MDN);
    int r = it - base; const int e = r / per; r -= e * per;
    const int ldw = SEL8(3080, 1024, 2 * FF, 1024, 3076, 1024, 2 * FFE, 1024), K = SEL8(1024, 1024, 1024, FF, 1024, 1024, 1024, FFE), N = SEL8(3072, 1024, 2 * FF, 1024, 3072, 1024, 2 * FFE, 1024);
    const int type = SEL8(1, 0, 3, 0, 2, 0, 3, 0), ffh = SEL8(0, 0, FF, 0, 0, 0, FFE, 0);
    const float* W = SEL8(ain(a, 2), ain(a, 10), ain(a, 12), ain(a, 13), ain(a, 15), ain(a, 19), ain(a, 22), ain(a, 23));
    const size_t wso = SEL8(WS_W_EIN, WS_W_EOUT, WS_W_FGU, WS_W_FDN, WS_W_OIN, WS_W_OOUT, WS_W_MGU, WS_W_MDN);
#undef SEL8
    const int nblk = N / 32, kb = r / nblk, nb = r - kb * nblk, k0 = 64 * kb, n0 = 32 * nb;
    ConvItem c; c.ldw = ldw; c.K = K;
    c.src = W + (size_t)e * K * ldw + (size_t)k0 * ldw + src_col(type, n0, ffh);
    c.dst = (bf16*)(ws + wso) + (size_t)e * N * K + (size_t)n0 * K + k0;
    return c;
}
__device__ __forceinline__ void conv_load(const ConvItem& c, int lane, f32x4 (&v)[8]) {
    const int kl = lane >> 3, n4 = (lane & 7) * 4;
#pragma unroll
    for (int i = 0; i < 8; ++i) v[i] = __builtin_nontemporal_load((const f32x4*)(c.src + (size_t)(kl + 8 * i) * c.ldw + n4));
}
__device__ __forceinline__ void conv_finish(const ConvItem& c, int lane, const f32x4 (&v)[8], LAS float* scr) {
    const int kl = lane >> 3, n4 = (lane & 7) * 4;
#pragma unroll
    for (int i = 0; i < 8; ++i) { LAS float* d = scr + (kl + 8 * i) * 33 + n4; d[0] = v[i].x; d[1] = v[i].y; d[2] = v[i].z; d[3] = v[i].w; }
    LDS_WAIT(); asm volatile("" ::: "memory");
    const int cc = lane & 7;
#pragma unroll
    for (int j = 0; j < 4; ++j) { const int n = (lane >> 3) + 8 * j; const LAS float* s = scr + (8 * cc) * 33 + n;
        u32x4 o; o.x = pk2(s[0 * 33], s[1 * 33]); o.y = pk2(s[2 * 33], s[3 * 33]); o.z = pk2(s[4 * 33], s[5 * 33]); o.w = pk2(s[6 * 33], s[7 * 33]);
        *(u32x4*)(c.dst + (size_t)n * c.K + 8 * cc) = o; }
    LDS_WAIT(); asm volatile("" ::: "memory");
}
constexpr int CONV_DENSE_ITEMS = 16 * 96 + 16 * 32 + 16 * 176 + 44 * 32 + 16 * 96 + 16 * 32, CONV_MGU_END = CONV_DENSE_ITEMS + NEXP * 16 * 224, CONV_ALL_ITEMS = CONV_MGU_END + NEXP * 56 * 32;
template <int LO, int HI, bool REV>
__device__ __forceinline__ void prologue_weights(KARGS& a, const Ctx& c) {
    LAS float* scr = (LAS float*)(c.lds + c.wave * 16384);
    const int gw = c.bid * NWAVES + c.wave, NGW = GRID * NWAVES;
    constexpr int NITEMS = HI - LO;
#define CONV_IT(i) (REV ? HI - 1 - (i) : LO + (i))
    int it = gw; if (it >= NITEMS) return;
    f32x4 va[8], vb[8]; ConvItem d0 = conv_decode(a, c.ws, CONV_IT(it)), d1 = d0; conv_load(d0, c.lane, va);
    for (;;) {
        const int it1 = it + NGW; const bool has1 = it1 < NITEMS;
        if (has1) { d1 = conv_decode(a, c.ws, CONV_IT(it1)); conv_load(d1, c.lane, vb); }
        conv_finish(d0, c.lane, va, scr);
        if (!has1) break;
        it = it1 + NGW; const bool has0 = it < NITEMS;
        if (has0) { d0 = conv_decode(a, c.ws, CONV_IT(it)); conv_load(d0, c.lane, va); }
        conv_finish(d1, c.lane, vb, scr);
        if (!has0) break;
    }
#undef CONV_IT
}
template <int LO, int HI, bool REV>
__device__ __forceinline__ void conv_dynamic(KARGS& a, const Ctx& c, unsigned* q) {
    LAS float* scr = (LAS float*)(c.lds + c.wave * 16384);
    LAS int* slot = (LAS int*)(c.lds + 131072);
    constexpr int NCH = (HI - LO) / 16; static_assert((HI - LO) % 16 == 0, "chunks");
#define CONV_IT(i) (REV ? HI - 1 - (i) : LO + (i))
    if (c.tid == 0) slot[0] = (int)__hip_atomic_fetch_add(q, 1u, RLX_AGENT);
    __syncthreads();
    int ch = slot[0];
    while (ch < NCH) {
        __syncthreads();
        if (c.tid == 0) slot[0] = (int)__hip_atomic_fetch_add(q, 1u, RLX_AGENT);
        const int i0 = ch * 16 + c.wave * 2;
        f32x4 va[8], vb[8]; const ConvItem d0 = conv_decode(a, c.ws, CONV_IT(i0)), d1 = conv_decode(a, c.ws, CONV_IT(i0 + 1));
        conv_load(d0, c.lane, va); conv_load(d1, c.lane, vb);
        conv_finish(d0, c.lane, va, scr); conv_finish(d1, c.lane, vb, scr);
        __syncthreads();
        ch = slot[0];
    }
#undef CONV_IT
}
__device__ __forceinline__ void prologue_tables(KARGS& a, const Ctx& c) {
    const int gt = c.bid * NTHR + c.tid, NGT = GRID * NTHR;
    bf16* sgw = (bf16*)(c.ws + WS_SGW); const float* w = ain(a, 8);
    for (int i = gt; i < 4 * 128 * 128; i += NGT) { const int tt = (i >> 7) & 127, ss = i & 127; sgw[i] = (bf16)(ss <= tt ? f2bf(w[i]) : 0u); }
    if (c.bid == 0 && c.wave == 0) { const float* l = ain(a, 17); const float p0 = wave_sum(l[c.lane] * l[64 + c.lane]), p1 = wave_sum(l[128 + c.lane] * l[192 + c.lane]);
        const float lambda_init = 0.8f - 0.6f * expf(-0.3f);
        if (c.lane == 0) *(float*)(c.ws + WS_MISC + MISC_LAM) = expf(p0) - expf(p1) + lambda_init; }
}

template <int NC> __device__ __forceinline__ void stage_wxt(const Ctx& c, const float* W, int ldw, int col0) {
    LAS float* wxt = (LAS float*)c.lds;
    for (int i = c.tid; i < NC * 1024; i += NTHR) { const int cc = i >> 10, k = i & 1023; wxt[i] = W[(size_t)k * ldw + col0 + cc]; }
    __syncthreads();
}
template <int MODE> __device__ __forceinline__ void row_phase(KARGS& a, const Ctx& c, const float* xin, const float* gain) {
    constexpr int NC = (MODE == 0 || MODE == 3) ? 8 : (MODE == 2 ? 4 : 0);
    unsigned char* ws = c.ws;
    LAS float* wxt = (LAS float*)c.lds; LAS int* lcnt = (LAS int*)(c.lds + 32768);
    if (MODE == 0) stage_wxt<8>(c, ain(a, 2), 3080, 2048);
    if (MODE == 2) stage_wxt<4>(c, ain(a, 15), 3076, 1536);
    if (MODE == 3) { if (c.tid < 8) lcnt[c.tid] = 0; stage_wxt<8>(c, ain(a, 21), 8, 0); }
    f32x4 g[4];
#pragma unroll
    for (int j = 0; j < 4; ++j) g[j] = *((const f32x4*)gain + c.lane + 64 * j);
    bf16* XN = (bf16*)(ws + WS_XN);
    int skSL = 2;
    if (MODE == 4) skSL = pg8::hyb_SL(__builtin_amdgcn_readfirstlane(ldi((const int*)(ws + WS_MISC + MISC_TS) + 8)) * 4 - 512);
#define ROW_INDEX(r) ((MODE == 4) ? (r) * (GRID * NWAVES) + c.bid * NWAVES + c.wave : 64 * c.bid + c.wave * 8 + (r))
#define ROW_LOAD(r, V, Y0, Y1, P0, P1) do { const int m_ = ROW_INDEX(r); const f32x4* xr_ = (const f32x4*)(xin + (size_t)m_ * DM) + c.lane; \
        _Pragma("unroll") for (int j = 0; j < 4; ++j) V[j] = xr_[64 * j]; \
        if (MODE == 4) { P0 = ldi((const int*)(ws + WS_PPOS) + 2 * m_); P1 = ldi((const int*)(ws + WS_PPOS) + 2 * m_ + 1); \
            const u32x2* y0_ = (const u32x2*)((const bf16*)(ws + WS_Y) + (size_t)P0 * DM) + c.lane; const u32x2* y1_ = (const u32x2*)((const bf16*)(ws + WS_Y) + (size_t)P1 * DM) + c.lane; \
            _Pragma("unroll") for (int j = 0; j < 4; ++j) { Y0[j] = y0_[64 * j]; Y1[j] = y1_[64 * j]; } } } while (0)
    f32x4 vn[4]; u32x2 yn0[4], yn1[4]; int pn0 = 0, pn1 = 0;
    ROW_LOAD(0, vn, yn0, yn1, pn0, pn1);
#pragma unroll
    for (int r = 0; r < 8; ++r) {
        const int m = ROW_INDEX(r);
        f32x4 v[4]; const int p0 = pn0, p1 = pn1;
#pragma unroll
        for (int j = 0; j < 4; ++j) { v[j] = vn[j]; if (MODE == 4) { v[j].x += bflo(yn0[j].x) + bflo(yn1[j].x); v[j].y += bfhi(yn0[j].x) + bfhi(yn1[j].x); v[j].z += bflo(yn0[j].y) + bflo(yn1[j].y); v[j].w += bfhi(yn0[j].y) + bfhi(yn1[j].y); } }
        if (r + 1 < 8) ROW_LOAD(r + 1, vn, yn0, yn1, pn0, pn1);
        if (MODE == 4) {
            const float* slab = (const float*)(ws + WS_XP);
            if (p0 >= 32768 || p1 >= 32768) {
#pragma unroll 1
                for (int q = 0; q < 2; ++q) { const int p = q ? p1 : p0; if (p < 32768) continue;
#pragma unroll
                    for (int j = 0; j < 4; ++j) { const float* sp = slab + ((size_t)(((p >> 8) * 4 + j - 512) * (skSL - 1)) * 256 + (p & 255)) * 256;
#pragma unroll 4
                        for (int s2 = 0; s2 < skSL - 1; ++s2) v[j] = v[j] + *((const f32x4*)(sp + (size_t)s2 * 65536) + c.lane); } } } }
        float s = 0.f;
#pragma unroll
        for (int j = 0; j < 4; ++j) s += (v[j].x * v[j].x + v[j].y * v[j].y) + (v[j].z * v[j].z + v[j].w * v[j].w);
#pragma unroll
        for (int j = 0; j < 4; ++j) v[j] = v[j] * g[j];
        float z[NC > 0 ? NC : 1];
        if constexpr (NC > 0) {
#pragma unroll
            for (int cc = 0; cc < NC; ++cc) { float pp = 0.f;
#pragma unroll
                for (int j = 0; j < 4; ++j) { const f32x4 w = *((const LAS f32x4*)(wxt + cc * 1024) + c.lane + 64 * j); pp += (v[j].x * w.x + v[j].y * w.y) + (v[j].z * w.z + v[j].w * w.w); }
                z[cc] = pp; }
#pragma unroll
            for (int cc = 0; cc < NC; ++cc) z[cc] = wave_sum(z[cc]);
        }
        const float rstd = 1.0f / sqrtf(wave_sum(s) * (1.0f / DM) + EPS);
#pragma unroll
        for (int j = 0; j < 4; ++j) v[j] = v[j] * rstd;
        if (MODE == 4) { f32x4* o = (f32x4*)((float*)(GAS float*)a.out + (size_t)m * DM) + c.lane;
#pragma unroll
            for (int j = 0; j < 4; ++j) o[64 * j] = v[j]; }
        else { u32x2* o = (u32x2*)(XN + (size_t)m * DM) + c.lane;
#pragma unroll
            for (int j = 0; j < 4; ++j) { u32x2 w; w.x = pk2(v[j].x, v[j].y); w.y = pk2(v[j].z, v[j].w); o[64 * j] = w; } }
        if constexpr (NC > 0) {
#pragma unroll
            for (int cc = 0; cc < NC; ++cc) z[cc] *= rstd;
            if (MODE == 0) { if (c.lane < 8) { float zz = z[0];
#pragma unroll
                    for (int cc = 1; cc < 8; ++cc) zz = (c.lane == cc) ? z[cc] : zz;
                    const float gb = ain(a, 5)[c.lane];
                    if (c.lane < 4) ((float*)(ws + WS_LI))[m * 4 + c.lane] = zz + gb; else ((float*)(ws + WS_LF))[m * 4 + c.lane - 4] = log_sigmoid_acc(zz + gb); } }
            if (MODE == 2) {
                if (c.lane < 4) { float zz = z[0];
#pragma unroll
                    for (int cc = 1; cc < 4; ++cc) zz = (c.lane == cc) ? z[cc] : zz;
                    ((float*)(ws + WS_LFX))[m * 4 + c.lane] = log_sigmoid_acc(zz + ain(a, 16)[c.lane]); } }
            if (MODE == 3) { if (c.lane == 0) {
                    int e1 = 0; float v1 = z[0];
#pragma unroll
                    for (int cc = 1; cc < 8; ++cc) if (z[cc] > v1) { v1 = z[cc]; e1 = cc; }
                    int e2 = -1; float v2 = -__builtin_inff();
#pragma unroll
                    for (int cc = 0; cc < 8; ++cc) if (cc != e1 && z[cc] > v2) { v2 = z[cc]; e2 = cc; }
                    const float w2 = 1.0f / (1.0f + expf(v1 - v2)), w1 = 1.0f - w2;
                    ((int*)(ws + WS_RTE))[2 * m] = e1; ((int*)(ws + WS_RTE))[2 * m + 1] = e2;
                    ((float*)(ws + WS_RTW))[2 * m] = w1; ((float*)(ws + WS_RTW))[2 * m + 1] = w2;
                    __hip_atomic_fetch_add(&lcnt[e1], 1, __ATOMIC_RELAXED, __HIP_MEMORY_SCOPE_WORKGROUP); __hip_atomic_fetch_add(&lcnt[e2], 1, __ATOMIC_RELAXED, __HIP_MEMORY_SCOPE_WORKGROUP); } }
        }
    }
#undef ROW_LOAD
#undef ROW_INDEX
    if (MODE == 3) { __syncthreads(); if (c.tid < 8) ((int*)(ws + WS_MISC + MISC_CNT))[c.bid * 8 + c.tid] = lcnt[c.tid]; }
    __syncthreads();
}

__device__ __forceinline__ int crow_(int r, int hi) { return (r & 3) + 8 * (r >> 2) + 4 * hi; }
__device__ __forceinline__ void wg_mma128(f32x16 (&acc)[2], const LAS bf16* A, const LAS bf16* Bt, int wave, int lane) {
    const int r32 = lane & 31, hi = lane >> 5, mblk = (wave >> 1) * 32, nblk = (wave & 1) * 64;
    const LAS bf16* ap = A + (mblk + r32) * TS_ + hi * 8; const LAS bf16* bp0 = Bt + (nblk + r32) * TS_ + hi * 8; const LAS bf16* bp1 = bp0 + 32 * TS_;
#pragma unroll
    for (int ks = 0; ks < 8; ++ks) {
        const bf16x8 av = *(const LAS bf16x8*)(ap + ks * 16), b0 = *(const LAS bf16x8*)(bp0 + ks * 16), b1 = *(const LAS bf16x8*)(bp1 + ks * 16);
        acc[0] = __builtin_amdgcn_mfma_f32_32x32x16_bf16(av, b0, acc[0], 0, 0, 0);
        acc[1] = __builtin_amdgcn_mfma_f32_32x32x16_bf16(av, b1, acc[1], 0, 0, 0);
    }
}
__device__ __forceinline__ void unpack8(const u32x4 w, float (&f)[8]) { f[0] = bflo(w.x); f[1] = bfhi(w.x); f[2] = bflo(w.y); f[3] = bfhi(w.y); f[4] = bflo(w.z); f[5] = bfhi(w.z); f[6] = bflo(w.w); f[7] = bfhi(w.w); }
__device__ __forceinline__ void stage_raw(const Ctx& c, const bf16* Z, int tok0, bool first, int col0, LAS bf16* raw) {
    for (int i = c.tid; i < 131 * 16; i += NTHR) { const int r = i >> 4, ch = i & 15;
        u32x4 v = {0u, 0u, 0u, 0u}; if (!(first && r < 3)) v = *(const u32x4*)(Z + (size_t)(tok0 - 3 + r) * ZP + col0 + ch * 8);
        *(LAS u32x4*)(raw + r * TS_ + ch * 8) = v; }
}
template <bool TRANSPOSE> __device__ __forceinline__ void conv_tile(const Ctx& c, const LAS bf16* raw, const float* cw  , const float* cb, float scale, LAS bf16* tile) {
    float w0[4][8], b0[8];
    if (!TRANSPOSE) { const int d0 = (c.tid & 15) * 8;
#pragma unroll
        for (int j = 0; j < 4; ++j)
#pragma unroll
            for (int i = 0; i < 8; ++i) w0[j][i] = cw[j * 1024 + d0 + i];
#pragma unroll
        for (int i = 0; i < 8; ++i) b0[i] = cb[d0 + i]; }
#pragma unroll 4
    for (int it = 0; it < 4; ++it) {
        const int ch = TRANSPOSE ? (c.tid >> 7) * 4 + it : (c.tid & 15), s = TRANSPOSE ? (c.tid & 127) : (c.tid >> 4) + 32 * it, d0 = ch * 8;
        float acc[8];
#pragma unroll
        for (int i = 0; i < 8; ++i) acc[i] = TRANSPOSE ? cb[d0 + i] : b0[i];
#pragma unroll
        for (int j = 0; j < 4; ++j) { float x[8]; unpack8(*(const LAS u32x4*)(raw + (s + j) * TS_ + d0), x);
#pragma unroll
            for (int i = 0; i < 8; ++i) acc[i] += (TRANSPOSE ? cw[j * 1024 + d0 + i] : w0[j][i]) * x[i]; }
#pragma unroll
        for (int i = 0; i < 8; ++i) acc[i] = siluf_(acc[i]) * scale;
        if (TRANSPOSE) {
#pragma unroll
            for (int i = 0; i < 8; ++i) tile[(d0 + i) * TS_ + s] = (bf16)f2bf(acc[i]);
        } else { u32x4 o; o.x = pk2(acc[0], acc[1]); o.y = pk2(acc[2], acc[3]); o.z = pk2(acc[4], acc[5]); o.w = pk2(acc[6], acc[7]); *(LAS u32x4*)(tile + s * TS_ + d0) = o; }
    }
}
struct RawRegs { u32x4 v[5]; };
__device__ __forceinline__ void raw_load(const Ctx& c, const bf16* Z, int tok0, bool first, int col0, RawRegs& R) {
#pragma unroll
    for (int n = 0; n < 5; ++n) { const int i = c.tid + NTHR * n, r = i >> 4, ch = i & 15; R.v[n] = (u32x4){0u, 0u, 0u, 0u};
        if (i < 131 * 16 && !(first && r < 3)) R.v[n] = *(const u32x4*)(Z + (size_t)(tok0 - 3 + r) * ZP + col0 + ch * 8); }
}
__device__ __forceinline__ void raw_store(const Ctx& c, const RawRegs& R, LAS bf16* raw) {
#pragma unroll
    for (int n = 0; n < 5; ++n) { const int i = c.tid + NTHR * n, r = i >> 4, ch = i & 15; if (i < 131 * 16) *(LAS u32x4*)(raw + r * TS_ + ch * 8) = R.v[n]; }
}
struct TRegs { u32x4 v[4]; };
__device__ __forceinline__ void tr_load(const Ctx& c, const bf16* src, TRegs& R) {
    const int s = c.tid & 127, chq = c.tid >> 7;
#pragma unroll
    for (int it = 0; it < 4; ++it) R.v[it] = *(const u32x4*)(src + (size_t)s * ZP + (chq * 4 + it) * 8);
}
template <class F> __device__ __forceinline__ void tr_store(const Ctx& c, const TRegs& R, LAS bf16* tile, const F& f) {
    const int s = c.tid & 127, chq = c.tid >> 7;
#pragma unroll
    for (int it = 0; it < 4; ++it) { const int e0 = (chq * 4 + it) * 8; float x[8]; unpack8(R.v[it], x);
#pragma unroll
        for (int i = 0; i < 8; ++i) tile[(e0 + i) * TS_ + s] = (bf16)f2bf(f(x[i], s, e0 + i)); }
}
struct CRegs { u32x4 v[4]; };
__device__ __forceinline__ void rows_load(const Ctx& c, const bf16* src  , CRegs& R) {
#pragma unroll
    for (int n = 0; n < 4; ++n) { const int i = c.tid + NTHR * n; R.v[n] = *(const u32x4*)(src + (i >> 4) * 128 + (i & 15) * 8); }
}
__device__ __forceinline__ void rows_store(const Ctx& c, const CRegs& R, LAS bf16* tile) {
#pragma unroll
    for (int n = 0; n < 4; ++n) { const int i = c.tid + NTHR * n; *(LAS u32x4*)(tile + (i >> 4) * TS_ + (i & 15) * 8) = R.v[n]; }
}
template <class F> __device__ __forceinline__ void stage_transposed(const Ctx& c, const bf16* src, LAS bf16* tile, const F& f) {
    const int s = c.tid & 127, chq = c.tid >> 7;
#pragma unroll
    for (int it = 0; it < 4; ++it) { const int e0 = (chq * 4 + it) * 8; float x[8]; unpack8(*(const u32x4*)(src + (size_t)s * ZP + e0), x);
#pragma unroll
        for (int i = 0; i < 8; ++i) tile[(e0 + i) * TS_ + s] = (bf16)f2bf(f(x[i], s, e0 + i)); }
}
constexpr int L_T0 = 0, L_T1 = TILE_B, L_T2 = 2 * TILE_B, L_T3 = 3 * TILE_B, L_TAB = 4 * TILE_B + 2048;
static_assert(L_TAB + 4096 <= LDSCTL_OFF, "LDS map");

__device__ __forceinline__ void ml_state_unit(KARGS& a, const Ctx& c0, int bhc) {
    Ctx c = c0; { int t_ = c0.wave * 64 + (int)__builtin_amdgcn_mbcnt_hi(~0u, __builtin_amdgcn_mbcnt_lo(~0u, 0u)); asm volatile("" : "+v"(t_)); c.tid = t_; c.lane = t_ & 63; c.wave = __builtin_amdgcn_readfirstlane(t_ >> 6); }
    unsigned char* ws = c.ws;
    const int bh = bhc >> 6, ck = bhc & 63, b = bh >> 2, h = bh & 3, tok0 = b * SEQ + ck * 128;
    const bf16* Z = (const bf16*)(ws + WS_ARENA);
    LAS bf16* KT = (LAS bf16*)(c.lds + L_T0); LAS bf16* VT = (LAS bf16*)(c.lds + L_T1); LAS bf16* RAW = (LAS bf16*)(c.lds + L_T2);
    LAS float* wt = (LAS float*)(c.lds + L_TAB);
    RawRegs rk; TRegs rv;
    raw_load(c, Z, tok0, ck == 0, 512 + h * 128, rk); tr_load(c, Z + (size_t)tok0 * ZP + 1024 + h * 128, rv);
    if (c.wave == 0) {
        const float* LF = (const float*)(ws + WS_LF); const float* LI = (const float*)(ws + WS_LI);
        const int s0 = 2 * c.lane;
        const float lf0 = ldf(LF + (size_t)(tok0 + s0) * 4 + h), lf1 = ldf(LF + (size_t)(tok0 + s0 + 1) * 4 + h);
        const float li0 = ldf(LI + (size_t)(tok0 + s0) * 4 + h), li1 = ldf(LI + (size_t)(tok0 + s0 + 1) * 4 + h);
        float sc = lf0 + lf1;
#pragma unroll
        for (int o = 1; o < 64; o <<= 1) { const float t = shfl_up_l(sc, o, c.lane); if (c.lane >= o) sc += t; }
        const float b1 = sc, b0 = sc - lf1, blast = shfl_idx_l(sc, 63);
        const float g0 = blast - b0 + li0, g1 = blast - b1 + li1;
        float mg = fmaxf(g0, g1);
#pragma unroll
        for (int o = 1; o < 64; o <<= 1) mg = fmaxf(mg, shfl_xor_l(mg, o, c.lane));
        wt[s0] = fast_exp(g0 - mg); wt[s0 + 1] = fast_exp(g1 - mg);
        if (c.lane == 0) { ((float*)(ws + WS_MISC + MISC_MG))[bhc] = mg; ((float*)(ws + WS_MISC + MISC_BL))[bhc] = blast; }
    }
    raw_store(c, rk, RAW);
    __syncthreads();
    conv_tile<true>(c, RAW, ain(a, 3) + 512 + h * 128, ain(a, 4) + 512 + h * 128, 1.0f, KT);
    tr_store(c, rv, VT, [&](float x, int s, int) { return x * wt[s]; });
    __syncthreads();
    f32x16 acc[2] = {};
    wg_mma128(acc, VT, KT, c.wave, c.lane);
    { const int r32 = c.lane & 31, hi = c.lane >> 5, mblk = (c.wave >> 1) * 32, nblk = (c.wave & 1) * 64; float* CH = (float*)(ws + WS_CH) + (size_t)bhc * 16384;
#pragma unroll
      for (int j = 0; j < 2; ++j)
#pragma unroll
        for (int i = 0; i < 16; ++i) CH[(mblk + crow_(i, hi)) * 128 + nblk + 32 * j + r32] = acc[j][i]; }
    { const int d = c.tid >> 2, part = c.tid & 3; float s = 0.f;
#pragma unroll
      for (int k = 0; k < 4; ++k) { float x[8]; unpack8(*(const LAS u32x4*)(KT + d * TS_ + part * 32 + 8 * k), x);
#pragma unroll
        for (int i = 0; i < 8; ++i) s += wt[part * 32 + 8 * k + i] * x[i]; }
      s = quad_sum(s);
      if (part == 0) ((float*)(ws + WS_NH))[(size_t)bhc * 128 + d] = s; }
    __syncthreads();
}
__device__ __forceinline__ void sg_unit(KARGS& a, const Ctx& c0, int idx) {
    Ctx c = c0; { int t_ = c0.wave * 64 + (int)__builtin_amdgcn_mbcnt_hi(~0u, __builtin_amdgcn_mbcnt_lo(~0u, 0u)); asm volatile("" : "+v"(t_)); c.tid = t_; c.lane = t_ & 63; c.wave = __builtin_amdgcn_readfirstlane(t_ >> 6); }
    unsigned char* ws = c.ws;
    const int bn = idx >> 2, g = idx & 3, tok0 = (bn >> 6) * SEQ + (bn & 63) * 128;
    const bf16* Z = (const bf16*)(ws + WS_ARENA);
    LAS bf16* WG = (LAS bf16*)(c.lds + L_T0); LAS bf16* VN = (LAS bf16*)(c.lds + L_T1); LAS float* rs = (LAS float*)(c.lds + L_TAB);
    const int r32 = c.lane & 31, hi = c.lane >> 5, mblk = (c.wave >> 1) * 32, nblk = (c.wave & 1) * 64, ch = c.tid & 15, c0e = ch * 8, chq = c.tid >> 7;
    TRegs rv; CRegs rw; u32x4 xv[16], uv[4]; f32x4 gv[4][2], bv[4];
    tr_load(c, Z + (size_t)tok0 * ZP + 2560 + g * 128, rv); rows_load(c, (const bf16*)(ws + WS_SGW) + (size_t)g * 16384, rw);
    { const bf16* p = Z + (size_t)(tok0 + (c.tid >> 2)) * ZP + 2560 + (c.tid & 3) * 128;
#pragma unroll
      for (int k = 0; k < 16; ++k) xv[k] = *(const u32x4*)(p + 8 * k); }
#pragma unroll
    for (int it = 0; it < 4; ++it) { uv[it] = *(const u32x4*)(Z + (size_t)(tok0 + (c.tid >> 4) + 32 * it) * ZP + 2048 + g * 128 + c0e);
        const float* gp = ain(a, 7) + g * 128 + (chq * 4 + it) * 8; gv[it][0] = *(const f32x4*)gp; gv[it][1] = *(const f32x4*)(gp + 4);
        bv[it] = *(const f32x4*)(ain(a, 9) + g * 128 + mblk + 8 * it + 4 * hi); }
    { const int s = c.tid >> 2, part = c.tid & 3; float ss = 0.f;
#pragma unroll
      for (int k = 0; k < 16; ++k) { float x[8]; unpack8(xv[k], x);
#pragma unroll
        for (int i = 0; i < 8; ++i) ss += x[i] * x[i]; }
      ss = quad_sum(ss);
      if (part == 0) rs[s] = 1.0f / sqrtf(ss * (1.0f / 512.0f) + EPS); }
    rows_store(c, rw, WG);
    __syncthreads();
    { const int s = c.tid & 127; const float r = rs[s];
#pragma unroll
      for (int it = 0; it < 4; ++it) { const int e0 = (chq * 4 + it) * 8; float x[8]; unpack8(rv.v[it], x);
#pragma unroll
        for (int i = 0; i < 8; ++i) VN[(e0 + i) * TS_ + s] = (bf16)f2bf(x[i] * r * gv[it][i >> 2][i & 3]); } }
    __syncthreads();
    f32x16 acc[2] = {};
    wg_mma128(acc, WG, VN, c.wave, c.lane);
    __syncthreads();
    LAS float* HT = (LAS float*)(c.lds + L_T0);
#pragma unroll
    for (int i = 0; i < 16; ++i) { const int t = mblk + crow_(i, hi); const float bs = bv[i >> 2][i & 3];
        HT[t * 132 + nblk + r32] = acc[0][i] + bs; HT[t * 132 + nblk + 32 + r32] = acc[1][i] + bs; }
    __syncthreads();
    { bf16* CAT = (bf16*)(ws + WS_CAT);
#pragma unroll
      for (int it = 0; it < 4; ++it) { const int t = (c.tid >> 4) + 32 * it; float u[8]; unpack8(uv[it], u);
          const f32x4 x0 = *(const LAS f32x4*)(HT + t * 132 + c0e), x1 = *(const LAS f32x4*)(HT + t * 132 + c0e + 4);
          u32x4 o; o.x = pk2(u[0] * x0.x, u[1] * x0.y); o.y = pk2(u[2] * x0.z, u[3] * x0.w);
          o.z = pk2(u[4] * x1.x, u[5] * x1.y); o.w = pk2(u[6] * x1.z, u[7] * x1.w);
          *(u32x4*)(CAT + (size_t)(tok0 + t) * DM + 512 + g * 128 + c0e) = o; } }
    __syncthreads();
}
__device__ __forceinline__ void ml_scan_phase(const Ctx& c) {
    unsigned char* ws = c.ws;
    const int gid = c.bid * NTHR + c.tid, bh = gid >> 14, idx = gid & 16383;
    LAS float* sdec = (LAS float*)c.lds; LAS float* ssc = sdec + 64; LAS float* smp = ssc + 64;
    if (c.wave == 0) {
        const float bl = ldf((const float*)(ws + WS_MISC + MISC_BL) + bh * 64 + c.lane), mg = ldf((const float*)(ws + WS_MISC + MISC_MG) + bh * 64 + c.lane);
        float m = 0.f, mprev = 0.f, mnew = 0.f;
        for (int k = 0; k < 64; ++k) { const float blk = __shfl(bl, k), mgk = __shfl(mg, k); const float mn = fmaxf(blk + m, mgk);
            if (c.lane == k) { mprev = m; mnew = mn; } m = mn; }
        smp[c.lane] = mprev; sdec[c.lane] = fast_exp(bl + mprev - mnew); ssc[c.lane] = fast_exp(mg - mnew);
    }
    __syncthreads();
    const float* CH = (const float*)(ws + WS_CH) + (size_t)bh * 64 * 16384 + idx; bf16* CP = (bf16*)(ws + WS_CP) + (size_t)bh * 64 * 16384 + idx;
    float C = 0.f;
#pragma unroll 1
    for (int k0 = 0; k0 < 64; k0 += 32) { float chv[32];
#pragma unroll
        for (int k = 0; k < 32; ++k) chv[k] = CH[(size_t)(k0 + k) * 16384];
#pragma unroll
        for (int k = 0; k < 32; ++k) { CP[(size_t)(k0 + k) * 16384] = (bf16)f2bf(C); C = sdec[k0 + k] * C + ssc[k0 + k] * chv[k]; } }
    if (idx < 128) { const float* NH = (const float*)(ws + WS_NH) + (size_t)bh * 64 * 128 + idx; float* NP = (float*)(ws + WS_NP) + (size_t)bh * 64 * 128 + idx; float n = 0.f;
#pragma unroll 8
        for (int k = 0; k < 64; ++k) { const float nh = NH[k * 128]; NP[k * 128] = n; n = sdec[k] * n + ssc[k] * nh; } }
    if (idx < 64) ((float*)(ws + WS_MISC + MISC_MP))[bh * 64 + idx] = smp[idx];
    __syncthreads();
}
template <int SKIP = 0> __device__ __forceinline__ void ml_out_unit(KARGS& a, const Ctx& c0, int bhc) {
    Ctx c = c0; { int t_ = c0.wave * 64 + (int)__builtin_amdgcn_mbcnt_hi(~0u, __builtin_amdgcn_mbcnt_lo(~0u, 0u)); asm volatile("" : "+v"(t_)); c.tid = t_; c.lane = t_ & 63; c.wave = __builtin_amdgcn_readfirstlane(t_ >> 6); }
    unsigned char* ws = c.ws;
    const int bh = bhc >> 6, ck = bhc & 63, b = bh >> 2, h = bh & 3, tok0 = b * SEQ + ck * 128;
    const bf16* Z = (const bf16*)(ws + WS_ARENA);
    LAS bf16* QT = (LAS bf16*)(c.lds + L_T0); LAS bf16* KT = (LAS bf16*)(c.lds + L_T1); LAS bf16* VT = (LAS bf16*)(c.lds + L_T2); LAS bf16* CT = (LAS bf16*)(c.lds + L_T3);
    LAS bf16* SW = KT; LAS bf16* RAW = (LAS bf16*)(c.lds + L_T3 + 1024); LAS bf16* RAWK = VT;
    RawRegs rq, rk; TRegs rv; CRegs rc;
    raw_load(c, Z, tok0, ck == 0, h * 128, rq); raw_load(c, Z, tok0, ck == 0, 512 + h * 128, rk);
    tr_load(c, Z + (size_t)tok0 * ZP + 1024 + h * 128, rv); rows_load(c, (const bf16*)(ws + WS_CP) + (size_t)bhc * 16384, rc);
    LAS float* t_a = (LAS float*)(c.lds + L_TAB); LAS float* t_mu = t_a + 128; LAS float* t_wi = t_a + 256; LAS float* t_emr = t_a + 384; LAS float* t_rden = t_a + 512; LAS float* t_np = t_a + 640; LAS float* t_ssq = t_a + 768;
    if (c.wave == 0) {
        const float* LF = (const float*)(ws + WS_LF); const float* LI = (const float*)(ws + WS_LI);
        const int s0 = 2 * c.lane;
        const float lf0 = ldf(LF + (size_t)(tok0 + s0) * 4 + h), lf1 = ldf(LF + (size_t)(tok0 + s0 + 1) * 4 + h);
        const float li0 = ldf(LI + (size_t)(tok0 + s0) * 4 + h), li1 = ldf(LI + (size_t)(tok0 + s0 + 1) * 4 + h);
        float sc = lf0 + lf1;
#pragma unroll
        for (int o = 1; o < 64; o <<= 1) { const float t = shfl_up_l(sc, o, c.lane); if (c.lane >= o) sc += t; }
        const float b1 = sc, b0 = sc - lf1;
        const float a0 = li0 - b0, a1 = li1 - b1;
        float pm = fmaxf(a0, a1);
#pragma unroll
        for (int o = 1; o < 64; o <<= 1) { const float t = shfl_up_l(pm, o, c.lane); if (c.lane >= o) pm = fmaxf(pm, t); }
        float pprev = shfl_up_l(pm, 1, c.lane); if (c.lane == 0) pprev = -__builtin_inff();
        const float pm0 = fmaxf(pprev, a0), pm1 = pm;
        const float mprev = ldf((const float*)(ws + WS_MISC + MISC_MP) + bhc);
        const float mu0 = fmaxf(mprev, pm0), mu1 = fmaxf(mprev, pm1);
        t_a[s0] = a0; t_a[s0 + 1] = a1; t_mu[s0] = mu0; t_mu[s0 + 1] = mu1;
        t_wi[s0] = fast_exp(mprev - mu0); t_wi[s0 + 1] = fast_exp(mprev - mu1);
        t_emr[s0] = fast_exp(-b0 - mu0); t_emr[s0 + 1] = fast_exp(-b1 - mu1);
    }
    if (c.wave == 1) { const float* NP = (const float*)(ws + WS_NP) + (size_t)bhc * 128; t_np[c.lane] = ldf(NP + c.lane); t_np[64 + c.lane] = ldf(NP + 64 + c.lane); }
    raw_store(c, rq, RAW); raw_store(c, rk, RAWK);
    __syncthreads();
    if (!(SKIP & 1)) { conv_tile<false>(c, RAW, ain(a, 3) + h * 128, ain(a, 4) + h * 128, 0.08838834764831845f, QT);
    conv_tile<false>(c, RAWK, ain(a, 3) + 512 + h * 128, ain(a, 4) + 512 + h * 128, 1.0f, KT); }
    __syncthreads();
    if (!(SKIP & 2)) tr_store(c, rv, VT, [](float x, int, int) { return x; });
    rows_store(c, rc, CT);
    __syncthreads();
    const int r32 = c.lane & 31, hi = c.lane >> 5, mblk = (c.wave >> 1) * 32, nblk = (c.wave & 1) * 64;
    f32x16 sa[2] = {};
    if (!(SKIP & 4)) wg_mma128(sa, QT, KT, c.wave, c.lane);
    __syncthreads();
    { const float as0 = t_a[nblk + r32], as1 = t_a[nblk + 32 + r32];
#pragma unroll
      for (int i = 0; i < 16; ++i) { const int t = mblk + crow_(i, hi); const float mu = t_mu[t];
          const int s0 = nblk + r32, s1 = s0 + 32;
          const float w0 = (s0 <= t) ? fast_exp(as0 - mu) : 0.f, w1 = (s1 <= t) ? fast_exp(as1 - mu) : 0.f;
          SW[t * TS_ + s0] = (bf16)f2bf(sa[0][i] * w0); SW[t * TS_ + s1] = (bf16)f2bf(sa[1][i] * w1); } }
    __syncthreads();
    f32x16 n1[2] = {}, n2[2] = {};
    if (!(SKIP & 4)) { wg_mma128(n1, SW, VT, c.wave, c.lane);
    wg_mma128(n2, QT, CT, c.wave, c.lane); }
    { const int t = c.tid >> 2, part = c.tid & 3; float ds = 0.f, dq = 0.f;
#pragma unroll
      for (int k = 0; k < 4; ++k) { float x[8], q[8]; unpack8(*(const LAS u32x4*)(SW + t * TS_ + part * 32 + 8 * k), x); unpack8(*(const LAS u32x4*)(QT + t * TS_ + part * 32 + 8 * k), q);
#pragma unroll
        for (int i = 0; i < 8; ++i) { ds += x[i]; dq += q[i] * t_np[part * 32 + 8 * k + i]; } }
      ds = quad_sum(ds); dq = quad_sum(dq);
      if (part == 0) { const float den = ds + t_wi[t] * dq; t_rden[t] = 1.0f / fmaxf(fabsf(den), t_emr[t]); } }
    __syncthreads();
    LAS float* HT = (LAS float*)(c.lds + L_T0);
#pragma unroll
    for (int i = 0; i < 16; ++i) { const int t = mblk + crow_(i, hi); const float wi = t_wi[t], rd = t_rden[t];
        HT[t * 132 + nblk + r32] = (n1[0][i] + wi * n2[0][i]) * rd; HT[t * 132 + nblk + 32 + r32] = (n1[1][i] + wi * n2[1][i]) * rd; }
    __syncthreads();
    { const int t = c.tid >> 2, part = c.tid & 3; float q = 0.f;
#pragma unroll
      for (int k = 0; k < 8; ++k) { const f32x4 x = *(const LAS f32x4*)(HT + t * 132 + part * 32 + 4 * k); q += (x.x * x.x + x.y * x.y) + (x.z * x.z + x.w * x.w); }
      q = quad_sum(q);
      if (part == 0) t_ssq[t] = 1.0f / sqrtf(q * (1.0f / 128.0f) + EPS); }
    __syncthreads();
    { int tt = c.tid; asm volatile("" : "+v"(tt));
      bf16* CAT = (bf16*)(ws + WS_CAT); const int ch = tt & 15, e0 = ch * 8; float gn[8];
#pragma unroll
      for (int i = 0; i < 8; ++i) gn[i] = ain(a, 6)[h * 128 + e0 + i];
#pragma unroll
      for (int it = 0; it < 4; ++it) { const int t = (tt >> 4) + 32 * it; float og[8]; unpack8(*(const u32x4*)(Z + (size_t)(tok0 + t) * ZP + 1536 + h * 128 + e0), og);
          const float rstd = t_ssq[t]; const f32x4 x0 = *(const LAS f32x4*)(HT + t * 132 + e0), x1 = *(const LAS f32x4*)(HT + t * 132 + e0 + 4);
          u32x4 o; o.x = pk2(x0.x * rstd * gn[0] * og[0], x0.y * rstd * gn[1] * og[1]); o.y = pk2(x0.z * rstd * gn[2] * og[2], x0.w * rstd * gn[3] * og[3]);
          o.z = pk2(x1.x * rstd * gn[4] * og[4], x1.y * rstd * gn[5] * og[5]); o.w = pk2(x1.z * rstd * gn[6] * og[6], x1.w * rstd * gn[7] * og[7]);
          *(u32x4*)(CAT + (size_t)(tok0 + t) * DM + h * 128 + e0) = o; } }
    __syncthreads();
}

__device__ __forceinline__ void fox_cumsum(const Ctx& c) {
    if (c.bid >= 8) return;
    unsigned char* ws = c.ws; const int bh = c.bid, b = bh >> 2, h = bh & 3;
    const float* LFX = (const float*)(ws + WS_LFX) + (size_t)b * SEQ * 4 + h; u32x2* KB = (u32x2*)(ws + WS_KB) + (size_t)bh * SEQ;
    LAS float* wsum = (LAS float*)c.lds;
    float v[16]; float tot = 0.f;
#pragma unroll
    for (int i = 0; i < 16; ++i) { v[i] = LFX[(size_t)(c.tid * 16 + i) * 4]; tot += v[i]; }
    float sc = tot;
#pragma unroll
    for (int o = 1; o < 64; o <<= 1) { const float t = shfl_up_l(sc, o, c.lane); if (c.lane >= o) sc += t; }
    if (c.lane == 63) wsum[c.wave] = sc;
    __syncthreads();
    float base = 0.f;
    for (int w = 0; w < c.wave; ++w) base += wsum[w];
    float run = base + sc - tot;
#pragma unroll
    for (int i = 0; i < 16; ++i) { run += v[i]; const float x = -run * 11.313708498984761f;
        const unsigned a = f2bf(x); const float r1 = x - bf2f(a); const unsigned b2 = f2bf(r1); const float r2 = r1 - bf2f(b2); const unsigned c2 = f2bf(r2);
        u32x2 w; w.x = a | (b2 << 16); w.y = c2; KB[c.tid * 16 + i] = w; }
}
#ifndef ATT_ONLY
#define ATT_ONLY 0
#endif
template <int ONLY = ATT_ONLY> __device__ __forceinline__ void attn_phase(KARGS& a, const Ctx& c, int qoff) {
    unsigned char* ws = c.ws; char* lds = (char*)c.lds;
    const bf16* Z = (const bf16*)(ws + WS_ARENA);
    LAS int* slot = (LAS int*)(c.lds + att::LDS_BYTES);
    unsigned* q = (unsigned*)(ws + WS_CTL) + CW_QUEUE + qoff;
    if (ONLY != 2) for (;;) {
        if (c.tid == 0) slot[0] = (int)__hip_atomic_fetch_add(q, 1u, RLX_AGENT);
        __syncthreads();
        const int it = slot[0];
        __syncthreads();
        if (it >= 256) break;
        const int qb = 31 - (it >> 3), bh = it & 7, b = bh >> 2, h = bh & 3; const size_t rb = (size_t)b * SEQ;
        att::BlockRef R; R.Q = Z + (rb + (size_t)qb * 256) * ZP + h * 128; R.K = Z + rb * ZP + 512 + h * 128; R.V = Z + rb * ZP + 1024 + h * 128;
        R.KB = (const u32x2*)(ws + WS_KB) + (size_t)bh * SEQ; R.P0 = qb * 256;
        int tl = c.tid; asm volatile("" : "+v"(tl));
        { const int ln = tl & 63, wv = __builtin_amdgcn_readfirstlane(tl >> 6);
          const f32x4* N2 = (const f32x4*)(ws + WS_NORM2) + rb * 8; LAS float* red = (LAS float*)(c.lds + att::LDS_BYTES + 64); LAS int* jl = (LAS int*)(c.lds + att::LDS_BYTES + 32);
          float km = 0.f, qm = 0.f; const int nk = R.P0 + 256;
          for (int s = tl; s < nk; s += NTHR) { const f32x4 pv = N2[(size_t)s * 8 + 4 + h]; km = fmaxf(km, (pv.x + pv.y) + (pv.z + pv.w)); }
          if (tl < 256) { const f32x4 pv = N2[(size_t)(R.P0 + tl) * 8 + h]; qm = (pv.x + pv.y) + (pv.z + pv.w); }
#pragma unroll
          for (int o = 1; o < 64; o <<= 1) { km = fmaxf(km, shfl_xor_l(km, o, ln)); qm = fmaxf(qm, shfl_xor_l(qm, o, ln)); }
          if (ln == 0) { red[wv] = km; red[8 + wv] = qm; }
          if (tl == 0) jl[0] = qb * 4;
          __syncthreads();
          float K2 = 0.f, Q2 = 0.f;
#pragma unroll
          for (int w = 0; w < 8; ++w) { K2 = fmaxf(K2, red[w]); Q2 = fmaxf(Q2, red[8 + w]); }
          const float B2 = 2.0f * 1.02f * sqrtf(K2 * Q2);
          if (tl < qb * 4) { const u32x2 w1 = R.KB[tl * 64 + 63], w0 = R.KB[R.P0];
              const float kb1 = bflo(w1.x) + bfhi(w1.x) + bflo(w1.y), kb0 = bflo(w0.x) + bfhi(w0.x) + bflo(w0.y);
              if (B2 + (kb1 - kb0) >= -30.0f * 11.313708498984761f) __hip_atomic_fetch_min(jl, tl, __ATOMIC_RELAXED, __HIP_MEMORY_SCOPE_WORKGROUP); }
          __syncthreads();
          R.JLO = jl[0];
          __syncthreads(); }
        att::Seam<128> S;
        att::causal_prime<128, true>(R, lds, S, tl);
        att::causal_block<128, true, 0>(R, R, lds, S, (void*)((bf16*)(ws + WS_CAT) + (rb + (size_t)qb * 256) * DM + h * 128), DM, tl);
    }
    if (ONLY != 1) for (;;) {
        if (c.tid == 0) slot[0] = (int)__hip_atomic_fetch_add(q + 64, 1u, RLX_AGENT);
        __syncthreads();
        const int it = slot[0];
        __syncthreads();
        if (it >= 512) break;
        const int qb = 31 - (it >> 4), d = it & 15, bh = d >> 1, mp = d & 1, b = bh >> 2, h = bh & 3; const size_t rb = (size_t)b * SEQ;
        att::BlockRef R; R.Q = Z + (rb + (size_t)qb * 256) * ZP + 1536 + h * 128 + mp * 64; R.K = Z + rb * ZP + 2048 + h * 128 + mp * 64; R.V = Z + rb * ZP + 2560 + h * 128;
        R.KB = nullptr; R.P0 = qb * 256; R.JLO = 0;
        att::Seam<64> S;
        int tl = c.tid; asm volatile("" : "+v"(tl));
        att::causal_prime<64, false>(R, lds, S, tl);
        att::causal_block<64, false, 1>(R, R, lds, S, (void*)((float*)(ws + WS_DO) + (size_t)mp * T * 512 + (rb + (size_t)qb * 256) * 512 + h * 128), 512, tl);
    }
}
__device__ __forceinline__ void diffnorm_phase(KARGS& a, const Ctx& c) {
    unsigned char* ws = c.ws;
    const float lam = ldf((const float*)(ws + WS_MISC + MISC_LAM)); const float post = 1.0f - (0.8f - 0.6f * expf(-0.3f));
    const float* D0 = (const float*)(ws + WS_DO); const float* D1 = D0 + (size_t)T * 512; bf16* CAT = (bf16*)(ws + WS_CAT);
    const int gw = c.bid * NWAVES + c.wave, NGW = GRID * NWAVES;
    const float g0 = ain(a, 18)[2 * c.lane] * post, g1 = ain(a, 18)[2 * c.lane + 1] * post;
    for (int p0 = gw * 8; p0 < T * 4; p0 += NGW * 8) {
        f32x2 x0[8], x1[8];
#pragma unroll
        for (int k = 0; k < 8; ++k) { const size_t o = (size_t)(p0 + k) * 128 + 2 * c.lane; x0[k] = *(const f32x2*)(D0 + o); x1[k] = *(const f32x2*)(D1 + o); }
#pragma unroll
        for (int k = 0; k < 8; ++k) { const int p = p0 + k, t = p >> 2, h = p & 3; const float y0 = x0[k].x - lam * x1[k].x, y1 = x0[k].y - lam * x1[k].y;
            const float rstd = 1.0f / sqrtf(wave_sum(y0 * y0 + y1 * y1) * (1.0f / 128.0f) + EPS);
            *(unsigned*)(CAT + (size_t)t * DM + 512 + h * 128 + 2 * c.lane) = pk2(y0 * rstd * g0, y1 * rstd * g1); } }
}

__device__ __forceinline__ void moe_scatter_phase(const Ctx& c) {
    unsigned char* ws = c.ws;
    LAS int* soff = (LAS int*)c.lds;
    LAS int* sts = soff + 8;
    LAS int* stot = soff + 32;
    LAS int* spos = soff + 64;
    const int* CNT = (const int*)(ws + WS_MISC + MISC_CNT);
    const bf16* XN = (const bf16*)(ws + WS_XN); bf16* XP = (bf16*)(ws + WS_XP);
    u32x4 rowv[8][2];
#pragma unroll
    for (int k = 0; k < 8; ++k) { const u32x4* src = (const u32x4*)(XN + (size_t)(64 * c.bid + c.wave * 8 + k) * DM); rowv[k][0] = src[c.lane]; rowv[k][1] = src[64 + c.lane]; }
    if (c.wave == 0) {
        typedef int i32x4 __attribute__((ext_vector_type(4)));
        i32x4 cv[8];
#pragma unroll
        for (int k = 0; k < 8; ++k) cv[k] = *((const i32x4*)(CNT + (size_t)c.lane * 32) + k);
        int tot[8], before[8];
#pragma unroll
        for (int e = 0; e < 8; ++e) { int s = 0, bf = 0;
#pragma unroll
            for (int k = 0; k < 4; ++k) { const int w = 4 * c.lane + k; const int v = cv[2 * k + (e >> 2)][e & 3]; s += v; if (w < c.bid) bf += v; }
            tot[e] = s; before[e] = bf; }
#pragma unroll
        for (int e = 0; e < 8; ++e) {
#pragma unroll
            for (int o = 1; o < 64; o <<= 1) { tot[e] += __shfl_xor(tot[e], o); before[e] += __shfl_xor(before[e], o); } }
        int ts = 0, so[8];
#pragma unroll
        for (int e = 0; e < 8; ++e) { if (c.lane == 0) { sts[e] = ts; stot[e] = tot[e]; } so[e] = ts * 256 + before[e]; ts += (tot[e] + 255) >> 8; }
        if (c.lane == 0) { sts[8] = ts; if (c.bid == 0) { int acc = 0; for (int e = 0; e < 8; ++e) { ((int*)(ws + WS_MISC + MISC_TS))[e] = acc; acc += (tot[e] + 255) >> 8; } ((int*)(ws + WS_MISC + MISC_TS))[8] = acc; } }
        const int m = 64 * c.bid + c.lane; const int e1 = ((const int*)(ws + WS_RTE))[2 * m], e2 = ((const int*)(ws + WS_RTE))[2 * m + 1];
        int p1 = 0, p2 = 0;
#pragma unroll
        for (int e = 0; e < 8; ++e) { const unsigned long long mask = __ballot(e1 == e || e2 == e); const int rank = __builtin_popcountll(mask & ((1ull << c.lane) - 1ull));
            if (e1 == e) p1 = so[e] + rank; if (e2 == e) p2 = so[e] + rank; }
        spos[2 * c.lane] = p1; spos[2 * c.lane + 1] = p2;
        ((int*)(ws + WS_PPOS))[2 * m] = p1; ((int*)(ws + WS_PPOS))[2 * m + 1] = p2;
        ((float*)(ws + WS_RW))[p1] = ((const float*)(ws + WS_RTW))[2 * m]; ((float*)(ws + WS_RW))[p2] = ((const float*)(ws + WS_RTW))[2 * m + 1];
    }
    __syncthreads();
#pragma unroll
    for (int k = 0; k < 8; ++k) { const int ti = c.wave * 8 + k;
#pragma unroll
        for (int sl = 0; sl < 2; ++sl) { u32x4* dst = (u32x4*)(XP + (size_t)spos[2 * ti + sl] * DM); dst[c.lane] = rowv[k][0]; dst[64 + c.lane] = rowv[k][1]; } }
    { const int gw = c.bid * NWAVES + c.wave;
      for (int e = 0; e < 8; ++e) { const int tot = stot[e], first = sts[e] * 256 + tot, npad = ((tot + 255) & ~255) - tot;
          for (int i = gw; i < npad; i += GRID * NWAVES) { u32x4* dst = (u32x4*)(XP + (size_t)(first + i) * DM); const u32x4 z = {0u, 0u, 0u, 0u}; dst[c.lane] = z; dst[64 + c.lane] = z;
              if (c.lane == 0) ((float*)(ws + WS_RW))[first + i] = 0.f; } } }
    __syncthreads();
}
#ifndef MK_PER_PHASE
#define MK_PER_PHASE 0
#endif
constexpr int NPHASE = 19;
__global__ void __launch_bounds__(NTHR, 2) fwd_kernel(Args args_by_value) {
    (void)args_by_value;
    extern __shared__ __attribute__((aligned(16))) unsigned char lds_raw[];
    KARGS* ap0 = (KARGS*)__builtin_amdgcn_kernarg_segment_ptr();
    Ctx c_; c_.lds = (LAS unsigned char*)lds_raw; c_.ws = (unsigned char*)(GAS unsigned char*)ap0->ws; c_.tid = threadIdx.x; c_.lane = c_.tid & 63; c_.wave = __builtin_amdgcn_readfirstlane(c_.tid >> 6); c_.bid = blockIdx.x;
    unsigned char* const ws0 = c_.ws;
    for (int u = c_.tid; u < (LDS_BYTES - LDSCTL_OFF) / 4; u += NTHR) ((LAS unsigned*)(c_.lds + LDSCTL_OFF))[u] = 0u;
    __syncthreads();
    XcdBarrier bar; bar.bar = (unsigned*)(ws0 + WS_CTL) + CW_BAR; bar.x = 0; bar.st = nullptr;
    if (!MK_PER_PHASE) bar = xcd_barrier_post((unsigned*)(ws0 + WS_CTL) + CW_BAR, (volatile LAS unsigned*)(c_.lds + LDSCTL_OFF));
    const int lo = ap0->ph_lo, hi = ap0->ph_hi; const int wave0 = c_.wave;
#ifndef PHASE_MASK
#define PHASE_MASK 0xFFFFFFFFu
#endif
#define IN(k) (((PHASE_MASK >> (k)) & 1u) && lo <= (k) && (k) < hi)
#define FRESH() Ctx c = c_; { int t_ = wave0 * 64 + (int)__builtin_amdgcn_mbcnt_hi(~0u, __builtin_amdgcn_mbcnt_lo(~0u, 0u)); asm volatile("" : "+v"(t_)); c.tid = t_; c.lane = t_ & 63; c.wave = __builtin_amdgcn_readfirstlane(t_ >> 6); KARGS* ap_ = (KARGS*)__builtin_amdgcn_kernarg_segment_ptr(); asm volatile("" : "+s"(ap_)); GAS unsigned char* w_ = (GAS unsigned char*)ap_->ws; c.ws = (unsigned char*)w_; } \
    KARGS& args = *(KARGS*)__builtin_amdgcn_kernarg_segment_ptr(); \
    unsigned char* const ws = c.ws; bf16* const XN = (bf16*)(ws + WS_XN); bf16* const CAT = (bf16*)(ws + WS_CAT); bf16* const ZA = (bf16*)(ws + WS_ARENA); float* const XR = (float*)(ws + WS_XR); (void)XN; (void)CAT; (void)ZA; (void)XR;
#define SEAM(k) do { if (IN(k) && IN((k) + 1)) xcd_barrier(bar); } while (0)
    PG8_LAS unsigned char* glds = (PG8_LAS unsigned char*)lds_raw;

#define QOFF 0
    if (IN(0)) { FRESH(); prologue_weights<0, CONV_DENSE_ITEMS, false>(args, c); prologue_tables(args, c); __syncthreads(); row_phase<0>(args, c, ain(args, 0), ain(args, 1)); }
    SEAM(0);
    if (IN(1)) { FRESH(); pg8::Gemm g{XN, (const bf16*)(ws + WS_W_EIN), T, 3072, 1024}; pg8::StaticOrder S; S.init(T, 3072, GRID, c.bid);
        pg8::EpiBf16 E{ZA, ZP, nullptr, 0, 0, nullptr, 6, 8, 12}; pg8::gemm_phase<pg8::EpiBf16, pg8::StaticOrder, true, true>(glds, g, S, E, c.tid); }
    SEAM(1);
    if (IN(2)) { FRESH(); for (int u = c.bid; u < 1024; u += GRID) { if (u < 512) ml_state_unit(args, c, u); else sg_unit(args, c, u - 512); } }
    SEAM(2);
    if (IN(3)) { FRESH(); ml_scan_phase(c); }
    SEAM(3);
    if (IN(4)) { FRESH(); for (int u = c.bid; u < 512; u += GRID) ml_out_unit(args, c, u); }
    SEAM(4);
    if (IN(5)) { FRESH(); pg8::Gemm g{CAT, (const bf16*)(ws + WS_W_EOUT), T, 1024, 1024}; pg8::StaticOrder S; S.init(T, 1024, GRID, c.bid);
        pg8::EpiResF32 E{ain(args, 0), XR, DM}; pg8::gemm_phase<pg8::EpiResF32, pg8::StaticOrder, false, true>(glds, g, S, E, c.tid); }
    SEAM(5);
    if (IN(6)) { FRESH(); row_phase<1>(args, c, XR, ain(args, 11)); }
    SEAM(6);
    if (IN(7)) { FRESH(); pg8::Gemm g{XN, (const bf16*)(ws + WS_W_FGU), T, 2 * FF, 1024}; pg8::StaticOrder S; S.init(T, 2 * FF, GRID, c.bid);
        pg8::EpiSwiglu E{ZA, FF}; pg8::gemm_phase<pg8::EpiSwiglu, pg8::StaticOrder, true, true>(glds, g, S, E, c.tid); }
    SEAM(7);
    if (IN(8)) { FRESH(); pg8::Gemm g{ZA, (const bf16*)(ws + WS_W_FDN), T, 1024, FF}; pg8::StaticOrder S; S.init(T, 1024, GRID, c.bid);
        pg8::EpiResF32 E{XR, XR, DM}; pg8::gemm_phase<pg8::EpiResF32, pg8::StaticOrder, false, true>(glds, g, S, E, c.tid); }
    SEAM(8);
    if (IN(9)) { FRESH(); row_phase<2>(args, c, XR, ain(args, 14)); }
    SEAM(9);
    if (IN(10)) { FRESH(); fox_cumsum(c); __syncthreads();
        pg8::Gemm g{XN, (const bf16*)(ws + WS_W_OIN), T, 3072, 1024}; pg8::StaticOrder S; S.init(T, 3072, GRID, c.bid);
        pg8::EpiBf16 E{ZA, ZP, (const float*)(ws + WS_ROPE), 6, 10, (float*)(ws + WS_NORM2), 99, 99, 99}; pg8::gemm_phase<pg8::EpiBf16, pg8::StaticOrder, true, true>(glds, g, S, E, c.tid); }
    SEAM(10);
    if (IN(11)) { FRESH(); attn_phase(args, c, QOFF); }
    SEAM(11);
    if (IN(12)) { FRESH(); diffnorm_phase(args, c); }
    SEAM(12);
    if (IN(13)) { FRESH(); pg8::Gemm g{CAT, (const bf16*)(ws + WS_W_OOUT), T, 1024, 1024}; pg8::StaticOrder S; S.init(T, 1024, GRID, c.bid);
        pg8::EpiResF32 E{XR, XR, DM}; pg8::gemm_phase<pg8::EpiResF32, pg8::StaticOrder, false, true>(glds, g, S, E, c.tid); }
    SEAM(13);
    if (IN(14)) { FRESH(); row_phase<3>(args, c, XR, ain(args, 20)); }
    SEAM(14);
    if (IN(15)) { FRESH(); moe_scatter_phase(c); prologue_weights<CONV_DENSE_ITEMS, CONV_MGU_END, true>(args, c); }
    SEAM(15);
    if (IN(16)) { FRESH(); pg8::Gemm g{(const bf16*)(ws + WS_XP), (const bf16*)(ws + WS_W_MGU), 0, 2 * FFE, 1024}; pg8::MoeOrder S;
#pragma unroll
        for (int e = 0; e < 9; ++e) S.ts[e] = __builtin_amdgcn_readfirstlane(ldi((const int*)(ws + WS_MISC + MISC_TS) + e));
        S.nM = S.ts[8]; S.nN = 2 * FFE / 256; S.nwg = S.nM * S.nN; S.G = GRID; S.c = c.bid;
        pg8::EpiSwiglu E{ZA, FFE}; pg8::gemm_phase<pg8::EpiSwiglu, pg8::MoeOrder, true, true>(glds, g, S, E, c.tid);
        __syncthreads(); conv_dynamic<CONV_MGU_END, CONV_ALL_ITEMS, true>(args, c, (unsigned*)(ws + WS_CTL) + CW_QUEUE + 256 + (QOFF ? 64 : 0)); }
    SEAM(16);
    if (IN(17)) { FRESH(); pg8::Gemm g{ZA, (const bf16*)(ws + WS_W_MDN), 0, 1024, FFE}; pg8::HybridOrder S;
#pragma unroll
        for (int e = 0; e < 9; ++e) S.ts[e] = __builtin_amdgcn_readfirstlane(ldi((const int*)(ws + WS_MISC + MISC_TS) + e));
        S.nN = 4; S.NKT = FFE / 64; S.U = S.ts[8] * 4; S.G = GRID; S.c = c.bid;
        pg8::EpiMoeDownSK E{(bf16*)(ws + WS_Y), DM, (const float*)(ws + WS_RW), (float*)(ws + WS_XP), pg8::hyb_SL(S.U - 512)}; pg8::gemm_phase<pg8::EpiMoeDownSK, pg8::HybridOrder, true, true>(glds, g, S, E, c.tid); }
    SEAM(17);
    if (IN(18)) { FRESH(); row_phase<4>(args, c, XR, ain(args, 24)); }
#undef QOFF
#undef IN
#undef SEAM
}

extern "C" void kernel_launch(void* const* d_in, const int* in_sizes, int n_in, void* d_out, int out_size, void* d_ws, size_t ws_size, hipStream_t stream) {
    static int ready = 0;
    if (ready == 0) {
        if (n_in != 25 || in_sizes[0] != T * DM || out_size != T * DM || ws_size < WS_END) {
            fprintf(stderr, "kernel_launch: built for 25 inputs, x/out of %d floats, >= %zu bytes of workspace; got n_in %d in0 %d out %d ws %zu; nothing launched\n", T * DM, (size_t)WS_END, n_in, n_in > 0 ? in_sizes[0] : -1, out_size, ws_size);
            ready = -1; return; }
        if (hipFuncSetAttribute((const void*)fwd_kernel, hipFuncAttributeMaxDynamicSharedMemorySize, LDS_BYTES) != hipSuccess) { fprintf(stderr, "kernel_launch: hipFuncSetAttribute(%d) failed\n", LDS_BYTES); ready = -1; return; }
        int dev = 0, cus = 0, per_cu = 0; (void)hipGetDevice(&dev); (void)hipDeviceGetAttribute(&cus, hipDeviceAttributeMultiprocessorCount, dev);
        if (hipOccupancyMaxActiveBlocksPerMultiprocessor(&per_cu, (const void*)fwd_kernel, NTHR, LDS_BYTES) != hipSuccess) per_cu = -1;
        (void)hipGetLastError();
        if (cus < GRID || per_cu < 1) fprintf(stderr, "kernel_launch: note: %d CUs, occupancy query %d; the kernel needs %d co-resident workgroups (one per CU)\n", cus, per_cu, GRID);
        ready = 1;
    }
    if (ready < 0) return;
    (void)hipMemsetAsync((char*)d_ws + WS_CTL, 0, CTL_ZERO_BYTES, stream);
    Args a{};
    for (int i = 0; i < 25; ++i) a.in[i] = (const float*)d_in[i];
    a.out = (float*)d_out; a.ws = (unsigned char*)d_ws;
#if MK_PER_PHASE
    for (int p = 0; p < NPHASE; ++p) { a.ph_lo = p; a.ph_hi = p + 1; hipLaunchKernelGGL(fwd_kernel, dim3(GRID), dim3(NTHR), LDS_BYTES, stream, a); }
#else
    a.ph_lo = 0; a.ph_hi = NPHASE; hipLaunchKernelGGL(fwd_kernel, dim3(GRID), dim3(NTHR), LDS_BYTES, stream, a);
#endif
    const hipError_t le = hipPeekAtLastError();
    if (le != hipSuccess) fprintf(stderr, "kernel_launch: launch failed: %s\n", hipGetErrorName(le));
}
```

```cpp
#include <hip/hip_runtime.h>
#include <cstdio>
#include <cstdint>

#define LAS __attribute__((address_space(3)))
#define GAS __attribute__((address_space(1)))
typedef unsigned short bf16;
typedef unsigned short bf16_t;
typedef short bf16x8 __attribute__((ext_vector_type(8)));
typedef short s16x4 __attribute__((ext_vector_type(4)));
typedef float f32x2 __attribute__((ext_vector_type(2)));
typedef float f32x4 __attribute__((ext_vector_type(4)));
typedef float f32x16 __attribute__((ext_vector_type(16)));
typedef unsigned u32x2 __attribute__((ext_vector_type(2)));
typedef unsigned u32x4 __attribute__((ext_vector_type(4)));
typedef GAS unsigned gu32;
#define RLX_AGENT __ATOMIC_RELAXED, __HIP_MEMORY_SCOPE_AGENT
#define LDS_WAIT() asm volatile("s_waitcnt lgkmcnt(0)" ::: "memory")
#define VM_WAIT() asm volatile("s_waitcnt vmcnt(0)" ::: "memory")

typedef __bf16 bf16x2_t __attribute__((ext_vector_type(2)));
__device__ __forceinline__ unsigned pk2(float lo, float hi) { const f32x2 v = {lo, hi}; return __builtin_bit_cast(unsigned, __builtin_convertvector(v, bf16x2_t)); }
__device__ __forceinline__ unsigned f2bf(float f) { return pk2(f, 0.f) & 0xffffu; }
__device__ __forceinline__ float bf2f(unsigned b) { return __builtin_bit_cast(float, b << 16); }
__device__ __forceinline__ float bflo(unsigned w) { return __builtin_bit_cast(float, w << 16); }
__device__ __forceinline__ float bfhi(unsigned w) { return __builtin_bit_cast(float, w & 0xffff0000u); }
__device__ __forceinline__ float ldf(const float* p) { return __builtin_bit_cast(float, __hip_atomic_load((const unsigned*)p, RLX_AGENT)); }
__device__ __forceinline__ int ldi(const int* p) { return __hip_atomic_load(p, RLX_AGENT); }
__device__ __forceinline__ float wave_sum(float v) {
#define DPPF(x, ctrl, rmask) __builtin_bit_cast(float, __builtin_amdgcn_update_dpp(0, __builtin_bit_cast(int, x), ctrl, rmask, 0xF, true))
    v += DPPF(v, 0xB1, 0xF);
    v += DPPF(v, 0x4E, 0xF);
    v += DPPF(v, 0x141, 0xF);
    v += DPPF(v, 0x140, 0xF);
    v += DPPF(v, 0x142, 0xA);
    v += DPPF(v, 0x143, 0xC);
#undef DPPF
    return __builtin_bit_cast(float, __builtin_amdgcn_readlane(__builtin_bit_cast(int, v), 63));
}
__device__ __forceinline__ float wave_max(float v) {
#pragma unroll
    for (int o = 1; o < 64; o <<= 1) v = fmaxf(v, __shfl_xor(v, o));
    return v;
}
__device__ __forceinline__ float shfl_up_l(float v, int o, int lane) { const int src = (lane >= o) ? lane - o : lane; return __builtin_bit_cast(float, __builtin_amdgcn_ds_bpermute(src << 2, __builtin_bit_cast(int, v))); }
__device__ __forceinline__ float shfl_idx_l(float v, int src) { return __builtin_bit_cast(float, __builtin_amdgcn_ds_bpermute(src << 2, __builtin_bit_cast(int, v))); }
__device__ __forceinline__ float shfl_xor_l(float v, int o, int lane) { return __builtin_bit_cast(float, __builtin_amdgcn_ds_bpermute((lane ^ o) << 2, __builtin_bit_cast(int, v))); }
__device__ __forceinline__ float quad_xor1(float v) { return __builtin_bit_cast(float, __builtin_amdgcn_update_dpp(0, __builtin_bit_cast(int, v), 0xB1, 0xF, 0xF, true)); }
__device__ __forceinline__ float quad_xor2(float v) { return __builtin_bit_cast(float, __builtin_amdgcn_update_dpp(0, __builtin_bit_cast(int, v), 0x4E, 0xF, 0xF, true)); }
__device__ __forceinline__ float quad_sum(float v) { v += quad_xor1(v); v += quad_xor2(v); return v; }
__device__ __forceinline__ float fast_exp(float x) { return __builtin_amdgcn_exp2f(x * 1.4426950408889634f); }
__device__ __forceinline__ float sigmoidf_(float x) { return __builtin_amdgcn_rcpf(1.0f + fast_exp(-x)); }
__device__ __forceinline__ float siluf_(float x) { return x * sigmoidf_(x); }
__device__ __forceinline__ float gelu_tanh(float x) {
    const float x2 = x * x, t = fmaf(x2, -2.3022082299f * 0.044715f, -2.3022082299f);
    return x * __builtin_amdgcn_rcpf(1.0f + __builtin_amdgcn_exp2f(x * t));
}
__device__ __forceinline__ float log_sigmoid_acc(float x) { return fminf(x, 0.f) - log1pf(expf(-fabsf(x))); }

namespace pg8 {
#define PG8_LAS __attribute__((address_space(3)))
constexpr int BM = 256, BK = 64, HALF = 128, HTB = HALF * BK * 2, STAGE_BYTES = 8 * HTB, NXCD = 8, WGM = 8;
__host__ __device__ __forceinline__ int lds_byte(int r, int c) { const int st = (r >> 4) * 2 + (c >> 5), rr = r & 15, cc = c & 31, ob = rr * 64 + cc * 2; return st * 1024 + (ob ^ (((ob >> 9) & 1) << 5)); }
__host__ __device__ __forceinline__ void stage_rc(int b, int& R, int& C) { const int st = b / 1024, sb = b % 1024, swz = sb ^ (((sb >> 9) & 1) << 5); R = (st >> 1) * 16 + swz / 64; C = (st & 1) * 32 + (swz % 64) / 2; }
__host__ __device__ __forceinline__ int perm32(int rho) { const int n = rho >> 4, i = rho & 15; return 8 * (i >> 2) + 4 * n + (i & 3); }

struct Unit { int pm, pn, pb, kt0, nkt; };
struct Gemm { const bf16_t* A; const bf16_t* Bt; int M, N, K; };

struct StaticOrder {
    int nM, nN, nwg, G, c; int wgm = WGM;
    __host__ __device__ void init(int M, int N, int G_, int c_) { nM = M / BM; nN = N / BM; nwg = nM * nN; G = G_; c = c_; }
    __host__ __device__ __forceinline__ bool next(int i, Unit& u) const {
        const long L = (long)i * G + c; if (L >= nwg) return false;
        int wgid = (int)L; { const int q = nwg / NXCD, r = nwg % NXCD, xcd = wgid % NXCD, off = wgid / NXCD; wgid = (xcd < r ? xcd * (q + 1) : r * (q + 1) + (xcd - r) * q) + off; }
        const int nig = wgm * nN, gid = wgid / nig, fm = gid * wgm, gsz = (nM - fm) < wgm ? (nM - fm) : wgm;
        u.pm = fm + ((wgid % nig) % gsz); u.pn = (wgid % nig) / gsz; u.pb = u.pn; return true;
    }
    static constexpr bool KRANGE = false;
    __device__ __forceinline__ void a_ready(const Unit&) const {}
    __device__ __forceinline__ void done(const Unit&) const {}
};
struct MoeOrder {
    int nM, nN, nwg, G, c; int ts[9]; int wgm = WGM;
    __device__ __forceinline__ bool next(int i, Unit& u) const {
        const long L = (long)i * G + c; if (L >= nwg) return false;
        int wgid = (int)L; { const int q = nwg / NXCD, r = nwg % NXCD, xcd = wgid % NXCD, off = wgid / NXCD; wgid = (xcd < r ? xcd * (q + 1) : r * (q + 1) + (xcd - r) * q) + off; }
        const int nig = wgm * nN, gid = wgid / nig, fm = gid * wgm, gsz = (nM - fm) < wgm ? (nM - fm) : wgm;
        u.pm = fm + ((wgid % nig) % gsz); u.pn = (wgid % nig) / gsz;
        int e = 0;
#pragma unroll
        for (int k = 1; k < 8; ++k) e += (u.pm >= ts[k]) ? 1 : 0;
        u.pb = e * nN + u.pn; return true;
    }
    static constexpr bool KRANGE = false;
    __device__ __forceinline__ void a_ready(const Unit&) const {}
    __device__ __forceinline__ void done(const Unit&) const {}
};
__host__ __device__ __forceinline__ int hyb_SL(int R) { return R <= 9 ? 28 : (R <= 18 ? 14 : (R <= 36 ? 7 : 4)); }
struct HybridOrder {
    int U, c, nN, NKT, G; int ts[9];
    __device__ __forceinline__ bool next(int i, Unit& u) const {
        const bool full = i < 2; const int R = U - 512, SL = hyb_SL(R), ui = c / SL, sl = c - ui * SL;
        if (!full && (i > 2 || R <= 0 || ui >= R)) return false;
        int wgid = i * G + c; { const int q = 512 / NXCD, xcd = wgid % NXCD, off = wgid / NXCD; wgid = xcd * q + off; }
        const int nig = WGM * nN, fm = (wgid / nig) * WGM, pm_f = fm + ((wgid % nig) % WGM), pn_f = (wgid % nig) / WGM;
        const int unit = 512 + ui, pm_s = unit / nN, pn_s = unit - pm_s * nN, nk_s = NKT / SL;
        const int pm = full ? pm_f : pm_s, pn = full ? pn_f : pn_s, nkt = full ? NKT : nk_s, kt0 = full ? 0 : sl * nk_s;
        int e = 0;
#pragma unroll
        for (int k = 1; k < 8; ++k) e += (pm >= ts[k]) ? 1 : 0;
        u.pm = pm; u.pn = pn; u.pb = e * nN + pn; u.kt0 = kt0; u.nkt = nkt; return true;
    }
    static constexpr bool KRANGE = true;
    __device__ __forceinline__ void a_ready(const Unit&) const {}
    __device__ __forceinline__ void done(const Unit&) const {}
};

__device__ __forceinline__ unsigned cvt_pk_bf16(float lo, float hi) { unsigned r; asm volatile("v_cvt_pk_bf16_f32 %0, %1, %2" : "=v"(r) : "v"(lo), "v"(hi)); return r; }

struct EpiBf16 {
    static constexpr bool PERM = true, AFTER_DRAIN = false;
    bf16_t* O; int ldc; const float* cs; int rope_pn0, rope_pn1; float* norm2; int sig_pn0, gelu_pn0, gelu_pn1;
    __device__ __forceinline__ void operator()(const f32x4 (&acc)[2][2][4][2], const Unit& u, int wr, int wc, int fr, int fq) const {
        const int row0 = u.pm * BM + wr * 64 + fr; const int col0 = u.pn * BM + wc * 32 + 8 * fq;
        if (norm2 != nullptr && u.pn < 4) {
#pragma unroll
            for (int ai = 0; ai < 2; ++ai)
#pragma unroll
                for (int m = 0; m < 4; ++m)
#pragma unroll
                    for (int bj = 0; bj < 2; ++bj) { const f32x4 a0 = acc[ai][bj][m][0], a1 = acc[ai][bj][m][1];
                        float s = (a0[0] * a0[0] + a0[1] * a0[1]) + (a0[2] * a0[2] + a0[3] * a0[3]) + (a1[0] * a1[0] + a1[1] * a1[1]) + (a1[2] * a1[2] + a1[3] * a1[3]);
                        s += __shfl_xor(s, 16); s += __shfl_xor(s, 32);
                        if (fq == 0) norm2[((size_t)(row0 + ai * HALF + m * 16) * 8 + (u.pn >> 1) * 4 + (u.pn & 1) * 2 + bj) * 4 + wc] = s; }
        }
        const bool rope = (u.pn >= rope_pn0) && (u.pn < rope_pn1) && ((wc & 1) == 0);
        const float sgn = (fq == 0) ? -1.f : 1.f;
#pragma unroll
        for (int ai = 0; ai < 2; ++ai)
#pragma unroll
            for (int m = 0; m < 4; ++m) { const int row = row0 + ai * HALF + m * 16; bf16_t* rowp = O + (size_t)row * ldc + col0;
                f32x4 c0 = {1.f, 1.f, 1.f, 1.f}, c1 = c0, s0 = {0.f, 0.f, 0.f, 0.f}, s1 = s0;
                if (rope) {
                    const float pos = (float)(row & 8191);
                    constexpr float IR[8] = {0.15915494309189535f, 0.03086376340470123f, 0.0059851857127137054f, 0.001160663641240061f, 0.00022507907903927653f, 4.3647952792802891e-05f, 8.4643308082414014e-06f, 1.6414262627950345e-06f};
#pragma unroll
                    for (int k = 0; k < 4; ++k) { const float r0 = __builtin_amdgcn_fractf(pos * IR[k]), r1 = __builtin_amdgcn_fractf(pos * IR[4 + k]);
                        c0[k] = __builtin_amdgcn_cosf(r0); s0[k] = __builtin_amdgcn_sinf(r0); c1[k] = __builtin_amdgcn_cosf(r1); s1[k] = __builtin_amdgcn_sinf(r1); } }
#pragma unroll
                for (int bj = 0; bj < 2; ++bj) { f32x4 v0 = acc[ai][bj][m][0], v1 = acc[ai][bj][m][1];
                    if (u.pn >= gelu_pn0 && u.pn < gelu_pn1) {
#pragma unroll
                        for (int i = 0; i < 4; ++i) { v0[i] = gelu_tanh(v0[i]); v1[i] = gelu_tanh(v1[i]); } }
                    else if (u.pn >= sig_pn0 && u.pn < gelu_pn0) {
#pragma unroll
                        for (int i = 0; i < 4; ++i) { v0[i] = sigmoidf_(v0[i]); v1[i] = sigmoidf_(v1[i]); } }
                    if (rope) { f32x4 p0, p1;
#pragma unroll
                        for (int i = 0; i < 4; ++i) { p0[i] = __shfl_xor(v0[i], 16); p1[i] = __shfl_xor(v1[i], 16); }
                        if (fq < 2) { v0 = v0 * c0 + (p0 * s0) * sgn; v1 = v1 * c1 + (p1 * s1) * sgn; } }
                    u32x4 w; w.x = cvt_pk_bf16(v0[0], v0[1]); w.y = cvt_pk_bf16(v0[2], v0[3]); w.z = cvt_pk_bf16(v1[0], v1[1]); w.w = cvt_pk_bf16(v1[2], v1[3]);
                    *(u32x4*)(rowp + bj * HALF) = w; } }
    }
};
struct EpiResF32 {
    static constexpr bool PERM = false, AFTER_DRAIN = false;
    const float* base; float* out; int ldc;
    __device__ __forceinline__ void operator()(const f32x4 (&acc)[2][2][4][2], const Unit& u, int wr, int wc, int fr, int fq) const {
        const int row0 = u.pm * BM + wr * 64 + fr, col0 = u.pn * BM + wc * 32 + 4 * fq;
#pragma unroll
        for (int ai = 0; ai < 2; ++ai) {
            f32x4 b[4][2][2];
#pragma unroll
            for (int m = 0; m < 4; ++m) { const size_t off = (size_t)(row0 + ai * HALF + m * 16) * ldc + col0;
#pragma unroll
                for (int bj = 0; bj < 2; ++bj)
#pragma unroll
                    for (int n = 0; n < 2; ++n) b[m][bj][n] = *(const f32x4*)(base + off + bj * HALF + n * 16); }
#pragma unroll
            for (int m = 0; m < 4; ++m) { const size_t off = (size_t)(row0 + ai * HALF + m * 16) * ldc + col0;
#pragma unroll
                for (int bj = 0; bj < 2; ++bj)
#pragma unroll
                    for (int n = 0; n < 2; ++n) *(f32x4*)(out + off + bj * HALF + n * 16) = b[m][bj][n] + acc[ai][bj][m][n]; }
            asm volatile("" ::: "memory"); }
    }
};
struct EpiSwiglu {
    static constexpr bool PERM = true, AFTER_DRAIN = false;
    bf16_t* O; int ldc;
    __device__ __forceinline__ void operator()(const f32x4 (&acc)[2][2][4][2], const Unit& u, int wr, int wc, int fr, int fq) const {
        const int row0 = u.pm * BM + wr * 64 + fr; const int col0 = u.pn * HALF + wc * 32 + 8 * fq;
#pragma unroll
        for (int ai = 0; ai < 2; ++ai)
#pragma unroll
            for (int m = 0; m < 4; ++m) { bf16_t* rowp = O + (size_t)(row0 + ai * HALF + m * 16) * ldc + col0;
                f32x4 h0, h1;
#pragma unroll
                for (int i = 0; i < 4; ++i) { h0[i] = siluf_(acc[ai][0][m][0][i]) * acc[ai][1][m][0][i]; h1[i] = siluf_(acc[ai][0][m][1][i]) * acc[ai][1][m][1][i]; }
                u32x4 w; w.x = cvt_pk_bf16(h0[0], h0[1]); w.y = cvt_pk_bf16(h0[2], h0[3]); w.z = cvt_pk_bf16(h1[0], h1[1]); w.w = cvt_pk_bf16(h1[2], h1[3]);
                *(u32x4*)rowp = w; }
    }
};
#if defined(PROBE_EPI)
struct EpiNone { static constexpr bool PERM = true, AFTER_DRAIN = false; bf16_t* O; int ldc;
    __device__ __forceinline__ void operator()(const f32x4 (&acc)[2][2][4][2], const Unit& u, int wr, int wc, int fr, int fq) const {
        float s = 0.f;
#pragma unroll
        for (int ai = 0; ai < 2; ++ai)
#pragma unroll
            for (int bj = 0; bj < 2; ++bj)
#pragma unroll
                for (int m = 0; m < 4; ++m)
#pragma unroll
                    for (int n = 0; n < 2; ++n) s += acc[ai][bj][m][n][0];
        if (s == 12345.678f) O[0] = 1; } };
struct EpiSwigluCheap {
    static constexpr bool PERM = true, AFTER_DRAIN = false;
    bf16_t* O; int ldc;
    __device__ __forceinline__ void operator()(const f32x4 (&acc)[2][2][4][2], const Unit& u, int wr, int wc, int fr, int fq) const {
        const int row0 = u.pm * BM + wr * 64 + fr; const int col0 = u.pn * HALF + wc * 32 + 8 * fq;
#pragma unroll
        for (int ai = 0; ai < 2; ++ai)
#pragma unroll
            for (int m = 0; m < 4; ++m) { bf16_t* rowp = O + (size_t)(row0 + ai * HALF + m * 16) * ldc + col0;
                const f32x4 h0 = acc[ai][0][m][0] * acc[ai][1][m][0], h1 = acc[ai][0][m][1] * acc[ai][1][m][1];
                u32x4 w; w.x = cvt_pk_bf16(h0[0], h0[1]); w.y = cvt_pk_bf16(h0[2], h0[3]); w.z = cvt_pk_bf16(h1[0], h1[1]); w.w = cvt_pk_bf16(h1[2], h1[3]);
                *(u32x4*)rowp = w; }
    }
};
#endif
struct EpiMoeDown {
    static constexpr bool PERM = false, AFTER_DRAIN = false;
    float* Y; int ldc; const float* rw;
    __device__ __forceinline__ void operator()(const f32x4 (&acc)[2][2][4][2], const Unit& u, int wr, int wc, int fr, int fq) const {
        const int row0 = u.pm * BM + wr * 64 + fr, col0 = u.pn * BM + wc * 32 + 4 * fq;
#pragma unroll
        for (int ai = 0; ai < 2; ++ai)
#pragma unroll
            for (int m = 0; m < 4; ++m) { const int row = row0 + ai * HALF + m * 16; const float w = ldf(rw + row); const size_t off = (size_t)row * ldc + col0;
#pragma unroll
                for (int bj = 0; bj < 2; ++bj)
#pragma unroll
                    for (int n = 0; n < 2; ++n) *(f32x4*)(Y + off + bj * HALF + n * 16) = acc[ai][bj][m][n] * w; }
    }
};

struct EpiMoeDownSK {
    static constexpr bool PERM = true, AFTER_DRAIN = false;
    bf16_t* Y; int ldc; const float* rw; float* slab; int SL;
    __device__ __forceinline__ void operator()(const f32x4 (&acc)[2][2][4][2], const Unit& u, int wr, int wc, int fr, int fq) const {
        const int r0 = wr * 64 + fr, c0 = wc * 32 + 8 * fq; const bool second = u.kt0 != 0;
        const int sidx = second ? (u.pm * 4 + u.pn - 512) * (SL - 1) + u.kt0 / u.nkt - 1 : 0;
        float* sb = slab + (size_t)sidx * 65536 + c0; bf16_t* yb = Y + (size_t)(u.pm * BM) * ldc + u.pn * BM + c0;
        float wv[2][4];
#pragma unroll
        for (int ai = 0; ai < 2; ++ai)
#pragma unroll
            for (int m = 0; m < 4; ++m) wv[ai][m] = rw[u.pm * BM + r0 + ai * HALF + m * 16];
#pragma unroll
        for (int ai = 0; ai < 2; ++ai)
#pragma unroll
            for (int m = 0; m < 4; ++m) { const int r = r0 + ai * HALF + m * 16; const float w = wv[ai][m];
#pragma unroll
                for (int bj = 0; bj < 2; ++bj) { const f32x4 v0 = acc[ai][bj][m][0] * w, v1 = acc[ai][bj][m][1] * w;
                    if (second) { *(f32x4*)(sb + (size_t)r * 256 + bj * HALF) = v0; *(f32x4*)(sb + (size_t)r * 256 + bj * HALF + 4) = v1; }
                    else { u32x4 o; o.x = cvt_pk_bf16(v0[0], v0[1]); o.y = cvt_pk_bf16(v0[2], v0[3]); o.z = cvt_pk_bf16(v1[0], v1[1]); o.w = cvt_pk_bf16(v1[2], v1[3]); *(u32x4*)(yb + (size_t)r * ldc + bj * HALF) = o; } } }
    }
};

template <class Epi, class Sched, bool ALIGN_EPI = false, bool SP2 = false>
__device__ __forceinline__ void gemm_phase(PG8_LAS unsigned char* lds, const Gemm g, const Sched& S, const Epi& E, const int tid) {
    const int wid = __builtin_amdgcn_readfirstlane(tid >> 6), lane = tid & 63, wr = wid >> 2, wc = wid & 3, fr = lane & 15, fq = lane >> 4;
    const int K = g.K; int nt = K / BK;
    unsigned voffA[2], voffB[2];
#pragma unroll
    for (int i = 0; i < 2; ++i) { int R, C; stage_rc(tid * 16 + i * 8192, R, C); const int Rb = Epi::PERM ? ((R & ~31) + perm32(R & 31)) : R;
        voffA[i] = (unsigned)(R * K + C) * 2u; voffB[i] = (unsigned)(Rb * K + C) * 2u; }
    const size_t kstep = (size_t)(BK * 2);
    const size_t hstep = (size_t)HALF * K * 2;
    const size_t tstep = 2 * hstep;
    const unsigned ldsw = (unsigned)wid * 1024u;
    const int aoff = lds_byte(wr * 64 + fr, fq * 8), boff = lds_byte(wc * 32 + fr, fq * 8);
#define PG8_SA(b, h) (((b) * 2 + (h)) * HTB)
#define PG8_SB(b, h) ((4 + (b) * 2 + (h)) * HTB)
#define PG8_STAGE(bufoff, gbase, voff) do { _Pragma("unroll") for (int _i = 0; _i < 2; ++_i) \
        __builtin_amdgcn_global_load_lds((const unsigned*)((const char*)(gbase) + (voff)[_i]), (PG8_LAS unsigned*)(lds + (bufoff) + ldsw + _i * 8192), 16, 0, 0); } while (0)
#define PG8_LDA(dst, b, h) do { _Pragma("unroll") for (int m = 0; m < 4; ++m) _Pragma("unroll") for (int k = 0; k < 2; ++k) dst[m][k] = *(const PG8_LAS bf16x8*)(lds + PG8_SA(b, h) + aoff + m * 2048 + k * 1024); } while (0)
#define PG8_LDB(dst, b, h) do { _Pragma("unroll") for (int n = 0; n < 2; ++n) _Pragma("unroll") for (int k = 0; k < 2; ++k) dst[n][k] = *(const PG8_LAS bf16x8*)(lds + PG8_SB(b, h) + boff + n * 2048 + k * 1024); } while (0)
#define PG8_MMA(ai, bj, At, Bt) do { __builtin_amdgcn_s_setprio(1); _Pragma("unroll") for (int m = 0; m < 4; ++m) _Pragma("unroll") for (int n = 0; n < 2; ++n) _Pragma("unroll") for (int k = 0; k < 2; ++k) \
        acc[ai][bj][m][n] = __builtin_amdgcn_mfma_f32_16x16x32_bf16(Bt[n][k], At[m][k], acc[ai][bj][m][n], 0, 0, 0); __builtin_amdgcn_s_setprio(0); } while (0)
#define PG8_WAIT_V(n) asm volatile("s_waitcnt vmcnt(" #n ")" ::: "memory")
#define PG8_WAIT_L(n) asm volatile("s_waitcnt lgkmcnt(" #n ")" ::: "memory")
#define PG8_BAR __builtin_amdgcn_s_barrier()
#define PG8_SCHED __builtin_amdgcn_sched_barrier(0)
    Unit cur, nxt; int ui = 0;
    if (!S.next(0, cur)) return;
    f32x4 acc[2][2][4][2];
#pragma unroll
    for (int a = 0; a < 2; ++a)
#pragma unroll
        for (int b = 0; b < 2; ++b)
#pragma unroll
            for (int m = 0; m < 4; ++m)
#pragma unroll
                for (int n = 0; n < 2; ++n) acc[a][b][m][n] = (f32x4){0.f, 0.f, 0.f, 0.f};
    bf16x8 At[4][2], B0[2][2], B1[2][2];
    const char* cA = (const char*)g.A + (size_t)cur.pm * tstep; const char* cB = (const char*)g.Bt + (size_t)cur.pb * tstep;
    if constexpr (Sched::KRANGE) { cA += (size_t)cur.kt0 * kstep; cB += (size_t)cur.kt0 * kstep; nt = cur.nkt; }
    S.a_ready(cur);
    if constexpr (SP2) {
        PG8_STAGE(PG8_SB(0, 0), cB, voffB); PG8_STAGE(PG8_SB(0, 1), cB + hstep, voffB); PG8_STAGE(PG8_SA(0, 0), cA, voffA); PG8_STAGE(PG8_SA(0, 1), cA + hstep, voffA);
        if (wr == 1) PG8_BAR;
        PG8_WAIT_V(2); PG8_BAR;
        PG8_STAGE(PG8_SB(1, 0), cB + kstep, voffB); PG8_STAGE(PG8_SA(1, 0), cA + kstep, voffA); PG8_STAGE(PG8_SB(1, 1), cB + hstep + kstep, voffB);
        PG8_WAIT_V(6); PG8_BAR;
    } else {
        PG8_STAGE(PG8_SB(0, 0), cB, voffB); PG8_STAGE(PG8_SA(0, 0), cA, voffA); PG8_STAGE(PG8_SB(0, 1), cB + hstep, voffB); PG8_STAGE(PG8_SA(0, 1), cA + hstep, voffA);
        if (wr == 1) PG8_BAR;
        PG8_WAIT_V(4); PG8_BAR;
        PG8_STAGE(PG8_SB(1, 0), cB + kstep, voffB); PG8_STAGE(PG8_SA(1, 0), cA + kstep, voffA); PG8_STAGE(PG8_SB(1, 1), cB + hstep + kstep, voffB);
        PG8_WAIT_V(6); PG8_BAR;
    }
    for (;;) {
        const bool has_next = S.next(ui + 1, nxt);
        const char* nA = has_next ? (const char*)g.A + (size_t)nxt.pm * tstep : cA; const char* nB = has_next ? (const char*)g.Bt + (size_t)nxt.pb * tstep : cB;
        if constexpr (Sched::KRANGE) { if (has_next) { nA += (size_t)nxt.kt0 * kstep; nB += (size_t)nxt.kt0 * kstep; } }
        for (int t = 0; t < nt; t += 2) {
            const bool last = (t == nt - 2);
            const char* a1 = cA + (size_t)(t + 1) * kstep;
            const char* a2 = last ? nA : cA + (size_t)(t + 2) * kstep; const char* b2 = last ? nB : cB + (size_t)(t + 2) * kstep;
            const char* a3 = a2 + kstep; const char* b3 = b2 + kstep;
            if (last && has_next) S.a_ready(nxt);
            if constexpr (SP2) {
            PG8_LDB(B0, 0, 0); PG8_LDB(B1, 0, 1); PG8_SCHED; PG8_LDA(At, 0, 0); PG8_STAGE(PG8_SA(1, 1), a1 + hstep, voffA);
            PG8_WAIT_V(8); PG8_WAIT_L(0); PG8_BAR; PG8_MMA(0, 0, At, B0); PG8_MMA(0, 1, At, B1); PG8_BAR; PG8_SCHED;
            PG8_LDA(At, 0, 1); PG8_STAGE(PG8_SB(0, 0), b2, voffB); PG8_STAGE(PG8_SB(0, 1), b2 + hstep, voffB); PG8_STAGE(PG8_SA(0, 0), a2, voffA);
            PG8_WAIT_V(8); PG8_WAIT_L(0); PG8_BAR; PG8_MMA(1, 0, At, B0); PG8_MMA(1, 1, At, B1); PG8_BAR; PG8_SCHED;
            PG8_LDB(B0, 1, 0); PG8_LDB(B1, 1, 1); PG8_SCHED; PG8_LDA(At, 1, 0); PG8_STAGE(PG8_SA(0, 1), a2 + hstep, voffA);
            PG8_WAIT_V(8); PG8_WAIT_L(0); PG8_BAR; PG8_MMA(0, 0, At, B0); PG8_MMA(0, 1, At, B1); PG8_BAR; PG8_SCHED;
            PG8_LDA(At, 1, 1); PG8_STAGE(PG8_SB(1, 0), b3, voffB); PG8_STAGE(PG8_SB(1, 1), b3 + hstep, voffB); PG8_STAGE(PG8_SA(1, 0), a3, voffA);
            PG8_WAIT_V(8); PG8_WAIT_L(0); PG8_BAR; PG8_MMA(1, 0, At, B0); PG8_MMA(1, 1, At, B1); PG8_BAR; PG8_SCHED;
            } else {
            PG8_LDB(B0, 0, 0); PG8_SCHED; PG8_LDA(At, 0, 0); PG8_STAGE(PG8_SA(1, 1), a1 + hstep, voffA);
            PG8_WAIT_L(8); PG8_BAR; PG8_WAIT_L(0); PG8_MMA(0, 0, At, B0); PG8_BAR; PG8_SCHED;
            PG8_LDB(B1, 0, 1); PG8_STAGE(PG8_SB(0, 0), b2, voffB);
            PG8_BAR; PG8_WAIT_L(0); PG8_MMA(0, 1, At, B1); PG8_BAR;
            PG8_LDA(At, 0, 1); PG8_STAGE(PG8_SA(0, 0), a2, voffA);
            PG8_BAR; PG8_WAIT_L(0); PG8_MMA(1, 0, At, B0); PG8_BAR; PG8_SCHED;
            PG8_STAGE(PG8_SB(0, 1), b2 + hstep, voffB);
            PG8_WAIT_V(6); PG8_BAR; PG8_MMA(1, 1, At, B1); PG8_BAR;
            PG8_LDB(B0, 1, 0); PG8_SCHED; PG8_LDA(At, 1, 0); PG8_STAGE(PG8_SA(0, 1), a2 + hstep, voffA);
            PG8_WAIT_L(8); PG8_BAR; PG8_WAIT_L(0); PG8_MMA(0, 0, At, B0); PG8_BAR; PG8_SCHED;
            PG8_LDB(B1, 1, 1); PG8_STAGE(PG8_SB(1, 0), b3, voffB);
            PG8_BAR; PG8_WAIT_L(0); PG8_MMA(0, 1, At, B1); PG8_BAR;
            PG8_LDA(At, 1, 1); PG8_STAGE(PG8_SA(1, 0), a3, voffA);
            PG8_BAR; PG8_WAIT_L(0); PG8_MMA(1, 0, At, B0); PG8_BAR; PG8_SCHED;
            PG8_STAGE(PG8_SB(1, 1), b3 + hstep, voffB);
            PG8_WAIT_V(6); PG8_BAR; PG8_MMA(1, 1, At, B1); PG8_BAR;
            }
        }
        if constexpr (ALIGN_EPI) { if (wr == 0) PG8_BAR; }
        if constexpr (!Epi::AFTER_DRAIN) { E(acc, cur, wr, wc, fr, fq); S.done(cur); }
        if (!has_next) break;
#pragma unroll
        for (int a = 0; a < 2; ++a)
#pragma unroll
            for (int b = 0; b < 2; ++b)
#pragma unroll
                for (int m = 0; m < 4; ++m)
#pragma unroll
                    for (int n = 0; n < 2; ++n) acc[a][b][m][n] = (f32x4){0.f, 0.f, 0.f, 0.f};
        cur = nxt; cA = nA; cB = nB; ++ui;
        if constexpr (Sched::KRANGE) nt = cur.nkt;
        if constexpr (ALIGN_EPI) { if (wr == 1) PG8_BAR; }
    }
    PG8_WAIT_V(0);
    if constexpr (!ALIGN_EPI) { if (wr == 0) PG8_BAR; }
    PG8_BAR;
#undef PG8_SA
#undef PG8_SB
#undef PG8_STAGE
#undef PG8_LDA
#undef PG8_LDB
#undef PG8_MMA
#undef PG8_WAIT_V
#undef PG8_WAIT_L
#undef PG8_BAR
#undef PG8_SCHED
}
}
namespace att {
constexpr int NW = 8, QBLK = 32, KVBLK = 64, QB = NW * QBLK, PITCH = 3072, DV = 128;
constexpr int SHM_V = KVBLK * DV * 2;
constexpr int LDS_V = 0, LDS_K = 2 * SHM_V, LDS_WS = 65536, LDS_BYTES = LDS_WS + NW * 64 * 4;
constexpr float THR = 8.f;
template <int DK> struct Cfg { static constexpr int SHM_K = KVBLK * DK * 2; static constexpr float SCALE = (DK == 128) ? 0.08838834764831845f : 0.125f; };

#define KSWZ(row, colB) ((row) * 256 + ((colB) ^ (((row) & 7) << 4)))
#define KSWZ64(row, ch) ((row) * 128 + ((((ch) ^ (((row) >> 1) & 7))) << 4))
#define SBAR() __builtin_amdgcn_sched_barrier(0)
__device__ __forceinline__ int v_st(int k, int c) { const int kk = (k & ~0xC) | ((k & 4) << 1) | ((k & 8) >> 1); return ((kk >> 3) * 4 + (c >> 5)) * 512 + ((kk & 7) * 32 + (c & 31)) * 2; }
__device__ __forceinline__ int v_rd_base(int lane) { return ((lane & 3) << 3) | (((lane >> 2) & 3) << 6) | (((lane >> 4) & 1) << 5) | (((lane >> 5) & 1) << 8); }
constexpr int v_rd_off(int d0, int ks, int half) { return d0 * 512 + ks * 4096 + half * 2048; }
__device__ __forceinline__ int crow(int r, int hi) { return (r & 3) + 8 * (r >> 2) + 4 * hi; }
__device__ __forceinline__ unsigned cvtpk(float lo, float hi) { unsigned r; asm volatile("v_cvt_pk_bf16_f32 %0, %1, %2" : "=v"(r) : "v"(lo), "v"(hi)); return r; }
__device__ __forceinline__ bf16x8 load8(const bf16* p) { return *reinterpret_cast<const bf16x8*>(p); }
__device__ __forceinline__ void mask_tile(f32x16& p0, f32x16& p1, int dq) {
    const float NEG = -__builtin_inff();
#pragma unroll
    for (int r = 0; r < 16; ++r) {
        const int c = (r & 3) + 8 * (r >> 2);
        if (dq - c < 0) p0[r] = NEG;
        if (dq - c - 32 < 0) p1[r] = NEG;
    }
}
template <int DK>
__device__ __forceinline__ void partialSM(f32x16& p0, f32x16& p1, float& m_reg, float& mn, float& alpha) {
    constexpr float SCALE = Cfg<DK>::SCALE;
    float pmax = p0[0]; for (int r = 1; r < 16; ++r) pmax = fmaxf(pmax, p0[r]); for (int r = 0; r < 16; ++r) pmax = fmaxf(pmax, p1[r]);
    { auto rr = __builtin_amdgcn_permlane32_swap(__float_as_uint(pmax), __float_as_uint(pmax), false, false);
      pmax = fmaxf(__uint_as_float(rr[0]), __uint_as_float(rr[1])); }
    constexpr float C2 = 1.4426950408889634f * SCALE;
    if (__builtin_expect(__all((pmax - m_reg) * SCALE <= THR), 1)) { mn = m_reg; alpha = 1.f; }
    else { mn = fmaxf(m_reg, pmax); alpha = __builtin_amdgcn_exp2f((m_reg - mn) * C2); m_reg = mn; }
    const float mnL = -mn * C2;
    for (int r = 0; r < 16; ++r) p0[r] = fmaf(p0[r], C2, mnL); for (int r = 0; r < 16; ++r) p1[r] = fmaf(p1[r], C2, mnL);
    for (int r = 0; r < 16; ++r) p0[r] = __builtin_amdgcn_exp2f(p0[r]);
}
__device__ __forceinline__ void finishSM(f32x16& p0, f32x16& p1, float alpha, float& l_reg, bf16x8& pa0, bf16x8& pa1, bf16x8& pa2, bf16x8& pa3) {
    for (int r = 0; r < 16; ++r) p1[r] = __builtin_amdgcn_exp2f(p1[r]);
    float ps = 0; for (int r = 0; r < 16; ++r) ps += p0[r]; for (int r = 0; r < 16; ++r) ps += p1[r];
    { auto rr = __builtin_amdgcn_permlane32_swap(__float_as_uint(ps), __float_as_uint(ps), false, false);
      ps = __uint_as_float(rr[0]) + __uint_as_float(rr[1]); }
    l_reg = l_reg * alpha + ps;
#define PK4(P, B_, OUT) do { unsigned a0 = cvtpk(P[B_+0], P[B_+1]), a1 = cvtpk(P[B_+2], P[B_+3]);                          \
        unsigned b0 = cvtpk(P[B_+4], P[B_+5]), b1 = cvtpk(P[B_+6], P[B_+7]);                                             \
        auto r0 = __builtin_amdgcn_permlane32_swap(a0, b0, false, false); auto r1 = __builtin_amdgcn_permlane32_swap(a1, b1, false, false); \
        u32x4 w = {r0[0], r1[0], r0[1], r1[1]}; OUT = *reinterpret_cast<bf16x8*>(&w); } while (0)
    PK4(p0, 0, pa0); PK4(p0, 8, pa1); PK4(p1, 0, pa2); PK4(p1, 8, pa3);
#undef PK4
}
__device__ __forceinline__ bf16x8 bias_frag(u32x2 kb, int hi) { u32x4 w = {hi ? 0u : kb.x, hi ? 0u : kb.y, 0u, 0u}; return *reinterpret_cast<bf16x8*>(&w); }
template <int KB, int DK, bool BIAS>
__device__ __forceinline__ void qkt(f32x16& p0, f32x16& p1, const char* K_lds, int r32, int hi, const bf16x8* qr, u32x2 kb0, u32x2 kb1) {
    constexpr int SHM_K = Cfg<DK>::SHM_K;
    p0 = f32x16{}; p1 = f32x16{};
    if constexpr (DK == 128) {
        const char* kb[4];
#pragma unroll
        for (int dd = 0; dd < 4; ++dd) kb[dd] = K_lds + KB * SHM_K + KSWZ(r32, (dd * 16 + hi * 8) * 2);
#pragma unroll
        for (int d0 = 0; d0 < 8; ++d0) { const char* a = kb[d0 & 3] + (d0 >> 2) * 128;
            bf16x8 b0 = *reinterpret_cast<const bf16x8*>(a);
            bf16x8 b1 = *reinterpret_cast<const bf16x8*>(a + 32 * 256);
            p0 = __builtin_amdgcn_mfma_f32_32x32x16_bf16(b0, qr[d0], p0, 0, 0, 0);
            p1 = __builtin_amdgcn_mfma_f32_32x32x16_bf16(b1, qr[d0], p1, 0, 0, 0); }
    } else {
#pragma unroll
        for (int d0 = 0; d0 < 4; ++d0) { const char* a = K_lds + KB * SHM_K + KSWZ64(r32, 2 * d0 + hi);
            bf16x8 b0 = *reinterpret_cast<const bf16x8*>(a);
            bf16x8 b1 = *reinterpret_cast<const bf16x8*>(a + 32 * 128);
            p0 = __builtin_amdgcn_mfma_f32_32x32x16_bf16(b0, qr[d0], p0, 0, 0, 0);
            p1 = __builtin_amdgcn_mfma_f32_32x32x16_bf16(b1, qr[d0], p1, 0, 0, 0); }
    }
    if constexpr (BIAS) {
        u32x4 ow = {hi ? 0u : 0x3f803f80u, hi ? 0u : 0x00003f80u, 0u, 0u}; const bf16x8 qone = *reinterpret_cast<bf16x8*>(&ow);
        p0 = __builtin_amdgcn_mfma_f32_32x32x16_bf16(bias_frag(kb0, hi), qone, p0, 0, 0, 0);
        p1 = __builtin_amdgcn_mfma_f32_32x32x16_bf16(bias_frag(kb1, hi), qone, p1, 0, 0, 0);
    }
}
template <int VB>
__device__ __forceinline__ void pv_tile(f32x16* o, int vb0, bf16x8 pa0, bf16x8 pa1, bf16x8 pa2, bf16x8 pa3) {
#define TRRD(dst, off) asm volatile("ds_read_b64_tr_b16 %0, %1 offset:%2" : "=&v"(dst) : "v"(vb0), "i"(off) : "memory")
#define PV_D0(d0) do { s16x4 l0, l1, l2, l3, h0, h1, h2, h3; constexpr int b_ = VB * SHM_V + v_rd_off(d0, 0, 0); \
        TRRD(l0, b_); TRRD(h0, b_ + 2048); TRRD(l1, b_ + 4096); TRRD(h1, b_ + 6144); TRRD(l2, b_ + 8192); TRRD(h2, b_ + 10240); TRRD(l3, b_ + 12288); TRRD(h3, b_ + 14336); \
        asm volatile("s_waitcnt lgkmcnt(0)" ::: "memory"); SBAR();   \
        o[d0] = __builtin_amdgcn_mfma_f32_32x32x16_bf16(pa0, (bf16x8){l0[0], l0[1], l0[2], l0[3], h0[0], h0[1], h0[2], h0[3]}, o[d0], 0, 0, 0);   \
        o[d0] = __builtin_amdgcn_mfma_f32_32x32x16_bf16(pa1, (bf16x8){l1[0], l1[1], l1[2], l1[3], h1[0], h1[1], h1[2], h1[3]}, o[d0], 0, 0, 0);   \
        o[d0] = __builtin_amdgcn_mfma_f32_32x32x16_bf16(pa2, (bf16x8){l2[0], l2[1], l2[2], l2[3], h2[0], h2[1], h2[2], h2[3]}, o[d0], 0, 0, 0);   \
        o[d0] = __builtin_amdgcn_mfma_f32_32x32x16_bf16(pa3, (bf16x8){l3[0], l3[1], l3[2], l3[3], h3[0], h3[1], h3[2], h3[3]}, o[d0], 0, 0, 0); } while (0)
    PV_D0(0); PV_D0(1); PV_D0(2); PV_D0(3);
#undef PV_D0
#undef TRRD
}

struct BlockRef { const bf16* Q; const bf16* K; const bf16* V; const u32x2* KB; int P0, JLO; };
template <int DK> struct Seam { bf16x8 qr[DK / 16]; bf16x8 st_v0, st_v1, st_k0, st_k1; u32x2 kbn0, kbn1; };
#define AROW(p, k0, rr) ((p) + (size_t)((k0) + (rr)) * PITCH + sc)
#define VMW() asm volatile("s_waitcnt vmcnt(0)" ::: "memory")
#define VMWN(n) asm volatile("s_waitcnt vmcnt(%0)" :: "i"(n) : "memory")
#define SLOAD_H(R_, k0) do { S.st_v0 = load8(AROW((R_).V, k0, sr)); S.st_v1 = load8(AROW((R_).V, k0, 32 + sr));                                   \
        if constexpr (DK == 128) { S.st_k0 = load8(AROW((R_).K, k0, sr)); S.st_k1 = load8(AROW((R_).K, k0, 32 + sr)); }                            \
        else { S.st_k0 = load8((R_).K + (size_t)((k0) + (tid >> 3)) * PITCH + (tid & 7) * 8); }                                                    \
        if constexpr (BIAS) { S.kbn0 = (R_).KB[(k0) + r32]; S.kbn1 = (R_).KB[(k0) + 32 + r32]; } } while (0)
#define SWRITE_HK(bf) do { if constexpr (DK == 128) { *(bf16x8*)(K_lds + (bf) * SHM_K + kws) = S.st_k0; *(bf16x8*)(K_lds + (bf) * SHM_K + kws + 32 * 256) = S.st_k1; } \
        else { *(bf16x8*)(K_lds + (bf) * SHM_K + kws) = S.st_k0; } } while (0)
#define SWRITE_HV(bf) do { *(bf16x8*)(V_lds + (bf) * SHM_V + vst0) = S.st_v0; *(bf16x8*)(V_lds + (bf) * SHM_V + vst1) = S.st_v1; } while (0)
#define SWRITE_H(bf) do { SWRITE_HV(bf); SWRITE_HK(bf); } while (0)
template <int DK, bool BIAS>
__device__ __forceinline__ void causal_prime(const BlockRef& cur, char* lds, Seam<DK>& S, int tid) {
    constexpr int SHM_K = Cfg<DK>::SHM_K;
    const int wid = __builtin_amdgcn_readfirstlane(tid >> 6), lane = tid & 63, r32 = lane & 31, hi = lane >> 5;
    const int sr = tid >> 4, sc = (tid & 15) * 8; const int kws = (DK == 128) ? KSWZ(sr, sc * 2) : KSWZ64(tid >> 3, tid & 7); char* K_lds = lds + LDS_K;
#pragma unroll
    for (int d0 = 0; d0 < DK / 16; ++d0) S.qr[d0] = load8(cur.Q + (size_t)(wid * QBLK + r32) * PITCH + d0 * 16 + hi * 8);
    SLOAD_H(cur, cur.JLO * KVBLK); VMW(); SWRITE_HK(0);
    __syncthreads();
}
template <int DK, bool BIAS, int OUT>
__device__ __forceinline__ void causal_block(const BlockRef& cur, const BlockRef& nxt, char* lds, Seam<DK>& S, void* Oblk, int opitch, int tid) {
    constexpr int SHM_K = Cfg<DK>::SHM_K;
    const int wid = __builtin_amdgcn_readfirstlane(tid >> 6), lane = tid & 63, r32 = lane & 31, hi = lane >> 5;
    const int NT = (cur.P0 + QB) / KVBLK - cur.JLO;
    const int qlo = cur.P0 + wid * QBLK, qm = qlo + r32 - 4 * hi;
    char* V_lds = lds + LDS_V; char* K_lds = lds + LDS_K;
    float* ws = (float*)(lds + LDS_WS) + wid * 64; float* li_l = ws, * al_l = ws + 32;
    float m_reg = -1e30f, l_reg = 0; f32x16 o[4] = {};
    const int sr = tid >> 4, sc = (tid & 15) * 8, vst0 = v_st(sr, sc), vst1 = v_st(32 + sr, sc);
    const int kws = (DK == 128) ? KSWZ(sr, sc * 2) : KSWZ64(tid >> 3, tid & 7);
    const int vb0 = (int)(uintptr_t)V_lds + v_rd_base(lane);
#define RESC(a) do { if (__any((a) < 1.f)) { if (hi == 0) al_l[r32] = (a); asm volatile("s_waitcnt lgkmcnt(0)" ::: "memory");              \
                     for (int d_ = 0; d_ < 4; ++d_) for (int r = 0; r < 16; ++r) o[d_][r] *= al_l[crow(r, hi)]; } } while (0)
#define KBASE(t) ((cur.JLO + (t)) * KVBLK)
#define MASKT(P0_, P1_, t) do { const int kb_ = KBASE(t); if (kb_ + KVBLK - 1 > qlo) mask_tile(P0_, P1_, qm - kb_); } while (0)
    constexpr int NQL = DK / 16;
#define SEAM_K0() do { VMWN(NQL); SWRITE_HK(0); SBAR(); } while (0)
    f32x16 pA0, pA1, pB0, pB1; float mnA, mnB, alA, alB; bf16x8 pa0, pa1, pa2, pa3;
    SWRITE_HV(0); SBAR();
    qkt<0, DK, BIAS>(pA0, pA1, K_lds, r32, hi, S.qr, S.kbn0, S.kbn1); SBAR();
    if (NT > 1) { SLOAD_H(cur, KBASE(1)); }
    SBAR();
    MASKT(pA0, pA1, 0); partialSM<DK>(pA0, pA1, m_reg, mnA, alA);
    if (NT > 1) { VMW(); SWRITE_H(1); }
    __syncthreads();
#define HALF_STEP(PX0, PX1, mnX, alX, PY0, PY1, alY, t, KB, VB, SB) do {                                                      \
        SBAR(); qkt<KB, DK, BIAS>(PX0, PX1, K_lds, r32, hi, S.qr, S.kbn0, S.kbn1);                                            \
        finishSM(PY0, PY1, alY, l_reg, pa0, pa1, pa2, pa3); SBAR();                                                           \
        if ((t) + 1 < NT) { SLOAD_H(cur, KBASE((t) + 1)); SBAR(); }                                                           \
        pv_tile<VB>(o, vb0, pa0, pa1, pa2, pa3); MASKT(PX0, PX1, (t)); partialSM<DK>(PX0, PX1, m_reg, mnX, alX);              \
        __syncthreads();                                                                                                      \
        if ((t) + 1 < NT) { VMW(); SWRITE_H(SB); }                                                                            \
        RESC(alX); __syncthreads(); } while (0)
    for (int t = 1; t + 1 < NT; t += 2) {
        HALF_STEP(pB0, pB1, mnB, alB, pA0, pA1, alA, t, 1, 0, 0);
        HALF_STEP(pA0, pA1, mnA, alA, pB0, pB1, alB, t + 1, 0, 1, 1);
    }
    const bool even = (NT & 1) == 0;
    if (even) { SBAR(); qkt<1, DK, BIAS>(pB0, pB1, K_lds, r32, hi, S.qr, S.kbn0, S.kbn1); SBAR(); }
    SLOAD_H(nxt, nxt.JLO * KVBLK); SBAR();
#pragma unroll
    for (int d0 = 0; d0 < DK / 16; ++d0) S.qr[d0] = load8(nxt.Q + (size_t)(wid * QBLK + r32) * PITCH + d0 * 16 + hi * 8);
    SBAR();
    finishSM(pA0, pA1, alA, l_reg, pa0, pa1, pa2, pa3); SBAR();
    pv_tile<0>(o, vb0, pa0, pa1, pa2, pa3);
    if (even) { MASKT(pB0, pB1, NT - 1); partialSM<DK>(pB0, pB1, m_reg, mnB, alB); __syncthreads(); RESC(alB);
        finishSM(pB0, pB1, alB, l_reg, pa0, pa1, pa2, pa3); SBAR(); pv_tile<1>(o, vb0, pa0, pa1, pa2, pa3); }
    SBAR(); SEAM_K0();
    if (hi == 0) li_l[r32] = l_reg; asm volatile("s_waitcnt lgkmcnt(0)" ::: "memory");
    float rli[16];
#pragma unroll
    for (int r = 0; r < 16; ++r) rli[r] = __builtin_amdgcn_rcpf(li_l[crow(r, hi)]);
#pragma unroll
    for (int r = 0; r < 16; ++r) { const int orow = wid * QBLK + crow(r, hi);
#pragma unroll
        for (int d0 = 0; d0 < 4; ++d0) { const float v = o[d0][r] * rli[r];
            if constexpr (OUT == 1) { ((float*)Oblk)[(size_t)orow * opitch + d0 * 32 + r32] = v; }
            else { const float vn = __shfl_xor(v, 1);
                   if ((r32 & 1) == 0) *(unsigned*)((bf16*)Oblk + (size_t)orow * opitch + d0 * 32 + r32) = cvtpk(v, vn); } } }
    __syncthreads();
#undef RESC
#undef KBASE
#undef MASKT
#undef SEAM_K0
#undef HALF_STEP
}
#undef AROW
#undef VMW
#undef VMWN
#undef SLOAD_H
#undef SWRITE_HK
#undef SWRITE_HV
#undef SWRITE_H
}
constexpr int T = 16384, DM = 1024, SEQ = 8192, NWAVES = 8, NTHR = 512, GRID = 256;
constexpr float EPS = 1e-6f;
constexpr int ZP = 3072;
constexpr int FF = 2816, FFE = 3584, NEXP = 8;
constexpr int XP_ROWS = 34816;
constexpr size_t MiB = 1u << 20, KiB = 1024;
constexpr size_t WS_CTL = 0, CTL_ZERO_BYTES = 65536;
constexpr size_t WS_SLOT = 1 * MiB, SLOT = 256 * KiB;
constexpr size_t WS_ROPE = WS_SLOT + 0 * SLOT;
constexpr size_t WS_LI = WS_SLOT + 2 * SLOT;
constexpr size_t WS_LF = WS_SLOT + 3 * SLOT;
constexpr size_t WS_LFX = WS_SLOT + 4 * SLOT;
constexpr size_t WS_KB = WS_SLOT + 14 * SLOT;
constexpr size_t WS_RTE = WS_SLOT + 6 * SLOT;
constexpr size_t WS_RTW = WS_SLOT + 7 * SLOT;
constexpr size_t WS_PPOS = WS_SLOT + 8 * SLOT;
constexpr size_t WS_RW = WS_SLOT + 9 * SLOT;
constexpr size_t WS_MISC = WS_SLOT + 10 * SLOT;
constexpr size_t WS_NH = WS_SLOT + 11 * SLOT;
constexpr size_t WS_NP = WS_SLOT + 12 * SLOT;
constexpr size_t WS_SGW = WS_SLOT + 13 * SLOT;
constexpr size_t WS_NORM2 = 5 * MiB;
constexpr size_t MISC_CNT = 0, MISC_MG = 8192, MISC_BL = 10240, MISC_MP = 12288, MISC_LAM = 14336, MISC_TS = 14400;
constexpr size_t WS_W_EIN = 8 * MiB, WS_W_EOUT = 14 * MiB, WS_W_FGU = 16 * MiB, WS_W_FDN = 27 * MiB, WS_W_OIN = 33 * MiB, WS_W_OOUT = 39 * MiB, WS_W_MGU = 41 * MiB, WS_W_MDN = 153 * MiB;
constexpr size_t WS_XR = 210 * MiB;
constexpr size_t WS_XN = 274 * MiB;
constexpr size_t WS_CAT = 306 * MiB;
constexpr size_t WS_ARENA = 338 * MiB;
constexpr size_t WS_CH = 576 * MiB;
constexpr size_t WS_CP = 608 * MiB;
constexpr size_t WS_DO = 576 * MiB;
constexpr size_t WS_XP = 640 * MiB;
constexpr size_t WS_Y = 708 * MiB;
constexpr size_t WS_END = 844 * MiB;
static_assert(WS_W_MDN + (size_t)NEXP * DM * FFE * 2 <= WS_XR && WS_ARENA + (size_t)XP_ROWS * FFE * 2 <= WS_CH && WS_XP + (size_t)XP_ROWS * DM * 2 <= WS_Y && WS_Y + (size_t)XP_ROWS * DM * 4 <= WS_END, "ws map");
constexpr int CW_BAR = 4096, CW_QUEUE = 8192;
constexpr int LDS_BYTES = 155648, LDSCTL_OFF = 151552;
constexpr int TS_ = 136;
constexpr int TILE_B = 128 * TS_ * 2;

#define XB_TMO      128
#define XB_XCNT(j)  (256  + 64 * (j))
#define XB_XSUB(j)  (1280 + 64 * (j))
#define XB_XGEN(j)  (2304 + 64 * (j))
#define XB_TOP      3328
#define XB_TOPGEN   3392
#define XCD_BAR_WORDS 3456
#define XB_SPIN_CAP (1u << 18)
__device__ __forceinline__ unsigned xb_ld(unsigned* p)              { return __hip_atomic_load(p, __ATOMIC_RELAXED, __HIP_MEMORY_SCOPE_AGENT); }
__device__ __forceinline__ unsigned xb_add(unsigned* p, unsigned v) { return __hip_atomic_fetch_add(p, v, __ATOMIC_RELAXED, __HIP_MEMORY_SCOPE_AGENT); }
__device__ __forceinline__ unsigned xb_xcc_id() { return (unsigned)__builtin_amdgcn_s_getreg((3 << 11) | 20) & 0xFu; }
#define XB_SPIN(cond, bar) do { unsigned _sp = 0; while (cond) { __builtin_amdgcn_s_sleep(1); \
    if ((++_sp & 255u) == 0u) { if (xb_ld(&(bar)[XB_TMO])) break; if (_sp > XB_SPIN_CAP) { atomicAdd(&(bar)[XB_TMO], 1u); break; } } } } while (0)
struct XcdBarrier { unsigned* bar; unsigned x; volatile LAS unsigned* st; };
__device__ __forceinline__ XcdBarrier xcd_barrier_post(unsigned* bar, volatile LAS unsigned* st) {
    XcdBarrier b; b.bar = bar; b.x = xb_xcc_id(); b.st = st;
    if (threadIdx.x == 0) (void)xb_add(&bar[XB_XCNT(b.x)], 1u);
    return b;
}
__device__ __forceinline__ void xcd_barrier_complete(unsigned* bar, unsigned x, unsigned& nloc, unsigned& nx) {
    const unsigned G = gridDim.x * gridDim.y * gridDim.z;
    unsigned sum, cnt, mine, sp = 0u;
    for (;;) {
        sum = 0u; cnt = 0u; mine = 0u;
#pragma unroll
        for (unsigned j = 0; j < 16; ++j) { const unsigned c = xb_ld(&bar[XB_XCNT(j)]); sum += c; cnt += (c > 0u) ? 1u : 0u; mine = (j == x) ? c : mine; }
        if (sum == G) break;
        __builtin_amdgcn_s_sleep(1);
        if ((++sp & 255u) == 0u) { if (xb_ld(&bar[XB_TMO])) break; if (sp > XB_SPIN_CAP) { atomicAdd(&bar[XB_TMO], 1u); break; } }
    }
    nloc = mine > 0u ? mine : 1u; nx = cnt > 0u ? cnt : 1u;
}
__device__ __forceinline__ void xcd_barrier(const XcdBarrier& b) {
    asm volatile("s_waitcnt vmcnt(0)" ::: "memory");
    __syncthreads();
    if (threadIdx.x == 0) {
        unsigned* bar = b.bar;
        __builtin_amdgcn_s_waitcnt(0);
        unsigned nloc = b.st[0], nx = b.st[1];
        if (nloc == 0u) { xcd_barrier_complete(bar, b.x, nloc, nx); b.st[0] = nloc; b.st[1] = nx; }
        const unsigned old = xb_add(&bar[XB_XSUB(b.x)], 1u);
        const unsigned gen = old / nloc;
        if (old + 1u == (gen + 1u) * nloc) {
            __builtin_amdgcn_fence(__ATOMIC_RELEASE, "agent");
            asm volatile("s_waitcnt vmcnt(0)" ::: "memory");
            const unsigned og = xb_add(&bar[XB_TOP], 1u);
            const unsigned tg = og / nx;
            if (og + 1u == (tg + 1u) * nx) xb_add(&bar[XB_TOPGEN], 1u);
            else XB_SPIN(xb_ld(&bar[XB_TOPGEN]) == tg, bar);
            __builtin_amdgcn_fence(__ATOMIC_ACQUIRE, "agent");
            xb_add(&bar[XB_XGEN(b.x)], 1u);
            asm volatile("s_waitcnt vmcnt(0)" ::: "memory");
        } else {
            XB_SPIN(xb_ld(&bar[XB_XGEN(b.x)]) == gen, bar);
            __builtin_amdgcn_fence(__ATOMIC_ACQUIRE, "agent");
            asm volatile("s_waitcnt vmcnt(0)" ::: "memory");
        }
    }
    __syncthreads();
}

struct Args { const float* in[25]; float* out; unsigned char* ws; int ph_lo, ph_hi; };
#define KARGS const __attribute__((address_space(4))) Args
__device__ __forceinline__ const float* ain(KARGS& a, int k) { return (const float*)(const GAS float*)a.in[k]; }
struct Ctx { LAS unsigned char* lds; unsigned char* ws; int tid, lane, wave, bid; };

struct ConvItem { const float* src; bf16* dst; int ldw, K; };
__device__ __forceinline__ int src_col(int type, int n0, int ffh) {
    const int pn = n0 >> 8, j = n0 & 255;
    const int t3 = j < 128 ? 128 * pn + j : ffh + 128 * pn + (j - 128);
    return type == 1 ? (n0 < 2048 ? n0 : n0 + 8) : (type == 2 ? (n0 < 1536 ? n0 : n0 + 4) : (type == 3 ? t3 : n0));
}
__device__ __forceinline__ ConvItem conv_decode(KARGS& a, unsigned char* ws, int it) {
    constexpr int I_EIN = 16 * 96, I_EOUT = 16 * 32, I_FGU = 16 * 176, I_FDN = 44 * 32, I_OIN = 16 * 96, I_OOUT = 16 * 32, I_MGU = 16 * 224, I_MDN = 56 * 32;
    constexpr int C1 = I_EIN, C2 = C1 + I_EOUT, C3 = C2 + I_FGU, C4 = C3 + I_FDN, C5 = C4 + I_OIN, C6 = C5 + I_OOUT, C7 = C6 + NEXP * I_MGU;
    const int kind = (it >= C1) + (it >= C2) + (it >= C3) + (it >= C4) + (it >= C5) + (it >= C6) + (it >= C7);
#define SEL8(v0, v1, v2, v3, v4, v5, v6, v7) (kind == 0 ? (v0) : kind == 1 ? (v1) : kind == 2 ? (v2) : kind == 3 ? (v3) : kind == 4 ? (v4) : kind == 5 ? (v5) : kind == 6 ? (v6) : (v7))
    const int base = SEL8(0, C1, C2, C3, C4, C5, C6, C7), per = SEL8(I_EIN, I_EOUT, I_FGU, I_FDN, I_OIN, I_OOUT, I_MGU, I_MDN);
    int r = it - base; const int e = r / per; r -= e * per;
    const int ldw = SEL8(3080, 1024, 2 * FF, 1024, 3076, 1024, 2 * FFE, 1024), K = SEL8(1024, 1024, 1024, FF, 1024, 1024, 1024, FFE), N = SEL8(3072, 1024, 2 * FF, 1024, 3072, 1024, 2 * FFE, 1024);
    const int type = SEL8(1, 0, 3, 0, 2, 0, 3, 0), ffh = SEL8(0, 0, FF, 0, 0, 0, FFE, 0);
    const float* W = SEL8(ain(a, 2), ain(a, 10), ain(a, 12), ain(a, 13), ain(a, 15), ain(a, 19), ain(a, 22), ain(a, 23));
    const size_t wso = SEL8(WS_W_EIN, WS_W_EOUT, WS_W_FGU, WS_W_FDN, WS_W_OIN, WS_W_OOUT, WS_W_MGU, WS_W_MDN);
#undef SEL8
    const int nblk = N / 32, kb = r / nblk, nb = r - kb * nblk, k0 = 64 * kb, n0 = 32 * nb;
    ConvItem c; c.ldw = ldw; c.K = K;
    c.src = W + (size_t)e * K * ldw + (size_t)k0 * ldw + src_col(type, n0, ffh);
    c.dst = (bf16*)(ws + wso) + (size_t)e * N * K + (size_t)n0 * K + k0;
    return c;
}
__device__ __forceinline__ void conv_load(const ConvItem& c, int lane, f32x4 (&v)[8]) {
    const int kl = lane >> 3, n4 = (lane & 7) * 4;
#pragma unroll
    for (int i = 0; i < 8; ++i) v[i] = __builtin_nontemporal_load((const f32x4*)(c.src + (size_t)(kl + 8 * i) * c.ldw + n4));
}
__device__ __forceinline__ void conv_finish(const ConvItem& c, int lane, const f32x4 (&v)[8], LAS float* scr) {
    const int kl = lane >> 3, n4 = (lane & 7) * 4;
#pragma unroll
    for (int i = 0; i < 8; ++i) { LAS float* d = scr + (kl + 8 * i) * 33 + n4; d[0] = v[i].x; d[1] = v[i].y; d[2] = v[i].z; d[3] = v[i].w; }
    LDS_WAIT(); asm volatile("" ::: "memory");
    const int cc = lane & 7;
#pragma unroll
    for (int j = 0; j < 4; ++j) { const int n = (lane >> 3) + 8 * j; const LAS float* s = scr + (8 * cc) * 33 + n;
        u32x4 o; o.x = pk2(s[0 * 33], s[1 * 33]); o.y = pk2(s[2 * 33], s[3 * 33]); o.z = pk2(s[4 * 33], s[5 * 33]); o.w = pk2(s[6 * 33], s[7 * 33]);
        *(u32x4*)(c.dst + (size_t)n * c.K + 8 * cc) = o; }
    LDS_WAIT(); asm volatile("" ::: "memory");
}
constexpr int CONV_FGU_END = 16 * 96 + 16 * 32 + 16 * 176, CONV_DENSE_ITEMS = 16 * 96 + 16 * 32 + 16 * 176 + 44 * 32 + 16 * 96 + 16 * 32, CONV_MGU_END = CONV_DENSE_ITEMS + NEXP * 16 * 224, CONV_ALL_ITEMS = CONV_MGU_END + NEXP * 56 * 32;
template <int LO, int HI, bool REV>
__device__ __forceinline__ void prologue_weights(KARGS& a, const Ctx& c) {
    LAS float* scr = (LAS float*)(c.lds + c.wave * 16384);
    const int gw = c.bid * NWAVES + c.wave, NGW = GRID * NWAVES;
    constexpr int NITEMS = HI - LO;
#define CONV_IT(i) (REV ? HI - 1 - (i) : LO + (i))
    int it = gw; if (it >= NITEMS) return;
    f32x4 va[8], vb[8]; ConvItem d0 = conv_decode(a, c.ws, CONV_IT(it)), d1 = d0; conv_load(d0, c.lane, va);
    for (;;) {
        const int it1 = it + NGW; const bool has1 = it1 < NITEMS;
        if (has1) { d1 = conv_decode(a, c.ws, CONV_IT(it1)); conv_load(d1, c.lane, vb); }
        conv_finish(d0, c.lane, va, scr);
        if (!has1) break;
        it = it1 + NGW; const bool has0 = it < NITEMS;
        if (has0) { d0 = conv_decode(a, c.ws, CONV_IT(it)); conv_load(d0, c.lane, va); }
        conv_finish(d1, c.lane, vb, scr);
        if (!has0) break;
    }
#undef CONV_IT
}
template <int LO, int HI, bool REV>
__device__ __forceinline__ void conv_dynamic(KARGS& a, const Ctx& c, unsigned* q) {
    LAS float* scr = (LAS float*)(c.lds + c.wave * 16384);
    LAS int* slot = (LAS int*)(c.lds + 131072);
    constexpr int NCH = (HI - LO) / 16; static_assert((HI - LO) % 16 == 0, "chunks");
#define CONV_IT(i) (REV ? HI - 1 - (i) : LO + (i))
    if (c.tid == 0) slot[0] = (int)__hip_atomic_fetch_add(q, 1u, RLX_AGENT);
    __syncthreads();
    int ch = slot[0];
    while (ch < NCH) {
        __syncthreads();
        if (c.tid == 0) slot[0] = (int)__hip_atomic_fetch_add(q, 1u, RLX_AGENT);
        const int i0 = ch * 16 + c.wave * 2;
        f32x4 va[8], vb[8]; const ConvItem d0 = conv_decode(a, c.ws, CONV_IT(i0)), d1 = conv_decode(a, c.ws, CONV_IT(i0 + 1));
        conv_load(d0, c.lane, va); conv_load(d1, c.lane, vb);
        conv_finish(d0, c.lane, va, scr); conv_finish(d1, c.lane, vb, scr);
        __syncthreads();
        ch = slot[0];
    }
#undef CONV_IT
}
__device__ __forceinline__ void prologue_tables(KARGS& a, const Ctx& c) {
    const int gt = c.bid * NTHR + c.tid, NGT = GRID * NTHR;
    bf16* sgw = (bf16*)(c.ws + WS_SGW); const float* w = ain(a, 8);
    for (int i = gt; i < 4 * 128 * 128; i += NGT) { const int tt = (i >> 7) & 127, ss = i & 127; sgw[i] = (bf16)(ss <= tt ? f2bf(w[i]) : 0u); }
    if (c.bid == 0 && c.wave == 0) { const float* l = ain(a, 17); const float p0 = wave_sum(l[c.lane] * l[64 + c.lane]), p1 = wave_sum(l[128 + c.lane] * l[192 + c.lane]);
        const float lambda_init = 0.8f - 0.6f * expf(-0.3f);
        if (c.lane == 0) *(float*)(c.ws + WS_MISC + MISC_LAM) = expf(p0) - expf(p1) + lambda_init; }
}

template <int NC> __device__ __forceinline__ void stage_wxt(const Ctx& c, const float* W, int ldw, int col0) {
    LAS float* wxt = (LAS float*)c.lds;
    for (int i = c.tid; i < NC * 1024; i += NTHR) { const int cc = i >> 10, k = i & 1023; wxt[i] = W[(size_t)k * ldw + col0 + cc]; }
    __syncthreads();
}
template <int MODE> __device__ __forceinline__ void row_phase(KARGS& a, const Ctx& c, const float* xin, const float* gain) {
    constexpr int NC = (MODE == 0 || MODE == 3) ? 8 : (MODE == 2 ? 4 : 0);
    unsigned char* ws = c.ws;
    LAS float* wxt = (LAS float*)c.lds; LAS int* lcnt = (LAS int*)(c.lds + 32768);
    if (MODE == 0) stage_wxt<8>(c, ain(a, 2), 3080, 2048);
    if (MODE == 2) stage_wxt<4>(c, ain(a, 15), 3076, 1536);
    if (MODE == 3) { if (c.tid < 8) lcnt[c.tid] = 0; stage_wxt<8>(c, ain(a, 21), 8, 0); }
    f32x4 g[4];
#pragma unroll
    for (int j = 0; j < 4; ++j) g[j] = *((const f32x4*)gain + c.lane + 64 * j);
    bf16* XN = (bf16*)(ws + WS_XN);
    int skSL = 2;
    if (MODE == 4) skSL = pg8::hyb_SL(__builtin_amdgcn_readfirstlane(ldi((const int*)(ws + WS_MISC + MISC_TS) + 8)) * 4 - 512);
#define ROW_INDEX(r) ((MODE == 4) ? (r) * (GRID * NWAVES) + c.bid * NWAVES + c.wave : 64 * c.bid + c.wave * 8 + (r))
#define ROW_LOAD(r, V, Y0, Y1, P0, P1) do { const int m_ = ROW_INDEX(r); const f32x4* xr_ = (const f32x4*)(xin + (size_t)m_ * DM) + c.lane; \
        _Pragma("unroll") for (int j = 0; j < 4; ++j) V[j] = xr_[64 * j]; \
        if (MODE == 4) { P0 = ldi((const int*)(ws + WS_PPOS) + 2 * m_); P1 = ldi((const int*)(ws + WS_PPOS) + 2 * m_ + 1); \
            const u32x2* y0_ = (const u32x2*)((const bf16*)(ws + WS_Y) + (size_t)P0 * DM) + c.lane; const u32x2* y1_ = (const u32x2*)((const bf16*)(ws + WS_Y) + (size_t)P1 * DM) + c.lane; \
            _Pragma("unroll") for (int j = 0; j < 4; ++j) { Y0[j] = y0_[64 * j]; Y1[j] = y1_[64 * j]; } } } while (0)
    f32x4 vn[4]; u32x2 yn0[4], yn1[4]; int pn0 = 0, pn1 = 0;
    ROW_LOAD(0, vn, yn0, yn1, pn0, pn1);
#pragma unroll
    for (int r = 0; r < 8; ++r) {
        const int m = ROW_INDEX(r);
        f32x4 v[4]; const int p0 = pn0, p1 = pn1;
#pragma unroll
        for (int j = 0; j < 4; ++j) { v[j] = vn[j]; if (MODE == 4) { v[j].x += bflo(yn0[j].x) + bflo(yn1[j].x); v[j].y += bfhi(yn0[j].x) + bfhi(yn1[j].x); v[j].z += bflo(yn0[j].y) + bflo(yn1[j].y); v[j].w += bfhi(yn0[j].y) + bfhi(yn1[j].y); } }
        if (r + 1 < 8) ROW_LOAD(r + 1, vn, yn0, yn1, pn0, pn1);
        if (MODE == 4) {
            const float* slab = (const float*)(ws + WS_XP);
            if (p0 >= 32768 || p1 >= 32768) {
#pragma unroll 1
                for (int q = 0; q < 2; ++q) { const int p = q ? p1 : p0; if (p < 32768) continue;
#pragma unroll
                    for (int j = 0; j < 4; ++j) { const float* sp = slab + ((size_t)(((p >> 8) * 4 + j - 512) * (skSL - 1)) * 256 + (p & 255)) * 256;
#pragma unroll 4
                        for (int s2 = 0; s2 < skSL - 1; ++s2) v[j] = v[j] + *((const f32x4*)(sp + (size_t)s2 * 65536) + c.lane); } } } }
        float s = 0.f;
#pragma unroll
        for (int j = 0; j < 4; ++j) s += (v[j].x * v[j].x + v[j].y * v[j].y) + (v[j].z * v[j].z + v[j].w * v[j].w);
#pragma unroll
        for (int j = 0; j < 4; ++j) v[j] = v[j] * g[j];
        float z[NC > 0 ? NC : 1];
        if constexpr (NC > 0) {
#pragma unroll
            for (int cc = 0; cc < NC; ++cc) { float pp = 0.f;
#pragma unroll
                for (int j = 0; j < 4; ++j) { const f32x4 w = *((const LAS f32x4*)(wxt + cc * 1024) + c.lane + 64 * j); pp += (v[j].x * w.x + v[j].y * w.y) + (v[j].z * w.z + v[j].w * w.w); }
                z[cc] = pp; }
#pragma unroll
            for (int cc = 0; cc < NC; ++cc) z[cc] = wave_sum(z[cc]);
        }
        const float rstd = 1.0f / sqrtf(wave_sum(s) * (1.0f / DM) + EPS);
#pragma unroll
        for (int j = 0; j < 4; ++j) v[j] = v[j] * rstd;
        if (MODE == 4) { f32x4* o = (f32x4*)((float*)(GAS float*)a.out + (size_t)m * DM) + c.lane;
#pragma unroll
            for (int j = 0; j < 4; ++j) o[64 * j] = v[j]; }
        else { u32x2* o = (u32x2*)(XN + (size_t)m * DM) + c.lane;
#pragma unroll
            for (int j = 0; j < 4; ++j) { u32x2 w; w.x = pk2(v[j].x, v[j].y); w.y = pk2(v[j].z, v[j].w); o[64 * j] = w; } }
        if constexpr (NC > 0) {
#pragma unroll
            for (int cc = 0; cc < NC; ++cc) z[cc] *= rstd;
            if (MODE == 0) { if (c.lane < 8) { float zz = z[0];
#pragma unroll
                    for (int cc = 1; cc < 8; ++cc) zz = (c.lane == cc) ? z[cc] : zz;
                    const float gb = ain(a, 5)[c.lane];
                    if (c.lane < 4) ((float*)(ws + WS_LI))[m * 4 + c.lane] = zz + gb; else ((float*)(ws + WS_LF))[m * 4 + c.lane - 4] = log_sigmoid_acc(zz + gb); } }
            if (MODE == 2) {
                if (c.lane < 4) { float zz = z[0];
#pragma unroll
                    for (int cc = 1; cc < 4; ++cc) zz = (c.lane == cc) ? z[cc] : zz;
                    ((float*)(ws + WS_LFX))[m * 4 + c.lane] = log_sigmoid_acc(zz + ain(a, 16)[c.lane]); } }
            if (MODE == 3) { if (c.lane == 0) {
                    int e1 = 0; float v1 = z[0];
#pragma unroll
                    for (int cc = 1; cc < 8; ++cc) if (z[cc] > v1) { v1 = z[cc]; e1 = cc; }
                    int e2 = -1; float v2 = -__builtin_inff();
#pragma unroll
                    for (int cc = 0; cc < 8; ++cc) if (cc != e1 && z[cc] > v2) { v2 = z[cc]; e2 = cc; }
                    const float w2 = 1.0f / (1.0f + expf(v1 - v2)), w1 = 1.0f - w2;
                    ((int*)(ws + WS_RTE))[2 * m] = e1; ((int*)(ws + WS_RTE))[2 * m + 1] = e2;
                    ((float*)(ws + WS_RTW))[2 * m] = w1; ((float*)(ws + WS_RTW))[2 * m + 1] = w2;
                    __hip_atomic_fetch_add(&lcnt[e1], 1, __ATOMIC_RELAXED, __HIP_MEMORY_SCOPE_WORKGROUP); __hip_atomic_fetch_add(&lcnt[e2], 1, __ATOMIC_RELAXED, __HIP_MEMORY_SCOPE_WORKGROUP); } }
        }
    }
#undef ROW_LOAD
#undef ROW_INDEX
    if (MODE == 3) { __syncthreads(); if (c.tid < 8) ((int*)(ws + WS_MISC + MISC_CNT))[c.bid * 8 + c.tid] = lcnt[c.tid]; }
    __syncthreads();
}

__device__ __forceinline__ int crow_(int r, int hi) { return (r & 3) + 8 * (r >> 2) + 4 * hi; }
__device__ __forceinline__ void wg_mma128(f32x16 (&acc)[2], const LAS bf16* A, const LAS bf16* Bt, int wave, int lane) {
    const int r32 = lane & 31, hi = lane >> 5, mblk = (wave >> 1) * 32, nblk = (wave & 1) * 64;
    const LAS bf16* ap = A + (mblk + r32) * TS_ + hi * 8; const LAS bf16* bp0 = Bt + (nblk + r32) * TS_ + hi * 8; const LAS bf16* bp1 = bp0 + 32 * TS_;
#pragma unroll
    for (int ks = 0; ks < 8; ++ks) {
        const bf16x8 av = *(const LAS bf16x8*)(ap + ks * 16), b0 = *(const LAS bf16x8*)(bp0 + ks * 16), b1 = *(const LAS bf16x8*)(bp1 + ks * 16);
        acc[0] = __builtin_amdgcn_mfma_f32_32x32x16_bf16(av, b0, acc[0], 0, 0, 0);
        acc[1] = __builtin_amdgcn_mfma_f32_32x32x16_bf16(av, b1, acc[1], 0, 0, 0);
    }
}
__device__ __forceinline__ void unpack8(const u32x4 w, float (&f)[8]) { f[0] = bflo(w.x); f[1] = bfhi(w.x); f[2] = bflo(w.y); f[3] = bfhi(w.y); f[4] = bflo(w.z); f[5] = bfhi(w.z); f[6] = bflo(w.w); f[7] = bfhi(w.w); }
__device__ __forceinline__ void stage_raw(const Ctx& c, const bf16* Z, int tok0, bool first, int col0, LAS bf16* raw) {
    for (int i = c.tid; i < 131 * 16; i += NTHR) { const int r = i >> 4, ch = i & 15;
        u32x4 v = {0u, 0u, 0u, 0u}; if (!(first && r < 3)) v = *(const u32x4*)(Z + (size_t)(tok0 - 3 + r) * ZP + col0 + ch * 8);
        *(LAS u32x4*)(raw + r * TS_ + ch * 8) = v; }
}
template <bool TRANSPOSE> __device__ __forceinline__ void conv_tile(const Ctx& c, const LAS bf16* raw, const float* cw  , const float* cb, float scale, LAS bf16* tile) {
    float w0[4][8], b0[8];
    if (!TRANSPOSE) { const int d0 = (c.tid & 15) * 8;
#pragma unroll
        for (int j = 0; j < 4; ++j)
#pragma unroll
            for (int i = 0; i < 8; ++i) w0[j][i] = cw[j * 1024 + d0 + i];
#pragma unroll
        for (int i = 0; i < 8; ++i) b0[i] = cb[d0 + i]; }
#pragma unroll 4
    for (int it = 0; it < 4; ++it) {
        const int ch = TRANSPOSE ? (c.tid >> 7) * 4 + it : (c.tid & 15), s = TRANSPOSE ? (c.tid & 127) : (c.tid >> 4) + 32 * it, d0 = ch * 8;
        float acc[8];
#pragma unroll
        for (int i = 0; i < 8; ++i) acc[i] = TRANSPOSE ? cb[d0 + i] : b0[i];
#pragma unroll
        for (int j = 0; j < 4; ++j) { float x[8]; unpack8(*(const LAS u32x4*)(raw + (s + j) * TS_ + d0), x);
#pragma unroll
            for (int i = 0; i < 8; ++i) acc[i] += (TRANSPOSE ? cw[j * 1024 + d0 + i] : w0[j][i]) * x[i]; }
#pragma unroll
        for (int i = 0; i < 8; ++i) acc[i] = siluf_(acc[i]) * scale;
        if (TRANSPOSE) {
#pragma unroll
            for (int i = 0; i < 8; ++i) tile[(d0 + i) * TS_ + s] = (bf16)f2bf(acc[i]);
        } else { u32x4 o; o.x = pk2(acc[0], acc[1]); o.y = pk2(acc[2], acc[3]); o.z = pk2(acc[4], acc[5]); o.w = pk2(acc[6], acc[7]); *(LAS u32x4*)(tile + s * TS_ + d0) = o; }
    }
}
struct RawRegs { u32x4 v[5]; };
__device__ __forceinline__ void raw_load(const Ctx& c, const bf16* Z, int tok0, bool first, int col0, RawRegs& R) {
#pragma unroll
    for (int n = 0; n < 5; ++n) { const int i = c.tid + NTHR * n, r = i >> 4, ch = i & 15; R.v[n] = (u32x4){0u, 0u, 0u, 0u};
        if (i < 131 * 16 && !(first && r < 3)) R.v[n] = *(const u32x4*)(Z + (size_t)(tok0 - 3 + r) * ZP + col0 + ch * 8); }
}
__device__ __forceinline__ void raw_store(const Ctx& c, const RawRegs& R, LAS bf16* raw) {
#pragma unroll
    for (int n = 0; n < 5; ++n) { const int i = c.tid + NTHR * n, r = i >> 4, ch = i & 15; if (i < 131 * 16) *(LAS u32x4*)(raw + r * TS_ + ch * 8) = R.v[n]; }
}
struct TRegs { u32x4 v[4]; };
__device__ __forceinline__ void tr_load(const Ctx& c, const bf16* src, TRegs& R) {
    const int s = c.tid & 127, chq = c.tid >> 7;
#pragma unroll
    for (int it = 0; it < 4; ++it) R.v[it] = *(const u32x4*)(src + (size_t)s * ZP + (chq * 4 + it) * 8);
}
template <class F> __device__ __forceinline__ void tr_store(const Ctx& c, const TRegs& R, LAS bf16* tile, const F& f) {
    const int s = c.tid & 127, chq = c.tid >> 7;
#pragma unroll
    for (int it = 0; it < 4; ++it) { const int e0 = (chq * 4 + it) * 8; float x[8]; unpack8(R.v[it], x);
#pragma unroll
        for (int i = 0; i < 8; ++i) tile[(e0 + i) * TS_ + s] = (bf16)f2bf(f(x[i], s, e0 + i)); }
}
struct CRegs { u32x4 v[4]; };
__device__ __forceinline__ void rows_load(const Ctx& c, const bf16* src  , CRegs& R) {
#pragma unroll
    for (int n = 0; n < 4; ++n) { const int i = c.tid + NTHR * n; R.v[n] = *(const u32x4*)(src + (i >> 4) * 128 + (i & 15) * 8); }
}
__device__ __forceinline__ void rows_store(const Ctx& c, const CRegs& R, LAS bf16* tile) {
#pragma unroll
    for (int n = 0; n < 4; ++n) { const int i = c.tid + NTHR * n; *(LAS u32x4*)(tile + (i >> 4) * TS_ + (i & 15) * 8) = R.v[n]; }
}
template <class F> __device__ __forceinline__ void stage_transposed(const Ctx& c, const bf16* src, LAS bf16* tile, const F& f) {
    const int s = c.tid & 127, chq = c.tid >> 7;
#pragma unroll
    for (int it = 0; it < 4; ++it) { const int e0 = (chq * 4 + it) * 8; float x[8]; unpack8(*(const u32x4*)(src + (size_t)s * ZP + e0), x);
#pragma unroll
        for (int i = 0; i < 8; ++i) tile[(e0 + i) * TS_ + s] = (bf16)f2bf(f(x[i], s, e0 + i)); }
}
constexpr int L_T0 = 0, L_T1 = TILE_B, L_T2 = 2 * TILE_B, L_T3 = 3 * TILE_B, L_TAB = 4 * TILE_B + 2048;
static_assert(L_TAB + 4096 <= LDSCTL_OFF, "LDS map");

__device__ __forceinline__ void ml_state_unit(KARGS& a, const Ctx& c0, int bhc) {
    Ctx c = c0; { int t_ = c0.wave * 64 + (int)__builtin_amdgcn_mbcnt_hi(~0u, __builtin_amdgcn_mbcnt_lo(~0u, 0u)); asm volatile("" : "+v"(t_)); c.tid = t_; c.lane = t_ & 63; c.wave = __builtin_amdgcn_readfirstlane(t_ >> 6); }
    unsigned char* ws = c.ws;
    const int bh = bhc >> 6, ck = bhc & 63, b = bh >> 2, h = bh & 3, tok0 = b * SEQ + ck * 128;
    const bf16* Z = (const bf16*)(ws + WS_ARENA);
    LAS bf16* KT = (LAS bf16*)(c.lds + L_T0); LAS bf16* VT = (LAS bf16*)(c.lds + L_T1); LAS bf16* RAW = (LAS bf16*)(c.lds + L_T2);
    LAS float* wt = (LAS float*)(c.lds + L_TAB);
    RawRegs rk; TRegs rv;
    raw_load(c, Z, tok0, ck == 0, 512 + h * 128, rk); tr_load(c, Z + (size_t)tok0 * ZP + 1024 + h * 128, rv);
    if (c.wave == 0) {
        const float* LF = (const float*)(ws + WS_LF); const float* LI = (const float*)(ws + WS_LI);
        const int s0 = 2 * c.lane;
        const float lf0 = ldf(LF + (size_t)(tok0 + s0) * 4 + h), lf1 = ldf(LF + (size_t)(tok0 + s0 + 1) * 4 + h);
        const float li0 = ldf(LI + (size_t)(tok0 + s0) * 4 + h), li1 = ldf(LI + (size_t)(tok0 + s0 + 1) * 4 + h);
        float sc = lf0 + lf1;
#pragma unroll
        for (int o = 1; o < 64; o <<= 1) { const float t = shfl_up_l(sc, o, c.lane); if (c.lane >= o) sc += t; }
        const float b1 = sc, b0 = sc - lf1, blast = shfl_idx_l(sc, 63);
        const float g0 = blast - b0 + li0, g1 = blast - b1 + li1;
        float mg = fmaxf(g0, g1);
#pragma unroll
        for (int o = 1; o < 64; o <<= 1) mg = fmaxf(mg, shfl_xor_l(mg, o, c.lane));
        wt[s0] = fast_exp(g0 - mg); wt[s0 + 1] = fast_exp(g1 - mg);
        if (c.lane == 0) { ((float*)(ws + WS_MISC + MISC_MG))[bhc] = mg; ((float*)(ws + WS_MISC + MISC_BL))[bhc] = blast; }
    }
    raw_store(c, rk, RAW);
    __syncthreads();
    conv_tile<true>(c, RAW, ain(a, 3) + 512 + h * 128, ain(a, 4) + 512 + h * 128, 1.0f, KT);
    tr_store(c, rv, VT, [&](float x, int s, int) { return x * wt[s]; });
    __syncthreads();
    f32x16 acc[2] = {};
    wg_mma128(acc, VT, KT, c.wave, c.lane);
    { const int r32 = c.lane & 31, hi = c.lane >> 5, mblk = (c.wave >> 1) * 32, nblk = (c.wave & 1) * 64; float* CH = (float*)(ws + WS_CH) + (size_t)bhc * 16384;
#pragma unroll
      for (int j = 0; j < 2; ++j)
#pragma unroll
        for (int i = 0; i < 16; ++i) CH[(mblk + crow_(i, hi)) * 128 + nblk + 32 * j + r32] = acc[j][i]; }
    { const int d = c.tid >> 2, part = c.tid & 3; float s = 0.f;
#pragma unroll
      for (int k = 0; k < 4; ++k) { float x[8]; unpack8(*(const LAS u32x4*)(KT + d * TS_ + part * 32 + 8 * k), x);
#pragma unroll
        for (int i = 0; i < 8; ++i) s += wt[part * 32 + 8 * k + i] * x[i]; }
      s = quad_sum(s);
      if (part == 0) ((float*)(ws + WS_NH))[(size_t)bhc * 128 + d] = s; }
    __syncthreads();
}
__device__ __forceinline__ void sg_unit(KARGS& a, const Ctx& c0, int idx) {
    Ctx c = c0; { int t_ = c0.wave * 64 + (int)__builtin_amdgcn_mbcnt_hi(~0u, __builtin_amdgcn_mbcnt_lo(~0u, 0u)); asm volatile("" : "+v"(t_)); c.tid = t_; c.lane = t_ & 63; c.wave = __builtin_amdgcn_readfirstlane(t_ >> 6); }
    unsigned char* ws = c.ws;
    const int bn = idx >> 2, g = idx & 3, tok0 = (bn >> 6) * SEQ + (bn & 63) * 128;
    const bf16* Z = (const bf16*)(ws + WS_ARENA);
    LAS bf16* WG = (LAS bf16*)(c.lds + L_T0); LAS bf16* VN = (LAS bf16*)(c.lds + L_T1); LAS float* rs = (LAS float*)(c.lds + L_TAB);
    const int r32 = c.lane & 31, hi = c.lane >> 5, mblk = (c.wave >> 1) * 32, nblk = (c.wave & 1) * 64, ch = c.tid & 15, c0e = ch * 8, chq = c.tid >> 7;
    TRegs rv; CRegs rw; u32x4 xv[16], uv[4]; f32x4 gv[4][2], bv[4];
    tr_load(c, Z + (size_t)tok0 * ZP + 2560 + g * 128, rv); rows_load(c, (const bf16*)(ws + WS_SGW) + (size_t)g * 16384, rw);
    { const bf16* p = Z + (size_t)(tok0 + (c.tid >> 2)) * ZP + 2560 + (c.tid & 3) * 128;
#pragma unroll
      for (int k = 0; k < 16; ++k) xv[k] = *(const u32x4*)(p + 8 * k); }
#pragma unroll
    for (int it = 0; it < 4; ++it) { uv[it] = *(const u32x4*)(Z + (size_t)(tok0 + (c.tid >> 4) + 32 * it) * ZP + 2048 + g * 128 + c0e);
        const float* gp = ain(a, 7) + g * 128 + (chq * 4 + it) * 8; gv[it][0] = *(const f32x4*)gp; gv[it][1] = *(const f32x4*)(gp + 4);
        bv[it] = *(const f32x4*)(ain(a, 9) + g * 128 + mblk + 8 * it + 4 * hi); }
    { const int s = c.tid >> 2, part = c.tid & 3; float ss = 0.f;
#pragma unroll
      for (int k = 0; k < 16; ++k) { float x[8]; unpack8(xv[k], x);
#pragma unroll
        for (int i = 0; i < 8; ++i) ss += x[i] * x[i]; }
      ss = quad_sum(ss);
      if (part == 0) rs[s] = 1.0f / sqrtf(ss * (1.0f / 512.0f) + EPS); }
    rows_store(c, rw, WG);
    __syncthreads();
    { const int s = c.tid & 127; const float r = rs[s];
#pragma unroll
      for (int it = 0; it < 4; ++it) { const int e0 = (chq * 4 + it) * 8; float x[8]; unpack8(rv.v[it], x);
#pragma unroll
        for (int i = 0; i < 8; ++i) VN[(e0 + i) * TS_ + s] = (bf16)f2bf(x[i] * r * gv[it][i >> 2][i & 3]); } }
    __syncthreads();
    f32x16 acc[2] = {};
    wg_mma128(acc, WG, VN, c.wave, c.lane);
    __syncthreads();
    LAS float* HT = (LAS float*)(c.lds + L_T0);
#pragma unroll
    for (int i = 0; i < 16; ++i) { const int t = mblk + crow_(i, hi); const float bs = bv[i >> 2][i & 3];
        HT[t * 132 + nblk + r32] = acc[0][i] + bs; HT[t * 132 + nblk + 32 + r32] = acc[1][i] + bs; }
    __syncthreads();
    { bf16* CAT = (bf16*)(ws + WS_CAT);
#pragma unroll
      for (int it = 0; it < 4; ++it) { const int t = (c.tid >> 4) + 32 * it; float u[8]; unpack8(uv[it], u);
          const f32x4 x0 = *(const LAS f32x4*)(HT + t * 132 + c0e), x1 = *(const LAS f32x4*)(HT + t * 132 + c0e + 4);
          u32x4 o; o.x = pk2(u[0] * x0.x, u[1] * x0.y); o.y = pk2(u[2] * x0.z, u[3] * x0.w);
          o.z = pk2(u[4] * x1.x, u[5] * x1.y); o.w = pk2(u[6] * x1.z, u[7] * x1.w);
          *(u32x4*)(CAT + (size_t)(tok0 + t) * DM + 512 + g * 128 + c0e) = o; } }
    __syncthreads();
}
__device__ __forceinline__ void ml_scan_phase(const Ctx& c) {
    unsigned char* ws = c.ws;
    const int gid = c.bid * NTHR + c.tid, bh = gid >> 14, idx = gid & 16383;
    LAS float* sdec = (LAS float*)c.lds; LAS float* ssc = sdec + 64; LAS float* smp = ssc + 64;
    if (c.wave == 0) {
        const float bl = ldf((const float*)(ws + WS_MISC + MISC_BL) + bh * 64 + c.lane), mg = ldf((const float*)(ws + WS_MISC + MISC_MG) + bh * 64 + c.lane);
        float m = 0.f, mprev = 0.f, mnew = 0.f;
        for (int k = 0; k < 64; ++k) { const float blk = __shfl(bl, k), mgk = __shfl(mg, k); const float mn = fmaxf(blk + m, mgk);
            if (c.lane == k) { mprev = m; mnew = mn; } m = mn; }
        smp[c.lane] = mprev; sdec[c.lane] = fast_exp(bl + mprev - mnew); ssc[c.lane] = fast_exp(mg - mnew);
    }
    __syncthreads();
    const float* CH = (const float*)(ws + WS_CH) + (size_t)bh * 64 * 16384 + idx; bf16* CP = (bf16*)(ws + WS_CP) + (size_t)bh * 64 * 16384 + idx;
    float C = 0.f;
#pragma unroll 1
    for (int k0 = 0; k0 < 64; k0 += 32) { float chv[32];
#pragma unroll
        for (int k = 0; k < 32; ++k) chv[k] = CH[(size_t)(k0 + k) * 16384];
#pragma unroll
        for (int k = 0; k < 32; ++k) { CP[(size_t)(k0 + k) * 16384] = (bf16)f2bf(C); C = sdec[k0 + k] * C + ssc[k0 + k] * chv[k]; } }
    if (idx < 128) { const float* NH = (const float*)(ws + WS_NH) + (size_t)bh * 64 * 128 + idx; float* NP = (float*)(ws + WS_NP) + (size_t)bh * 64 * 128 + idx; float n = 0.f;
#pragma unroll 8
        for (int k = 0; k < 64; ++k) { const float nh = NH[k * 128]; NP[k * 128] = n; n = sdec[k] * n + ssc[k] * nh; } }
    if (idx < 64) ((float*)(ws + WS_MISC + MISC_MP))[bh * 64 + idx] = smp[idx];
    __syncthreads();
}
template <int SKIP = 0> __device__ __forceinline__ void ml_out_unit(KARGS& a, const Ctx& c0, int bhc) {
    Ctx c = c0; { int t_ = c0.wave * 64 + (int)__builtin_amdgcn_mbcnt_hi(~0u, __builtin_amdgcn_mbcnt_lo(~0u, 0u)); asm volatile("" : "+v"(t_)); c.tid = t_; c.lane = t_ & 63; c.wave = __builtin_amdgcn_readfirstlane(t_ >> 6); }
    unsigned char* ws = c.ws;
    const int bh = bhc >> 6, ck = bhc & 63, b = bh >> 2, h = bh & 3, tok0 = b * SEQ + ck * 128;
    const bf16* Z = (const bf16*)(ws + WS_ARENA);
    LAS bf16* QT = (LAS bf16*)(c.lds + L_T0); LAS bf16* KT = (LAS bf16*)(c.lds + L_T1); LAS bf16* VT = (LAS bf16*)(c.lds + L_T2); LAS bf16* CT = (LAS bf16*)(c.lds + L_T3);
    LAS bf16* SW = KT; LAS bf16* RAW = (LAS bf16*)(c.lds + L_T3 + 1024); LAS bf16* RAWK = VT;
    RawRegs rq, rk; TRegs rv; CRegs rc;
    raw_load(c, Z, tok0, ck == 0, h * 128, rq); raw_load(c, Z, tok0, ck == 0, 512 + h * 128, rk);
    tr_load(c, Z + (size_t)tok0 * ZP + 1024 + h * 128, rv); rows_load(c, (const bf16*)(ws + WS_CP) + (size_t)bhc * 16384, rc);
    LAS float* t_a = (LAS float*)(c.lds + L_TAB); LAS float* t_mu = t_a + 128; LAS float* t_wi = t_a + 256; LAS float* t_emr = t_a + 384; LAS float* t_rden = t_a + 512; LAS float* t_np = t_a + 640; LAS float* t_ssq = t_a + 768;
    if (c.wave == 0) {
        const float* LF = (const float*)(ws + WS_LF); const float* LI = (const float*)(ws + WS_LI);
        const int s0 = 2 * c.lane;
        const float lf0 = ldf(LF + (size_t)(tok0 + s0) * 4 + h), lf1 = ldf(LF + (size_t)(tok0 + s0 + 1) * 4 + h);
        const float li0 = ldf(LI + (size_t)(tok0 + s0) * 4 + h), li1 = ldf(LI + (size_t)(tok0 + s0 + 1) * 4 + h);
        float sc = lf0 + lf1;
#pragma unroll
        for (int o = 1; o < 64; o <<= 1) { const float t = shfl_up_l(sc, o, c.lane); if (c.lane >= o) sc += t; }
        const float b1 = sc, b0 = sc - lf1;
        const float a0 = li0 - b0, a1 = li1 - b1;
        float pm = fmaxf(a0, a1);
#pragma unroll
        for (int o = 1; o < 64; o <<= 1) { const float t = shfl_up_l(pm, o, c.lane); if (c.lane >= o) pm = fmaxf(pm, t); }
        float pprev = shfl_up_l(pm, 1, c.lane); if (c.lane == 0) pprev = -__builtin_inff();
        const float pm0 = fmaxf(pprev, a0), pm1 = pm;
        const float mprev = ldf((const float*)(ws + WS_MISC + MISC_MP) + bhc);
        const float mu0 = fmaxf(mprev, pm0), mu1 = fmaxf(mprev, pm1);
        t_a[s0] = a0; t_a[s0 + 1] = a1; t_mu[s0] = mu0; t_mu[s0 + 1] = mu1;
        t_wi[s0] = fast_exp(mprev - mu0); t_wi[s0 + 1] = fast_exp(mprev - mu1);
        t_emr[s0] = fast_exp(-b0 - mu0); t_emr[s0 + 1] = fast_exp(-b1 - mu1);
    }
    if (c.wave == 1) { const float* NP = (const float*)(ws + WS_NP) + (size_t)bhc * 128; t_np[c.lane] = ldf(NP + c.lane); t_np[64 + c.lane] = ldf(NP + 64 + c.lane); }
    raw_store(c, rq, RAW); raw_store(c, rk, RAWK);
    __syncthreads();
    if (!(SKIP & 1)) { conv_tile<false>(c, RAW, ain(a, 3) + h * 128, ain(a, 4) + h * 128, 0.08838834764831845f, QT);
    conv_tile<false>(c, RAWK, ain(a, 3) + 512 + h * 128, ain(a, 4) + 512 + h * 128, 1.0f, KT); }
    __syncthreads();
    if (!(SKIP & 2)) tr_store(c, rv, VT, [](float x, int, int) { return x; });
    rows_store(c, rc, CT);
    __syncthreads();
    const int r32 = c.lane & 31, hi = c.lane >> 5, mblk = (c.wave >> 1) * 32, nblk = (c.wave & 1) * 64;
    f32x16 sa[2] = {};
    if (!(SKIP & 4)) wg_mma128(sa, QT, KT, c.wave, c.lane);
    __syncthreads();
    { const float as0 = t_a[nblk + r32], as1 = t_a[nblk + 32 + r32];
#pragma unroll
      for (int i = 0; i < 16; ++i) { const int t = mblk + crow_(i, hi); const float mu = t_mu[t];
          const int s0 = nblk + r32, s1 = s0 + 32;
          const float w0 = (s0 <= t) ? fast_exp(as0 - mu) : 0.f, w1 = (s1 <= t) ? fast_exp(as1 - mu) : 0.f;
          SW[t * TS_ + s0] = (bf16)f2bf(sa[0][i] * w0); SW[t * TS_ + s1] = (bf16)f2bf(sa[1][i] * w1); } }
    __syncthreads();
    f32x16 n1[2] = {}, n2[2] = {};
    if (!(SKIP & 4)) { wg_mma128(n1, SW, VT, c.wave, c.lane);
    wg_mma128(n2, QT, CT, c.wave, c.lane); }
    { const int t = c.tid >> 2, part = c.tid & 3; float ds = 0.f, dq = 0.f;
#pragma unroll
      for (int k = 0; k < 4; ++k) { float x[8], q[8]; unpack8(*(const LAS u32x4*)(SW + t * TS_ + part * 32 + 8 * k), x); unpack8(*(const LAS u32x4*)(QT + t * TS_ + part * 32 + 8 * k), q);
#pragma unroll
        for (int i = 0; i < 8; ++i) { ds += x[i]; dq += q[i] * t_np[part * 32 + 8 * k + i]; } }
      ds = quad_sum(ds); dq = quad_sum(dq);
      if (part == 0) { const float den = ds + t_wi[t] * dq; t_rden[t] = 1.0f / fmaxf(fabsf(den), t_emr[t]); } }
    __syncthreads();
    LAS float* HT = (LAS float*)(c.lds + L_T0);
#pragma unroll
    for (int i = 0; i < 16; ++i) { const int t = mblk + crow_(i, hi); const float wi = t_wi[t], rd = t_rden[t];
        HT[t * 132 + nblk + r32] = (n1[0][i] + wi * n2[0][i]) * rd; HT[t * 132 + nblk + 32 + r32] = (n1[1][i] + wi * n2[1][i]) * rd; }
    __syncthreads();
    { const int t = c.tid >> 2, part = c.tid & 3; float q = 0.f;
#pragma unroll
      for (int k = 0; k < 8; ++k) { const f32x4 x = *(const LAS f32x4*)(HT + t * 132 + part * 32 + 4 * k); q += (x.x * x.x + x.y * x.y) + (x.z * x.z + x.w * x.w); }
      q = quad_sum(q);
      if (part == 0) t_ssq[t] = 1.0f / sqrtf(q * (1.0f / 128.0f) + EPS); }
    __syncthreads();
    { int tt = c.tid; asm volatile("" : "+v"(tt));
      bf16* CAT = (bf16*)(ws + WS_CAT); const int ch = tt & 15, e0 = ch * 8; float gn[8];
#pragma unroll
      for (int i = 0; i < 8; ++i) gn[i] = ain(a, 6)[h * 128 + e0 + i];
#pragma unroll
      for (int it = 0; it < 4; ++it) { const int t = (tt >> 4) + 32 * it; float og[8]; unpack8(*(const u32x4*)(Z + (size_t)(tok0 + t) * ZP + 1536 + h * 128 + e0), og);
          const float rstd = t_ssq[t]; const f32x4 x0 = *(const LAS f32x4*)(HT + t * 132 + e0), x1 = *(const LAS f32x4*)(HT + t * 132 + e0 + 4);
          u32x4 o; o.x = pk2(x0.x * rstd * gn[0] * og[0], x0.y * rstd * gn[1] * og[1]); o.y = pk2(x0.z * rstd * gn[2] * og[2], x0.w * rstd * gn[3] * og[3]);
          o.z = pk2(x1.x * rstd * gn[4] * og[4], x1.y * rstd * gn[5] * og[5]); o.w = pk2(x1.z * rstd * gn[6] * og[6], x1.w * rstd * gn[7] * og[7]);
          *(u32x4*)(CAT + (size_t)(tok0 + t) * DM + h * 128 + e0) = o; } }
    __syncthreads();
}

__device__ __forceinline__ void fox_cumsum(const Ctx& c) {
    if (c.bid >= 8) return;
    unsigned char* ws = c.ws; const int bh = c.bid, b = bh >> 2, h = bh & 3;
    const float* LFX = (const float*)(ws + WS_LFX) + (size_t)b * SEQ * 4 + h; u32x2* KB = (u32x2*)(ws + WS_KB) + (size_t)bh * SEQ;
    LAS float* wsum = (LAS float*)c.lds;
    float v[16]; float tot = 0.f;
#pragma unroll
    for (int i = 0; i < 16; ++i) { v[i] = LFX[(size_t)(c.tid * 16 + i) * 4]; tot += v[i]; }
    float sc = tot;
#pragma unroll
    for (int o = 1; o < 64; o <<= 1) { const float t = shfl_up_l(sc, o, c.lane); if (c.lane >= o) sc += t; }
    if (c.lane == 63) wsum[c.wave] = sc;
    __syncthreads();
    float base = 0.f;
    for (int w = 0; w < c.wave; ++w) base += wsum[w];
    float run = base + sc - tot;
#pragma unroll
    for (int i = 0; i < 16; ++i) { run += v[i]; const float x = -run * 11.313708498984761f;
        const unsigned a = f2bf(x); const float r1 = x - bf2f(a); const unsigned b2 = f2bf(r1); const float r2 = r1 - bf2f(b2); const unsigned c2 = f2bf(r2);
        u32x2 w; w.x = a | (b2 << 16); w.y = c2; KB[c.tid * 16 + i] = w; }
}
#ifndef ATT_ONLY
#define ATT_ONLY 0
#endif
template <int ONLY = ATT_ONLY> __device__ __forceinline__ void attn_phase(KARGS& a, const Ctx& c, int qoff) {
    unsigned char* ws = c.ws; char* lds = (char*)c.lds;
    const bf16* Z = (const bf16*)(ws + WS_ARENA);
    LAS int* slot = (LAS int*)(c.lds + att::LDS_BYTES);
    unsigned* q = (unsigned*)(ws + WS_CTL) + CW_QUEUE + qoff;
    if (ONLY != 2) for (;;) {
        if (c.tid == 0) slot[0] = (int)__hip_atomic_fetch_add(q, 1u, RLX_AGENT);
        __syncthreads();
        const int it = slot[0];
        __syncthreads();
        if (it >= 256) break;
        const int qb = 31 - (it >> 3), bh = it & 7, b = bh >> 2, h = bh & 3; const size_t rb = (size_t)b * SEQ;
        att::BlockRef R; R.Q = Z + (rb + (size_t)qb * 256) * ZP + h * 128; R.K = Z + rb * ZP + 512 + h * 128; R.V = Z + rb * ZP + 1024 + h * 128;
        R.KB = (const u32x2*)(ws + WS_KB) + (size_t)bh * SEQ; R.P0 = qb * 256;
        int tl = c.tid; asm volatile("" : "+v"(tl));
        { const int ln = tl & 63, wv = __builtin_amdgcn_readfirstlane(tl >> 6);
          const f32x4* N2 = (const f32x4*)(ws + WS_NORM2) + rb * 8; LAS float* red = (LAS float*)(c.lds + att::LDS_BYTES + 64); LAS int* jl = (LAS int*)(c.lds + att::LDS_BYTES + 32);
          float km = 0.f, qm = 0.f; const int nk = R.P0 + 256;
          for (int s = tl; s < nk; s += NTHR) { const f32x4 pv = N2[(size_t)s * 8 + 4 + h]; km = fmaxf(km, (pv.x + pv.y) + (pv.z + pv.w)); }
          if (tl < 256) { const f32x4 pv = N2[(size_t)(R.P0 + tl) * 8 + h]; qm = (pv.x + pv.y) + (pv.z + pv.w); }
#pragma unroll
          for (int o = 1; o < 64; o <<= 1) { km = fmaxf(km, shfl_xor_l(km, o, ln)); qm = fmaxf(qm, shfl_xor_l(qm, o, ln)); }
          if (ln == 0) { red[wv] = km; red[8 + wv] = qm; }
          if (tl == 0) jl[0] = qb * 4;
          __syncthreads();
          float K2 = 0.f, Q2 = 0.f;
#pragma unroll
          for (int w = 0; w < 8; ++w) { K2 = fmaxf(K2, red[w]); Q2 = fmaxf(Q2, red[8 + w]); }
          const float B2 = 2.0f * 1.02f * sqrtf(K2 * Q2);
          if (tl < qb * 4) { const u32x2 w1 = R.KB[tl * 64 + 63], w0 = R.KB[R.P0];
              const float kb1 = bflo(w1.x) + bfhi(w1.x) + bflo(w1.y), kb0 = bflo(w0.x) + bfhi(w0.x) + bflo(w0.y);
              if (B2 + (kb1 - kb0) >= -30.0f * 11.313708498984761f) __hip_atomic_fetch_min(jl, tl, __ATOMIC_RELAXED, __HIP_MEMORY_SCOPE_WORKGROUP); }
          __syncthreads();
          R.JLO = jl[0];
          __syncthreads(); }
        att::Seam<128> S;
        att::causal_prime<128, true>(R, lds, S, tl);
        att::causal_block<128, true, 0>(R, R, lds, S, (void*)((bf16*)(ws + WS_CAT) + (rb + (size_t)qb * 256) * DM + h * 128), DM, tl);
    }
    if (ONLY != 1) for (;;) {
        if (c.tid == 0) slot[0] = (int)__hip_atomic_fetch_add(q + 64, 1u, RLX_AGENT);
        __syncthreads();
        const int it = slot[0];
        __syncthreads();
        if (it >= 512) break;
        const int qb = 31 - (it >> 4), d = it & 15, bh = d >> 1, mp = d & 1, b = bh >> 2, h = bh & 3; const size_t rb = (size_t)b * SEQ;
        att::BlockRef R; R.Q = Z + (rb + (size_t)qb * 256) * ZP + 1536 + h * 128 + mp * 64; R.K = Z + rb * ZP + 2048 + h * 128 + mp * 64; R.V = Z + rb * ZP + 2560 + h * 128;
        R.KB = nullptr; R.P0 = qb * 256; R.JLO = 0;
        att::Seam<64> S;
        int tl = c.tid; asm volatile("" : "+v"(tl));
        att::causal_prime<64, false>(R, lds, S, tl);
        att::causal_block<64, false, 1>(R, R, lds, S, (void*)((float*)(ws + WS_DO) + (size_t)mp * T * 512 + (rb + (size_t)qb * 256) * 512 + h * 128), 512, tl);
    }
}
__device__ __forceinline__ void diffnorm_phase(KARGS& a, const Ctx& c) {
    unsigned char* ws = c.ws;
    const float lam = ldf((const float*)(ws + WS_MISC + MISC_LAM)); const float post = 1.0f - (0.8f - 0.6f * expf(-0.3f));
    const float* D0 = (const float*)(ws + WS_DO); const float* D1 = D0 + (size_t)T * 512; bf16* CAT = (bf16*)(ws + WS_CAT);
    const int gw = c.bid * NWAVES + c.wave, NGW = GRID * NWAVES;
    const float g0 = ain(a, 18)[2 * c.lane] * post, g1 = ain(a, 18)[2 * c.lane + 1] * post;
    for (int p0 = gw * 8; p0 < T * 4; p0 += NGW * 8) {
        f32x2 x0[8], x1[8];
#pragma unroll
        for (int k = 0; k < 8; ++k) { const size_t o = (size_t)(p0 + k) * 128 + 2 * c.lane; x0[k] = *(const f32x2*)(D0 + o); x1[k] = *(const f32x2*)(D1 + o); }
#pragma unroll
        for (int k = 0; k < 8; ++k) { const int p = p0 + k, t = p >> 2, h = p & 3; const float y0 = x0[k].x - lam * x1[k].x, y1 = x0[k].y - lam * x1[k].y;
            const float rstd = 1.0f / sqrtf(wave_sum(y0 * y0 + y1 * y1) * (1.0f / 128.0f) + EPS);
            *(unsigned*)(CAT + (size_t)t * DM + 512 + h * 128 + 2 * c.lane) = pk2(y0 * rstd * g0, y1 * rstd * g1); } }
}

__device__ __forceinline__ void moe_scatter_phase(const Ctx& c) {
    unsigned char* ws = c.ws;
    LAS int* soff = (LAS int*)c.lds;
    LAS int* sts = soff + 8;
    LAS int* stot = soff + 32;
    LAS int* spos = soff + 64;
    const int* CNT = (const int*)(ws + WS_MISC + MISC_CNT);
    const bf16* XN = (const bf16*)(ws + WS_XN); bf16* XP = (bf16*)(ws + WS_XP);
    u32x4 rowv[8][2];
#pragma unroll
    for (int k = 0; k < 8; ++k) { const u32x4* src = (const u32x4*)(XN + (size_t)(64 * c.bid + c.wave * 8 + k) * DM); rowv[k][0] = src[c.lane]; rowv[k][1] = src[64 + c.lane]; }
    if (c.wave == 0) {
        typedef int i32x4 __attribute__((ext_vector_type(4)));
        i32x4 cv[8];
#pragma unroll
        for (int k = 0; k < 8; ++k) cv[k] = *((const i32x4*)(CNT + (size_t)c.lane * 32) + k);
        int tot[8], before[8];
#pragma unroll
        for (int e = 0; e < 8; ++e) { int s = 0, bf = 0;
#pragma unroll
            for (int k = 0; k < 4; ++k) { const int w = 4 * c.lane + k; const int v = cv[2 * k + (e >> 2)][e & 3]; s += v; if (w < c.bid) bf += v; }
            tot[e] = s; before[e] = bf; }
#pragma unroll
        for (int e = 0; e < 8; ++e) {
#pragma unroll
            for (int o = 1; o < 64; o <<= 1) { tot[e] += __shfl_xor(tot[e], o); before[e] += __shfl_xor(before[e], o); } }
        int ts = 0, so[8];
#pragma unroll
        for (int e = 0; e < 8; ++e) { if (c.lane == 0) { sts[e] = ts; stot[e] = tot[e]; } so[e] = ts * 256 + before[e]; ts += (tot[e] + 255) >> 8; }
        if (c.lane == 0) { sts[8] = ts; if (c.bid == 0) { int acc = 0; for (int e = 0; e < 8; ++e) { ((int*)(ws + WS_MISC + MISC_TS))[e] = acc; acc += (tot[e] + 255) >> 8; } ((int*)(ws + WS_MISC + MISC_TS))[8] = acc; } }
        const int m = 64 * c.bid + c.lane; const int e1 = ((const int*)(ws + WS_RTE))[2 * m], e2 = ((const int*)(ws + WS_RTE))[2 * m + 1];
        int p1 = 0, p2 = 0;
#pragma unroll
        for (int e = 0; e < 8; ++e) { const unsigned long long mask = __ballot(e1 == e || e2 == e); const int rank = __builtin_popcountll(mask & ((1ull << c.lane) - 1ull));
            if (e1 == e) p1 = so[e] + rank; if (e2 == e) p2 = so[e] + rank; }
        spos[2 * c.lane] = p1; spos[2 * c.lane + 1] = p2;
        ((int*)(ws + WS_PPOS))[2 * m] = p1; ((int*)(ws + WS_PPOS))[2 * m + 1] = p2;
        ((float*)(ws + WS_RW))[p1] = ((const float*)(ws + WS_RTW))[2 * m]; ((float*)(ws + WS_RW))[p2] = ((const float*)(ws + WS_RTW))[2 * m + 1];
    }
    __syncthreads();
#pragma unroll
    for (int k = 0; k < 8; ++k) { const int ti = c.wave * 8 + k;
#pragma unroll
        for (int sl = 0; sl < 2; ++sl) { u32x4* dst = (u32x4*)(XP + (size_t)spos[2 * ti + sl] * DM); dst[c.lane] = rowv[k][0]; dst[64 + c.lane] = rowv[k][1]; } }
    { const int gw = c.bid * NWAVES + c.wave;
      for (int e = 0; e < 8; ++e) { const int tot = stot[e], first = sts[e] * 256 + tot, npad = ((tot + 255) & ~255) - tot;
          for (int i = gw; i < npad; i += GRID * NWAVES) { u32x4* dst = (u32x4*)(XP + (size_t)(first + i) * DM); const u32x4 z = {0u, 0u, 0u, 0u}; dst[c.lane] = z; dst[64 + c.lane] = z;
              if (c.lane == 0) ((float*)(ws + WS_RW))[first + i] = 0.f; } } }
    __syncthreads();
}
#ifndef MK_PER_PHASE
#define MK_PER_PHASE 0
#endif
constexpr int NPHASE = 19;
__global__ void __launch_bounds__(NTHR, 2) fwd_kernel(Args args_by_value) {
    (void)args_by_value;
    extern __shared__ __attribute__((aligned(16))) unsigned char lds_raw[];
    KARGS* ap0 = (KARGS*)__builtin_amdgcn_kernarg_segment_ptr();
    Ctx c_; c_.lds = (LAS unsigned char*)lds_raw; c_.ws = (unsigned char*)(GAS unsigned char*)ap0->ws; c_.tid = threadIdx.x; c_.lane = c_.tid & 63; c_.wave = __builtin_amdgcn_readfirstlane(c_.tid >> 6); c_.bid = blockIdx.x;
    unsigned char* const ws0 = c_.ws;
    for (int u = c_.tid; u < (LDS_BYTES - LDSCTL_OFF) / 4; u += NTHR) ((LAS unsigned*)(c_.lds + LDSCTL_OFF))[u] = 0u;
    __syncthreads();
    XcdBarrier bar; bar.bar = (unsigned*)(ws0 + WS_CTL) + CW_BAR; bar.x = 0; bar.st = nullptr;
    if (!MK_PER_PHASE) bar = xcd_barrier_post((unsigned*)(ws0 + WS_CTL) + CW_BAR, (volatile LAS unsigned*)(c_.lds + LDSCTL_OFF));
    const int lo = ap0->ph_lo, hi = ap0->ph_hi; const int wave0 = c_.wave;
#ifndef PHASE_MASK
#define PHASE_MASK 0xFFFFFFFFu
#endif
#define IN(k) (((PHASE_MASK >> (k)) & 1u) && lo <= (k) && (k) < hi)
#define FRESH() Ctx c = c_; { int t_ = wave0 * 64 + (int)__builtin_amdgcn_mbcnt_hi(~0u, __builtin_amdgcn_mbcnt_lo(~0u, 0u)); asm volatile("" : "+v"(t_)); c.tid = t_; c.lane = t_ & 63; c.wave = __builtin_amdgcn_readfirstlane(t_ >> 6); KARGS* ap_ = (KARGS*)__builtin_amdgcn_kernarg_segment_ptr(); asm volatile("" : "+s"(ap_)); GAS unsigned char* w_ = (GAS unsigned char*)ap_->ws; c.ws = (unsigned char*)w_; } \
    KARGS& args = *(KARGS*)__builtin_amdgcn_kernarg_segment_ptr(); \
    unsigned char* const ws = c.ws; bf16* const XN = (bf16*)(ws + WS_XN); bf16* const CAT = (bf16*)(ws + WS_CAT); bf16* const ZA = (bf16*)(ws + WS_ARENA); float* const XR = (float*)(ws + WS_XR); (void)XN; (void)CAT; (void)ZA; (void)XR;
#define SEAM(k) do { if (IN(k) && IN((k) + 1)) xcd_barrier(bar); } while (0)
    PG8_LAS unsigned char* glds = (PG8_LAS unsigned char*)lds_raw;

#define QOFF 0
    if (IN(0)) { FRESH(); prologue_weights<0, CONV_FGU_END, false>(args, c); prologue_tables(args, c); __syncthreads(); row_phase<0>(args, c, ain(args, 0), ain(args, 1)); }
    SEAM(0);
    if (IN(1)) { FRESH(); pg8::Gemm g{XN, (const bf16*)(ws + WS_W_EIN), T, 3072, 1024}; pg8::StaticOrder S; S.init(T, 3072, GRID, c.bid);
        pg8::EpiBf16 E{ZA, ZP, nullptr, 0, 0, nullptr, 6, 8, 12}; pg8::gemm_phase<pg8::EpiBf16, pg8::StaticOrder, true, true>(glds, g, S, E, c.tid); }
    SEAM(1);
    if (IN(2)) { FRESH(); for (int u = c.bid; u < 1024; u += GRID) { if (u < 512) ml_state_unit(args, c, u); else sg_unit(args, c, u - 512); } }
    SEAM(2);
    if (IN(3)) { FRESH(); ml_scan_phase(c); }
    SEAM(3);
    if (IN(4)) { FRESH(); for (int u = c.bid; u < 512; u += GRID) ml_out_unit(args, c, u); }
    SEAM(4);
    if (IN(5)) { FRESH(); pg8::Gemm g{CAT, (const bf16*)(ws + WS_W_EOUT), T, 1024, 1024}; pg8::StaticOrder S; S.init(T, 1024, GRID, c.bid);
        pg8::EpiResF32 E{ain(args, 0), XR, DM}; pg8::gemm_phase<pg8::EpiResF32, pg8::StaticOrder, false, true>(glds, g, S, E, c.tid); }
    SEAM(5);
    if (IN(6)) { FRESH(); row_phase<1>(args, c, XR, ain(args, 11)); }
    SEAM(6);
    if (IN(7)) { FRESH(); pg8::Gemm g{XN, (const bf16*)(ws + WS_W_FGU), T, 2 * FF, 1024}; pg8::StaticOrder S; S.init(T, 2 * FF, GRID, c.bid);
        pg8::EpiSwiglu E{ZA, FF}; pg8::gemm_phase<pg8::EpiSwiglu, pg8::StaticOrder, true, true>(glds, g, S, E, c.tid);
        __syncthreads(); conv_dynamic<CONV_FGU_END, CONV_DENSE_ITEMS, false>(args, c, (unsigned*)(ws + WS_CTL) + CW_QUEUE + 384 + (QOFF ? 64 : 0)); }
    SEAM(7);
    if (IN(8)) { FRESH(); pg8::Gemm g{ZA, (const bf16*)(ws + WS_W_FDN), T, 1024, FF}; pg8::StaticOrder S; S.init(T, 1024, GRID, c.bid);
        pg8::EpiResF32 E{XR, XR, DM}; pg8::gemm_phase<pg8::EpiResF32, pg8::StaticOrder, false, true>(glds, g, S, E, c.tid); }
    SEAM(8);
    if (IN(9)) { FRESH(); row_phase<2>(args, c, XR, ain(args, 14)); }
    SEAM(9);
    if (IN(10)) { FRESH(); fox_cumsum(c); __syncthreads();
        pg8::Gemm g{XN, (const bf16*)(ws + WS_W_OIN), T, 3072, 1024}; pg8::StaticOrder S; S.init(T, 3072, GRID, c.bid);
        pg8::EpiBf16 E{ZA, ZP, (const float*)(ws + WS_ROPE), 6, 10, (float*)(ws + WS_NORM2), 99, 99, 99}; pg8::gemm_phase<pg8::EpiBf16, pg8::StaticOrder, true, true>(glds, g, S, E, c.tid); }
    SEAM(10);
    if (IN(11)) { FRESH(); attn_phase(args, c, QOFF); }
    SEAM(11);
    if (IN(12)) { FRESH(); diffnorm_phase(args, c); }
    SEAM(12);
    if (IN(13)) { FRESH(); pg8::Gemm g{CAT, (const bf16*)(ws + WS_W_OOUT), T, 1024, 1024}; pg8::StaticOrder S; S.init(T, 1024, GRID, c.bid);
        pg8::EpiResF32 E{XR, XR, DM}; pg8::gemm_phase<pg8::EpiResF32, pg8::StaticOrder, false, true>(glds, g, S, E, c.tid); }
    SEAM(13);
    if (IN(14)) { FRESH(); row_phase<3>(args, c, XR, ain(args, 20)); }
    SEAM(14);
    if (IN(15)) { FRESH(); moe_scatter_phase(c); prologue_weights<CONV_DENSE_ITEMS, CONV_MGU_END, true>(args, c); }
    SEAM(15);
    if (IN(16)) { FRESH(); pg8::Gemm g{(const bf16*)(ws + WS_XP), (const bf16*)(ws + WS_W_MGU), 0, 2 * FFE, 1024}; pg8::MoeOrder S;
#pragma unroll
        for (int e = 0; e < 9; ++e) S.ts[e] = __builtin_amdgcn_readfirstlane(ldi((const int*)(ws + WS_MISC + MISC_TS) + e));
        S.nM = S.ts[8]; S.nN = 2 * FFE / 256; S.nwg = S.nM * S.nN; S.G = GRID; S.c = c.bid;
        pg8::EpiSwiglu E{ZA, FFE}; pg8::gemm_phase<pg8::EpiSwiglu, pg8::MoeOrder, true, true>(glds, g, S, E, c.tid);
        __syncthreads(); conv_dynamic<CONV_MGU_END, CONV_ALL_ITEMS, true>(args, c, (unsigned*)(ws + WS_CTL) + CW_QUEUE + 256 + (QOFF ? 64 : 0)); }
    SEAM(16);
    if (IN(17)) { FRESH(); pg8::Gemm g{ZA, (const bf16*)(ws + WS_W_MDN), 0, 1024, FFE}; pg8::HybridOrder S;
#pragma unroll
        for (int e = 0; e < 9; ++e) S.ts[e] = __builtin_amdgcn_readfirstlane(ldi((const int*)(ws + WS_MISC + MISC_TS) + e));
        S.nN = 4; S.NKT = FFE / 64; S.U = S.ts[8] * 4; S.G = GRID; S.c = c.bid;
        pg8::EpiMoeDownSK E{(bf16*)(ws + WS_Y), DM, (const float*)(ws + WS_RW), (float*)(ws + WS_XP), pg8::hyb_SL(S.U - 512)}; pg8::gemm_phase<pg8::EpiMoeDownSK, pg8::HybridOrder, true, true>(glds, g, S, E, c.tid); }
    SEAM(17);
    if (IN(18)) { FRESH(); row_phase<4>(args, c, XR, ain(args, 24)); }
#undef QOFF
#undef IN
#undef SEAM
}

extern "C" void kernel_launch(void* const* d_in, const int* in_sizes, int n_in, void* d_out, int out_size, void* d_ws, size_t ws_size, hipStream_t stream) {
    static int ready = 0;
    if (ready == 0) {
        if (n_in != 25 || in_sizes[0] != T * DM || out_size != T * DM || ws_size < WS_END) {
            fprintf(stderr, "kernel_launch: built for 25 inputs, x/out of %d floats, >= %zu bytes of workspace; got n_in %d in0 %d out %d ws %zu; nothing launched\n", T * DM, (size_t)WS_END, n_in, n_in > 0 ? in_sizes[0] : -1, out_size, ws_size);
            ready = -1; return; }
        if (hipFuncSetAttribute((const void*)fwd_kernel, hipFuncAttributeMaxDynamicSharedMemorySize, LDS_BYTES) != hipSuccess) { fprintf(stderr, "kernel_launch: hipFuncSetAttribute(%d) failed\n", LDS_BYTES); ready = -1; return; }
        int dev = 0, cus = 0, per_cu = 0; (void)hipGetDevice(&dev); (void)hipDeviceGetAttribute(&cus, hipDeviceAttributeMultiprocessorCount, dev);
        if (hipOccupancyMaxActiveBlocksPerMultiprocessor(&per_cu, (const void*)fwd_kernel, NTHR, LDS_BYTES) != hipSuccess) per_cu = -1;
        (void)hipGetLastError();
        if (cus < GRID || per_cu < 1) fprintf(stderr, "kernel_launch: note: %d CUs, occupancy query %d; the kernel needs %d co-resident workgroups (one per CU)\n", cus, per_cu, GRID);
        ready = 1;
    }
    if (ready < 0) return;
    (void)hipMemsetAsync((char*)d_ws + WS_CTL, 0, CTL_ZERO_BYTES, stream);
    Args a{};
    for (int i = 0; i < 25; ++i) a.in[i] = (const float*)d_in[i];
    a.out = (float*)d_out; a.ws = (unsigned char*)d_ws;
#if MK_PER_PHASE
    for (int p = 0; p < NPHASE; ++p) { a.ph_lo = p; a.ph_hi = p + 1; hipLaunchKernelGGL(fwd_kernel, dim3(GRID), dim3(NTHR), LDS_BYTES, stream, a); }
#else
    a.ph_lo = 0; a.ph_hi = NPHASE; hipLaunchKernelGGL(fwd_kernel, dim3(GRID), dim3(NTHR), LDS_BYTES, stream, a);
#endif
    const hipError_t le = hipPeekAtLastError();
    if (le != hipSuccess) fprintf(stderr, "kernel_launch: launch failed: %s\n", hipGetErrorName(le));
}
```

```cpp
#include <hip/hip_runtime.h>
#include <cstdio>
#include <cstdint>

#define LAS __attribute__((address_space(3)))
#define GAS __attribute__((address_space(1)))
typedef unsigned short bf16;
typedef unsigned short bf16_t;
typedef short bf16x8 __attribute__((ext_vector_type(8)));
typedef short s16x4 __attribute__((ext_vector_type(4)));
typedef float f32x2 __attribute__((ext_vector_type(2)));
typedef float f32x4 __attribute__((ext_vector_type(4)));
typedef float f32x16 __attribute__((ext_vector_type(16)));
typedef unsigned u32x2 __attribute__((ext_vector_type(2)));
typedef unsigned u32x4 __attribute__((ext_vector_type(4)));
typedef GAS unsigned gu32;
#define RLX_AGENT __ATOMIC_RELAXED, __HIP_MEMORY_SCOPE_AGENT
#define LDS_WAIT() asm volatile("s_waitcnt lgkmcnt(0)" ::: "memory")
#define VM_WAIT() asm volatile("s_waitcnt vmcnt(0)" ::: "memory")

typedef __bf16 bf16x2_t __attribute__((ext_vector_type(2)));
__device__ __forceinline__ unsigned pk2(float lo, float hi) { const f32x2 v = {lo, hi}; return __builtin_bit_cast(unsigned, __builtin_convertvector(v, bf16x2_t)); }
__device__ __forceinline__ unsigned f2bf(float f) { return pk2(f, 0.f) & 0xffffu; }
__device__ __forceinline__ float bf2f(unsigned b) { return __builtin_bit_cast(float, b << 16); }
__device__ __forceinline__ float bflo(unsigned w) { return __builtin_bit_cast(float, w << 16); }
__device__ __forceinline__ float bfhi(unsigned w) { return __builtin_bit_cast(float, w & 0xffff0000u); }
__device__ __forceinline__ float ldf(const float* p) { return __builtin_bit_cast(float, __hip_atomic_load((const unsigned*)p, RLX_AGENT)); }
__device__ __forceinline__ int ldi(const int* p) { return __hip_atomic_load(p, RLX_AGENT); }
__device__ __forceinline__ float wave_sum(float v) {
#define DPPF(x, ctrl, rmask) __builtin_bit_cast(float, __builtin_amdgcn_update_dpp(0, __builtin_bit_cast(int, x), ctrl, rmask, 0xF, true))
    v += DPPF(v, 0xB1, 0xF);
    v += DPPF(v, 0x4E, 0xF);
    v += DPPF(v, 0x141, 0xF);
    v += DPPF(v, 0x140, 0xF);
    v += DPPF(v, 0x142, 0xA);
    v += DPPF(v, 0x143, 0xC);
#undef DPPF
    return __builtin_bit_cast(float, __builtin_amdgcn_readlane(__builtin_bit_cast(int, v), 63));
}
__device__ __forceinline__ float wave_max(float v) {
#pragma unroll
    for (int o = 1; o < 64; o <<= 1) v = fmaxf(v, __shfl_xor(v, o));
    return v;
}
__device__ __forceinline__ float shfl_up_l(float v, int o, int lane) { const int src = (lane >= o) ? lane - o : lane; return __builtin_bit_cast(float, __builtin_amdgcn_ds_bpermute(src << 2, __builtin_bit_cast(int, v))); }
__device__ __forceinline__ float shfl_idx_l(float v, int src) { return __builtin_bit_cast(float, __builtin_amdgcn_ds_bpermute(src << 2, __builtin_bit_cast(int, v))); }
__device__ __forceinline__ float shfl_xor_l(float v, int o, int lane) { return __builtin_bit_cast(float, __builtin_amdgcn_ds_bpermute((lane ^ o) << 2, __builtin_bit_cast(int, v))); }
__device__ __forceinline__ float quad_xor1(float v) { return __builtin_bit_cast(float, __builtin_amdgcn_update_dpp(0, __builtin_bit_cast(int, v), 0xB1, 0xF, 0xF, true)); }
__device__ __forceinline__ float quad_xor2(float v) { return __builtin_bit_cast(float, __builtin_amdgcn_update_dpp(0, __builtin_bit_cast(int, v), 0x4E, 0xF, 0xF, true)); }
__device__ __forceinline__ float quad_sum(float v) { v += quad_xor1(v); v += quad_xor2(v); return v; }
__device__ __forceinline__ float fast_exp(float x) { return __builtin_amdgcn_exp2f(x * 1.4426950408889634f); }
__device__ __forceinline__ float sigmoidf_(float x) { return __builtin_amdgcn_rcpf(1.0f + fast_exp(-x)); }
__device__ __forceinline__ float siluf_(float x) { return x * sigmoidf_(x); }
__device__ __forceinline__ float gelu_tanh(float x) {
    const float x2 = x * x, t = fmaf(x2, -2.3022082299f * 0.044715f, -2.3022082299f);
    return x * __builtin_amdgcn_rcpf(1.0f + __builtin_amdgcn_exp2f(x * t));
}
__device__ __forceinline__ float log_sigmoid_acc(float x) { return fminf(x, 0.f) - log1pf(expf(-fabsf(x))); }

namespace pg8 {
#define PG8_LAS __attribute__((address_space(3)))
constexpr int BM = 256, BK = 64, HALF = 128, HTB = HALF * BK * 2, STAGE_BYTES = 8 * HTB, NXCD = 8, WGM = 8;
__host__ __device__ __forceinline__ int lds_byte(int r, int c) { const int st = (r >> 4) * 2 + (c >> 5), rr = r & 15, cc = c & 31, ob = rr * 64 + cc * 2; return st * 1024 + (ob ^ (((ob >> 9) & 1) << 5)); }
__host__ __device__ __forceinline__ void stage_rc(int b, int& R, int& C) { const int st = b / 1024, sb = b % 1024, swz = sb ^ (((sb >> 9) & 1) << 5); R = (st >> 1) * 16 + swz / 64; C = (st & 1) * 32 + (swz % 64) / 2; }
__host__ __device__ __forceinline__ int perm32(int rho) { const int n = rho >> 4, i = rho & 15; return 8 * (i >> 2) + 4 * n + (i & 3); }

struct Unit { int pm, pn, pb, kt0, nkt; };
struct Gemm { const bf16_t* A; const bf16_t* Bt; int M, N, K; };

struct StaticOrder {
    int nM, nN, nwg, G, c; int wgm = WGM;
    __host__ __device__ void init(int M, int N, int G_, int c_) { nM = M / BM; nN = N / BM; nwg = nM * nN; G = G_; c = c_; }
    __host__ __device__ __forceinline__ bool next(int i, Unit& u) const {
        const long L = (long)i * G + c; if (L >= nwg) return false;
        int wgid = (int)L; { const int q = nwg / NXCD, r = nwg % NXCD, xcd = wgid % NXCD, off = wgid / NXCD; wgid = (xcd < r ? xcd * (q + 1) : r * (q + 1) + (xcd - r) * q) + off; }
        const int nig = wgm * nN, gid = wgid / nig, fm = gid * wgm, gsz = (nM - fm) < wgm ? (nM - fm) : wgm;
        u.pm = fm + ((wgid % nig) % gsz); u.pn = (wgid % nig) / gsz; u.pb = u.pn; return true;
    }
    static constexpr bool KRANGE = false;
    __device__ __forceinline__ void a_ready(const Unit&) const {}
    __device__ __forceinline__ void done(const Unit&) const {}
};
struct MoeOrder {
    int nM, nN, nwg, G, c; int ts[9]; int wgm = WGM;
    __device__ __forceinline__ bool next(int i, Unit& u) const {
        const long L = (long)i * G + c; if (L >= nwg) return false;
        int wgid = (int)L; { const int q = nwg / NXCD, r = nwg % NXCD, xcd = wgid % NXCD, off = wgid / NXCD; wgid = (xcd < r ? xcd * (q + 1) : r * (q + 1) + (xcd - r) * q) + off; }
        const int nig = wgm * nN, gid = wgid / nig, fm = gid * wgm, gsz = (nM - fm) < wgm ? (nM - fm) : wgm;
        u.pm = fm + ((wgid % nig) % gsz); u.pn = (wgid % nig) / gsz;
        int e = 0;
#pragma unroll
        for (int k = 1; k < 8; ++k) e += (u.pm >= ts[k]) ? 1 : 0;
        u.pb = e * nN + u.pn; return true;
    }
    static constexpr bool KRANGE = false;
    __device__ __forceinline__ void a_ready(const Unit&) const {}
    __device__ __forceinline__ void done(const Unit&) const {}
};
__host__ __device__ __forceinline__ int hyb_SL(int R) { return R <= 9 ? 28 : (R <= 18 ? 14 : (R <= 36 ? 7 : 4)); }
struct HybridOrder {
    int U, c, nN, NKT, G; int ts[9];
    __device__ __forceinline__ bool next(int i, Unit& u) const {
        const bool full = i < 2; const int R = U - 512, SL = hyb_SL(R), ui = c / SL, sl = c - ui * SL;
        if (!full && (i > 2 || R <= 0 || ui >= R)) return false;
        int wgid = i * G + c; { const int q = 512 / NXCD, xcd = wgid % NXCD, off = wgid / NXCD; wgid = xcd * q + off; }
        const int nig = WGM * nN, fm = (wgid / nig) * WGM, pm_f = fm + ((wgid % nig) % WGM), pn_f = (wgid % nig) / WGM;
        const int unit = 512 + ui, pm_s = unit / nN, pn_s = unit - pm_s * nN, nk_s = NKT / SL;
        const int pm = full ? pm_f : pm_s, pn = full ? pn_f : pn_s, nkt = full ? NKT : nk_s, kt0 = full ? 0 : sl * nk_s;
        int e = 0;
#pragma unroll
        for (int k = 1; k < 8; ++k) e += (pm >= ts[k]) ? 1 : 0;
        u.pm = pm; u.pn = pn; u.pb = e * nN + pn; u.kt0 = kt0; u.nkt = nkt; return true;
    }
    static constexpr bool KRANGE = true;
    __device__ __forceinline__ void a_ready(const Unit&) const {}
    __device__ __forceinline__ void done(const Unit&) const {}
};

__device__ __forceinline__ unsigned cvt_pk_bf16(float lo, float hi) { unsigned r; asm volatile("v_cvt_pk_bf16_f32 %0, %1, %2" : "=v"(r) : "v"(lo), "v"(hi)); return r; }

struct EpiBf16 {
    static constexpr bool PERM = true, AFTER_DRAIN = false;
    bf16_t* O; int ldc; const float* cs; int rope_pn0, rope_pn1; float* norm2; int sig_pn0, gelu_pn0, gelu_pn1;
    __device__ __forceinline__ void operator()(const f32x4 (&acc)[2][2][4][2], const Unit& u, int wr, int wc, int fr, int fq) const {
        const int row0 = u.pm * BM + wr * 64 + fr; const int col0 = u.pn * BM + wc * 32 + 8 * fq;
        if (norm2 != nullptr && u.pn < 4) {
#pragma unroll
            for (int ai = 0; ai < 2; ++ai)
#pragma unroll
                for (int m = 0; m < 4; ++m)
#pragma unroll
                    for (int bj = 0; bj < 2; ++bj) { const f32x4 a0 = acc[ai][bj][m][0], a1 = acc[ai][bj][m][1];
                        float s = (a0[0] * a0[0] + a0[1] * a0[1]) + (a0[2] * a0[2] + a0[3] * a0[3]) + (a1[0] * a1[0] + a1[1] * a1[1]) + (a1[2] * a1[2] + a1[3] * a1[3]);
                        s += __shfl_xor(s, 16); s += __shfl_xor(s, 32);
                        if (fq == 0) norm2[((size_t)(row0 + ai * HALF + m * 16) * 8 + (u.pn >> 1) * 4 + (u.pn & 1) * 2 + bj) * 4 + wc] = s; }
        }
        const bool rope = (u.pn >= rope_pn0) && (u.pn < rope_pn1) && ((wc & 1) == 0);
        const float sgn = (fq == 0) ? -1.f : 1.f;
#pragma unroll
        for (int ai = 0; ai < 2; ++ai)
#pragma unroll
            for (int m = 0; m < 4; ++m) { const int row = row0 + ai * HALF + m * 16; bf16_t* rowp = O + (size_t)row * ldc + col0;
                f32x4 c0 = {1.f, 1.f, 1.f, 1.f}, c1 = c0, s0 = {0.f, 0.f, 0.f, 0.f}, s1 = s0;
                if (rope) {
                    const float pos = (float)(row & 8191);
                    constexpr float IR[8] = {0.15915494309189535f, 0.03086376340470123f, 0.0059851857127137054f, 0.001160663641240061f, 0.00022507907903927653f, 4.3647952792802891e-05f, 8.4643308082414014e-06f, 1.6414262627950345e-06f};
#pragma unroll
                    for (int k = 0; k < 4; ++k) { const float r0 = __builtin_amdgcn_fractf(pos * IR[k]), r1 = __builtin_amdgcn_fractf(pos * IR[4 + k]);
                        c0[k] = __builtin_amdgcn_cosf(r0); s0[k] = __builtin_amdgcn_sinf(r0); c1[k] = __builtin_amdgcn_cosf(r1); s1[k] = __builtin_amdgcn_sinf(r1); } }
#pragma unroll
                for (int bj = 0; bj < 2; ++bj) { f32x4 v0 = acc[ai][bj][m][0], v1 = acc[ai][bj][m][1];
                    if (u.pn >= gelu_pn0 && u.pn < gelu_pn1) {
#pragma unroll
                        for (int i = 0; i < 4; ++i) { v0[i] = gelu_tanh(v0[i]); v1[i] = gelu_tanh(v1[i]); } }
                    else if (u.pn >= sig_pn0 && u.pn < gelu_pn0) {
#pragma unroll
                        for (int i = 0; i < 4; ++i) { v0[i] = sigmoidf_(v0[i]); v1[i] = sigmoidf_(v1[i]); } }
                    if (rope) { f32x4 p0, p1;
#pragma unroll
                        for (int i = 0; i < 4; ++i) { p0[i] = __shfl_xor(v0[i], 16); p1[i] = __shfl_xor(v1[i], 16); }
                        if (fq < 2) { v0 = v0 * c0 + (p0 * s0) * sgn; v1 = v1 * c1 + (p1 * s1) * sgn; } }
                    u32x4 w; w.x = cvt_pk_bf16(v0[0], v0[1]); w.y = cvt_pk_bf16(v0[2], v0[3]); w.z = cvt_pk_bf16(v1[0], v1[1]); w.w = cvt_pk_bf16(v1[2], v1[3]);
                    *(u32x4*)(rowp + bj * HALF) = w; } }
    }
};
struct EpiResF32 {
    static constexpr bool PERM = false, AFTER_DRAIN = false;
    const float* base; float* out; int ldc;
    __device__ __forceinline__ void operator()(const f32x4 (&acc)[2][2][4][2], const Unit& u, int wr, int wc, int fr, int fq) const {
        const int row0 = u.pm * BM + wr * 64 + fr, col0 = u.pn * BM + wc * 32 + 4 * fq;
#pragma unroll
        for (int ai = 0; ai < 2; ++ai) {
            f32x4 b[4][2][2];
#pragma unroll
            for (int m = 0; m < 4; ++m) { const size_t off = (size_t)(row0 + ai * HALF + m * 16) * ldc + col0;
#pragma unroll
                for (int bj = 0; bj < 2; ++bj)
#pragma unroll
                    for (int n = 0; n < 2; ++n) b[m][bj][n] = *(const f32x4*)(base + off + bj * HALF + n * 16); }
#pragma unroll
            for (int m = 0; m < 4; ++m) { const size_t off = (size_t)(row0 + ai * HALF + m * 16) * ldc + col0;
#pragma unroll
                for (int bj = 0; bj < 2; ++bj)
#pragma unroll
                    for (int n = 0; n < 2; ++n) *(f32x4*)(out + off + bj * HALF + n * 16) = b[m][bj][n] + acc[ai][bj][m][n]; }
            asm volatile("" ::: "memory"); }
    }
};
template <class TB>
struct EpiResB {
    static constexpr bool PERM = true, AFTER_DRAIN = false;
    const TB* base; bf16_t* out; int ldc;
    __device__ __forceinline__ void operator()(const f32x4 (&acc)[2][2][4][2], const Unit& u, int wr, int wc, int fr, int fq) const {
        constexpr bool F32 = sizeof(TB) == 4;
        const int row0 = u.pm * BM + wr * 64 + fr, col0 = u.pn * BM + wc * 32 + 8 * fq;
#pragma unroll
        for (int ai = 0; ai < 2; ++ai) {
            f32x4 bf[F32 ? 4 : 1][2][2]; u32x4 bb[F32 ? 1 : 4][2];
#pragma unroll
            for (int m = 0; m < 4; ++m) { const size_t off = (size_t)(row0 + ai * HALF + m * 16) * ldc + col0;
#pragma unroll
                for (int bj = 0; bj < 2; ++bj) {
                    if constexpr (F32) { bf[m][bj][0] = *(const f32x4*)((const float*)base + off + bj * HALF); bf[m][bj][1] = *(const f32x4*)((const float*)base + off + bj * HALF + 4); }
                    else bb[m][bj] = *(const u32x4*)((const bf16_t*)base + off + bj * HALF); } }
#pragma unroll
            for (int m = 0; m < 4; ++m) { const size_t off = (size_t)(row0 + ai * HALF + m * 16) * ldc + col0;
#pragma unroll
                for (int bj = 0; bj < 2; ++bj) { f32x4 r0, r1;
                    if constexpr (F32) { r0 = bf[m][bj][0]; r1 = bf[m][bj][1]; }
                    else { const u32x4 w = bb[m][bj]; r0 = (f32x4){bflo(w.x), bfhi(w.x), bflo(w.y), bfhi(w.y)}; r1 = (f32x4){bflo(w.z), bfhi(w.z), bflo(w.w), bfhi(w.w)}; }
                    const f32x4 v0 = r0 + acc[ai][bj][m][0], v1 = r1 + acc[ai][bj][m][1];
                    u32x4 o; o.x = cvt_pk_bf16(v0[0], v0[1]); o.y = cvt_pk_bf16(v0[2], v0[3]); o.z = cvt_pk_bf16(v1[0], v1[1]); o.w = cvt_pk_bf16(v1[2], v1[3]);
                    *(u32x4*)(out + off + bj * HALF) = o; } }
            asm volatile("" ::: "memory"); }
    }
};
struct EpiSwiglu {
    static constexpr bool PERM = true, AFTER_DRAIN = false;
    bf16_t* O; int ldc;
    __device__ __forceinline__ void operator()(const f32x4 (&acc)[2][2][4][2], const Unit& u, int wr, int wc, int fr, int fq) const {
        const int row0 = u.pm * BM + wr * 64 + fr; const int col0 = u.pn * HALF + wc * 32 + 8 * fq;
#pragma unroll
        for (int ai = 0; ai < 2; ++ai)
#pragma unroll
            for (int m = 0; m < 4; ++m) { bf16_t* rowp = O + (size_t)(row0 + ai * HALF + m * 16) * ldc + col0;
                f32x4 h0, h1;
#pragma unroll
                for (int i = 0; i < 4; ++i) { h0[i] = siluf_(acc[ai][0][m][0][i]) * acc[ai][1][m][0][i]; h1[i] = siluf_(acc[ai][0][m][1][i]) * acc[ai][1][m][1][i]; }
                u32x4 w; w.x = cvt_pk_bf16(h0[0], h0[1]); w.y = cvt_pk_bf16(h0[2], h0[3]); w.z = cvt_pk_bf16(h1[0], h1[1]); w.w = cvt_pk_bf16(h1[2], h1[3]);
                *(u32x4*)rowp = w; }
    }
};
#if defined(PROBE_EPI)
struct EpiNone { static constexpr bool PERM = true, AFTER_DRAIN = false; bf16_t* O; int ldc;
    __device__ __forceinline__ void operator()(const f32x4 (&acc)[2][2][4][2], const Unit& u, int wr, int wc, int fr, int fq) const {
        float s = 0.f;
#pragma unroll
        for (int ai = 0; ai < 2; ++ai)
#pragma unroll
            for (int bj = 0; bj < 2; ++bj)
#pragma unroll
                for (int m = 0; m < 4; ++m)
#pragma unroll
                    for (int n = 0; n < 2; ++n) s += acc[ai][bj][m][n][0];
        if (s == 12345.678f) O[0] = 1; } };
struct EpiSwigluCheap {
    static constexpr bool PERM = true, AFTER_DRAIN = false;
    bf16_t* O; int ldc;
    __device__ __forceinline__ void operator()(const f32x4 (&acc)[2][2][4][2], const Unit& u, int wr, int wc, int fr, int fq) const {
        const int row0 = u.pm * BM + wr * 64 + fr; const int col0 = u.pn * HALF + wc * 32 + 8 * fq;
#pragma unroll
        for (int ai = 0; ai < 2; ++ai)
#pragma unroll
            for (int m = 0; m < 4; ++m) { bf16_t* rowp = O + (size_t)(row0 + ai * HALF + m * 16) * ldc + col0;
                const f32x4 h0 = acc[ai][0][m][0] * acc[ai][1][m][0], h1 = acc[ai][0][m][1] * acc[ai][1][m][1];
                u32x4 w; w.x = cvt_pk_bf16(h0[0], h0[1]); w.y = cvt_pk_bf16(h0[2], h0[3]); w.z = cvt_pk_bf16(h1[0], h1[1]); w.w = cvt_pk_bf16(h1[2], h1[3]);
                *(u32x4*)rowp = w; }
    }
};
#endif
struct EpiMoeDown {
    static constexpr bool PERM = false, AFTER_DRAIN = false;
    float* Y; int ldc; const float* rw;
    __device__ __forceinline__ void operator()(const f32x4 (&acc)[2][2][4][2], const Unit& u, int wr, int wc, int fr, int fq) const {
        const int row0 = u.pm * BM + wr * 64 + fr, col0 = u.pn * BM + wc * 32 + 4 * fq;
#pragma unroll
        for (int ai = 0; ai < 2; ++ai)
#pragma unroll
            for (int m = 0; m < 4; ++m) { const int row = row0 + ai * HALF + m * 16; const float w = ldf(rw + row); const size_t off = (size_t)row * ldc + col0;
#pragma unroll
                for (int bj = 0; bj < 2; ++bj)
#pragma unroll
                    for (int n = 0; n < 2; ++n) *(f32x4*)(Y + off + bj * HALF + n * 16) = acc[ai][bj][m][n] * w; }
    }
};

struct EpiMoeDownSK {
    static constexpr bool PERM = true, AFTER_DRAIN = false;
    bf16_t* Y; int ldc; const float* rw; float* slab; int SL;
    __device__ __forceinline__ void operator()(const f32x4 (&acc)[2][2][4][2], const Unit& u, int wr, int wc, int fr, int fq) const {
        const int r0 = wr * 64 + fr, c0 = wc * 32 + 8 * fq; const bool second = u.kt0 != 0;
        const int sidx = second ? (u.pm * 4 + u.pn - 512) * (SL - 1) + u.kt0 / u.nkt - 1 : 0;
        float* sb = slab + (size_t)sidx * 65536 + c0; bf16_t* yb = Y + (size_t)(u.pm * BM) * ldc + u.pn * BM + c0;
        float wv[2][4];
#pragma unroll
        for (int ai = 0; ai < 2; ++ai)
#pragma unroll
            for (int m = 0; m < 4; ++m) wv[ai][m] = rw[u.pm * BM + r0 + ai * HALF + m * 16];
#pragma unroll
        for (int ai = 0; ai < 2; ++ai)
#pragma unroll
            for (int m = 0; m < 4; ++m) { const int r = r0 + ai * HALF + m * 16; const float w = wv[ai][m];
#pragma unroll
                for (int bj = 0; bj < 2; ++bj) { const f32x4 v0 = acc[ai][bj][m][0] * w, v1 = acc[ai][bj][m][1] * w;
                    if (second) { *(f32x4*)(sb + (size_t)r * 256 + bj * HALF) = v0; *(f32x4*)(sb + (size_t)r * 256 + bj * HALF + 4) = v1; }
                    else { u32x4 o; o.x = cvt_pk_bf16(v0[0], v0[1]); o.y = cvt_pk_bf16(v0[2], v0[3]); o.z = cvt_pk_bf16(v1[0], v1[1]); o.w = cvt_pk_bf16(v1[2], v1[3]); *(u32x4*)(yb + (size_t)r * ldc + bj * HALF) = o; } } }
    }
};

template <class Epi, class Sched, bool ALIGN_EPI = false, bool SP2 = false>
__device__ __forceinline__ void gemm_phase(PG8_LAS unsigned char* lds, const Gemm g, const Sched& S, const Epi& E, const int tid) {
    const int wid = __builtin_amdgcn_readfirstlane(tid >> 6), lane = tid & 63, wr = wid >> 2, wc = wid & 3, fr = lane & 15, fq = lane >> 4;
    const int K = g.K; int nt = K / BK;
    unsigned voffA[2], voffB[2];
#pragma unroll
    for (int i = 0; i < 2; ++i) { int R, C; stage_rc(tid * 16 + i * 8192, R, C); const int Rb = Epi::PERM ? ((R & ~31) + perm32(R & 31)) : R;
        voffA[i] = (unsigned)(R * K + C) * 2u; voffB[i] = (unsigned)(Rb * K + C) * 2u; }
    const size_t kstep = (size_t)(BK * 2);
    const size_t hstep = (size_t)HALF * K * 2;
    const size_t tstep = 2 * hstep;
    const unsigned ldsw = (unsigned)wid * 1024u;
    const int aoff = lds_byte(wr * 64 + fr, fq * 8), boff = lds_byte(wc * 32 + fr, fq * 8);
#define PG8_SA(b, h) (((b) * 2 + (h)) * HTB)
#define PG8_SB(b, h) ((4 + (b) * 2 + (h)) * HTB)
#define PG8_STAGE(bufoff, gbase, voff) do { _Pragma("unroll") for (int _i = 0; _i < 2; ++_i) \
        __builtin_amdgcn_global_load_lds((const unsigned*)((const char*)(gbase) + (voff)[_i]), (PG8_LAS unsigned*)(lds + (bufoff) + ldsw + _i * 8192), 16, 0, 0); } while (0)
#define PG8_LDA(dst, b, h) do { _Pragma("unroll") for (int m = 0; m < 4; ++m) _Pragma("unroll") for (int k = 0; k < 2; ++k) dst[m][k] = *(const PG8_LAS bf16x8*)(lds + PG8_SA(b, h) + aoff + m * 2048 + k * 1024); } while (0)
#define PG8_LDB(dst, b, h) do { _Pragma("unroll") for (int n = 0; n < 2; ++n) _Pragma("unroll") for (int k = 0; k < 2; ++k) dst[n][k] = *(const PG8_LAS bf16x8*)(lds + PG8_SB(b, h) + boff + n * 2048 + k * 1024); } while (0)
#define PG8_MMA(ai, bj, At, Bt) do { __builtin_amdgcn_s_setprio(1); _Pragma("unroll") for (int m = 0; m < 4; ++m) _Pragma("unroll") for (int n = 0; n < 2; ++n) _Pragma("unroll") for (int k = 0; k < 2; ++k) \
        acc[ai][bj][m][n] = __builtin_amdgcn_mfma_f32_16x16x32_bf16(Bt[n][k], At[m][k], acc[ai][bj][m][n], 0, 0, 0); __builtin_amdgcn_s_setprio(0); } while (0)
#define PG8_WAIT_V(n) asm volatile("s_waitcnt vmcnt(" #n ")" ::: "memory")
#define PG8_WAIT_L(n) asm volatile("s_waitcnt lgkmcnt(" #n ")" ::: "memory")
#define PG8_BAR __builtin_amdgcn_s_barrier()
#define PG8_SCHED __builtin_amdgcn_sched_barrier(0)
    Unit cur, nxt; int ui = 0;
    if (!S.next(0, cur)) return;
    f32x4 acc[2][2][4][2];
#pragma unroll
    for (int a = 0; a < 2; ++a)
#pragma unroll
        for (int b = 0; b < 2; ++b)
#pragma unroll
            for (int m = 0; m < 4; ++m)
#pragma unroll
                for (int n = 0; n < 2; ++n) acc[a][b][m][n] = (f32x4){0.f, 0.f, 0.f, 0.f};
    bf16x8 At[4][2], B0[2][2], B1[2][2];
    const char* cA = (const char*)g.A + (size_t)cur.pm * tstep; const char* cB = (const char*)g.Bt + (size_t)cur.pb * tstep;
    if constexpr (Sched::KRANGE) { cA += (size_t)cur.kt0 * kstep; cB += (size_t)cur.kt0 * kstep; nt = cur.nkt; }
    S.a_ready(cur);
    if constexpr (SP2) {
        PG8_STAGE(PG8_SB(0, 0), cB, voffB); PG8_STAGE(PG8_SB(0, 1), cB + hstep, voffB); PG8_STAGE(PG8_SA(0, 0), cA, voffA); PG8_STAGE(PG8_SA(0, 1), cA + hstep, voffA);
        if (wr == 1) PG8_BAR;
        PG8_WAIT_V(2); PG8_BAR;
        PG8_STAGE(PG8_SB(1, 0), cB + kstep, voffB); PG8_STAGE(PG8_SA(1, 0), cA + kstep, voffA); PG8_STAGE(PG8_SB(1, 1), cB + hstep + kstep, voffB);
        PG8_WAIT_V(6); PG8_BAR;
    } else {
        PG8_STAGE(PG8_SB(0, 0), cB, voffB); PG8_STAGE(PG8_SA(0, 0), cA, voffA); PG8_STAGE(PG8_SB(0, 1), cB + hstep, voffB); PG8_STAGE(PG8_SA(0, 1), cA + hstep, voffA);
        if (wr == 1) PG8_BAR;
        PG8_WAIT_V(4); PG8_BAR;
        PG8_STAGE(PG8_SB(1, 0), cB + kstep, voffB); PG8_STAGE(PG8_SA(1, 0), cA + kstep, voffA); PG8_STAGE(PG8_SB(1, 1), cB + hstep + kstep, voffB);
        PG8_WAIT_V(6); PG8_BAR;
    }
    for (;;) {
        const bool has_next = S.next(ui + 1, nxt);
        const char* nA = has_next ? (const char*)g.A + (size_t)nxt.pm * tstep : cA; const char* nB = has_next ? (const char*)g.Bt + (size_t)nxt.pb * tstep : cB;
        if constexpr (Sched::KRANGE) { if (has_next) { nA += (size_t)nxt.kt0 * kstep; nB += (size_t)nxt.kt0 * kstep; } }
        for (int t = 0; t < nt; t += 2) {
            const bool last = (t == nt - 2);
            const char* a1 = cA + (size_t)(t + 1) * kstep;
            const char* a2 = last ? nA : cA + (size_t)(t + 2) * kstep; const char* b2 = last ? nB : cB + (size_t)(t + 2) * kstep;
            const char* a3 = a2 + kstep; const char* b3 = b2 + kstep;
            if (last && has_next) S.a_ready(nxt);
            if constexpr (SP2) {
            PG8_LDB(B0, 0, 0); PG8_LDB(B1, 0, 1); PG8_SCHED; PG8_LDA(At, 0, 0); PG8_STAGE(PG8_SA(1, 1), a1 + hstep, voffA);
            PG8_WAIT_V(8); PG8_WAIT_L(0); PG8_BAR; PG8_MMA(0, 0, At, B0); PG8_MMA(0, 1, At, B1); PG8_BAR; PG8_SCHED;
            PG8_LDA(At, 0, 1); PG8_STAGE(PG8_SB(0, 0), b2, voffB); PG8_STAGE(PG8_SB(0, 1), b2 + hstep, voffB); PG8_STAGE(PG8_SA(0, 0), a2, voffA);
            PG8_WAIT_V(8); PG8_WAIT_L(0); PG8_BAR; PG8_MMA(1, 0, At, B0); PG8_MMA(1, 1, At, B1); PG8_BAR; PG8_SCHED;
            PG8_LDB(B0, 1, 0); PG8_LDB(B1, 1, 1); PG8_SCHED; PG8_LDA(At, 1, 0); PG8_STAGE(PG8_SA(0, 1), a2 + hstep, voffA);
            PG8_WAIT_V(8); PG8_WAIT_L(0); PG8_BAR; PG8_MMA(0, 0, At, B0); PG8_MMA(0, 1, At, B1); PG8_BAR; PG8_SCHED;
            PG8_LDA(At, 1, 1); PG8_STAGE(PG8_SB(1, 0), b3, voffB); PG8_STAGE(PG8_SB(1, 1), b3 + hstep, voffB); PG8_STAGE(PG8_SA(1, 0), a3, voffA);
            PG8_WAIT_V(8); PG8_WAIT_L(0); PG8_BAR; PG8_MMA(1, 0, At, B0); PG8_MMA(1, 1, At, B1); PG8_BAR; PG8_SCHED;
            } else {
            PG8_LDB(B0, 0, 0); PG8_SCHED; PG8_LDA(At, 0, 0); PG8_STAGE(PG8_SA(1, 1), a1 + hstep, voffA);
            PG8_WAIT_L(8); PG8_BAR; PG8_WAIT_L(0); PG8_MMA(0, 0, At, B0); PG8_BAR; PG8_SCHED;
            PG8_LDB(B1, 0, 1); PG8_STAGE(PG8_SB(0, 0), b2, voffB);
            PG8_BAR; PG8_WAIT_L(0); PG8_MMA(0, 1, At, B1); PG8_BAR;
            PG8_LDA(At, 0, 1); PG8_STAGE(PG8_SA(0, 0), a2, voffA);
            PG8_BAR; PG8_WAIT_L(0); PG8_MMA(1, 0, At, B0); PG8_BAR; PG8_SCHED;
            PG8_STAGE(PG8_SB(0, 1), b2 + hstep, voffB);
            PG8_WAIT_V(6); PG8_BAR; PG8_MMA(1, 1, At, B1); PG8_BAR;
            PG8_LDB(B0, 1, 0); PG8_SCHED; PG8_LDA(At, 1, 0); PG8_STAGE(PG8_SA(0, 1), a2 + hstep, voffA);
            PG8_WAIT_L(8); PG8_BAR; PG8_WAIT_L(0); PG8_MMA(0, 0, At, B0); PG8_BAR; PG8_SCHED;
            PG8_LDB(B1, 1, 1); PG8_STAGE(PG8_SB(1, 0), b3, voffB);
            PG8_BAR; PG8_WAIT_L(0); PG8_MMA(0, 1, At, B1); PG8_BAR;
            PG8_LDA(At, 1, 1); PG8_STAGE(PG8_SA(1, 0), a3, voffA);
            PG8_BAR; PG8_WAIT_L(0); PG8_MMA(1, 0, At, B0); PG8_BAR; PG8_SCHED;
            PG8_STAGE(PG8_SB(1, 1), b3 + hstep, voffB);
            PG8_WAIT_V(6); PG8_BAR; PG8_MMA(1, 1, At, B1); PG8_BAR;
            }
        }
        if constexpr (ALIGN_EPI) { if (wr == 0) PG8_BAR; }
        if constexpr (!Epi::AFTER_DRAIN) { E(acc, cur, wr, wc, fr, fq); S.done(cur); }
        if (!has_next) break;
#pragma unroll
        for (int a = 0; a < 2; ++a)
#pragma unroll
            for (int b = 0; b < 2; ++b)
#pragma unroll
                for (int m = 0; m < 4; ++m)
#pragma unroll
                    for (int n = 0; n < 2; ++n) acc[a][b][m][n] = (f32x4){0.f, 0.f, 0.f, 0.f};
        cur = nxt; cA = nA; cB = nB; ++ui;
        if constexpr (Sched::KRANGE) nt = cur.nkt;
        if constexpr (ALIGN_EPI) { if (wr == 1) PG8_BAR; }
    }
    PG8_WAIT_V(0);
    if constexpr (!ALIGN_EPI) { if (wr == 0) PG8_BAR; }
    PG8_BAR;
#undef PG8_SA
#undef PG8_SB
#undef PG8_STAGE
#undef PG8_LDA
#undef PG8_LDB
#undef PG8_MMA
#undef PG8_WAIT_V
#undef PG8_WAIT_L
#undef PG8_BAR
#undef PG8_SCHED
}
}
namespace att {
constexpr int NW = 8, QBLK = 32, KVBLK = 64, QB = NW * QBLK, PITCH = 3072, DV = 128;
constexpr int SHM_V = KVBLK * DV * 2;
constexpr int LDS_V = 0, LDS_K = 2 * SHM_V, LDS_WS = 65536, LDS_BYTES = LDS_WS + NW * 64 * 4;
constexpr float THR = 8.f;
template <int DK> struct Cfg { static constexpr int SHM_K = KVBLK * DK * 2; static constexpr float SCALE = (DK == 128) ? 0.08838834764831845f : 0.125f; };

#define KSWZ(row, colB) ((row) * 256 + ((colB) ^ (((row) & 7) << 4)))
#define KSWZ64(row, ch) ((row) * 128 + ((((ch) ^ (((row) >> 1) & 7))) << 4))
#define SBAR() __builtin_amdgcn_sched_barrier(0)
__device__ __forceinline__ int v_st(int k, int c) { const int kk = (k & ~0xC) | ((k & 4) << 1) | ((k & 8) >> 1); return ((kk >> 3) * 4 + (c >> 5)) * 512 + ((kk & 7) * 32 + (c & 31)) * 2; }
__device__ __forceinline__ int v_rd_base(int lane) { return ((lane & 3) << 3) | (((lane >> 2) & 3) << 6) | (((lane >> 4) & 1) << 5) | (((lane >> 5) & 1) << 8); }
constexpr int v_rd_off(int d0, int ks, int half) { return d0 * 512 + ks * 4096 + half * 2048; }
__device__ __forceinline__ int crow(int r, int hi) { return (r & 3) + 8 * (r >> 2) + 4 * hi; }
__device__ __forceinline__ unsigned cvtpk(float lo, float hi) { unsigned r; asm volatile("v_cvt_pk_bf16_f32 %0, %1, %2" : "=v"(r) : "v"(lo), "v"(hi)); return r; }
__device__ __forceinline__ bf16x8 load8(const bf16* p) { return *reinterpret_cast<const bf16x8*>(p); }
__device__ __forceinline__ void mask_tile(f32x16& p0, f32x16& p1, int dq) {
    const float NEG = -__builtin_inff();
#pragma unroll
    for (int r = 0; r < 16; ++r) {
        const int c = (r & 3) + 8 * (r >> 2);
        if (dq - c < 0) p0[r] = NEG;
        if (dq - c - 32 < 0) p1[r] = NEG;
    }
}
template <int DK>
__device__ __forceinline__ void partialSM(f32x16& p0, f32x16& p1, float& m_reg, float& mn, float& alpha) {
    constexpr float SCALE = Cfg<DK>::SCALE;
    float pmax = p0[0]; for (int r = 1; r < 16; ++r) pmax = fmaxf(pmax, p0[r]); for (int r = 0; r < 16; ++r) pmax = fmaxf(pmax, p1[r]);
    { auto rr = __builtin_amdgcn_permlane32_swap(__float_as_uint(pmax), __float_as_uint(pmax), false, false);
      pmax = fmaxf(__uint_as_float(rr[0]), __uint_as_float(rr[1])); }
    constexpr float C2 = 1.4426950408889634f * SCALE;
    if (__builtin_expect(__all((pmax - m_reg) * SCALE <= THR), 1)) { mn = m_reg; alpha = 1.f; }
    else { mn = fmaxf(m_reg, pmax); alpha = __builtin_amdgcn_exp2f((m_reg - mn) * C2); m_reg = mn; }
    const float mnL = -mn * C2;
    for (int r = 0; r < 16; ++r) p0[r] = fmaf(p0[r], C2, mnL); for (int r = 0; r < 16; ++r) p1[r] = fmaf(p1[r], C2, mnL);
    for (int r = 0; r < 16; ++r) p0[r] = __builtin_amdgcn_exp2f(p0[r]);
}
__device__ __forceinline__ void finishSM(f32x16& p0, f32x16& p1, float alpha, float& l_reg, bf16x8& pa0, bf16x8& pa1, bf16x8& pa2, bf16x8& pa3) {
    for (int r = 0; r < 16; ++r) p1[r] = __builtin_amdgcn_exp2f(p1[r]);
    float ps = 0; for (int r = 0; r < 16; ++r) ps += p0[r]; for (int r = 0; r < 16; ++r) ps += p1[r];
    { auto rr = __builtin_amdgcn_permlane32_swap(__float_as_uint(ps), __float_as_uint(ps), false, false);
      ps = __uint_as_float(rr[0]) + __uint_as_float(rr[1]); }
    l_reg = l_reg * alpha + ps;
#define PK4(P, B_, OUT) do { unsigned a0 = cvtpk(P[B_+0], P[B_+1]), a1 = cvtpk(P[B_+2], P[B_+3]);                          \
        unsigned b0 = cvtpk(P[B_+4], P[B_+5]), b1 = cvtpk(P[B_+6], P[B_+7]);                                             \
        auto r0 = __builtin_amdgcn_permlane32_swap(a0, b0, false, false); auto r1 = __builtin_amdgcn_permlane32_swap(a1, b1, false, false); \
        u32x4 w = {r0[0], r1[0], r0[1], r1[1]}; OUT = *reinterpret_cast<bf16x8*>(&w); } while (0)
    PK4(p0, 0, pa0); PK4(p0, 8, pa1); PK4(p1, 0, pa2); PK4(p1, 8, pa3);
#undef PK4
}
__device__ __forceinline__ bf16x8 bias_frag(u32x2 kb, int hi) { u32x4 w = {hi ? 0u : kb.x, hi ? 0u : kb.y, 0u, 0u}; return *reinterpret_cast<bf16x8*>(&w); }
template <int KB, int DK, bool BIAS>
__device__ __forceinline__ void qkt(f32x16& p0, f32x16& p1, const char* K_lds, int r32, int hi, const bf16x8* qr, u32x2 kb0, u32x2 kb1) {
    constexpr int SHM_K = Cfg<DK>::SHM_K;
    p0 = f32x16{}; p1 = f32x16{};
    if constexpr (DK == 128) {
        const char* kb[4];
#pragma unroll
        for (int dd = 0; dd < 4; ++dd) kb[dd] = K_lds + KB * SHM_K + KSWZ(r32, (dd * 16 + hi * 8) * 2);
#pragma unroll
        for (int d0 = 0; d0 < 8; ++d0) { const char* a = kb[d0 & 3] + (d0 >> 2) * 128;
            bf16x8 b0 = *reinterpret_cast<const bf16x8*>(a);
            bf16x8 b1 = *reinterpret_cast<const bf16x8*>(a + 32 * 256);
            p0 = __builtin_amdgcn_mfma_f32_32x32x16_bf16(b0, qr[d0], p0, 0, 0, 0);
            p1 = __builtin_amdgcn_mfma_f32_32x32x16_bf16(b1, qr[d0], p1, 0, 0, 0); }
    } else {
#pragma unroll
        for (int d0 = 0; d0 < 4; ++d0) { const char* a = K_lds + KB * SHM_K + KSWZ64(r32, 2 * d0 + hi);
            bf16x8 b0 = *reinterpret_cast<const bf16x8*>(a);
            bf16x8 b1 = *reinterpret_cast<const bf16x8*>(a + 32 * 128);
            p0 = __builtin_amdgcn_mfma_f32_32x32x16_bf16(b0, qr[d0], p0, 0, 0, 0);
            p1 = __builtin_amdgcn_mfma_f32_32x32x16_bf16(b1, qr[d0], p1, 0, 0, 0); }
    }
    if constexpr (BIAS) {
        u32x4 ow = {hi ? 0u : 0x3f803f80u, hi ? 0u : 0x00003f80u, 0u, 0u}; const bf16x8 qone = *reinterpret_cast<bf16x8*>(&ow);
        p0 = __builtin_amdgcn_mfma_f32_32x32x16_bf16(bias_frag(kb0, hi), qone, p0, 0, 0, 0);
        p1 = __builtin_amdgcn_mfma_f32_32x32x16_bf16(bias_frag(kb1, hi), qone, p1, 0, 0, 0);
    }
}
template <int VB>
__device__ __forceinline__ void pv_tile(f32x16* o, int vb0, bf16x8 pa0, bf16x8 pa1, bf16x8 pa2, bf16x8 pa3) {
#define TRRD(dst, off) asm volatile("ds_read_b64_tr_b16 %0, %1 offset:%2" : "=&v"(dst) : "v"(vb0), "i"(off) : "memory")
#define PV_D0(d0) do { s16x4 l0, l1, l2, l3, h0, h1, h2, h3; constexpr int b_ = VB * SHM_V + v_rd_off(d0, 0, 0); \
        TRRD(l0, b_); TRRD(h0, b_ + 2048); TRRD(l1, b_ + 4096); TRRD(h1, b_ + 6144); TRRD(l2, b_ + 8192); TRRD(h2, b_ + 10240); TRRD(l3, b_ + 12288); TRRD(h3, b_ + 14336); \
        asm volatile("s_waitcnt lgkmcnt(0)" ::: "memory"); SBAR();   \
        o[d0] = __builtin_amdgcn_mfma_f32_32x32x16_bf16(pa0, (bf16x8){l0[0], l0[1], l0[2], l0[3], h0[0], h0[1], h0[2], h0[3]}, o[d0], 0, 0, 0);   \
        o[d0] = __builtin_amdgcn_mfma_f32_32x32x16_bf16(pa1, (bf16x8){l1[0], l1[1], l1[2], l1[3], h1[0], h1[1], h1[2], h1[3]}, o[d0], 0, 0, 0);   \
        o[d0] = __builtin_amdgcn_mfma_f32_32x32x16_bf16(pa2, (bf16x8){l2[0], l2[1], l2[2], l2[3], h2[0], h2[1], h2[2], h2[3]}, o[d0], 0, 0, 0);   \
        o[d0] = __builtin_amdgcn_mfma_f32_32x32x16_bf16(pa3, (bf16x8){l3[0], l3[1], l3[2], l3[3], h3[0], h3[1], h3[2], h3[3]}, o[d0], 0, 0, 0); } while (0)
    PV_D0(0); PV_D0(1); PV_D0(2); PV_D0(3);
#undef PV_D0
#undef TRRD
}

struct BlockRef { const bf16* Q; const bf16* K; const bf16* V; const u32x2* KB; int P0, JLO; };
template <int DK> struct Seam { bf16x8 qr[DK / 16]; bf16x8 st_v0, st_v1, st_k0, st_k1; u32x2 kbn0, kbn1; };
#define AROW(p, k0, rr) ((p) + (size_t)((k0) + (rr)) * PITCH + sc)
#define VMW() asm volatile("s_waitcnt vmcnt(0)" ::: "memory")
#define VMWN(n) asm volatile("s_waitcnt vmcnt(%0)" :: "i"(n) : "memory")
#define SLOAD_H(R_, k0) do { S.st_v0 = load8(AROW((R_).V, k0, sr)); S.st_v1 = load8(AROW((R_).V, k0, 32 + sr));                                   \
        if constexpr (DK == 128) { S.st_k0 = load8(AROW((R_).K, k0, sr)); S.st_k1 = load8(AROW((R_).K, k0, 32 + sr)); }                            \
        else { S.st_k0 = load8((R_).K + (size_t)((k0) + (tid >> 3)) * PITCH + (tid & 7) * 8); }                                                    \
        if constexpr (BIAS) { S.kbn0 = (R_).KB[(k0) + r32]; S.kbn1 = (R_).KB[(k0) + 32 + r32]; } } while (0)
#define SWRITE_HK(bf) do { if constexpr (DK == 128) { *(bf16x8*)(K_lds + (bf) * SHM_K + kws) = S.st_k0; *(bf16x8*)(K_lds + (bf) * SHM_K + kws + 32 * 256) = S.st_k1; } \
        else { *(bf16x8*)(K_lds + (bf) * SHM_K + kws) = S.st_k0; } } while (0)
#define SWRITE_HV(bf) do { *(bf16x8*)(V_lds + (bf) * SHM_V + vst0) = S.st_v0; *(bf16x8*)(V_lds + (bf) * SHM_V + vst1) = S.st_v1; } while (0)
#define SWRITE_H(bf) do { SWRITE_HV(bf); SWRITE_HK(bf); } while (0)
template <int DK, bool BIAS>
__device__ __forceinline__ void causal_prime(const BlockRef& cur, char* lds, Seam<DK>& S, int tid) {
    constexpr int SHM_K = Cfg<DK>::SHM_K;
    const int wid = __builtin_amdgcn_readfirstlane(tid >> 6), lane = tid & 63, r32 = lane & 31, hi = lane >> 5;
    const int sr = tid >> 4, sc = (tid & 15) * 8; const int kws = (DK == 128) ? KSWZ(sr, sc * 2) : KSWZ64(tid >> 3, tid & 7); char* K_lds = lds + LDS_K;
#pragma unroll
    for (int d0 = 0; d0 < DK / 16; ++d0) S.qr[d0] = load8(cur.Q + (size_t)(wid * QBLK + r32) * PITCH + d0 * 16 + hi * 8);
    SLOAD_H(cur, cur.JLO * KVBLK); VMW(); SWRITE_HK(0);
    __syncthreads();
}
template <int DK, bool BIAS, int OUT>
__device__ __forceinline__ void causal_block(const BlockRef& cur, const BlockRef& nxt, char* lds, Seam<DK>& S, void* Oblk, int opitch, int tid) {
    constexpr int SHM_K = Cfg<DK>::SHM_K;
    const int wid = __builtin_amdgcn_readfirstlane(tid >> 6), lane = tid & 63, r32 = lane & 31, hi = lane >> 5;
    const int NT = (cur.P0 + QB) / KVBLK - cur.JLO;
    const int qlo = cur.P0 + wid * QBLK, qm = qlo + r32 - 4 * hi;
    char* V_lds = lds + LDS_V; char* K_lds = lds + LDS_K;
    float* ws = (float*)(lds + LDS_WS) + wid * 64; float* li_l = ws, * al_l = ws + 32;
    float m_reg = -1e30f, l_reg = 0; f32x16 o[4] = {};
    const int sr = tid >> 4, sc = (tid & 15) * 8, vst0 = v_st(sr, sc), vst1 = v_st(32 + sr, sc);
    const int kws = (DK == 128) ? KSWZ(sr, sc * 2) : KSWZ64(tid >> 3, tid & 7);
    const int vb0 = (int)(uintptr_t)V_lds + v_rd_base(lane);
#define RESC(a) do { if (__any((a) < 1.f)) { if (hi == 0) al_l[r32] = (a); asm volatile("s_waitcnt lgkmcnt(0)" ::: "memory");              \
                     for (int d_ = 0; d_ < 4; ++d_) for (int r = 0; r < 16; ++r) o[d_][r] *= al_l[crow(r, hi)]; } } while (0)
#define KBASE(t) ((cur.JLO + (t)) * KVBLK)
#define MASKT(P0_, P1_, t) do { const int kb_ = KBASE(t); if (kb_ + KVBLK - 1 > qlo) mask_tile(P0_, P1_, qm - kb_); } while (0)
    constexpr int NQL = DK / 16;
#define SEAM_K0() do { VMWN(NQL); SWRITE_HK(0); SBAR(); } while (0)
    f32x16 pA0, pA1, pB0, pB1; float mnA, mnB, alA, alB; bf16x8 pa0, pa1, pa2, pa3;
    SWRITE_HV(0); SBAR();
    qkt<0, DK, BIAS>(pA0, pA1, K_lds, r32, hi, S.qr, S.kbn0, S.kbn1); SBAR();
    if (NT > 1) { SLOAD_H(cur, KBASE(1)); }
    SBAR();
    MASKT(pA0, pA1, 0); partialSM<DK>(pA0, pA1, m_reg, mnA, alA);
    if (NT > 1) { VMW(); SWRITE_H(1); }
    __syncthreads();
#define HALF_STEP(PX0, PX1, mnX, alX, PY0, PY1, alY, t, KB, VB, SB) do {                                                      \
        SBAR(); qkt<KB, DK, BIAS>(PX0, PX1, K_lds, r32, hi, S.qr, S.kbn0, S.kbn1);                                            \
        finishSM(PY0, PY1, alY, l_reg, pa0, pa1, pa2, pa3); SBAR();                                                           \
        if ((t) + 1 < NT) { SLOAD_H(cur, KBASE((t) + 1)); SBAR(); }                                                           \
        pv_tile<VB>(o, vb0, pa0, pa1, pa2, pa3); MASKT(PX0, PX1, (t)); partialSM<DK>(PX0, PX1, m_reg, mnX, alX);              \
        __syncthreads();                                                                                                      \
        if ((t) + 1 < NT) { VMW(); SWRITE_H(SB); }                                                                            \
        RESC(alX); __syncthreads(); } while (0)
    for (int t = 1; t + 1 < NT; t += 2) {
        HALF_STEP(pB0, pB1, mnB, alB, pA0, pA1, alA, t, 1, 0, 0);
        HALF_STEP(pA0, pA1, mnA, alA, pB0, pB1, alB, t + 1, 0, 1, 1);
    }
    const bool even = (NT & 1) == 0;
    if (even) { SBAR(); qkt<1, DK, BIAS>(pB0, pB1, K_lds, r32, hi, S.qr, S.kbn0, S.kbn1); SBAR(); }
    SLOAD_H(nxt, nxt.JLO * KVBLK); SBAR();
#pragma unroll
    for (int d0 = 0; d0 < DK / 16; ++d0) S.qr[d0] = load8(nxt.Q + (size_t)(wid * QBLK + r32) * PITCH + d0 * 16 + hi * 8);
    SBAR();
    finishSM(pA0, pA1, alA, l_reg, pa0, pa1, pa2, pa3); SBAR();
    pv_tile<0>(o, vb0, pa0, pa1, pa2, pa3);
    if (even) { MASKT(pB0, pB1, NT - 1); partialSM<DK>(pB0, pB1, m_reg, mnB, alB); __syncthreads(); RESC(alB);
        finishSM(pB0, pB1, alB, l_reg, pa0, pa1, pa2, pa3); SBAR(); pv_tile<1>(o, vb0, pa0, pa1, pa2, pa3); }
    SBAR(); SEAM_K0();
    if (hi == 0) li_l[r32] = l_reg; asm volatile("s_waitcnt lgkmcnt(0)" ::: "memory");
    float rli[16];
#pragma unroll
    for (int r = 0; r < 16; ++r) rli[r] = __builtin_amdgcn_rcpf(li_l[crow(r, hi)]);
#pragma unroll
    for (int r = 0; r < 16; ++r) { const int orow = wid * QBLK + crow(r, hi);
#pragma unroll
        for (int d0 = 0; d0 < 4; ++d0) { const float v = o[d0][r] * rli[r];
            if constexpr (OUT == 1) { ((float*)Oblk)[(size_t)orow * opitch + d0 * 32 + r32] = v; }
            else { const float vn = __shfl_xor(v, 1);
                   if ((r32 & 1) == 0) *(unsigned*)((bf16*)Oblk + (size_t)orow * opitch + d0 * 32 + r32) = cvtpk(v, vn); } } }
    __syncthreads();
#undef RESC
#undef KBASE
#undef MASKT
#undef SEAM_K0
#undef HALF_STEP
}
#undef AROW
#undef VMW
#undef VMWN
#undef SLOAD_H
#undef SWRITE_HK
#undef SWRITE_HV
#undef SWRITE_H
}
constexpr int T = 16384, DM = 1024, SEQ = 8192, NWAVES = 8, NTHR = 512, GRID = 256;
constexpr float EPS = 1e-6f;
constexpr int ZP = 3072;
constexpr int FF = 2816, FFE = 3584, NEXP = 8;
constexpr int XP_ROWS = 34816;
constexpr size_t MiB = 1u << 20, KiB = 1024;
constexpr size_t WS_CTL = 0, CTL_ZERO_BYTES = 65536;
constexpr size_t WS_SLOT = 1 * MiB, SLOT = 256 * KiB;
constexpr size_t WS_ROPE = WS_SLOT + 0 * SLOT;
constexpr size_t WS_LI = WS_SLOT + 2 * SLOT;
constexpr size_t WS_LF = WS_SLOT + 3 * SLOT;
constexpr size_t WS_LFX = WS_SLOT + 4 * SLOT;
constexpr size_t WS_KB = WS_SLOT + 14 * SLOT;
constexpr size_t WS_RTE = WS_SLOT + 6 * SLOT;
constexpr size_t WS_RTW = WS_SLOT + 7 * SLOT;
constexpr size_t WS_PPOS = WS_SLOT + 8 * SLOT;
constexpr size_t WS_RW = WS_SLOT + 9 * SLOT;
constexpr size_t WS_MISC = WS_SLOT + 10 * SLOT;
constexpr size_t WS_NH = WS_SLOT + 11 * SLOT;
constexpr size_t WS_NP = WS_SLOT + 12 * SLOT;
constexpr size_t WS_SGW = WS_SLOT + 13 * SLOT;
constexpr size_t WS_NORM2 = 5 * MiB;
constexpr size_t MISC_CNT = 0, MISC_MG = 8192, MISC_BL = 10240, MISC_MP = 12288, MISC_LAM = 14336, MISC_TS = 14400;
constexpr size_t WS_W_EIN = 8 * MiB, WS_W_EOUT = 14 * MiB, WS_W_FGU = 16 * MiB, WS_W_FDN = 27 * MiB, WS_W_OIN = 33 * MiB, WS_W_OOUT = 39 * MiB, WS_W_MGU = 41 * MiB, WS_W_MDN = 153 * MiB;
constexpr size_t WS_XR = 210 * MiB;
constexpr size_t WS_XN = 274 * MiB;
constexpr size_t WS_CAT = 306 * MiB;
constexpr size_t WS_ARENA = 338 * MiB;
constexpr size_t WS_CH = 576 * MiB;
constexpr size_t WS_CP = 608 * MiB;
constexpr size_t WS_DO = 576 * MiB;
constexpr size_t WS_XP = 640 * MiB;
constexpr size_t WS_Y = 708 * MiB;
constexpr size_t WS_END = 844 * MiB;
static_assert(WS_W_MDN + (size_t)NEXP * DM * FFE * 2 <= WS_XR && WS_ARENA + (size_t)XP_ROWS * FFE * 2 <= WS_CH && WS_XP + (size_t)XP_ROWS * DM * 2 <= WS_Y && WS_Y + (size_t)XP_ROWS * DM * 4 <= WS_END, "ws map");
constexpr int CW_BAR = 4096, CW_QUEUE = 8192;
constexpr int LDS_BYTES = 155648, LDSCTL_OFF = 151552;
constexpr int TS_ = 136;
constexpr int TILE_B = 128 * TS_ * 2;

#define XB_TMO      128
#define XB_XCNT(j)  (256  + 64 * (j))
#define XB_XSUB(j)  (1280 + 64 * (j))
#define XB_XGEN(j)  (2304 + 64 * (j))
#define XB_TOP      3328
#define XB_TOPGEN   3392
#define XCD_BAR_WORDS 3456
#define XB_SPIN_CAP (1u << 18)
__device__ __forceinline__ unsigned xb_ld(unsigned* p)              { return __hip_atomic_load(p, __ATOMIC_RELAXED, __HIP_MEMORY_SCOPE_AGENT); }
__device__ __forceinline__ unsigned xb_add(unsigned* p, unsigned v) { return __hip_atomic_fetch_add(p, v, __ATOMIC_RELAXED, __HIP_MEMORY_SCOPE_AGENT); }
__device__ __forceinline__ unsigned xb_xcc_id() { return (unsigned)__builtin_amdgcn_s_getreg((3 << 11) | 20) & 0xFu; }
#define XB_SPIN(cond, bar) do { unsigned _sp = 0; while (cond) { __builtin_amdgcn_s_sleep(1); \
    if ((++_sp & 255u) == 0u) { if (xb_ld(&(bar)[XB_TMO])) break; if (_sp > XB_SPIN_CAP) { atomicAdd(&(bar)[XB_TMO], 1u); break; } } } } while (0)
struct XcdBarrier { unsigned* bar; unsigned x; volatile LAS unsigned* st; };
__device__ __forceinline__ XcdBarrier xcd_barrier_post(unsigned* bar, volatile LAS unsigned* st) {
    XcdBarrier b; b.bar = bar; b.x = xb_xcc_id(); b.st = st;
    if (threadIdx.x == 0) (void)xb_add(&bar[XB_XCNT(b.x)], 1u);
    return b;
}
__device__ __forceinline__ void xcd_barrier_complete(unsigned* bar, unsigned x, unsigned& nloc, unsigned& nx) {
    const unsigned G = gridDim.x * gridDim.y * gridDim.z;
    unsigned sum, cnt, mine, sp = 0u;
    for (;;) {
        sum = 0u; cnt = 0u; mine = 0u;
#pragma unroll
        for (unsigned j = 0; j < 16; ++j) { const unsigned c = xb_ld(&bar[XB_XCNT(j)]); sum += c; cnt += (c > 0u) ? 1u : 0u; mine = (j == x) ? c : mine; }
        if (sum == G) break;
        __builtin_amdgcn_s_sleep(1);
        if ((++sp & 255u) == 0u) { if (xb_ld(&bar[XB_TMO])) break; if (sp > XB_SPIN_CAP) { atomicAdd(&bar[XB_TMO], 1u); break; } }
    }
    nloc = mine > 0u ? mine : 1u; nx = cnt > 0u ? cnt : 1u;
}
__device__ __forceinline__ void xcd_barrier(const XcdBarrier& b) {
    asm volatile("s_waitcnt vmcnt(0)" ::: "memory");
    __syncthreads();
    if (threadIdx.x == 0) {
        unsigned* bar = b.bar;
        __builtin_amdgcn_s_waitcnt(0);
        unsigned nloc = b.st[0], nx = b.st[1];
        if (nloc == 0u) { xcd_barrier_complete(bar, b.x, nloc, nx); b.st[0] = nloc; b.st[1] = nx; }
        const unsigned old = xb_add(&bar[XB_XSUB(b.x)], 1u);
        const unsigned gen = old / nloc;
        if (old + 1u == (gen + 1u) * nloc) {
            __builtin_amdgcn_fence(__ATOMIC_RELEASE, "agent");
            asm volatile("s_waitcnt vmcnt(0)" ::: "memory");
            const unsigned og = xb_add(&bar[XB_TOP], 1u);
            const unsigned tg = og / nx;
            if (og + 1u == (tg + 1u) * nx) xb_add(&bar[XB_TOPGEN], 1u);
            else XB_SPIN(xb_ld(&bar[XB_TOPGEN]) == tg, bar);
            __builtin_amdgcn_fence(__ATOMIC_ACQUIRE, "agent");
            xb_add(&bar[XB_XGEN(b.x)], 1u);
            asm volatile("s_waitcnt vmcnt(0)" ::: "memory");
        } else {
            XB_SPIN(xb_ld(&bar[XB_XGEN(b.x)]) == gen, bar);
            __builtin_amdgcn_fence(__ATOMIC_ACQUIRE, "agent");
            asm volatile("s_waitcnt vmcnt(0)" ::: "memory");
        }
    }
    __syncthreads();
}

struct Args { const float* in[25]; float* out; unsigned char* ws; int ph_lo, ph_hi; };
#define KARGS const __attribute__((address_space(4))) Args
__device__ __forceinline__ const float* ain(KARGS& a, int k) { return (const float*)(const GAS float*)a.in[k]; }
struct Ctx { LAS unsigned char* lds; unsigned char* ws; int tid, lane, wave, bid; };

struct ConvItem { const float* src; bf16* dst; int ldw, K; };
__device__ __forceinline__ int src_col(int type, int n0, int ffh) {
    const int pn = n0 >> 8, j = n0 & 255;
    const int t3 = j < 128 ? 128 * pn + j : ffh + 128 * pn + (j - 128);
    return type == 1 ? (n0 < 2048 ? n0 : n0 + 8) : (type == 2 ? (n0 < 1536 ? n0 : n0 + 4) : (type == 3 ? t3 : n0));
}
__device__ __forceinline__ ConvItem conv_decode(KARGS& a, unsigned char* ws, int it) {
    constexpr int I_EIN = 16 * 96, I_EOUT = 16 * 32, I_FGU = 16 * 176, I_FDN = 44 * 32, I_OIN = 16 * 96, I_OOUT = 16 * 32, I_MGU = 16 * 224, I_MDN = 56 * 32;
    constexpr int C1 = I_EIN, C2 = C1 + I_EOUT, C3 = C2 + I_FGU, C4 = C3 + I_FDN, C5 = C4 + I_OIN, C6 = C5 + I_OOUT, C7 = C6 + NEXP * I_MGU;
    const int kind = (it >= C1) + (it >= C2) + (it >= C3) + (it >= C4) + (it >= C5) + (it >= C6) + (it >= C7);
#define SEL8(v0, v1, v2, v3, v4, v5, v6, v7) (kind == 0 ? (v0) : kind == 1 ? (v1) : kind == 2 ? (v2) : kind == 3 ? (v3) : kind == 4 ? (v4) : kind == 5 ? (v5) : kind == 6 ? (v6) : (v7))
    const int base = SEL8(0, C1, C2, C3, C4, C5, C6, C7), per = SEL8(I_EIN, I_EOUT, I_FGU, I_FDN, I_OIN, I_OOUT, I_MGU, I_MDN);
    int r = it - base; const int e = r / per; r -= e * per;
    const int ldw = SEL8(3080, 1024, 2 * FF, 1024, 3076, 1024, 2 * FFE, 1024), K = SEL8(1024, 1024, 1024, FF, 1024, 1024, 1024, FFE), N = SEL8(3072, 1024, 2 * FF, 1024, 3072, 1024, 2 * FFE, 1024);
    const int type = SEL8(1, 0, 3, 0, 2, 0, 3, 0), ffh = SEL8(0, 0, FF, 0, 0, 0, FFE, 0);
    const float* W = SEL8(ain(a, 2), ain(a, 10), ain(a, 12), ain(a, 13), ain(a, 15), ain(a, 19), ain(a, 22), ain(a, 23));
    const size_t wso = SEL8(WS_W_EIN, WS_W_EOUT, WS_W_FGU, WS_W_FDN, WS_W_OIN, WS_W_OOUT, WS_W_MGU, WS_W_MDN);
#undef SEL8
    const int nblk = N / 32, kb = r / nblk, nb = r - kb * nblk, k0 = 64 * kb, n0 = 32 * nb;
    ConvItem c; c.ldw = ldw; c.K = K;
    c.src = W + (size_t)e * K * ldw + (size_t)k0 * ldw + src_col(type, n0, ffh);
    c.dst = (bf16*)(ws + wso) + (size_t)e * N * K + (size_t)n0 * K + k0;
    return c;
}
__device__ __forceinline__ void conv_load(const ConvItem& c, int lane, f32x4 (&v)[8]) {
    const int kl = lane >> 3, n4 = (lane & 7) * 4;
#pragma unroll
    for (int i = 0; i < 8; ++i) v[i] = __builtin_nontemporal_load((const f32x4*)(c.src + (size_t)(kl + 8 * i) * c.ldw + n4));
}
__device__ __forceinline__ void conv_finish(const ConvItem& c, int lane, const f32x4 (&v)[8], LAS float* scr) {
    const int kl = lane >> 3, n4 = (lane & 7) * 4;
#pragma unroll
    for (int i = 0; i < 8; ++i) { LAS float* d = scr + (kl + 8 * i) * 33 + n4; d[0] = v[i].x; d[1] = v[i].y; d[2] = v[i].z; d[3] = v[i].w; }
    LDS_WAIT(); asm volatile("" ::: "memory");
    const int cc = lane & 7;
#pragma unroll
    for (int j = 0; j < 4; ++j) { const int n = (lane >> 3) + 8 * j; const LAS float* s = scr + (8 * cc) * 33 + n;
        u32x4 o; o.x = pk2(s[0 * 33], s[1 * 33]); o.y = pk2(s[2 * 33], s[3 * 33]); o.z = pk2(s[4 * 33], s[5 * 33]); o.w = pk2(s[6 * 33], s[7 * 33]);
        *(u32x4*)(c.dst + (size_t)n * c.K + 8 * cc) = o; }
    LDS_WAIT(); asm volatile("" ::: "memory");
}
constexpr int CONV_FGU_END = 16 * 96 + 16 * 32 + 16 * 176, CONV_DENSE_ITEMS = 16 * 96 + 16 * 32 + 16 * 176 + 44 * 32 + 16 * 96 + 16 * 32, CONV_MGU_END = CONV_DENSE_ITEMS + NEXP * 16 * 224, CONV_ALL_ITEMS = CONV_MGU_END + NEXP * 56 * 32;
template <int LO, int HI, bool REV>
__device__ __forceinline__ void prologue_weights(KARGS& a, const Ctx& c) {
    LAS float* scr = (LAS float*)(c.lds + c.wave * 16384);
    const int gw = c.bid * NWAVES + c.wave, NGW = GRID * NWAVES;
    constexpr int NITEMS = HI - LO;
#define CONV_IT(i) (REV ? HI - 1 - (i) : LO + (i))
    int it = gw; if (it >= NITEMS) return;
    f32x4 va[8], vb[8]; ConvItem d0 = conv_decode(a, c.ws, CONV_IT(it)), d1 = d0; conv_load(d0, c.lane, va);
    for (;;) {
        const int it1 = it + NGW; const bool has1 = it1 < NITEMS;
        if (has1) { d1 = conv_decode(a, c.ws, CONV_IT(it1)); conv_load(d1, c.lane, vb); }
        conv_finish(d0, c.lane, va, scr);
        if (!has1) break;
        it = it1 + NGW; const bool has0 = it < NITEMS;
        if (has0) { d0 = conv_decode(a, c.ws, CONV_IT(it)); conv_load(d0, c.lane, va); }
        conv_finish(d1, c.lane, vb, scr);
        if (!has0) break;
    }
#undef CONV_IT
}
template <int LO, int HI, bool REV>
__device__ __forceinline__ void conv_dynamic(KARGS& a, const Ctx& c, unsigned* q) {
    LAS float* scr = (LAS float*)(c.lds + c.wave * 16384);
    LAS int* slot = (LAS int*)(c.lds + 131072);
    constexpr int NCH = (HI - LO) / 16; static_assert((HI - LO) % 16 == 0, "chunks");
#define CONV_IT(i) (REV ? HI - 1 - (i) : LO + (i))
    if (c.tid == 0) slot[0] = (int)__hip_atomic_fetch_add(q, 1u, RLX_AGENT);
    __syncthreads();
    int ch = slot[0];
    while (ch < NCH) {
        __syncthreads();
        if (c.tid == 0) slot[0] = (int)__hip_atomic_fetch_add(q, 1u, RLX_AGENT);
        const int i0 = ch * 16 + c.wave * 2;
        f32x4 va[8], vb[8]; const ConvItem d0 = conv_decode(a, c.ws, CONV_IT(i0)), d1 = conv_decode(a, c.ws, CONV_IT(i0 + 1));
        conv_load(d0, c.lane, va); conv_load(d1, c.lane, vb);
        conv_finish(d0, c.lane, va, scr); conv_finish(d1, c.lane, vb, scr);
        __syncthreads();
        ch = slot[0];
    }
#undef CONV_IT
}
__device__ __forceinline__ void prologue_tables(KARGS& a, const Ctx& c) {
    const int gt = c.bid * NTHR + c.tid, NGT = GRID * NTHR;
    bf16* sgw = (bf16*)(c.ws + WS_SGW); const float* w = ain(a, 8);
    for (int i = gt; i < 4 * 128 * 128; i += NGT) { const int tt = (i >> 7) & 127, ss = i & 127; sgw[i] = (bf16)(ss <= tt ? f2bf(w[i]) : 0u); }
    if (c.bid == 0 && c.wave == 0) { const float* l = ain(a, 17); const float p0 = wave_sum(l[c.lane] * l[64 + c.lane]), p1 = wave_sum(l[128 + c.lane] * l[192 + c.lane]);
        const float lambda_init = 0.8f - 0.6f * expf(-0.3f);
        if (c.lane == 0) *(float*)(c.ws + WS_MISC + MISC_LAM) = expf(p0) - expf(p1) + lambda_init; }
}

template <int NC> __device__ __forceinline__ void stage_wxt(const Ctx& c, const float* W, int ldw, int col0) {
    LAS float* wxt = (LAS float*)c.lds;
    for (int i = c.tid; i < NC * 1024; i += NTHR) { const int cc = i >> 10, k = i & 1023; wxt[i] = W[(size_t)k * ldw + col0 + cc]; }
    __syncthreads();
}
template <int MODE> __device__ __forceinline__ void row_phase(KARGS& a, const Ctx& c, const void* xin_, const float* gain) {
    constexpr bool XBF = MODE != 0; const float* xin = (const float*)xin_; const bf16* xinb = (const bf16*)xin_; (void)xin; (void)xinb;
    constexpr int NC = (MODE == 0 || MODE == 3) ? 8 : (MODE == 2 ? 4 : 0);
    unsigned char* ws = c.ws;
    LAS float* wxt = (LAS float*)c.lds; LAS int* lcnt = (LAS int*)(c.lds + 32768);
    if (MODE == 0) stage_wxt<8>(c, ain(a, 2), 3080, 2048);
    if (MODE == 2) stage_wxt<4>(c, ain(a, 15), 3076, 1536);
    if (MODE == 3) { if (c.tid < 8) lcnt[c.tid] = 0; stage_wxt<8>(c, ain(a, 21), 8, 0); }
    f32x4 g[4];
#pragma unroll
    for (int j = 0; j < 4; ++j) g[j] = *((const f32x4*)gain + c.lane + 64 * j);
    bf16* XN = (bf16*)(ws + WS_XN);
    int skSL = 2;
    if (MODE == 4) skSL = pg8::hyb_SL(__builtin_amdgcn_readfirstlane(ldi((const int*)(ws + WS_MISC + MISC_TS) + 8)) * 4 - 512);
#define ROW_INDEX(r) ((MODE == 4) ? (r) * (GRID * NWAVES) + c.bid * NWAVES + c.wave : 64 * c.bid + c.wave * 8 + (r))
#define ROW_LOAD(r, V, Y0, Y1, P0, P1) do { const int m_ = ROW_INDEX(r); \
        if (XBF) { const u32x2* xr_ = (const u32x2*)(xinb + (size_t)m_ * DM) + c.lane; _Pragma("unroll") for (int j = 0; j < 4; ++j) vnb[j] = xr_[64 * j]; } \
        else { const f32x4* xr_ = (const f32x4*)(xin + (size_t)m_ * DM) + c.lane; _Pragma("unroll") for (int j = 0; j < 4; ++j) V[j] = xr_[64 * j]; } \
        if (MODE == 4) { P0 = ldi((const int*)(ws + WS_PPOS) + 2 * m_); P1 = ldi((const int*)(ws + WS_PPOS) + 2 * m_ + 1); \
            const u32x2* y0_ = (const u32x2*)((const bf16*)(ws + WS_Y) + (size_t)P0 * DM) + c.lane; const u32x2* y1_ = (const u32x2*)((const bf16*)(ws + WS_Y) + (size_t)P1 * DM) + c.lane; \
            _Pragma("unroll") for (int j = 0; j < 4; ++j) { Y0[j] = y0_[64 * j]; Y1[j] = y1_[64 * j]; } } } while (0)
    f32x4 vn[4]; u32x2 vnb[4], yn0[4], yn1[4]; int pn0 = 0, pn1 = 0;
    ROW_LOAD(0, vn, yn0, yn1, pn0, pn1);
#pragma unroll
    for (int r = 0; r < 8; ++r) {
        const int m = ROW_INDEX(r);
        f32x4 v[4]; const int p0 = pn0, p1 = pn1;
#pragma unroll
        for (int j = 0; j < 4; ++j) { if (XBF) { const unsigned w0 = vnb[j].x, w1 = vnb[j].y; v[j] = (f32x4){bflo(w0), bfhi(w0), bflo(w1), bfhi(w1)}; } else v[j] = vn[j];
            if (MODE == 4) { v[j].x += bflo(yn0[j].x) + bflo(yn1[j].x); v[j].y += bfhi(yn0[j].x) + bfhi(yn1[j].x); v[j].z += bflo(yn0[j].y) + bflo(yn1[j].y); v[j].w += bfhi(yn0[j].y) + bfhi(yn1[j].y); } }
        if (r + 1 < 8) ROW_LOAD(r + 1, vn, yn0, yn1, pn0, pn1);
        if (MODE == 4) {
            const float* slab = (const float*)(ws + WS_XP);
            if (p0 >= 32768 || p1 >= 32768) {
#pragma unroll 1
                for (int q = 0; q < 2; ++q) { const int p = q ? p1 : p0; if (p < 32768) continue;
#pragma unroll
                    for (int j = 0; j < 4; ++j) { const float* sp = slab + ((size_t)(((p >> 8) * 4 + j - 512) * (skSL - 1)) * 256 + (p & 255)) * 256;
#pragma unroll 4
                        for (int s2 = 0; s2 < skSL - 1; ++s2) v[j] = v[j] + *((const f32x4*)(sp + (size_t)s2 * 65536) + c.lane); } } } }
        float s = 0.f;
#pragma unroll
        for (int j = 0; j < 4; ++j) s += (v[j].x * v[j].x + v[j].y * v[j].y) + (v[j].z * v[j].z + v[j].w * v[j].w);
#pragma unroll
        for (int j = 0; j < 4; ++j) v[j] = v[j] * g[j];
        float z[NC > 0 ? NC : 1];
        if constexpr (NC > 0) {
#pragma unroll
            for (int cc = 0; cc < NC; ++cc) { float pp = 0.f;
#pragma unroll
                for (int j = 0; j < 4; ++j) { const f32x4 w = *((const LAS f32x4*)(wxt + cc * 1024) + c.lane + 64 * j); pp += (v[j].x * w.x + v[j].y * w.y) + (v[j].z * w.z + v[j].w * w.w); }
                z[cc] = pp; }
#pragma unroll
            for (int cc = 0; cc < NC; ++cc) z[cc] = wave_sum(z[cc]);
        }
        const float rstd = 1.0f / sqrtf(wave_sum(s) * (1.0f / DM) + EPS);
#pragma unroll
        for (int j = 0; j < 4; ++j) v[j] = v[j] * rstd;
        if (MODE == 4) { f32x4* o = (f32x4*)((float*)(GAS float*)a.out + (size_t)m * DM) + c.lane;
#pragma unroll
            for (int j = 0; j < 4; ++j) o[64 * j] = v[j]; }
        else { u32x2* o = (u32x2*)(XN + (size_t)m * DM) + c.lane;
#pragma unroll
            for (int j = 0; j < 4; ++j) { u32x2 w; w.x = pk2(v[j].x, v[j].y); w.y = pk2(v[j].z, v[j].w); o[64 * j] = w; } }
        if constexpr (NC > 0) {
#pragma unroll
            for (int cc = 0; cc < NC; ++cc) z[cc] *= rstd;
            if (MODE == 0) { if (c.lane < 8) { float zz = z[0];
#pragma unroll
                    for (int cc = 1; cc < 8; ++cc) zz = (c.lane == cc) ? z[cc] : zz;
                    const float gb = ain(a, 5)[c.lane];
                    if (c.lane < 4) ((float*)(ws + WS_LI))[m * 4 + c.lane] = zz + gb; else ((float*)(ws + WS_LF))[m * 4 + c.lane - 4] = log_sigmoid_acc(zz + gb); } }
            if (MODE == 2) {
                if (c.lane < 4) { float zz = z[0];
#pragma unroll
                    for (int cc = 1; cc < 4; ++cc) zz = (c.lane == cc) ? z[cc] : zz;
                    ((float*)(ws + WS_LFX))[m * 4 + c.lane] = log_sigmoid_acc(zz + ain(a, 16)[c.lane]); } }
            if (MODE == 3) { if (c.lane == 0) {
                    int e1 = 0; float v1 = z[0];
#pragma unroll
                    for (int cc = 1; cc < 8; ++cc) if (z[cc] > v1) { v1 = z[cc]; e1 = cc; }
                    int e2 = -1; float v2 = -__builtin_inff();
#pragma unroll
                    for (int cc = 0; cc < 8; ++cc) if (cc != e1 && z[cc] > v2) { v2 = z[cc]; e2 = cc; }
                    const float w2 = 1.0f / (1.0f + expf(v1 - v2)), w1 = 1.0f - w2;
                    ((int*)(ws + WS_RTE))[2 * m] = e1; ((int*)(ws + WS_RTE))[2 * m + 1] = e2;
                    ((float*)(ws + WS_RTW))[2 * m] = w1; ((float*)(ws + WS_RTW))[2 * m + 1] = w2;
                    __hip_atomic_fetch_add(&lcnt[e1], 1, __ATOMIC_RELAXED, __HIP_MEMORY_SCOPE_WORKGROUP); __hip_atomic_fetch_add(&lcnt[e2], 1, __ATOMIC_RELAXED, __HIP_MEMORY_SCOPE_WORKGROUP); } }
        }
    }
#undef ROW_LOAD
#undef ROW_INDEX
    if (MODE == 3) { __syncthreads(); if (c.tid < 8) ((int*)(ws + WS_MISC + MISC_CNT))[c.bid * 8 + c.tid] = lcnt[c.tid]; }
    __syncthreads();
}

__device__ __forceinline__ int crow_(int r, int hi) { return (r & 3) + 8 * (r >> 2) + 4 * hi; }
__device__ __forceinline__ void wg_mma128(f32x16 (&acc)[2], const LAS bf16* A, const LAS bf16* Bt, int wave, int lane) {
    const int r32 = lane & 31, hi = lane >> 5, mblk = (wave >> 1) * 32, nblk = (wave & 1) * 64;
    const LAS bf16* ap = A + (mblk + r32) * TS_ + hi * 8; const LAS bf16* bp0 = Bt + (nblk + r32) * TS_ + hi * 8; const LAS bf16* bp1 = bp0 + 32 * TS_;
#pragma unroll
    for (int ks = 0; ks < 8; ++ks) {
        const bf16x8 av = *(const LAS bf16x8*)(ap + ks * 16), b0 = *(const LAS bf16x8*)(bp0 + ks * 16), b1 = *(const LAS bf16x8*)(bp1 + ks * 16);
        acc[0] = __builtin_amdgcn_mfma_f32_32x32x16_bf16(av, b0, acc[0], 0, 0, 0);
        acc[1] = __builtin_amdgcn_mfma_f32_32x32x16_bf16(av, b1, acc[1], 0, 0, 0);
    }
}
__device__ __forceinline__ void unpack8(const u32x4 w, float (&f)[8]) { f[0] = bflo(w.x); f[1] = bfhi(w.x); f[2] = bflo(w.y); f[3] = bfhi(w.y); f[4] = bflo(w.z); f[5] = bfhi(w.z); f[6] = bflo(w.w); f[7] = bfhi(w.w); }
__device__ __forceinline__ void stage_raw(const Ctx& c, const bf16* Z, int tok0, bool first, int col0, LAS bf16* raw) {
    for (int i = c.tid; i < 131 * 16; i += NTHR) { const int r = i >> 4, ch = i & 15;
        u32x4 v = {0u, 0u, 0u, 0u}; if (!(first && r < 3)) v = *(const u32x4*)(Z + (size_t)(tok0 - 3 + r) * ZP + col0 + ch * 8);
        *(LAS u32x4*)(raw + r * TS_ + ch * 8) = v; }
}
template <bool TRANSPOSE> __device__ __forceinline__ void conv_tile(const Ctx& c, const LAS bf16* raw, const float* cw  , const float* cb, float scale, LAS bf16* tile) {
    float w0[4][8], b0[8];
    if (!TRANSPOSE) { const int d0 = (c.tid & 15) * 8;
#pragma unroll
        for (int j = 0; j < 4; ++j)
#pragma unroll
            for (int i = 0; i < 8; ++i) w0[j][i] = cw[j * 1024 + d0 + i];
#pragma unroll
        for (int i = 0; i < 8; ++i) b0[i] = cb[d0 + i]; }
#pragma unroll 4
    for (int it = 0; it < 4; ++it) {
        const int ch = TRANSPOSE ? (c.tid >> 7) * 4 + it : (c.tid & 15), s = TRANSPOSE ? (c.tid & 127) : (c.tid >> 4) + 32 * it, d0 = ch * 8;
        float acc[8];
#pragma unroll
        for (int i = 0; i < 8; ++i) acc[i] = TRANSPOSE ? cb[d0 + i] : b0[i];
#pragma unroll
        for (int j = 0; j < 4; ++j) { float x[8]; unpack8(*(const LAS u32x4*)(raw + (s + j) * TS_ + d0), x);
#pragma unroll
            for (int i = 0; i < 8; ++i) acc[i] += (TRANSPOSE ? cw[j * 1024 + d0 + i] : w0[j][i]) * x[i]; }
#pragma unroll
        for (int i = 0; i < 8; ++i) acc[i] = siluf_(acc[i]) * scale;
        if (TRANSPOSE) {
#pragma unroll
            for (int i = 0; i < 8; ++i) tile[(d0 + i) * TS_ + s] = (bf16)f2bf(acc[i]);
        } else { u32x4 o; o.x = pk2(acc[0], acc[1]); o.y = pk2(acc[2], acc[3]); o.z = pk2(acc[4], acc[5]); o.w = pk2(acc[6], acc[7]); *(LAS u32x4*)(tile + s * TS_ + d0) = o; }
    }
}
struct RawRegs { u32x4 v[5]; };
__device__ __forceinline__ void raw_load(const Ctx& c, const bf16* Z, int tok0, bool first, int col0, RawRegs& R) {
#pragma unroll
    for (int n = 0; n < 5; ++n) { const int i = c.tid + NTHR * n, r = i >> 4, ch = i & 15; R.v[n] = (u32x4){0u, 0u, 0u, 0u};
        if (i < 131 * 16 && !(first && r < 3)) R.v[n] = *(const u32x4*)(Z + (size_t)(tok0 - 3 + r) * ZP + col0 + ch * 8); }
}
__device__ __forceinline__ void raw_store(const Ctx& c, const RawRegs& R, LAS bf16* raw) {
#pragma unroll
    for (int n = 0; n < 5; ++n) { const int i = c.tid + NTHR * n, r = i >> 4, ch = i & 15; if (i < 131 * 16) *(LAS u32x4*)(raw + r * TS_ + ch * 8) = R.v[n]; }
}
struct TRegs { u32x4 v[4]; };
__device__ __forceinline__ void tr_load(const Ctx& c, const bf16* src, TRegs& R) {
    const int s = c.tid & 127, chq = c.tid >> 7;
#pragma unroll
    for (int it = 0; it < 4; ++it) R.v[it] = *(const u32x4*)(src + (size_t)s * ZP + (chq * 4 + it) * 8);
}
template <class F> __device__ __forceinline__ void tr_store(const Ctx& c, const TRegs& R, LAS bf16* tile, const F& f) {
    const int s = c.tid & 127, chq = c.tid >> 7;
#pragma unroll
    for (int it = 0; it < 4; ++it) { const int e0 = (chq * 4 + it) * 8; float x[8]; unpack8(R.v[it], x);
#pragma unroll
        for (int i = 0; i < 8; ++i) tile[(e0 + i) * TS_ + s] = (bf16)f2bf(f(x[i], s, e0 + i)); }
}
struct CRegs { u32x4 v[4]; };
__device__ __forceinline__ void rows_load(const Ctx& c, const bf16* src  , CRegs& R) {
#pragma unroll
    for (int n = 0; n < 4; ++n) { const int i = c.tid + NTHR * n; R.v[n] = *(const u32x4*)(src + (i >> 4) * 128 + (i & 15) * 8); }
}
__device__ __forceinline__ void rows_store(const Ctx& c, const CRegs& R, LAS bf16* tile) {
#pragma unroll
    for (int n = 0; n < 4; ++n) { const int i = c.tid + NTHR * n; *(LAS u32x4*)(tile + (i >> 4) * TS_ + (i & 15) * 8) = R.v[n]; }
}
template <class F> __device__ __forceinline__ void stage_transposed(const Ctx& c, const bf16* src, LAS bf16* tile, const F& f) {
    const int s = c.tid & 127, chq = c.tid >> 7;
#pragma unroll
    for (int it = 0; it < 4; ++it) { const int e0 = (chq * 4 + it) * 8; float x[8]; unpack8(*(const u32x4*)(src + (size_t)s * ZP + e0), x);
#pragma unroll
        for (int i = 0; i < 8; ++i) tile[(e0 + i) * TS_ + s] = (bf16)f2bf(f(x[i], s, e0 + i)); }
}
constexpr int L_T0 = 0, L_T1 = TILE_B, L_T2 = 2 * TILE_B, L_T3 = 3 * TILE_B, L_TAB = 4 * TILE_B + 2048;
static_assert(L_TAB + 4096 <= LDSCTL_OFF, "LDS map");

__device__ __forceinline__ void ml_state_unit(KARGS& a, const Ctx& c0, int bhc) {
    Ctx c = c0; { int t_ = c0.wave * 64 + (int)__builtin_amdgcn_mbcnt_hi(~0u, __builtin_amdgcn_mbcnt_lo(~0u, 0u)); asm volatile("" : "+v"(t_)); c.tid = t_; c.lane = t_ & 63; c.wave = __builtin_amdgcn_readfirstlane(t_ >> 6); }
    unsigned char* ws = c.ws;
    const int bh = bhc >> 6, ck = bhc & 63, b = bh >> 2, h = bh & 3, tok0 = b * SEQ + ck * 128;
    const bf16* Z = (const bf16*)(ws + WS_ARENA);
    LAS bf16* KT = (LAS bf16*)(c.lds + L_T0); LAS bf16* VT = (LAS bf16*)(c.lds + L_T1); LAS bf16* RAW = (LAS bf16*)(c.lds + L_T2);
    LAS float* wt = (LAS float*)(c.lds + L_TAB);
    RawRegs rk; TRegs rv;
    raw_load(c, Z, tok0, ck == 0, 512 + h * 128, rk); tr_load(c, Z + (size_t)tok0 * ZP + 1024 + h * 128, rv);
    if (c.wave == 0) {
        const float* LF = (const float*)(ws + WS_LF); const float* LI = (const float*)(ws + WS_LI);
        const int s0 = 2 * c.lane;
        const float lf0 = ldf(LF + (size_t)(tok0 + s0) * 4 + h), lf1 = ldf(LF + (size_t)(tok0 + s0 + 1) * 4 + h);
        const float li0 = ldf(LI + (size_t)(tok0 + s0) * 4 + h), li1 = ldf(LI + (size_t)(tok0 + s0 + 1) * 4 + h);
        float sc = lf0 + lf1;
#pragma unroll
        for (int o = 1; o < 64; o <<= 1) { const float t = shfl_up_l(sc, o, c.lane); if (c.lane >= o) sc += t; }
        const float b1 = sc, b0 = sc - lf1, blast = shfl_idx_l(sc, 63);
        const float g0 = blast - b0 + li0, g1 = blast - b1 + li1;
        float mg = fmaxf(g0, g1);
#pragma unroll
        for (int o = 1; o < 64; o <<= 1) mg = fmaxf(mg, shfl_xor_l(mg, o, c.lane));
        wt[s0] = fast_exp(g0 - mg); wt[s0 + 1] = fast_exp(g1 - mg);
        if (c.lane == 0) { ((float*)(ws + WS_MISC + MISC_MG))[bhc] = mg; ((float*)(ws + WS_MISC + MISC_BL))[bhc] = blast; }
    }
    raw_store(c, rk, RAW);
    __syncthreads();
    conv_tile<true>(c, RAW, ain(a, 3) + 512 + h * 128, ain(a, 4) + 512 + h * 128, 1.0f, KT);
    tr_store(c, rv, VT, [&](float x, int s, int) { return x * wt[s]; });
    __syncthreads();
    f32x16 acc[2] = {};
    wg_mma128(acc, VT, KT, c.wave, c.lane);
    { const int r32 = c.lane & 31, hi = c.lane >> 5, mblk = (c.wave >> 1) * 32, nblk = (c.wave & 1) * 64; float* CH = (float*)(ws + WS_CH) + (size_t)bhc * 16384;
#pragma unroll
      for (int j = 0; j < 2; ++j)
#pragma unroll
        for (int i = 0; i < 16; ++i) CH[(mblk + crow_(i, hi)) * 128 + nblk + 32 * j + r32] = acc[j][i]; }
    { const int d = c.tid >> 2, part = c.tid & 3; float s = 0.f;
#pragma unroll
      for (int k = 0; k < 4; ++k) { float x[8]; unpack8(*(const LAS u32x4*)(KT + d * TS_ + part * 32 + 8 * k), x);
#pragma unroll
        for (int i = 0; i < 8; ++i) s += wt[part * 32 + 8 * k + i] * x[i]; }
      s = quad_sum(s);
      if (part == 0) ((float*)(ws + WS_NH))[(size_t)bhc * 128 + d] = s; }
    __syncthreads();
}
__device__ __forceinline__ void sg_unit(KARGS& a, const Ctx& c0, int idx) {
    Ctx c = c0; { int t_ = c0.wave * 64 + (int)__builtin_amdgcn_mbcnt_hi(~0u, __builtin_amdgcn_mbcnt_lo(~0u, 0u)); asm volatile("" : "+v"(t_)); c.tid = t_; c.lane = t_ & 63; c.wave = __builtin_amdgcn_readfirstlane(t_ >> 6); }
    unsigned char* ws = c.ws;
    const int bn = idx >> 2, g = idx & 3, tok0 = (bn >> 6) * SEQ + (bn & 63) * 128;
    const bf16* Z = (const bf16*)(ws + WS_ARENA);
    LAS bf16* WG = (LAS bf16*)(c.lds + L_T0); LAS bf16* VN = (LAS bf16*)(c.lds + L_T1); LAS float* rs = (LAS float*)(c.lds + L_TAB);
    const int r32 = c.lane & 31, hi = c.lane >> 5, mblk = (c.wave >> 1) * 32, nblk = (c.wave & 1) * 64, ch = c.tid & 15, c0e = ch * 8, chq = c.tid >> 7;
    TRegs rv; CRegs rw; u32x4 xv[16], uv[4]; f32x4 gv[4][2], bv[4];
    tr_load(c, Z + (size_t)tok0 * ZP + 2560 + g * 128, rv); rows_load(c, (const bf16*)(ws + WS_SGW) + (size_t)g * 16384, rw);
    { const bf16* p = Z + (size_t)(tok0 + (c.tid >> 2)) * ZP + 2560 + (c.tid & 3) * 128;
#pragma unroll
      for (int k = 0; k < 16; ++k) xv[k] = *(const u32x4*)(p + 8 * k); }
#pragma unroll
    for (int it = 0; it < 4; ++it) { uv[it] = *(const u32x4*)(Z + (size_t)(tok0 + (c.tid >> 4) + 32 * it) * ZP + 2048 + g * 128 + c0e);
        const float* gp = ain(a, 7) + g * 128 + (chq * 4 + it) * 8; gv[it][0] = *(const f32x4*)gp; gv[it][1] = *(const f32x4*)(gp + 4);
        bv[it] = *(const f32x4*)(ain(a, 9) + g * 128 + mblk + 8 * it + 4 * hi); }
    { const int s = c.tid >> 2, part = c.tid & 3; float ss = 0.f;
#pragma unroll
      for (int k = 0; k < 16; ++k) { float x[8]; unpack8(xv[k], x);
#pragma unroll
        for (int i = 0; i < 8; ++i) ss += x[i] * x[i]; }
      ss = quad_sum(ss);
      if (part == 0) rs[s] = 1.0f / sqrtf(ss * (1.0f / 512.0f) + EPS); }
    rows_store(c, rw, WG);
    __syncthreads();
    { const int s = c.tid & 127; const float r = rs[s];
#pragma unroll
      for (int it = 0; it < 4; ++it) { const int e0 = (chq * 4 + it) * 8; float x[8]; unpack8(rv.v[it], x);
#pragma unroll
        for (int i = 0; i < 8; ++i) VN[(e0 + i) * TS_ + s] = (bf16)f2bf(x[i] * r * gv[it][i >> 2][i & 3]); } }
    __syncthreads();
    f32x16 acc[2] = {};
    wg_mma128(acc, WG, VN, c.wave, c.lane);
    __syncthreads();
    LAS float* HT = (LAS float*)(c.lds + L_T0);
#pragma unroll
    for (int i = 0; i < 16; ++i) { const int t = mblk + crow_(i, hi); const float bs = bv[i >> 2][i & 3];
        HT[t * 132 + nblk + r32] = acc[0][i] + bs; HT[t * 132 + nblk + 32 + r32] = acc[1][i] + bs; }
    __syncthreads();
    { bf16* CAT = (bf16*)(ws + WS_CAT);
#pragma unroll
      for (int it = 0; it < 4; ++it) { const int t = (c.tid >> 4) + 32 * it; float u[8]; unpack8(uv[it], u);
          const f32x4 x0 = *(const LAS f32x4*)(HT + t * 132 + c0e), x1 = *(const LAS f32x4*)(HT + t * 132 + c0e + 4);
          u32x4 o; o.x = pk2(u[0] * x0.x, u[1] * x0.y); o.y = pk2(u[2] * x0.z, u[3] * x0.w);
          o.z = pk2(u[4] * x1.x, u[5] * x1.y); o.w = pk2(u[6] * x1.z, u[7] * x1.w);
          *(u32x4*)(CAT + (size_t)(tok0 + t) * DM + 512 + g * 128 + c0e) = o; } }
    __syncthreads();
}
__device__ __forceinline__ void ml_scan_phase(const Ctx& c) {
    unsigned char* ws = c.ws;
    const int gid = c.bid * NTHR + c.tid, bh = gid >> 14, idx = gid & 16383;
    LAS float* sdec = (LAS float*)c.lds; LAS float* ssc = sdec + 64; LAS float* smp = ssc + 64;
    if (c.wave == 0) {
        const float bl = ldf((const float*)(ws + WS_MISC + MISC_BL) + bh * 64 + c.lane), mg = ldf((const float*)(ws + WS_MISC + MISC_MG) + bh * 64 + c.lane);
        float m = 0.f, mprev = 0.f, mnew = 0.f;
        for (int k = 0; k < 64; ++k) { const float blk = __shfl(bl, k), mgk = __shfl(mg, k); const float mn = fmaxf(blk + m, mgk);
            if (c.lane == k) { mprev = m; mnew = mn; } m = mn; }
        smp[c.lane] = mprev; sdec[c.lane] = fast_exp(bl + mprev - mnew); ssc[c.lane] = fast_exp(mg - mnew);
    }
    __syncthreads();
    const float* CH = (const float*)(ws + WS_CH) + (size_t)bh * 64 * 16384 + idx; bf16* CP = (bf16*)(ws + WS_CP) + (size_t)bh * 64 * 16384 + idx;
    float C = 0.f;
#pragma unroll 1
    for (int k0 = 0; k0 < 64; k0 += 32) { float chv[32];
#pragma unroll
        for (int k = 0; k < 32; ++k) chv[k] = CH[(size_t)(k0 + k) * 16384];
#pragma unroll
        for (int k = 0; k < 32; ++k) { CP[(size_t)(k0 + k) * 16384] = (bf16)f2bf(C); C = sdec[k0 + k] * C + ssc[k0 + k] * chv[k]; } }
    if (idx < 128) { const float* NH = (const float*)(ws + WS_NH) + (size_t)bh * 64 * 128 + idx; float* NP = (float*)(ws + WS_NP) + (size_t)bh * 64 * 128 + idx; float n = 0.f;
#pragma unroll 8
        for (int k = 0; k < 64; ++k) { const float nh = NH[k * 128]; NP[k * 128] = n; n = sdec[k] * n + ssc[k] * nh; } }
    if (idx < 64) ((float*)(ws + WS_MISC + MISC_MP))[bh * 64 + idx] = smp[idx];
    __syncthreads();
}
template <int SKIP = 0> __device__ __forceinline__ void ml_out_unit(KARGS& a, const Ctx& c0, int bhc) {
    Ctx c = c0; { int t_ = c0.wave * 64 + (int)__builtin_amdgcn_mbcnt_hi(~0u, __builtin_amdgcn_mbcnt_lo(~0u, 0u)); asm volatile("" : "+v"(t_)); c.tid = t_; c.lane = t_ & 63; c.wave = __builtin_amdgcn_readfirstlane(t_ >> 6); }
    unsigned char* ws = c.ws;
    const int bh = bhc >> 6, ck = bhc & 63, b = bh >> 2, h = bh & 3, tok0 = b * SEQ + ck * 128;
    const bf16* Z = (const bf16*)(ws + WS_ARENA);
    LAS bf16* QT = (LAS bf16*)(c.lds + L_T0); LAS bf16* KT = (LAS bf16*)(c.lds + L_T1); LAS bf16* VT = (LAS bf16*)(c.lds + L_T2); LAS bf16* CT = (LAS bf16*)(c.lds + L_T3);
    LAS bf16* SW = KT; LAS bf16* RAW = (LAS bf16*)(c.lds + L_T3 + 1024); LAS bf16* RAWK = VT;
    RawRegs rq, rk; TRegs rv; CRegs rc;
    raw_load(c, Z, tok0, ck == 0, h * 128, rq); raw_load(c, Z, tok0, ck == 0, 512 + h * 128, rk);
    tr_load(c, Z + (size_t)tok0 * ZP + 1024 + h * 128, rv); rows_load(c, (const bf16*)(ws + WS_CP) + (size_t)bhc * 16384, rc);
    LAS float* t_a = (LAS float*)(c.lds + L_TAB); LAS float* t_mu = t_a + 128; LAS float* t_wi = t_a + 256; LAS float* t_emr = t_a + 384; LAS float* t_rden = t_a + 512; LAS float* t_np = t_a + 640; LAS float* t_ssq = t_a + 768;
    if (c.wave == 0) {
        const float* LF = (const float*)(ws + WS_LF); const float* LI = (const float*)(ws + WS_LI);
        const int s0 = 2 * c.lane;
        const float lf0 = ldf(LF + (size_t)(tok0 + s0) * 4 + h), lf1 = ldf(LF + (size_t)(tok0 + s0 + 1) * 4 + h);
        const float li0 = ldf(LI + (size_t)(tok0 + s0) * 4 + h), li1 = ldf(LI + (size_t)(tok0 + s0 + 1) * 4 + h);
        float sc = lf0 + lf1;
#pragma unroll
        for (int o = 1; o < 64; o <<= 1) { const float t = shfl_up_l(sc, o, c.lane); if (c.lane >= o) sc += t; }
        const float b1 = sc, b0 = sc - lf1;
        const float a0 = li0 - b0, a1 = li1 - b1;
        float pm = fmaxf(a0, a1);
#pragma unroll
        for (int o = 1; o < 64; o <<= 1) { const float t = shfl_up_l(pm, o, c.lane); if (c.lane >= o) pm = fmaxf(pm, t); }
        float pprev = shfl_up_l(pm, 1, c.lane); if (c.lane == 0) pprev = -__builtin_inff();
        const float pm0 = fmaxf(pprev, a0), pm1 = pm;
        const float mprev = ldf((const float*)(ws + WS_MISC + MISC_MP) + bhc);
        const float mu0 = fmaxf(mprev, pm0), mu1 = fmaxf(mprev, pm1);
        t_a[s0] = a0; t_a[s0 + 1] = a1; t_mu[s0] = mu0; t_mu[s0 + 1] = mu1;
        t_wi[s0] = fast_exp(mprev - mu0); t_wi[s0 + 1] = fast_exp(mprev - mu1);
        t_emr[s0] = fast_exp(-b0 - mu0); t_emr[s0 + 1] = fast_exp(-b1 - mu1);
    }
    if (c.wave == 1) { const float* NP = (const float*)(ws + WS_NP) + (size_t)bhc * 128; t_np[c.lane] = ldf(NP + c.lane); t_np[64 + c.lane] = ldf(NP + 64 + c.lane); }
    raw_store(c, rq, RAW); raw_store(c, rk, RAWK);
    __syncthreads();
    if (!(SKIP & 1)) { conv_tile<false>(c, RAW, ain(a, 3) + h * 128, ain(a, 4) + h * 128, 0.08838834764831845f, QT);
    conv_tile<false>(c, RAWK, ain(a, 3) + 512 + h * 128, ain(a, 4) + 512 + h * 128, 1.0f, KT); }
    __syncthreads();
    if (!(SKIP & 2)) tr_store(c, rv, VT, [](float x, int, int) { return x; });
    rows_store(c, rc, CT);
    __syncthreads();
    const int r32 = c.lane & 31, hi = c.lane >> 5, mblk = (c.wave >> 1) * 32, nblk = (c.wave & 1) * 64;
    f32x16 sa[2] = {};
    if (!(SKIP & 4)) wg_mma128(sa, QT, KT, c.wave, c.lane);
    __syncthreads();
    { const float as0 = t_a[nblk + r32], as1 = t_a[nblk + 32 + r32];
#pragma unroll
      for (int i = 0; i < 16; ++i) { const int t = mblk + crow_(i, hi); const float mu = t_mu[t];
          const int s0 = nblk + r32, s1 = s0 + 32;
          const float w0 = (s0 <= t) ? fast_exp(as0 - mu) : 0.f, w1 = (s1 <= t) ? fast_exp(as1 - mu) : 0.f;
          SW[t * TS_ + s0] = (bf16)f2bf(sa[0][i] * w0); SW[t * TS_ + s1] = (bf16)f2bf(sa[1][i] * w1); } }
    __syncthreads();
    f32x16 n1[2] = {}, n2[2] = {};
    if (!(SKIP & 4)) { wg_mma128(n1, SW, VT, c.wave, c.lane);
    wg_mma128(n2, QT, CT, c.wave, c.lane); }
    { const int t = c.tid >> 2, part = c.tid & 3; float ds = 0.f, dq = 0.f;
#pragma unroll
      for (int k = 0; k < 4; ++k) { float x[8], q[8]; unpack8(*(const LAS u32x4*)(SW + t * TS_ + part * 32 + 8 * k), x); unpack8(*(const LAS u32x4*)(QT + t * TS_ + part * 32 + 8 * k), q);
#pragma unroll
        for (int i = 0; i < 8; ++i) { ds += x[i]; dq += q[i] * t_np[part * 32 + 8 * k + i]; } }
      ds = quad_sum(ds); dq = quad_sum(dq);
      if (part == 0) { const float den = ds + t_wi[t] * dq; t_rden[t] = 1.0f / fmaxf(fabsf(den), t_emr[t]); } }
    __syncthreads();
    LAS float* HT = (LAS float*)(c.lds + L_T0);
#pragma unroll
    for (int i = 0; i < 16; ++i) { const int t = mblk + crow_(i, hi); const float wi = t_wi[t], rd = t_rden[t];
        HT[t * 132 + nblk + r32] = (n1[0][i] + wi * n2[0][i]) * rd; HT[t * 132 + nblk + 32 + r32] = (n1[1][i] + wi * n2[1][i]) * rd; }
    __syncthreads();
    { const int t = c.tid >> 2, part = c.tid & 3; float q = 0.f;
#pragma unroll
      for (int k = 0; k < 8; ++k) { const f32x4 x = *(const LAS f32x4*)(HT + t * 132 + part * 32 + 4 * k); q += (x.x * x.x + x.y * x.y) + (x.z * x.z + x.w * x.w); }
      q = quad_sum(q);
      if (part == 0) t_ssq[t] = 1.0f / sqrtf(q * (1.0f / 128.0f) + EPS); }
    __syncthreads();
    { int tt = c.tid; asm volatile("" : "+v"(tt));
      bf16* CAT = (bf16*)(ws + WS_CAT); const int ch = tt & 15, e0 = ch * 8; float gn[8];
#pragma unroll
      for (int i = 0; i < 8; ++i) gn[i] = ain(a, 6)[h * 128 + e0 + i];
#pragma unroll
      for (int it = 0; it < 4; ++it) { const int t = (tt >> 4) + 32 * it; float og[8]; unpack8(*(const u32x4*)(Z + (size_t)(tok0 + t) * ZP + 1536 + h * 128 + e0), og);
          const float rstd = t_ssq[t]; const f32x4 x0 = *(const LAS f32x4*)(HT + t * 132 + e0), x1 = *(const LAS f32x4*)(HT + t * 132 + e0 + 4);
          u32x4 o; o.x = pk2(x0.x * rstd * gn[0] * og[0], x0.y * rstd * gn[1] * og[1]); o.y = pk2(x0.z * rstd * gn[2] * og[2], x0.w * rstd * gn[3] * og[3]);
          o.z = pk2(x1.x * rstd * gn[4] * og[4], x1.y * rstd * gn[5] * og[5]); o.w = pk2(x1.z * rstd * gn[6] * og[6], x1.w * rstd * gn[7] * og[7]);
          *(u32x4*)(CAT + (size_t)(tok0 + t) * DM + h * 128 + e0) = o; } }
    __syncthreads();
}

__device__ __forceinline__ void fox_cumsum(const Ctx& c) {
    if (c.bid >= 8) return;
    unsigned char* ws = c.ws; const int bh = c.bid, b = bh >> 2, h = bh & 3;
    const float* LFX = (const float*)(ws + WS_LFX) + (size_t)b * SEQ * 4 + h; u32x2* KB = (u32x2*)(ws + WS_KB) + (size_t)bh * SEQ;
    LAS float* wsum = (LAS float*)c.lds;
    float v[16]; float tot = 0.f;
#pragma unroll
    for (int i = 0; i < 16; ++i) { v[i] = LFX[(size_t)(c.tid * 16 + i) * 4]; tot += v[i]; }
    float sc = tot;
#pragma unroll
    for (int o = 1; o < 64; o <<= 1) { const float t = shfl_up_l(sc, o, c.lane); if (c.lane >= o) sc += t; }
    if (c.lane == 63) wsum[c.wave] = sc;
    __syncthreads();
    float base = 0.f;
    for (int w = 0; w < c.wave; ++w) base += wsum[w];
    float run = base + sc - tot;
#pragma unroll
    for (int i = 0; i < 16; ++i) { run += v[i]; const float x = -run * 11.313708498984761f;
        const unsigned a = f2bf(x); const float r1 = x - bf2f(a); const unsigned b2 = f2bf(r1); const float r2 = r1 - bf2f(b2); const unsigned c2 = f2bf(r2);
        u32x2 w; w.x = a | (b2 << 16); w.y = c2; KB[c.tid * 16 + i] = w; }
}
#ifndef ATT_ONLY
#define ATT_ONLY 0
#endif
template <int ONLY = ATT_ONLY> __device__ __forceinline__ void attn_phase(KARGS& a, const Ctx& c, int qoff) {
    unsigned char* ws = c.ws; char* lds = (char*)c.lds;
    const bf16* Z = (const bf16*)(ws + WS_ARENA);
    LAS int* slot = (LAS int*)(c.lds + att::LDS_BYTES);
    unsigned* q = (unsigned*)(ws + WS_CTL) + CW_QUEUE + qoff;
    if (ONLY != 2) for (;;) {
        if (c.tid == 0) slot[0] = (int)__hip_atomic_fetch_add(q, 1u, RLX_AGENT);
        __syncthreads();
        const int it = slot[0];
        __syncthreads();
        if (it >= 256) break;
        const int qb = 31 - (it >> 3), bh = it & 7, b = bh >> 2, h = bh & 3; const size_t rb = (size_t)b * SEQ;
        att::BlockRef R; R.Q = Z + (rb + (size_t)qb * 256) * ZP + h * 128; R.K = Z + rb * ZP + 512 + h * 128; R.V = Z + rb * ZP + 1024 + h * 128;
        R.KB = (const u32x2*)(ws + WS_KB) + (size_t)bh * SEQ; R.P0 = qb * 256;
        int tl = c.tid; asm volatile("" : "+v"(tl));
        { const int ln = tl & 63, wv = __builtin_amdgcn_readfirstlane(tl >> 6);
          const f32x4* N2 = (const f32x4*)(ws + WS_NORM2) + rb * 8; LAS float* red = (LAS float*)(c.lds + att::LDS_BYTES + 64); LAS int* jl = (LAS int*)(c.lds + att::LDS_BYTES + 32);
          float km = 0.f, qm = 0.f; const int nk = R.P0 + 256;
          for (int s = tl; s < nk; s += NTHR) { const f32x4 pv = N2[(size_t)s * 8 + 4 + h]; km = fmaxf(km, (pv.x + pv.y) + (pv.z + pv.w)); }
          if (tl < 256) { const f32x4 pv = N2[(size_t)(R.P0 + tl) * 8 + h]; qm = (pv.x + pv.y) + (pv.z + pv.w); }
#pragma unroll
          for (int o = 1; o < 64; o <<= 1) { km = fmaxf(km, shfl_xor_l(km, o, ln)); qm = fmaxf(qm, shfl_xor_l(qm, o, ln)); }
          if (ln == 0) { red[wv] = km; red[8 + wv] = qm; }
          if (tl == 0) jl[0] = qb * 4;
          __syncthreads();
          float K2 = 0.f, Q2 = 0.f;
#pragma unroll
          for (int w = 0; w < 8; ++w) { K2 = fmaxf(K2, red[w]); Q2 = fmaxf(Q2, red[8 + w]); }
          const float B2 = 2.0f * 1.02f * sqrtf(K2 * Q2);
          if (tl < qb * 4) { const u32x2 w1 = R.KB[tl * 64 + 63], w0 = R.KB[R.P0];
              const float kb1 = bflo(w1.x) + bfhi(w1.x) + bflo(w1.y), kb0 = bflo(w0.x) + bfhi(w0.x) + bflo(w0.y);
              if (B2 + (kb1 - kb0) >= -30.0f * 11.313708498984761f) __hip_atomic_fetch_min(jl, tl, __ATOMIC_RELAXED, __HIP_MEMORY_SCOPE_WORKGROUP); }
          __syncthreads();
          R.JLO = jl[0];
          __syncthreads(); }
        att::Seam<128> S;
        att::causal_prime<128, true>(R, lds, S, tl);
        att::causal_block<128, true, 0>(R, R, lds, S, (void*)((bf16*)(ws + WS_CAT) + (rb + (size_t)qb * 256) * DM + h * 128), DM, tl);
    }
    if (ONLY != 1) for (;;) {
        if (c.tid == 0) slot[0] = (int)__hip_atomic_fetch_add(q + 64, 1u, RLX_AGENT);
        __syncthreads();
        const int it = slot[0];
        __syncthreads();
        if (it >= 512) break;
        const int qb = 31 - (it >> 4), d = it & 15, bh = d >> 1, mp = d & 1, b = bh >> 2, h = bh & 3; const size_t rb = (size_t)b * SEQ;
        att::BlockRef R; R.Q = Z + (rb + (size_t)qb * 256) * ZP + 1536 + h * 128 + mp * 64; R.K = Z + rb * ZP + 2048 + h * 128 + mp * 64; R.V = Z + rb * ZP + 2560 + h * 128;
        R.KB = nullptr; R.P0 = qb * 256; R.JLO = 0;
        att::Seam<64> S;
        int tl = c.tid; asm volatile("" : "+v"(tl));
        att::causal_prime<64, false>(R, lds, S, tl);
        att::causal_block<64, false, 1>(R, R, lds, S, (void*)((float*)(ws + WS_DO) + (size_t)mp * T * 512 + (rb + (size_t)qb * 256) * 512 + h * 128), 512, tl);
    }
}
__device__ __forceinline__ void diffnorm_phase(KARGS& a, const Ctx& c) {
    unsigned char* ws = c.ws;
    const float lam = ldf((const float*)(ws + WS_MISC + MISC_LAM)); const float post = 1.0f - (0.8f - 0.6f * expf(-0.3f));
    const float* D0 = (const float*)(ws + WS_DO); const float* D1 = D0 + (size_t)T * 512; bf16* CAT = (bf16*)(ws + WS_CAT);
    const int gw = c.bid * NWAVES + c.wave, NGW = GRID * NWAVES;
    const float g0 = ain(a, 18)[2 * c.lane] * post, g1 = ain(a, 18)[2 * c.lane + 1] * post;
    for (int p0 = gw * 8; p0 < T * 4; p0 += NGW * 8) {
        f32x2 x0[8], x1[8];
#pragma unroll
        for (int k = 0; k < 8; ++k) { const size_t o = (size_t)(p0 + k) * 128 + 2 * c.lane; x0[k] = *(const f32x2*)(D0 + o); x1[k] = *(const f32x2*)(D1 + o); }
#pragma unroll
        for (int k = 0; k < 8; ++k) { const int p = p0 + k, t = p >> 2, h = p & 3; const float y0 = x0[k].x - lam * x1[k].x, y1 = x0[k].y - lam * x1[k].y;
            const float rstd = 1.0f / sqrtf(wave_sum(y0 * y0 + y1 * y1) * (1.0f / 128.0f) + EPS);
            *(unsigned*)(CAT + (size_t)t * DM + 512 + h * 128 + 2 * c.lane) = pk2(y0 * rstd * g0, y1 * rstd * g1); } }
}

__device__ __forceinline__ void moe_scatter_phase(const Ctx& c) {
    unsigned char* ws = c.ws;
    LAS int* soff = (LAS int*)c.lds;
    LAS int* sts = soff + 8;
    LAS int* stot = soff + 32;
    LAS int* spos = soff + 64;
    const int* CNT = (const int*)(ws + WS_MISC + MISC_CNT);
    const bf16* XN = (const bf16*)(ws + WS_XN); bf16* XP = (bf16*)(ws + WS_XP);
    u32x4 rowv[8][2];
#pragma unroll
    for (int k = 0; k < 8; ++k) { const u32x4* src = (const u32x4*)(XN + (size_t)(64 * c.bid + c.wave * 8 + k) * DM); rowv[k][0] = src[c.lane]; rowv[k][1] = src[64 + c.lane]; }
    if (c.wave == 0) {
        typedef int i32x4 __attribute__((ext_vector_type(4)));
        i32x4 cv[8];
#pragma unroll
        for (int k = 0; k < 8; ++k) cv[k] = *((const i32x4*)(CNT + (size_t)c.lane * 32) + k);
        int tot[8], before[8];
#pragma unroll
        for (int e = 0; e < 8; ++e) { int s = 0, bf = 0;
#pragma unroll
            for (int k = 0; k < 4; ++k) { const int w = 4 * c.lane + k; const int v = cv[2 * k + (e >> 2)][e & 3]; s += v; if (w < c.bid) bf += v; }
            tot[e] = s; before[e] = bf; }
#pragma unroll
        for (int e = 0; e < 8; ++e) {
#pragma unroll
            for (int o = 1; o < 64; o <<= 1) { tot[e] += __shfl_xor(tot[e], o); before[e] += __shfl_xor(before[e], o); } }
        int ts = 0, so[8];
#pragma unroll
        for (int e = 0; e < 8; ++e) { if (c.lane == 0) { sts[e] = ts; stot[e] = tot[e]; } so[e] = ts * 256 + before[e]; ts += (tot[e] + 255) >> 8; }
        if (c.lane == 0) { sts[8] = ts; if (c.bid == 0) { int acc = 0; for (int e = 0; e < 8; ++e) { ((int*)(ws + WS_MISC + MISC_TS))[e] = acc; acc += (tot[e] + 255) >> 8; } ((int*)(ws + WS_MISC + MISC_TS))[8] = acc; } }
        const int m = 64 * c.bid + c.lane; const int e1 = ((const int*)(ws + WS_RTE))[2 * m], e2 = ((const int*)(ws + WS_RTE))[2 * m + 1];
        int p1 = 0, p2 = 0;
#pragma unroll
        for (int e = 0; e < 8; ++e) { const unsigned long long mask = __ballot(e1 == e || e2 == e); const int rank = __builtin_popcountll(mask & ((1ull << c.lane) - 1ull));
            if (e1 == e) p1 = so[e] + rank; if (e2 == e) p2 = so[e] + rank; }
        spos[2 * c.lane] = p1; spos[2 * c.lane + 1] = p2;
        ((int*)(ws + WS_PPOS))[2 * m] = p1; ((int*)(ws + WS_PPOS))[2 * m + 1] = p2;
        ((float*)(ws + WS_RW))[p1] = ((const float*)(ws + WS_RTW))[2 * m]; ((float*)(ws + WS_RW))[p2] = ((const float*)(ws + WS_RTW))[2 * m + 1];
    }
    __syncthreads();
#pragma unroll
    for (int k = 0; k < 8; ++k) { const int ti = c.wave * 8 + k;
#pragma unroll
        for (int sl = 0; sl < 2; ++sl) { u32x4* dst = (u32x4*)(XP + (size_t)spos[2 * ti + sl] * DM); dst[c.lane] = rowv[k][0]; dst[64 + c.lane] = rowv[k][1]; } }
    { const int gw = c.bid * NWAVES + c.wave;
      for (int e = 0; e < 8; ++e) { const int tot = stot[e], first = sts[e] * 256 + tot, npad = ((tot + 255) & ~255) - tot;
          for (int i = gw; i < npad; i += GRID * NWAVES) { u32x4* dst = (u32x4*)(XP + (size_t)(first + i) * DM); const u32x4 z = {0u, 0u, 0u, 0u}; dst[c.lane] = z; dst[64 + c.lane] = z;
              if (c.lane == 0) ((float*)(ws + WS_RW))[first + i] = 0.f; } } }
    __syncthreads();
}
#ifndef MK_PER_PHASE
#define MK_PER_PHASE 0
#endif
constexpr int NPHASE = 19;
__global__ void __launch_bounds__(NTHR, 2) fwd_kernel(Args args_by_value) {
    (void)args_by_value;
    extern __shared__ __attribute__((aligned(16))) unsigned char lds_raw[];
    KARGS* ap0 = (KARGS*)__builtin_amdgcn_kernarg_segment_ptr();
    Ctx c_; c_.lds = (LAS unsigned char*)lds_raw; c_.ws = (unsigned char*)(GAS unsigned char*)ap0->ws; c_.tid = threadIdx.x; c_.lane = c_.tid & 63; c_.wave = __builtin_amdgcn_readfirstlane(c_.tid >> 6); c_.bid = blockIdx.x;
    unsigned char* const ws0 = c_.ws;
    for (int u = c_.tid; u < (LDS_BYTES - LDSCTL_OFF) / 4; u += NTHR) ((LAS unsigned*)(c_.lds + LDSCTL_OFF))[u] = 0u;
    __syncthreads();
    XcdBarrier bar; bar.bar = (unsigned*)(ws0 + WS_CTL) + CW_BAR; bar.x = 0; bar.st = nullptr;
    if (!MK_PER_PHASE) bar = xcd_barrier_post((unsigned*)(ws0 + WS_CTL) + CW_BAR, (volatile LAS unsigned*)(c_.lds + LDSCTL_OFF));
    const int lo = ap0->ph_lo, hi = ap0->ph_hi; const int wave0 = c_.wave;
#ifndef PHASE_MASK
#define PHASE_MASK 0xFFFFFFFFu
#endif
#define IN(k) (((PHASE_MASK >> (k)) & 1u) && lo <= (k) && (k) < hi)
#define FRESH() Ctx c = c_; { int t_ = wave0 * 64 + (int)__builtin_amdgcn_mbcnt_hi(~0u, __builtin_amdgcn_mbcnt_lo(~0u, 0u)); asm volatile("" : "+v"(t_)); c.tid = t_; c.lane = t_ & 63; c.wave = __builtin_amdgcn_readfirstlane(t_ >> 6); KARGS* ap_ = (KARGS*)__builtin_amdgcn_kernarg_segment_ptr(); asm volatile("" : "+s"(ap_)); GAS unsigned char* w_ = (GAS unsigned char*)ap_->ws; c.ws = (unsigned char*)w_; } \
    KARGS& args = *(KARGS*)__builtin_amdgcn_kernarg_segment_ptr(); \
    unsigned char* const ws = c.ws; bf16* const XN = (bf16*)(ws + WS_XN); bf16* const CAT = (bf16*)(ws + WS_CAT); bf16* const ZA = (bf16*)(ws + WS_ARENA); bf16* const XR = (bf16*)(ws + WS_XR); (void)XN; (void)CAT; (void)ZA; (void)XR;
#define SEAM(k) do { if (IN(k) && IN((k) + 1)) xcd_barrier(bar); } while (0)
    PG8_LAS unsigned char* glds = (PG8_LAS unsigned char*)lds_raw;

#define QOFF 0
    if (IN(0)) { FRESH(); prologue_weights<0, CONV_FGU_END, false>(args, c); prologue_tables(args, c); __syncthreads(); row_phase<0>(args, c, ain(args, 0), ain(args, 1)); }
    SEAM(0);
    if (IN(1)) { FRESH(); pg8::Gemm g{XN, (const bf16*)(ws + WS_W_EIN), T, 3072, 1024}; pg8::StaticOrder S; S.init(T, 3072, GRID, c.bid);
        pg8::EpiBf16 E{ZA, ZP, nullptr, 0, 0, nullptr, 6, 8, 12}; pg8::gemm_phase<pg8::EpiBf16, pg8::StaticOrder, true, true>(glds, g, S, E, c.tid); }
    SEAM(1);
    if (IN(2)) { FRESH(); for (int u = c.bid; u < 1024; u += GRID) { if (u < 512) ml_state_unit(args, c, u); else sg_unit(args, c, u - 512); } }
    SEAM(2);
    if (IN(3)) { FRESH(); ml_scan_phase(c); }
    SEAM(3);
    if (IN(4)) { FRESH(); for (int u = c.bid; u < 512; u += GRID) ml_out_unit(args, c, u); }
    SEAM(4);
    if (IN(5)) { FRESH(); pg8::Gemm g{CAT, (const bf16*)(ws + WS_W_EOUT), T, 1024, 1024}; pg8::StaticOrder S; S.init(T, 1024, GRID, c.bid);
        pg8::EpiResB<float> E{ain(args, 0), XR, DM}; pg8::gemm_phase<pg8::EpiResB<float>, pg8::StaticOrder, false, true>(glds, g, S, E, c.tid); }
    SEAM(5);
    if (IN(6)) { FRESH(); row_phase<1>(args, c, XR, ain(args, 11)); }
    SEAM(6);
    if (IN(7)) { FRESH(); pg8::Gemm g{XN, (const bf16*)(ws + WS_W_FGU), T, 2 * FF, 1024}; pg8::StaticOrder S; S.init(T, 2 * FF, GRID, c.bid);
        pg8::EpiSwiglu E{ZA, FF}; pg8::gemm_phase<pg8::EpiSwiglu, pg8::StaticOrder, true, true>(glds, g, S, E, c.tid);
        __syncthreads(); conv_dynamic<CONV_FGU_END, CONV_DENSE_ITEMS, false>(args, c, (unsigned*)(ws + WS_CTL) + CW_QUEUE + 384 + (QOFF ? 64 : 0)); }
    SEAM(7);
    if (IN(8)) { FRESH(); pg8::Gemm g{ZA, (const bf16*)(ws + WS_W_FDN), T, 1024, FF}; pg8::StaticOrder S; S.init(T, 1024, GRID, c.bid);
        pg8::EpiResB<bf16> E{XR, XR, DM}; pg8::gemm_phase<pg8::EpiResB<bf16>, pg8::StaticOrder, false, true>(glds, g, S, E, c.tid); }
    SEAM(8);
    if (IN(9)) { FRESH(); row_phase<2>(args, c, XR, ain(args, 14)); }
    SEAM(9);
    if (IN(10)) { FRESH(); fox_cumsum(c); __syncthreads();
        pg8::Gemm g{XN, (const bf16*)(ws + WS_W_OIN), T, 3072, 1024}; pg8::StaticOrder S; S.init(T, 3072, GRID, c.bid);
        pg8::EpiBf16 E{ZA, ZP, (const float*)(ws + WS_ROPE), 6, 10, (float*)(ws + WS_NORM2), 99, 99, 99}; pg8::gemm_phase<pg8::EpiBf16, pg8::StaticOrder, true, true>(glds, g, S, E, c.tid); }
    SEAM(10);
    if (IN(11)) { FRESH(); attn_phase(args, c, QOFF); }
    SEAM(11);
    if (IN(12)) { FRESH(); diffnorm_phase(args, c); }
    SEAM(12);
    if (IN(13)) { FRESH(); pg8::Gemm g{CAT, (const bf16*)(ws + WS_W_OOUT), T, 1024, 1024}; pg8::StaticOrder S; S.init(T, 1024, GRID, c.bid);
        pg8::EpiResB<bf16> E{XR, XR, DM}; pg8::gemm_phase<pg8::EpiResB<bf16>, pg8::StaticOrder, false, true>(glds, g, S, E, c.tid); }
    SEAM(13);
    if (IN(14)) { FRESH(); row_phase<3>(args, c, XR, ain(args, 20)); }
    SEAM(14);
    if (IN(15)) { FRESH(); moe_scatter_phase(c); prologue_weights<CONV_DENSE_ITEMS, CONV_MGU_END, true>(args, c); }
    SEAM(15);
    if (IN(16)) { FRESH(); pg8::Gemm g{(const bf16*)(ws + WS_XP), (const bf16*)(ws + WS_W_MGU), 0, 2 * FFE, 1024}; pg8::MoeOrder S;
#pragma unroll
        for (int e = 0; e < 9; ++e) S.ts[e] = __builtin_amdgcn_readfirstlane(ldi((const int*)(ws + WS_MISC + MISC_TS) + e));
        S.nM = S.ts[8]; S.nN = 2 * FFE / 256; S.nwg = S.nM * S.nN; S.G = GRID; S.c = c.bid;
        pg8::EpiSwiglu E{ZA, FFE}; pg8::gemm_phase<pg8::EpiSwiglu, pg8::MoeOrder, true, true>(glds, g, S, E, c.tid);
        __syncthreads(); conv_dynamic<CONV_MGU_END, CONV_ALL_ITEMS, true>(args, c, (unsigned*)(ws + WS_CTL) + CW_QUEUE + 256 + (QOFF ? 64 : 0)); }
    SEAM(16);
    if (IN(17)) { FRESH(); pg8::Gemm g{ZA, (const bf16*)(ws + WS_W_MDN), 0, 1024, FFE}; pg8::HybridOrder S;
#pragma unroll
        for (int e = 0; e < 9; ++e) S.ts[e] = __builtin_amdgcn_readfirstlane(ldi((const int*)(ws + WS_MISC + MISC_TS) + e));
        S.nN = 4; S.NKT = FFE / 64; S.U = S.ts[8] * 4; S.G = GRID; S.c = c.bid;
        pg8::EpiMoeDownSK E{(bf16*)(ws + WS_Y), DM, (const float*)(ws + WS_RW), (float*)(ws + WS_XP), pg8::hyb_SL(S.U - 512)}; pg8::gemm_phase<pg8::EpiMoeDownSK, pg8::HybridOrder, true, true>(glds, g, S, E, c.tid); }
    SEAM(17);
    if (IN(18)) { FRESH(); row_phase<4>(args, c, XR, ain(args, 24)); }
#undef QOFF
#undef IN
#undef SEAM
}

extern "C" void kernel_launch(void* const* d_in, const int* in_sizes, int n_in, void* d_out, int out_size, void* d_ws, size_t ws_size, hipStream_t stream) {
    static int ready = 0;
    if (ready == 0) {
        if (n_in != 25 || in_sizes[0] != T * DM || out_size != T * DM || ws_size < WS_END) {
            fprintf(stderr, "kernel_launch: built for 25 inputs, x/out of %d floats, >= %zu bytes of workspace; got n_in %d in0 %d out %d ws %zu; nothing launched\n", T * DM, (size_t)WS_END, n_in, n_in > 0 ? in_sizes[0] : -1, out_size, ws_size);
            ready = -1; return; }
        if (hipFuncSetAttribute((const void*)fwd_kernel, hipFuncAttributeMaxDynamicSharedMemorySize, LDS_BYTES) != hipSuccess) { fprintf(stderr, "kernel_launch: hipFuncSetAttribute(%d) failed\n", LDS_BYTES); ready = -1; return; }
        int dev = 0, cus = 0, per_cu = 0; (void)hipGetDevice(&dev); (void)hipDeviceGetAttribute(&cus, hipDeviceAttributeMultiprocessorCount, dev);
        if (hipOccupancyMaxActiveBlocksPerMultiprocessor(&per_cu, (const void*)fwd_kernel, NTHR, LDS_BYTES) != hipSuccess) per_cu = -1;
        (void)hipGetLastError();
        if (cus < GRID || per_cu < 1) fprintf(stderr, "kernel_launch: note: %d CUs, occupancy query %d; the kernel needs %d co-resident workgroups (one per CU)\n", cus, per_cu, GRID);
        ready = 1;
    }
    if (ready < 0) return;
    (void)hipMemsetAsync((char*)d_ws + WS_CTL, 0, CTL_ZERO_BYTES, stream);
    Args a{};
    for (int i = 0; i < 25; ++i) a.in[i] = (const float*)d_in[i];
    a.out = (float*)d_out; a.ws = (unsigned char*)d_ws;
#if MK_PER_PHASE
    for (int p = 0; p < NPHASE; ++p) { a.ph_lo = p; a.ph_hi = p + 1; hipLaunchKernelGGL(fwd_kernel, dim3(GRID), dim3(NTHR), LDS_BYTES, stream, a); }
#else
    a.ph_lo = 0; a.ph_hi = NPHASE; hipLaunchKernelGGL(fwd_kernel, dim3(GRID), dim3(NTHR), LDS_BYTES, stream, a);
#endif
    const hipError_t le = hipPeekAtLastError();
    if (le != hipSuccess) fprintf(stderr, "kernel_launch: launch failed: %s\n", hipGetErrorName(le));
}
```

```cpp
#include <hip/hip_runtime.h>
#include <cstdio>
#include <cstdint>

#define LAS __attribute__((address_space(3)))
#define GAS __attribute__((address_space(1)))
typedef unsigned short bf16;
typedef unsigned short bf16_t;
typedef short bf16x8 __attribute__((ext_vector_type(8)));
typedef short s16x4 __attribute__((ext_vector_type(4)));
typedef float f32x2 __attribute__((ext_vector_type(2)));
typedef float f32x4 __attribute__((ext_vector_type(4)));
typedef float f32x16 __attribute__((ext_vector_type(16)));
typedef unsigned u32x2 __attribute__((ext_vector_type(2)));
typedef unsigned u32x4 __attribute__((ext_vector_type(4)));
typedef GAS unsigned gu32;
#define RLX_AGENT __ATOMIC_RELAXED, __HIP_MEMORY_SCOPE_AGENT
#define LDS_WAIT() asm volatile("s_waitcnt lgkmcnt(0)" ::: "memory")
#define VM_WAIT() asm volatile("s_waitcnt vmcnt(0)" ::: "memory")

typedef __bf16 bf16x2_t __attribute__((ext_vector_type(2)));
__device__ __forceinline__ unsigned pk2(float lo, float hi) { const f32x2 v = {lo, hi}; return __builtin_bit_cast(unsigned, __builtin_convertvector(v, bf16x2_t)); }
__device__ __forceinline__ unsigned f2bf(float f) { return pk2(f, 0.f) & 0xffffu; }
__device__ __forceinline__ float bf2f(unsigned b) { return __builtin_bit_cast(float, b << 16); }
__device__ __forceinline__ float bflo(unsigned w) { return __builtin_bit_cast(float, w << 16); }
__device__ __forceinline__ float bfhi(unsigned w) { return __builtin_bit_cast(float, w & 0xffff0000u); }
__device__ __forceinline__ float ldf(const float* p) { return __builtin_bit_cast(float, __hip_atomic_load((const unsigned*)p, RLX_AGENT)); }
__device__ __forceinline__ int ldi(const int* p) { return __hip_atomic_load(p, RLX_AGENT); }
__device__ __forceinline__ float wave_sum(float v) {
#define DPPF(x, ctrl, rmask) __builtin_bit_cast(float, __builtin_amdgcn_update_dpp(0, __builtin_bit_cast(int, x), ctrl, rmask, 0xF, true))
    v += DPPF(v, 0xB1, 0xF);
    v += DPPF(v, 0x4E, 0xF);
    v += DPPF(v, 0x141, 0xF);
    v += DPPF(v, 0x140, 0xF);
    v += DPPF(v, 0x142, 0xA);
    v += DPPF(v, 0x143, 0xC);
#undef DPPF
    return __builtin_bit_cast(float, __builtin_amdgcn_readlane(__builtin_bit_cast(int, v), 63));
}
__device__ __forceinline__ float wave_max(float v) {
#pragma unroll
    for (int o = 1; o < 64; o <<= 1) v = fmaxf(v, __shfl_xor(v, o));
    return v;
}
__device__ __forceinline__ float shfl_up_l(float v, int o, int lane) { const int src = (lane >= o) ? lane - o : lane; return __builtin_bit_cast(float, __builtin_amdgcn_ds_bpermute(src << 2, __builtin_bit_cast(int, v))); }
__device__ __forceinline__ float shfl_idx_l(float v, int src) { return __builtin_bit_cast(float, __builtin_amdgcn_ds_bpermute(src << 2, __builtin_bit_cast(int, v))); }
__device__ __forceinline__ float shfl_xor_l(float v, int o, int lane) { return __builtin_bit_cast(float, __builtin_amdgcn_ds_bpermute((lane ^ o) << 2, __builtin_bit_cast(int, v))); }
__device__ __forceinline__ float quad_xor1(float v) { return __builtin_bit_cast(float, __builtin_amdgcn_update_dpp(0, __builtin_bit_cast(int, v), 0xB1, 0xF, 0xF, true)); }
__device__ __forceinline__ float quad_xor2(float v) { return __builtin_bit_cast(float, __builtin_amdgcn_update_dpp(0, __builtin_bit_cast(int, v), 0x4E, 0xF, 0xF, true)); }
__device__ __forceinline__ float quad_sum(float v) { v += quad_xor1(v); v += quad_xor2(v); return v; }
__device__ __forceinline__ float fast_exp(float x) { return __builtin_amdgcn_exp2f(x * 1.4426950408889634f); }
__device__ __forceinline__ float sigmoidf_(float x) { return __builtin_amdgcn_rcpf(1.0f + fast_exp(-x)); }
__device__ __forceinline__ float siluf_(float x) { return x * sigmoidf_(x); }
__device__ __forceinline__ float gelu_tanh(float x) {
    const float x2 = x * x, t = fmaf(x2, -2.3022082299f * 0.044715f, -2.3022082299f);
    return x * __builtin_amdgcn_rcpf(1.0f + __builtin_amdgcn_exp2f(x * t));
}
__device__ __forceinline__ float log_sigmoid_acc(float x) { return fminf(x, 0.f) - log1pf(expf(-fabsf(x))); }

namespace pg8 {
#define PG8_LAS __attribute__((address_space(3)))
constexpr int BM = 256, BK = 64, HALF = 128, HTB = HALF * BK * 2, STAGE_BYTES = 8 * HTB, NXCD = 8, WGM = 8;
__host__ __device__ __forceinline__ int lds_byte(int r, int c) { const int st = (r >> 4) * 2 + (c >> 5), rr = r & 15, cc = c & 31, ob = rr * 64 + cc * 2; return st * 1024 + (ob ^ (((ob >> 9) & 1) << 5)); }
__host__ __device__ __forceinline__ void stage_rc(int b, int& R, int& C) { const int st = b / 1024, sb = b % 1024, swz = sb ^ (((sb >> 9) & 1) << 5); R = (st >> 1) * 16 + swz / 64; C = (st & 1) * 32 + (swz % 64) / 2; }
__host__ __device__ __forceinline__ int perm32(int rho) { const int n = rho >> 4, i = rho & 15; return 8 * (i >> 2) + 4 * n + (i & 3); }

struct Unit { int pm, pn, pb, kt0, nkt; };
struct Gemm { const bf16_t* A; const bf16_t* Bt; int M, N, K; const int* aidx = nullptr; };

struct StaticOrder {
    int nM, nN, nwg, G, c; int wgm = WGM;
    __host__ __device__ void init(int M, int N, int G_, int c_) { nM = M / BM; nN = N / BM; nwg = nM * nN; G = G_; c = c_; }
    __host__ __device__ __forceinline__ bool next(int i, Unit& u) const {
        const long L = (long)i * G + c; if (L >= nwg) return false;
        int wgid = (int)L; { const int q = nwg / NXCD, r = nwg % NXCD, xcd = wgid % NXCD, off = wgid / NXCD; wgid = (xcd < r ? xcd * (q + 1) : r * (q + 1) + (xcd - r) * q) + off; }
        const int nig = wgm * nN, gid = wgid / nig, fm = gid * wgm, gsz = (nM - fm) < wgm ? (nM - fm) : wgm;
        u.pm = fm + ((wgid % nig) % gsz); u.pn = (wgid % nig) / gsz; u.pb = u.pn; return true;
    }
    static constexpr bool KRANGE = false;
    __device__ __forceinline__ void a_ready(const Unit&) const {}
    __device__ __forceinline__ void done(const Unit&) const {}
};
struct MoeOrder {
    int nM, nN, nwg, G, c; int ts[9]; int wgm = WGM;
    __device__ __forceinline__ bool next(int i, Unit& u) const {
        const long L = (long)i * G + c; if (L >= nwg) return false;
        int wgid = (int)L; { const int q = nwg / NXCD, r = nwg % NXCD, xcd = wgid % NXCD, off = wgid / NXCD; wgid = (xcd < r ? xcd * (q + 1) : r * (q + 1) + (xcd - r) * q) + off; }
        const int nig = wgm * nN, gid = wgid / nig, fm = gid * wgm, gsz = (nM - fm) < wgm ? (nM - fm) : wgm;
        u.pm = fm + ((wgid % nig) % gsz); u.pn = (wgid % nig) / gsz;
        int e = 0;
#pragma unroll
        for (int k = 1; k < 8; ++k) e += (u.pm >= ts[k]) ? 1 : 0;
        u.pb = e * nN + u.pn; return true;
    }
    static constexpr bool KRANGE = false;
    __device__ __forceinline__ void a_ready(const Unit&) const {}
    __device__ __forceinline__ void done(const Unit&) const {}
};
__host__ __device__ __forceinline__ int hyb_SL(int R) { return R <= 9 ? 28 : (R <= 18 ? 14 : (R <= 36 ? 7 : 4)); }
struct HybridOrder {
    int U, c, nN, NKT, G; int ts[9];
    __device__ __forceinline__ bool next(int i, Unit& u) const {
        const bool full = i < 2; const int R = U - 512, SL = hyb_SL(R), ui = c / SL, sl = c - ui * SL;
        if (!full && (i > 2 || R <= 0 || ui >= R)) return false;
        int wgid = i * G + c; { const int q = 512 / NXCD, xcd = wgid % NXCD, off = wgid / NXCD; wgid = xcd * q + off; }
        const int nig = WGM * nN, fm = (wgid / nig) * WGM, pm_f = fm + ((wgid % nig) % WGM), pn_f = (wgid % nig) / WGM;
        const int unit = 512 + ui, pm_s = unit / nN, pn_s = unit - pm_s * nN, nk_s = NKT / SL;
        const int pm = full ? pm_f : pm_s, pn = full ? pn_f : pn_s, nkt = full ? NKT : nk_s, kt0 = full ? 0 : sl * nk_s;
        int e = 0;
#pragma unroll
        for (int k = 1; k < 8; ++k) e += (pm >= ts[k]) ? 1 : 0;
        u.pm = pm; u.pn = pn; u.pb = e * nN + pn; u.kt0 = kt0; u.nkt = nkt; return true;
    }
    static constexpr bool KRANGE = true;
    __device__ __forceinline__ void a_ready(const Unit&) const {}
    __device__ __forceinline__ void done(const Unit&) const {}
};

__device__ __forceinline__ unsigned cvt_pk_bf16(float lo, float hi) { unsigned r; asm volatile("v_cvt_pk_bf16_f32 %0, %1, %2" : "=v"(r) : "v"(lo), "v"(hi)); return r; }

struct EpiBf16 {
    static constexpr bool PERM = true, AFTER_DRAIN = false;
    bf16_t* O; int ldc; const float* cs; int rope_pn0, rope_pn1; float* norm2; int sig_pn0, gelu_pn0, gelu_pn1;
    __device__ __forceinline__ void operator()(const f32x4 (&acc)[2][2][4][2], const Unit& u, int wr, int wc, int fr, int fq) const {
        const int row0 = u.pm * BM + wr * 64 + fr; const int col0 = u.pn * BM + wc * 32 + 8 * fq;
        if (norm2 != nullptr && u.pn < 4) {
#pragma unroll
            for (int ai = 0; ai < 2; ++ai)
#pragma unroll
                for (int m = 0; m < 4; ++m)
#pragma unroll
                    for (int bj = 0; bj < 2; ++bj) { const f32x4 a0 = acc[ai][bj][m][0], a1 = acc[ai][bj][m][1];
                        float s = (a0[0] * a0[0] + a0[1] * a0[1]) + (a0[2] * a0[2] + a0[3] * a0[3]) + (a1[0] * a1[0] + a1[1] * a1[1]) + (a1[2] * a1[2] + a1[3] * a1[3]);
                        s += __shfl_xor(s, 16); s += __shfl_xor(s, 32);
                        if (fq == 0) norm2[((size_t)(row0 + ai * HALF + m * 16) * 8 + (u.pn >> 1) * 4 + (u.pn & 1) * 2 + bj) * 4 + wc] = s; }
        }
        const bool rope = (u.pn >= rope_pn0) && (u.pn < rope_pn1) && ((wc & 1) == 0);
        const float sgn = (fq == 0) ? -1.f : 1.f;
#pragma unroll
        for (int ai = 0; ai < 2; ++ai)
#pragma unroll
            for (int m = 0; m < 4; ++m) { const int row = row0 + ai * HALF + m * 16; bf16_t* rowp = O + (size_t)row * ldc + col0;
                f32x4 c0 = {1.f, 1.f, 1.f, 1.f}, c1 = c0, s0 = {0.f, 0.f, 0.f, 0.f}, s1 = s0;
                if (rope) {
                    const float pos = (float)(row & 8191);
                    constexpr float IR[8] = {0.15915494309189535f, 0.03086376340470123f, 0.0059851857127137054f, 0.001160663641240061f, 0.00022507907903927653f, 4.3647952792802891e-05f, 8.4643308082414014e-06f, 1.6414262627950345e-06f};
#pragma unroll
                    for (int k = 0; k < 4; ++k) { const float r0 = __builtin_amdgcn_fractf(pos * IR[k]), r1 = __builtin_amdgcn_fractf(pos * IR[4 + k]);
                        c0[k] = __builtin_amdgcn_cosf(r0); s0[k] = __builtin_amdgcn_sinf(r0); c1[k] = __builtin_amdgcn_cosf(r1); s1[k] = __builtin_amdgcn_sinf(r1); } }
#pragma unroll
                for (int bj = 0; bj < 2; ++bj) { f32x4 v0 = acc[ai][bj][m][0], v1 = acc[ai][bj][m][1];
                    if (u.pn >= gelu_pn0 && u.pn < gelu_pn1) {
#pragma unroll
                        for (int i = 0; i < 4; ++i) { v0[i] = gelu_tanh(v0[i]); v1[i] = gelu_tanh(v1[i]); } }
                    else if (u.pn >= sig_pn0 && u.pn < gelu_pn0) {
#pragma unroll
                        for (int i = 0; i < 4; ++i) { v0[i] = sigmoidf_(v0[i]); v1[i] = sigmoidf_(v1[i]); } }
                    if (rope) { f32x4 p0, p1;
#pragma unroll
                        for (int i = 0; i < 4; ++i) { p0[i] = __shfl_xor(v0[i], 16); p1[i] = __shfl_xor(v1[i], 16); }
                        if (fq < 2) { v0 = v0 * c0 + (p0 * s0) * sgn; v1 = v1 * c1 + (p1 * s1) * sgn; } }
                    u32x4 w; w.x = cvt_pk_bf16(v0[0], v0[1]); w.y = cvt_pk_bf16(v0[2], v0[3]); w.z = cvt_pk_bf16(v1[0], v1[1]); w.w = cvt_pk_bf16(v1[2], v1[3]);
                    *(u32x4*)(rowp + bj * HALF) = w; } }
    }
};
struct EpiResF32 {
    static constexpr bool PERM = false, AFTER_DRAIN = false;
    const float* base; float* out; int ldc;
    __device__ __forceinline__ void operator()(const f32x4 (&acc)[2][2][4][2], const Unit& u, int wr, int wc, int fr, int fq) const {
        const int row0 = u.pm * BM + wr * 64 + fr, col0 = u.pn * BM + wc * 32 + 4 * fq;
#pragma unroll
        for (int ai = 0; ai < 2; ++ai) {
            f32x4 b[4][2][2];
#pragma unroll
            for (int m = 0; m < 4; ++m) { const size_t off = (size_t)(row0 + ai * HALF + m * 16) * ldc + col0;
#pragma unroll
                for (int bj = 0; bj < 2; ++bj)
#pragma unroll
                    for (int n = 0; n < 2; ++n) b[m][bj][n] = *(const f32x4*)(base + off + bj * HALF + n * 16); }
#pragma unroll
            for (int m = 0; m < 4; ++m) { const size_t off = (size_t)(row0 + ai * HALF + m * 16) * ldc + col0;
#pragma unroll
                for (int bj = 0; bj < 2; ++bj)
#pragma unroll
                    for (int n = 0; n < 2; ++n) *(f32x4*)(out + off + bj * HALF + n * 16) = b[m][bj][n] + acc[ai][bj][m][n]; }
            asm volatile("" ::: "memory"); }
    }
};
template <class TB>
struct EpiResB {
    static constexpr bool PERM = true, AFTER_DRAIN = false;
    const TB* base; bf16_t* out; int ldc;
    __device__ __forceinline__ void operator()(const f32x4 (&acc)[2][2][4][2], const Unit& u, int wr, int wc, int fr, int fq) const {
        constexpr bool F32 = sizeof(TB) == 4;
        const int row0 = u.pm * BM + wr * 64 + fr, col0 = u.pn * BM + wc * 32 + 8 * fq;
#pragma unroll
        for (int ai = 0; ai < 2; ++ai) {
            f32x4 bf[F32 ? 4 : 1][2][2]; u32x4 bb[F32 ? 1 : 4][2];
#pragma unroll
            for (int m = 0; m < 4; ++m) { const size_t off = (size_t)(row0 + ai * HALF + m * 16) * ldc + col0;
#pragma unroll
                for (int bj = 0; bj < 2; ++bj) {
                    if constexpr (F32) { bf[m][bj][0] = __builtin_nontemporal_load((const f32x4*)((const float*)base + off + bj * HALF)); bf[m][bj][1] = __builtin_nontemporal_load((const f32x4*)((const float*)base + off + bj * HALF + 4)); }
                    else bb[m][bj] = __builtin_nontemporal_load((const u32x4*)((const bf16_t*)base + off + bj * HALF)); } }
#pragma unroll
            for (int m = 0; m < 4; ++m) { const size_t off = (size_t)(row0 + ai * HALF + m * 16) * ldc + col0;
#pragma unroll
                for (int bj = 0; bj < 2; ++bj) { f32x4 r0, r1;
                    if constexpr (F32) { r0 = bf[m][bj][0]; r1 = bf[m][bj][1]; }
                    else { const u32x4 w = bb[m][bj]; r0 = (f32x4){bflo(w.x), bfhi(w.x), bflo(w.y), bfhi(w.y)}; r1 = (f32x4){bflo(w.z), bfhi(w.z), bflo(w.w), bfhi(w.w)}; }
                    const f32x4 v0 = r0 + acc[ai][bj][m][0], v1 = r1 + acc[ai][bj][m][1];
                    u32x4 o; o.x = cvt_pk_bf16(v0[0], v0[1]); o.y = cvt_pk_bf16(v0[2], v0[3]); o.z = cvt_pk_bf16(v1[0], v1[1]); o.w = cvt_pk_bf16(v1[2], v1[3]);
                    *(u32x4*)(out + off + bj * HALF) = o; } }
            asm volatile("" ::: "memory"); }
    }
};
struct EpiSwiglu {
    static constexpr bool PERM = true, AFTER_DRAIN = false;
    bf16_t* O; int ldc;
    __device__ __forceinline__ void operator()(const f32x4 (&acc)[2][2][4][2], const Unit& u, int wr, int wc, int fr, int fq) const {
        const int row0 = u.pm * BM + wr * 64 + fr; const int col0 = u.pn * HALF + wc * 32 + 8 * fq;
#pragma unroll
        for (int ai = 0; ai < 2; ++ai)
#pragma unroll
            for (int m = 0; m < 4; ++m) { bf16_t* rowp = O + (size_t)(row0 + ai * HALF + m * 16) * ldc + col0;
                f32x4 h0, h1;
#pragma unroll
                for (int i = 0; i < 4; i += 2) {
                    const f32x2 g0 = {acc[ai][0][m][0][i], acc[ai][0][m][0][i + 1]}, u0 = {acc[ai][1][m][0][i], acc[ai][1][m][0][i + 1]};
                    const f32x2 g1 = {acc[ai][0][m][1][i], acc[ai][0][m][1][i + 1]}, u1 = {acc[ai][1][m][1][i], acc[ai][1][m][1][i + 1]};
                    const f32x2 t0 = g0 * (f32x2){-1.4426950408889634f, -1.4426950408889634f}, t1 = g1 * (f32x2){-1.4426950408889634f, -1.4426950408889634f};
                    const f32x2 d0 = (f32x2){__builtin_amdgcn_exp2f(t0.x), __builtin_amdgcn_exp2f(t0.y)} + (f32x2){1.f, 1.f}, d1 = (f32x2){__builtin_amdgcn_exp2f(t1.x), __builtin_amdgcn_exp2f(t1.y)} + (f32x2){1.f, 1.f};
                    const f32x2 r0 = (g0 * u0) * (f32x2){__builtin_amdgcn_rcpf(d0.x), __builtin_amdgcn_rcpf(d0.y)}, r1 = (g1 * u1) * (f32x2){__builtin_amdgcn_rcpf(d1.x), __builtin_amdgcn_rcpf(d1.y)};
                    h0[i] = r0.x; h0[i + 1] = r0.y; h1[i] = r1.x; h1[i + 1] = r1.y; }
                u32x4 w; w.x = cvt_pk_bf16(h0[0], h0[1]); w.y = cvt_pk_bf16(h0[2], h0[3]); w.z = cvt_pk_bf16(h1[0], h1[1]); w.w = cvt_pk_bf16(h1[2], h1[3]);
                *(u32x4*)rowp = w; }
    }
};
#if defined(PROBE_EPI)
struct EpiNone { static constexpr bool PERM = true, AFTER_DRAIN = false; bf16_t* O; int ldc;
    __device__ __forceinline__ void operator()(const f32x4 (&acc)[2][2][4][2], const Unit& u, int wr, int wc, int fr, int fq) const {
        float s = 0.f;
#pragma unroll
        for (int ai = 0; ai < 2; ++ai)
#pragma unroll
            for (int bj = 0; bj < 2; ++bj)
#pragma unroll
                for (int m = 0; m < 4; ++m)
#pragma unroll
                    for (int n = 0; n < 2; ++n) s += acc[ai][bj][m][n][0];
        if (s == 12345.678f) O[0] = 1; } };
struct EpiSwigluCheap {
    static constexpr bool PERM = true, AFTER_DRAIN = false;
    bf16_t* O; int ldc;
    __device__ __forceinline__ void operator()(const f32x4 (&acc)[2][2][4][2], const Unit& u, int wr, int wc, int fr, int fq) const {
        const int row0 = u.pm * BM + wr * 64 + fr; const int col0 = u.pn * HALF + wc * 32 + 8 * fq;
#pragma unroll
        for (int ai = 0; ai < 2; ++ai)
#pragma unroll
            for (int m = 0; m < 4; ++m) { bf16_t* rowp = O + (size_t)(row0 + ai * HALF + m * 16) * ldc + col0;
                const f32x4 h0 = acc[ai][0][m][0] * acc[ai][1][m][0], h1 = acc[ai][0][m][1] * acc[ai][1][m][1];
                u32x4 w; w.x = cvt_pk_bf16(h0[0], h0[1]); w.y = cvt_pk_bf16(h0[2], h0[3]); w.z = cvt_pk_bf16(h1[0], h1[1]); w.w = cvt_pk_bf16(h1[2], h1[3]);
                *(u32x4*)rowp = w; }
    }
};
#endif
struct EpiMoeDown {
    static constexpr bool PERM = false, AFTER_DRAIN = false;
    float* Y; int ldc; const float* rw;
    __device__ __forceinline__ void operator()(const f32x4 (&acc)[2][2][4][2], const Unit& u, int wr, int wc, int fr, int fq) const {
        const int row0 = u.pm * BM + wr * 64 + fr, col0 = u.pn * BM + wc * 32 + 4 * fq;
#pragma unroll
        for (int ai = 0; ai < 2; ++ai)
#pragma unroll
            for (int m = 0; m < 4; ++m) { const int row = row0 + ai * HALF + m * 16; const float w = ldf(rw + row); const size_t off = (size_t)row * ldc + col0;
#pragma unroll
                for (int bj = 0; bj < 2; ++bj)
#pragma unroll
                    for (int n = 0; n < 2; ++n) *(f32x4*)(Y + off + bj * HALF + n * 16) = acc[ai][bj][m][n] * w; }
    }
};

struct EpiMoeDownSK {
    static constexpr bool PERM = true, AFTER_DRAIN = false;
    bf16_t* Y; int ldc; const float* rw; bf16_t* slab; int SL;
    __device__ __forceinline__ void operator()(const f32x4 (&acc)[2][2][4][2], const Unit& u, int wr, int wc, int fr, int fq) const {
        const int r0 = wr * 64 + fr, c0 = wc * 32 + 8 * fq; const bool second = u.kt0 != 0;
        const int sidx = second ? (u.pm * 4 + u.pn - 512) * (SL - 1) + u.kt0 / u.nkt - 1 : 0;
        bf16_t* sb = slab + (size_t)sidx * 65536 + c0; bf16_t* yb = Y + (size_t)(u.pm * BM) * ldc + u.pn * BM + c0;
        float wv[2][4];
#pragma unroll
        for (int ai = 0; ai < 2; ++ai)
#pragma unroll
            for (int m = 0; m < 4; ++m) wv[ai][m] = rw[u.pm * BM + r0 + ai * HALF + m * 16];
#pragma unroll
        for (int ai = 0; ai < 2; ++ai)
#pragma unroll
            for (int m = 0; m < 4; ++m) { const int r = r0 + ai * HALF + m * 16; const float w = wv[ai][m];
#pragma unroll
                for (int bj = 0; bj < 2; ++bj) { const f32x4 v0 = acc[ai][bj][m][0] * w, v1 = acc[ai][bj][m][1] * w;
                    u32x4 o; o.x = cvt_pk_bf16(v0[0], v0[1]); o.y = cvt_pk_bf16(v0[2], v0[3]); o.z = cvt_pk_bf16(v1[0], v1[1]); o.w = cvt_pk_bf16(v1[2], v1[3]);
                    *(u32x4*)(second ? sb + (size_t)r * 256 + bj * HALF : yb + (size_t)r * ldc + bj * HALF) = o; } }
    }
};

template <class Epi, class Sched, bool ALIGN_EPI = false, bool SP2 = false, bool GATHER = false>
__device__ __forceinline__ void gemm_phase(PG8_LAS unsigned char* lds, const Gemm g, const Sched& S, const Epi& E, const int tid) {
    const int wid = __builtin_amdgcn_readfirstlane(tid >> 6), lane = tid & 63, wr = wid >> 2, wc = wid & 3, fr = lane & 15, fq = lane >> 4;
    const int K = g.K; int nt = K / BK;
    unsigned voffA[2], voffB[2]; int gR[2], gC[2];
#pragma unroll
    for (int i = 0; i < 2; ++i) { int R, C; stage_rc(tid * 16 + i * 8192, R, C); const int Rb = Epi::PERM ? ((R & ~31) + perm32(R & 31)) : R;
        voffA[i] = (unsigned)(R * K + C) * 2u; voffB[i] = (unsigned)(Rb * K + C) * 2u; gR[i] = R; gC[i] = C; }
    unsigned vA[2][2] = {{0u, 0u}, {0u, 0u}}, nvA[2][2] = {{0u, 0u}, {0u, 0u}}, sA[2][2] = {{0u, 0u}, {0u, 0u}}; (void)vA; (void)nvA; (void)sA; (void)gR; (void)gC; (void)voffA;
    const size_t kstep = (size_t)(BK * 2);
    const size_t hstep = (size_t)HALF * K * 2;
    const size_t tstep = 2 * hstep;
    const unsigned ldsw = (unsigned)wid * 1024u;
    const int aoff = lds_byte(wr * 64 + fr, fq * 8), boff = lds_byte(wc * 32 + fr, fq * 8);
#define PG8_SA(b, h) (((b) * 2 + (h)) * HTB)
#define PG8_SB(b, h) ((4 + (b) * 2 + (h)) * HTB)
#define PG8_STAGE(bufoff, gbase, voff) do { _Pragma("unroll") for (int _i = 0; _i < 2; ++_i) \
        __builtin_amdgcn_global_load_lds((const unsigned*)((const char*)(gbase) + (voff)[_i]), (PG8_LAS unsigned*)(lds + (bufoff) + ldsw + _i * 8192), 16, 0, 0); } while (0)
#define PG8_STAGE_A(bufoff, ptr, h, V) do { _Pragma("unroll") for (int _i = 0; _i < 2; ++_i) { \
        if constexpr (GATHER) __builtin_amdgcn_global_load_lds((const unsigned*)((const char*)(ptr) + (V)[h][_i]), (PG8_LAS unsigned*)(lds + (bufoff) + ldsw + _i * 8192), 16, 0, 0); \
        else __builtin_amdgcn_global_load_lds((const unsigned*)((const char*)(ptr) + (size_t)(h) * hstep + voffA[_i]), (PG8_LAS unsigned*)(lds + (bufoff) + ldsw + _i * 8192), 16, 0, 0); } } while (0)
#define PG8_GIDX(u_, O) do { _Pragma("unroll") for (int _h = 0; _h < 2; ++_h) _Pragma("unroll") for (int _i = 0; _i < 2; ++_i) \
        O[_h][_i] = (unsigned)(g.aidx[(u_).pm * BM + gR[_i] + _h * HALF] * K + gC[_i]) * 2u; } while (0)
#define PG8_LDA(dst, b, h) do { _Pragma("unroll") for (int m = 0; m < 4; ++m) _Pragma("unroll") for (int k = 0; k < 2; ++k) dst[m][k] = *(const PG8_LAS bf16x8*)(lds + PG8_SA(b, h) + aoff + m * 2048 + k * 1024); } while (0)
#define PG8_LDB(dst, b, h) do { _Pragma("unroll") for (int n = 0; n < 2; ++n) _Pragma("unroll") for (int k = 0; k < 2; ++k) dst[n][k] = *(const PG8_LAS bf16x8*)(lds + PG8_SB(b, h) + boff + n * 2048 + k * 1024); } while (0)
#define PG8_MMA(ai, bj, At, Bt) do { __builtin_amdgcn_s_setprio(1); _Pragma("unroll") for (int m = 0; m < 4; ++m) _Pragma("unroll") for (int n = 0; n < 2; ++n) _Pragma("unroll") for (int k = 0; k < 2; ++k) \
        acc[ai][bj][m][n] = __builtin_amdgcn_mfma_f32_16x16x32_bf16(Bt[n][k], At[m][k], acc[ai][bj][m][n], 0, 0, 0); __builtin_amdgcn_s_setprio(0); } while (0)
#define PG8_WAIT_V(n) asm volatile("s_waitcnt vmcnt(" #n ")" ::: "memory")
#define PG8_WAIT_L(n) asm volatile("s_waitcnt lgkmcnt(" #n ")" ::: "memory")
#define PG8_BAR __builtin_amdgcn_s_barrier()
#define PG8_SCHED __builtin_amdgcn_sched_barrier(0)
    Unit cur, nxt; int ui = 0;
    if (!S.next(0, cur)) return;
    f32x4 acc[2][2][4][2];
#pragma unroll
    for (int a = 0; a < 2; ++a)
#pragma unroll
        for (int b = 0; b < 2; ++b)
#pragma unroll
            for (int m = 0; m < 4; ++m)
#pragma unroll
                for (int n = 0; n < 2; ++n) acc[a][b][m][n] = (f32x4){0.f, 0.f, 0.f, 0.f};
    bf16x8 At[4][2], B0[2][2], B1[2][2];
    const char* cA = (const char*)g.A + (GATHER ? (size_t)0 : (size_t)cur.pm * tstep); const char* cB = (const char*)g.Bt + (size_t)cur.pb * tstep;
    if constexpr (GATHER) PG8_GIDX(cur, vA);
    if constexpr (Sched::KRANGE) { cA += (size_t)cur.kt0 * kstep; cB += (size_t)cur.kt0 * kstep; nt = cur.nkt; }
    S.a_ready(cur);
    if constexpr (SP2) {
        PG8_STAGE(PG8_SB(0, 0), cB, voffB); PG8_STAGE(PG8_SB(0, 1), cB + hstep, voffB); PG8_STAGE_A(PG8_SA(0, 0), cA, 0, vA); PG8_STAGE_A(PG8_SA(0, 1), cA, 1, vA);
        if (wr == 1) PG8_BAR;
        PG8_WAIT_V(2); PG8_BAR;
        PG8_STAGE(PG8_SB(1, 0), cB + kstep, voffB); PG8_STAGE_A(PG8_SA(1, 0), cA + kstep, 0, vA); PG8_STAGE(PG8_SB(1, 1), cB + hstep + kstep, voffB);
        PG8_WAIT_V(6); PG8_BAR;
    } else {
        PG8_STAGE(PG8_SB(0, 0), cB, voffB); PG8_STAGE_A(PG8_SA(0, 0), cA, 0, vA); PG8_STAGE(PG8_SB(0, 1), cB + hstep, voffB); PG8_STAGE_A(PG8_SA(0, 1), cA, 1, vA);
        if (wr == 1) PG8_BAR;
        PG8_WAIT_V(4); PG8_BAR;
        PG8_STAGE(PG8_SB(1, 0), cB + kstep, voffB); PG8_STAGE_A(PG8_SA(1, 0), cA + kstep, 0, vA); PG8_STAGE(PG8_SB(1, 1), cB + hstep + kstep, voffB);
        PG8_WAIT_V(6); PG8_BAR;
    }
    for (;;) {
        const bool has_next = S.next(ui + 1, nxt);
        const char* nA = has_next ? (const char*)g.A + (GATHER ? (size_t)0 : (size_t)nxt.pm * tstep) : cA; const char* nB = has_next ? (const char*)g.Bt + (size_t)nxt.pb * tstep : cB;
        if constexpr (GATHER) { if (has_next) PG8_GIDX(nxt, nvA); }
        if constexpr (Sched::KRANGE) { if (has_next) { nA += (size_t)nxt.kt0 * kstep; nB += (size_t)nxt.kt0 * kstep; } }
        for (int t = 0; t < nt; t += 2) {
            const bool last = (t == nt - 2);
            const char* a1 = cA + (size_t)(t + 1) * kstep;
            const char* a2 = last ? nA : cA + (size_t)(t + 2) * kstep; const char* b2 = last ? nB : cB + (size_t)(t + 2) * kstep;
            const char* a3 = a2 + kstep; const char* b3 = b2 + kstep;
            if (last && has_next) S.a_ready(nxt);
            if constexpr (GATHER) {
#pragma unroll
                for (int h_ = 0; h_ < 2; ++h_)
#pragma unroll
                    for (int i_ = 0; i_ < 2; ++i_) sA[h_][i_] = (last && has_next) ? nvA[h_][i_] : vA[h_][i_]; }
            if constexpr (SP2) {
            PG8_LDB(B0, 0, 0); PG8_LDB(B1, 0, 1); PG8_SCHED; PG8_LDA(At, 0, 0); PG8_STAGE_A(PG8_SA(1, 1), a1, 1, vA);
            PG8_WAIT_V(8); PG8_WAIT_L(0); PG8_BAR; PG8_MMA(0, 0, At, B0); PG8_MMA(0, 1, At, B1); PG8_BAR; PG8_SCHED;
            PG8_LDA(At, 0, 1); PG8_STAGE(PG8_SB(0, 0), b2, voffB); PG8_STAGE(PG8_SB(0, 1), b2 + hstep, voffB); PG8_STAGE_A(PG8_SA(0, 0), a2, 0, sA);
            PG8_WAIT_V(8); PG8_WAIT_L(0); PG8_BAR; PG8_MMA(1, 0, At, B0); PG8_MMA(1, 1, At, B1); PG8_BAR; PG8_SCHED;
            PG8_LDB(B0, 1, 0); PG8_LDB(B1, 1, 1); PG8_SCHED; PG8_LDA(At, 1, 0); PG8_STAGE_A(PG8_SA(0, 1), a2, 1, sA);
            PG8_WAIT_V(8); PG8_WAIT_L(0); PG8_BAR; PG8_MMA(0, 0, At, B0); PG8_MMA(0, 1, At, B1); PG8_BAR; PG8_SCHED;
            PG8_LDA(At, 1, 1); PG8_STAGE(PG8_SB(1, 0), b3, voffB); PG8_STAGE(PG8_SB(1, 1), b3 + hstep, voffB); PG8_STAGE_A(PG8_SA(1, 0), a3, 0, sA);
            PG8_WAIT_V(8); PG8_WAIT_L(0); PG8_BAR; PG8_MMA(1, 0, At, B0); PG8_MMA(1, 1, At, B1); PG8_BAR; PG8_SCHED;
            } else {
            PG8_LDB(B0, 0, 0); PG8_SCHED; PG8_LDA(At, 0, 0); PG8_STAGE_A(PG8_SA(1, 1), a1, 1, vA);
            PG8_WAIT_L(8); PG8_BAR; PG8_WAIT_L(0); PG8_MMA(0, 0, At, B0); PG8_BAR; PG8_SCHED;
            PG8_LDB(B1, 0, 1); PG8_STAGE(PG8_SB(0, 0), b2, voffB);
            PG8_BAR; PG8_WAIT_L(0); PG8_MMA(0, 1, At, B1); PG8_BAR;
            PG8_LDA(At, 0, 1); PG8_STAGE_A(PG8_SA(0, 0), a2, 0, sA);
            PG8_BAR; PG8_WAIT_L(0); PG8_MMA(1, 0, At, B0); PG8_BAR; PG8_SCHED;
            PG8_STAGE(PG8_SB(0, 1), b2 + hstep, voffB);
            PG8_WAIT_V(6); PG8_BAR; PG8_MMA(1, 1, At, B1); PG8_BAR;
            PG8_LDB(B0, 1, 0); PG8_SCHED; PG8_LDA(At, 1, 0); PG8_STAGE_A(PG8_SA(0, 1), a2, 1, sA);
            PG8_WAIT_L(8); PG8_BAR; PG8_WAIT_L(0); PG8_MMA(0, 0, At, B0); PG8_BAR; PG8_SCHED;
            PG8_LDB(B1, 1, 1); PG8_STAGE(PG8_SB(1, 0), b3, voffB);
            PG8_BAR; PG8_WAIT_L(0); PG8_MMA(0, 1, At, B1); PG8_BAR;
            PG8_LDA(At, 1, 1); PG8_STAGE_A(PG8_SA(1, 0), a3, 0, sA);
            PG8_BAR; PG8_WAIT_L(0); PG8_MMA(1, 0, At, B0); PG8_BAR; PG8_SCHED;
            PG8_STAGE(PG8_SB(1, 1), b3 + hstep, voffB);
            PG8_WAIT_V(6); PG8_BAR; PG8_MMA(1, 1, At, B1); PG8_BAR;
            }
        }
        if constexpr (ALIGN_EPI) { if (wr == 0) PG8_BAR; }
        if constexpr (!Epi::AFTER_DRAIN) { E(acc, cur, wr, wc, fr, fq); S.done(cur); }
        if (!has_next) break;
#pragma unroll
        for (int a = 0; a < 2; ++a)
#pragma unroll
            for (int b = 0; b < 2; ++b)
#pragma unroll
                for (int m = 0; m < 4; ++m)
#pragma unroll
                    for (int n = 0; n < 2; ++n) acc[a][b][m][n] = (f32x4){0.f, 0.f, 0.f, 0.f};
        cur = nxt; cA = nA; cB = nB; ++ui;
        if constexpr (GATHER) {
#pragma unroll
            for (int h_ = 0; h_ < 2; ++h_)
#pragma unroll
                for (int i_ = 0; i_ < 2; ++i_) vA[h_][i_] = nvA[h_][i_]; }
        if constexpr (Sched::KRANGE) nt = cur.nkt;
        if constexpr (ALIGN_EPI) { if (wr == 1) PG8_BAR; }
    }
    PG8_WAIT_V(0);
    if constexpr (!ALIGN_EPI) { if (wr == 0) PG8_BAR; }
    PG8_BAR;
#undef PG8_SA
#undef PG8_SB
#undef PG8_STAGE
#undef PG8_LDA
#undef PG8_STAGE_A
#undef PG8_GIDX
#undef PG8_LDB
#undef PG8_MMA
#undef PG8_WAIT_V
#undef PG8_WAIT_L
#undef PG8_BAR
#undef PG8_SCHED
}
}
namespace att {
constexpr int NW = 8, QBLK = 32, KVBLK = 64, QB = NW * QBLK, PITCH = 3072, DV = 128;
constexpr int SHM_V = KVBLK * DV * 2;
constexpr int LDS_V = 0, LDS_K = 2 * SHM_V, LDS_WS = 65536, LDS_BYTES = LDS_WS + NW * 64 * 4;
constexpr float THR = 8.f;
template <int DK> struct Cfg { static constexpr int SHM_K = KVBLK * DK * 2; static constexpr float SCALE = (DK == 128) ? 0.08838834764831845f : 0.125f; };

#define KSWZ(row, colB) ((row) * 256 + ((colB) ^ (((row) & 7) << 4)))
#define KSWZ64(row, ch) ((row) * 128 + ((((ch) ^ (((row) >> 1) & 7))) << 4))
#define SBAR() __builtin_amdgcn_sched_barrier(0)
__device__ __forceinline__ int v_st(int k, int c) { const int kk = (k & ~0xC) | ((k & 4) << 1) | ((k & 8) >> 1); return ((kk >> 3) * 4 + (c >> 5)) * 512 + ((kk & 7) * 32 + (c & 31)) * 2; }
__device__ __forceinline__ int v_rd_base(int lane) { return ((lane & 3) << 3) | (((lane >> 2) & 3) << 6) | (((lane >> 4) & 1) << 5) | (((lane >> 5) & 1) << 8); }
constexpr int v_rd_off(int d0, int ks, int half) { return d0 * 512 + ks * 4096 + half * 2048; }
__device__ __forceinline__ int crow(int r, int hi) { return (r & 3) + 8 * (r >> 2) + 4 * hi; }
__device__ __forceinline__ unsigned cvtpk(float lo, float hi) { unsigned r; asm volatile("v_cvt_pk_bf16_f32 %0, %1, %2" : "=v"(r) : "v"(lo), "v"(hi)); return r; }
__device__ __forceinline__ bf16x8 load8(const bf16* p) { return *reinterpret_cast<const bf16x8*>(p); }
__device__ __forceinline__ void mask_tile(f32x16& p0, f32x16& p1, int dq) {
    const float NEG = -__builtin_inff();
#pragma unroll
    for (int r = 0; r < 16; ++r) {
        const int c = (r & 3) + 8 * (r >> 2);
        if (dq - c < 0) p0[r] = NEG;
        if (dq - c - 32 < 0) p1[r] = NEG;
    }
}
template <int DK>
__device__ __forceinline__ void partialSM(f32x16& p0, f32x16& p1, float& m_reg, float& mn, float& alpha) {
    constexpr float SCALE = Cfg<DK>::SCALE;
    float pmax = p0[0]; for (int r = 1; r < 16; ++r) pmax = fmaxf(pmax, p0[r]); for (int r = 0; r < 16; ++r) pmax = fmaxf(pmax, p1[r]);
    { auto rr = __builtin_amdgcn_permlane32_swap(__float_as_uint(pmax), __float_as_uint(pmax), false, false);
      pmax = fmaxf(__uint_as_float(rr[0]), __uint_as_float(rr[1])); }
    constexpr float C2 = 1.4426950408889634f * SCALE;
    if (__builtin_expect(__all((pmax - m_reg) * SCALE <= THR), 1)) { mn = m_reg; alpha = 1.f; }
    else { mn = fmaxf(m_reg, pmax); alpha = __builtin_amdgcn_exp2f((m_reg - mn) * C2); m_reg = mn; }
    const float mnL = -mn * C2;
    for (int r = 0; r < 16; ++r) p0[r] = fmaf(p0[r], C2, mnL); for (int r = 0; r < 16; ++r) p1[r] = fmaf(p1[r], C2, mnL);
    for (int r = 0; r < 16; ++r) p0[r] = __builtin_amdgcn_exp2f(p0[r]);
}
__device__ __forceinline__ void finishSM(f32x16& p0, f32x16& p1, float alpha, float& l_reg, bf16x8& pa0, bf16x8& pa1, bf16x8& pa2, bf16x8& pa3) {
    for (int r = 0; r < 16; ++r) p1[r] = __builtin_amdgcn_exp2f(p1[r]);
    float ps = 0; for (int r = 0; r < 16; ++r) ps += p0[r]; for (int r = 0; r < 16; ++r) ps += p1[r];
    { auto rr = __builtin_amdgcn_permlane32_swap(__float_as_uint(ps), __float_as_uint(ps), false, false);
      ps = __uint_as_float(rr[0]) + __uint_as_float(rr[1]); }
    l_reg = l_reg * alpha + ps;
#define PK4(P, B_, OUT) do { unsigned a0 = cvtpk(P[B_+0], P[B_+1]), a1 = cvtpk(P[B_+2], P[B_+3]);                          \
        unsigned b0 = cvtpk(P[B_+4], P[B_+5]), b1 = cvtpk(P[B_+6], P[B_+7]);                                             \
        auto r0 = __builtin_amdgcn_permlane32_swap(a0, b0, false, false); auto r1 = __builtin_amdgcn_permlane32_swap(a1, b1, false, false); \
        u32x4 w = {r0[0], r1[0], r0[1], r1[1]}; OUT = *reinterpret_cast<bf16x8*>(&w); } while (0)
    PK4(p0, 0, pa0); PK4(p0, 8, pa1); PK4(p1, 0, pa2); PK4(p1, 8, pa3);
#undef PK4
}
__device__ __forceinline__ bf16x8 bias_frag(u32x2 kb, int hi) { u32x4 w = {hi ? 0u : kb.x, hi ? 0u : kb.y, 0u, 0u}; return *reinterpret_cast<bf16x8*>(&w); }
template <int KB, int DK, bool BIAS>
__device__ __forceinline__ void qkt(f32x16& p0, f32x16& p1, const char* K_lds, int r32, int hi, const bf16x8* qr, u32x2 kb0, u32x2 kb1) {
    constexpr int SHM_K = Cfg<DK>::SHM_K;
    p0 = f32x16{}; p1 = f32x16{};
    if constexpr (DK == 128) {
        const char* kb[4];
#pragma unroll
        for (int dd = 0; dd < 4; ++dd) kb[dd] = K_lds + KB * SHM_K + KSWZ(r32, (dd * 16 + hi * 8) * 2);
#pragma unroll
        for (int d0 = 0; d0 < 8; ++d0) { const char* a = kb[d0 & 3] + (d0 >> 2) * 128;
            bf16x8 b0 = *reinterpret_cast<const bf16x8*>(a);
            bf16x8 b1 = *reinterpret_cast<const bf16x8*>(a + 32 * 256);
            p0 = __builtin_amdgcn_mfma_f32_32x32x16_bf16(b0, qr[d0], p0, 0, 0, 0);
            p1 = __builtin_amdgcn_mfma_f32_32x32x16_bf16(b1, qr[d0], p1, 0, 0, 0); }
    } else {
#pragma unroll
        for (int d0 = 0; d0 < 4; ++d0) { const char* a = K_lds + KB * SHM_K + KSWZ64(r32, 2 * d0 + hi);
            bf16x8 b0 = *reinterpret_cast<const bf16x8*>(a);
            bf16x8 b1 = *reinterpret_cast<const bf16x8*>(a + 32 * 128);
            p0 = __builtin_amdgcn_mfma_f32_32x32x16_bf16(b0, qr[d0], p0, 0, 0, 0);
            p1 = __builtin_amdgcn_mfma_f32_32x32x16_bf16(b1, qr[d0], p1, 0, 0, 0); }
    }
    if constexpr (BIAS) {
        u32x4 ow = {hi ? 0u : 0x3f803f80u, hi ? 0u : 0x00003f80u, 0u, 0u}; const bf16x8 qone = *reinterpret_cast<bf16x8*>(&ow);
        p0 = __builtin_amdgcn_mfma_f32_32x32x16_bf16(bias_frag(kb0, hi), qone, p0, 0, 0, 0);
        p1 = __builtin_amdgcn_mfma_f32_32x32x16_bf16(bias_frag(kb1, hi), qone, p1, 0, 0, 0);
    }
}
template <int VB>
__device__ __forceinline__ void pv_tile(f32x16* o, int vb0, bf16x8 pa0, bf16x8 pa1, bf16x8 pa2, bf16x8 pa3) {
#define TRRD(dst, off) asm volatile("ds_read_b64_tr_b16 %0, %1 offset:%2" : "=&v"(dst) : "v"(vb0), "i"(off) : "memory")
#define PV_D0(d0) do { s16x4 l0, l1, l2, l3, h0, h1, h2, h3; constexpr int b_ = VB * SHM_V + v_rd_off(d0, 0, 0); \
        TRRD(l0, b_); TRRD(h0, b_ + 2048); TRRD(l1, b_ + 4096); TRRD(h1, b_ + 6144); TRRD(l2, b_ + 8192); TRRD(h2, b_ + 10240); TRRD(l3, b_ + 12288); TRRD(h3, b_ + 14336); \
        asm volatile("s_waitcnt lgkmcnt(0)" ::: "memory"); SBAR();   \
        o[d0] = __builtin_amdgcn_mfma_f32_32x32x16_bf16(pa0, (bf16x8){l0[0], l0[1], l0[2], l0[3], h0[0], h0[1], h0[2], h0[3]}, o[d0], 0, 0, 0);   \
        o[d0] = __builtin_amdgcn_mfma_f32_32x32x16_bf16(pa1, (bf16x8){l1[0], l1[1], l1[2], l1[3], h1[0], h1[1], h1[2], h1[3]}, o[d0], 0, 0, 0);   \
        o[d0] = __builtin_amdgcn_mfma_f32_32x32x16_bf16(pa2, (bf16x8){l2[0], l2[1], l2[2], l2[3], h2[0], h2[1], h2[2], h2[3]}, o[d0], 0, 0, 0);   \
        o[d0] = __builtin_amdgcn_mfma_f32_32x32x16_bf16(pa3, (bf16x8){l3[0], l3[1], l3[2], l3[3], h3[0], h3[1], h3[2], h3[3]}, o[d0], 0, 0, 0); } while (0)
    PV_D0(0); PV_D0(1); PV_D0(2); PV_D0(3);
#undef PV_D0
#undef TRRD
}

struct BlockRef { const bf16* Q; const bf16* K; const bf16* V; const u32x2* KB; int P0, JLO; };
template <int DK> struct Seam { bf16x8 qr[DK / 16]; bf16x8 st_v0, st_v1, st_k0, st_k1; u32x2 kbn0, kbn1; };
#define AROW(p, k0, rr) ((p) + (size_t)((k0) + (rr)) * PITCH + sc)
#define VMW() asm volatile("s_waitcnt vmcnt(0)" ::: "memory")
#define VMWN(n) asm volatile("s_waitcnt vmcnt(%0)" :: "i"(n) : "memory")
#define SLOAD_H(R_, k0) do { S.st_v0 = load8(AROW((R_).V, k0, sr)); S.st_v1 = load8(AROW((R_).V, k0, 32 + sr));                                   \
        if constexpr (DK == 128) { S.st_k0 = load8(AROW((R_).K, k0, sr)); S.st_k1 = load8(AROW((R_).K, k0, 32 + sr)); }                            \
        else { S.st_k0 = load8((R_).K + (size_t)((k0) + (tid >> 3)) * PITCH + (tid & 7) * 8); }                                                    \
        if constexpr (BIAS) { S.kbn0 = (R_).KB[(k0) + r32]; S.kbn1 = (R_).KB[(k0) + 32 + r32]; } } while (0)
#define SWRITE_HK(bf) do { if constexpr (DK == 128) { *(bf16x8*)(K_lds + (bf) * SHM_K + kws) = S.st_k0; *(bf16x8*)(K_lds + (bf) * SHM_K + kws + 32 * 256) = S.st_k1; } \
        else { *(bf16x8*)(K_lds + (bf) * SHM_K + kws) = S.st_k0; } } while (0)
#define SWRITE_HV(bf) do { *(bf16x8*)(V_lds + (bf) * SHM_V + vst0) = S.st_v0; *(bf16x8*)(V_lds + (bf) * SHM_V + vst1) = S.st_v1; } while (0)
#define SWRITE_H(bf) do { SWRITE_HV(bf); SWRITE_HK(bf); } while (0)
template <int DK, bool BIAS>
__device__ __forceinline__ void causal_prime(const BlockRef& cur, char* lds, Seam<DK>& S, int tid) {
    constexpr int SHM_K = Cfg<DK>::SHM_K;
    const int wid = __builtin_amdgcn_readfirstlane(tid >> 6), lane = tid & 63, r32 = lane & 31, hi = lane >> 5;
    const int sr = tid >> 4, sc = (tid & 15) * 8; const int kws = (DK == 128) ? KSWZ(sr, sc * 2) : KSWZ64(tid >> 3, tid & 7); char* K_lds = lds + LDS_K;
#pragma unroll
    for (int d0 = 0; d0 < DK / 16; ++d0) S.qr[d0] = load8(cur.Q + (size_t)(wid * QBLK + r32) * PITCH + d0 * 16 + hi * 8);
    SLOAD_H(cur, cur.JLO * KVBLK); VMW(); SWRITE_HK(0);
    __syncthreads();
}
template <int DK, bool BIAS, int OUT>
__device__ __forceinline__ void causal_block(const BlockRef& cur, const BlockRef& nxt, char* lds, Seam<DK>& S, void* Oblk, int opitch, int tid) {
    constexpr int SHM_K = Cfg<DK>::SHM_K;
    const int wid = __builtin_amdgcn_readfirstlane(tid >> 6), lane = tid & 63, r32 = lane & 31, hi = lane >> 5;
    const int NT = (cur.P0 + QB) / KVBLK - cur.JLO;
    const int qlo = cur.P0 + wid * QBLK, qm = qlo + r32 - 4 * hi;
    char* V_lds = lds + LDS_V; char* K_lds = lds + LDS_K;
    float* ws = (float*)(lds + LDS_WS) + wid * 64; float* li_l = ws, * al_l = ws + 32;
    float m_reg = -1e30f, l_reg = 0; f32x16 o[4] = {};
    const int sr = tid >> 4, sc = (tid & 15) * 8, vst0 = v_st(sr, sc), vst1 = v_st(32 + sr, sc);
    const int kws = (DK == 128) ? KSWZ(sr, sc * 2) : KSWZ64(tid >> 3, tid & 7);
    const int vb0 = (int)(uintptr_t)V_lds + v_rd_base(lane);
#define RESC(a) do { if (__any((a) < 1.f)) { if (hi == 0) al_l[r32] = (a); asm volatile("s_waitcnt lgkmcnt(0)" ::: "memory");              \
                     for (int d_ = 0; d_ < 4; ++d_) for (int r = 0; r < 16; ++r) o[d_][r] *= al_l[crow(r, hi)]; } } while (0)
#define KBASE(t) ((cur.JLO + (t)) * KVBLK)
#define MASKT(P0_, P1_, t) do { const int kb_ = KBASE(t); if (kb_ + KVBLK - 1 > qlo) mask_tile(P0_, P1_, qm - kb_); } while (0)
    constexpr int NQL = DK / 16;
#define SEAM_K0() do { VMWN(NQL); SWRITE_HK(0); SBAR(); } while (0)
    f32x16 pA0, pA1, pB0, pB1; float mnA, mnB, alA, alB; bf16x8 pa0, pa1, pa2, pa3;
    SWRITE_HV(0); SBAR();
    qkt<0, DK, BIAS>(pA0, pA1, K_lds, r32, hi, S.qr, S.kbn0, S.kbn1); SBAR();
    if (NT > 1) { SLOAD_H(cur, KBASE(1)); }
    SBAR();
    MASKT(pA0, pA1, 0); partialSM<DK>(pA0, pA1, m_reg, mnA, alA);
    if (NT > 1) { VMW(); SWRITE_H(1); }
    __syncthreads();
#define HALF_STEP(PX0, PX1, mnX, alX, PY0, PY1, alY, t, KB, VB, SB) do {                                                      \
        SBAR(); qkt<KB, DK, BIAS>(PX0, PX1, K_lds, r32, hi, S.qr, S.kbn0, S.kbn1);                                            \
        finishSM(PY0, PY1, alY, l_reg, pa0, pa1, pa2, pa3); SBAR();                                                           \
        if ((t) + 1 < NT) { SLOAD_H(cur, KBASE((t) + 1)); SBAR(); }                                                           \
        pv_tile<VB>(o, vb0, pa0, pa1, pa2, pa3); MASKT(PX0, PX1, (t)); partialSM<DK>(PX0, PX1, m_reg, mnX, alX);              \
        __syncthreads();                                                                                                      \
        if ((t) + 1 < NT) { VMW(); SWRITE_H(SB); }                                                                            \
        RESC(alX); __syncthreads(); } while (0)
    for (int t = 1; t + 1 < NT; t += 2) {
        HALF_STEP(pB0, pB1, mnB, alB, pA0, pA1, alA, t, 1, 0, 0);
        HALF_STEP(pA0, pA1, mnA, alA, pB0, pB1, alB, t + 1, 0, 1, 1);
    }
    const bool even = (NT & 1) == 0;
    if (even) { SBAR(); qkt<1, DK, BIAS>(pB0, pB1, K_lds, r32, hi, S.qr, S.kbn0, S.kbn1); SBAR(); }
    SLOAD_H(nxt, nxt.JLO * KVBLK); SBAR();
#pragma unroll
    for (int d0 = 0; d0 < DK / 16; ++d0) S.qr[d0] = load8(nxt.Q + (size_t)(wid * QBLK + r32) * PITCH + d0 * 16 + hi * 8);
    SBAR();
    finishSM(pA0, pA1, alA, l_reg, pa0, pa1, pa2, pa3); SBAR();
    pv_tile<0>(o, vb0, pa0, pa1, pa2, pa3);
    if (even) { MASKT(pB0, pB1, NT - 1); partialSM<DK>(pB0, pB1, m_reg, mnB, alB); __syncthreads(); RESC(alB);
        finishSM(pB0, pB1, alB, l_reg, pa0, pa1, pa2, pa3); SBAR(); pv_tile<1>(o, vb0, pa0, pa1, pa2, pa3); }
    SBAR(); SEAM_K0();
    if (hi == 0) li_l[r32] = l_reg; asm volatile("s_waitcnt lgkmcnt(0)" ::: "memory");
    float rli[16];
#pragma unroll
    for (int r = 0; r < 16; ++r) rli[r] = __builtin_amdgcn_rcpf(li_l[crow(r, hi)]);
#pragma unroll
    for (int r = 0; r < 16; ++r) { const int orow = wid * QBLK + crow(r, hi);
#pragma unroll
        for (int d0 = 0; d0 < 4; ++d0) { const float v = o[d0][r] * rli[r];
            if constexpr (OUT == 1) { __builtin_nontemporal_store(v, (float*)Oblk + (size_t)orow * opitch + d0 * 32 + r32); }
            else { const float vn = __shfl_xor(v, 1);
                   if ((r32 & 1) == 0) *(unsigned*)((bf16*)Oblk + (size_t)orow * opitch + d0 * 32 + r32) = cvtpk(v, vn); } } }
    __syncthreads();
#undef RESC
#undef KBASE
#undef MASKT
#undef SEAM_K0
#undef HALF_STEP
}
#undef AROW
#undef VMW
#undef VMWN
#undef SLOAD_H
#undef SWRITE_HK
#undef SWRITE_HV
#undef SWRITE_H
}
constexpr int T = 16384, DM = 1024, SEQ = 8192, NWAVES = 8, NTHR = 512, GRID = 256;
constexpr float EPS = 1e-6f;
constexpr int ZP = 3072;
constexpr int FF = 2816, FFE = 3584, NEXP = 8;
constexpr int XP_ROWS = 34816;
constexpr size_t MiB = 1u << 20, KiB = 1024;
constexpr size_t WS_CTL = 0, CTL_ZERO_BYTES = 65536;
constexpr size_t WS_SLOT = 1 * MiB, SLOT = 256 * KiB;
constexpr size_t WS_ROPE = WS_SLOT + 0 * SLOT;
constexpr size_t WS_LI = WS_SLOT + 2 * SLOT;
constexpr size_t WS_LF = WS_SLOT + 3 * SLOT;
constexpr size_t WS_LFX = WS_SLOT + 4 * SLOT;
constexpr size_t WS_KB = WS_SLOT + 14 * SLOT;
constexpr size_t WS_ROWTOK = WS_SLOT + 5 * SLOT;
constexpr size_t WS_RTE = WS_SLOT + 6 * SLOT;
constexpr size_t WS_RTW = WS_SLOT + 7 * SLOT;
constexpr size_t WS_PPOS = WS_SLOT + 8 * SLOT;
constexpr size_t WS_RW = WS_SLOT + 9 * SLOT;
constexpr size_t WS_MISC = WS_SLOT + 10 * SLOT;
constexpr size_t WS_NH = WS_SLOT + 11 * SLOT;
constexpr size_t WS_NP = WS_SLOT + 12 * SLOT;
constexpr size_t WS_SGW = WS_SLOT + 13 * SLOT;
constexpr size_t WS_NORM2 = 5 * MiB;
constexpr size_t MISC_CNT = 0, MISC_MG = 8192, MISC_BL = 10240, MISC_MP = 12288, MISC_LAM = 14336, MISC_TS = 14400;
constexpr size_t WS_W_EIN = 8 * MiB, WS_W_EOUT = 14 * MiB, WS_W_FGU = 16 * MiB, WS_W_FDN = 27 * MiB, WS_W_OIN = 33 * MiB, WS_W_OOUT = 39 * MiB, WS_W_MGU = 41 * MiB, WS_W_MDN = 153 * MiB;
constexpr size_t WS_XR = 210 * MiB;
constexpr size_t WS_XN = 274 * MiB;
constexpr size_t WS_CAT = 306 * MiB;
constexpr size_t WS_ARENA = 338 * MiB;
constexpr size_t WS_CH = 576 * MiB;
constexpr size_t WS_CP = 608 * MiB;
constexpr size_t WS_DO = 576 * MiB;
constexpr size_t WS_XP = 640 * MiB;
constexpr size_t WS_Y = 708 * MiB;
constexpr size_t WS_END = 844 * MiB;
static_assert(WS_W_MDN + (size_t)NEXP * DM * FFE * 2 <= WS_XR && WS_ARENA + (size_t)XP_ROWS * FFE * 2 <= WS_CH && WS_XP + (size_t)XP_ROWS * DM * 2 <= WS_Y && WS_Y + (size_t)XP_ROWS * DM * 4 <= WS_END, "ws map");
constexpr int CW_BAR = 4096, CW_QUEUE = 8192;
constexpr int LDS_BYTES = 155648, LDSCTL_OFF = 151552;
constexpr int TS_ = 136;
constexpr int TILE_B = 128 * TS_ * 2;

#define XB_TMO      128
#define XB_XCNT(j)  (256  + 64 * (j))
#define XB_XSUB(j)  (1280 + 64 * (j))
#define XB_XGEN(j)  (2304 + 64 * (j))
#define XB_TOP      3328
#define XB_TOPGEN   3392
#define XCD_BAR_WORDS 3456
#define XB_SPIN_CAP (1u << 18)
__device__ __forceinline__ unsigned xb_ld(unsigned* p)              { return __hip_atomic_load(p, __ATOMIC_RELAXED, __HIP_MEMORY_SCOPE_AGENT); }
__device__ __forceinline__ unsigned xb_add(unsigned* p, unsigned v) { return __hip_atomic_fetch_add(p, v, __ATOMIC_RELAXED, __HIP_MEMORY_SCOPE_AGENT); }
__device__ __forceinline__ unsigned xb_xcc_id() { return (unsigned)__builtin_amdgcn_s_getreg((3 << 11) | 20) & 0xFu; }
#define XB_SPIN(cond, bar) do { unsigned _sp = 0; while (cond) { __builtin_amdgcn_s_sleep(1); \
    if ((++_sp & 255u) == 0u) { if (xb_ld(&(bar)[XB_TMO])) break; if (_sp > XB_SPIN_CAP) { atomicAdd(&(bar)[XB_TMO], 1u); break; } } } } while (0)
struct XcdBarrier { unsigned* bar; unsigned x; volatile LAS unsigned* st; };
__device__ __forceinline__ XcdBarrier xcd_barrier_post(unsigned* bar, volatile LAS unsigned* st) {
    XcdBarrier b; b.bar = bar; b.x = xb_xcc_id(); b.st = st;
    if (threadIdx.x == 0) (void)xb_add(&bar[XB_XCNT(b.x)], 1u);
    return b;
}
__device__ __forceinline__ void xcd_barrier_complete(unsigned* bar, unsigned x, unsigned& nloc, unsigned& nx) {
    const unsigned G = gridDim.x * gridDim.y * gridDim.z;
    unsigned sum, cnt, mine, sp = 0u;
    for (;;) {
        sum = 0u; cnt = 0u; mine = 0u;
#pragma unroll
        for (unsigned j = 0; j < 16; ++j) { const unsigned c = xb_ld(&bar[XB_XCNT(j)]); sum += c; cnt += (c > 0u) ? 1u : 0u; mine = (j == x) ? c : mine; }
        if (sum == G) break;
        __builtin_amdgcn_s_sleep(1);
        if ((++sp & 255u) == 0u) { if (xb_ld(&bar[XB_TMO])) break; if (sp > XB_SPIN_CAP) { atomicAdd(&bar[XB_TMO], 1u); break; } }
    }
    nloc = mine > 0u ? mine : 1u; nx = cnt > 0u ? cnt : 1u;
}
__device__ __forceinline__ void xcd_barrier(const XcdBarrier& b) {
    asm volatile("s_waitcnt vmcnt(0)" ::: "memory");
    __syncthreads();
    if (threadIdx.x == 0) {
        unsigned* bar = b.bar;
        __builtin_amdgcn_s_waitcnt(0);
        unsigned nloc = b.st[0], nx = b.st[1];
        if (nloc == 0u) { xcd_barrier_complete(bar, b.x, nloc, nx); b.st[0] = nloc; b.st[1] = nx; }
        const unsigned old = xb_add(&bar[XB_XSUB(b.x)], 1u);
        const unsigned gen = old / nloc;
        if (old + 1u == (gen + 1u) * nloc) {
            __builtin_amdgcn_fence(__ATOMIC_RELEASE, "agent");
            asm volatile("s_waitcnt vmcnt(0)" ::: "memory");
            const unsigned og = xb_add(&bar[XB_TOP], 1u);
            const unsigned tg = og / nx;
            if (og + 1u == (tg + 1u) * nx) xb_add(&bar[XB_TOPGEN], 1u);
            else XB_SPIN(xb_ld(&bar[XB_TOPGEN]) == tg, bar);
            __builtin_amdgcn_fence(__ATOMIC_ACQUIRE, "agent");
            xb_add(&bar[XB_XGEN(b.x)], 1u);
            asm volatile("s_waitcnt vmcnt(0)" ::: "memory");
        } else {
            XB_SPIN(xb_ld(&bar[XB_XGEN(b.x)]) == gen, bar);
            __builtin_amdgcn_fence(__ATOMIC_ACQUIRE, "agent");
            asm volatile("s_waitcnt vmcnt(0)" ::: "memory");
        }
    }
    __syncthreads();
}

struct Args { const float* in[25]; float* out; unsigned char* ws; int ph_lo, ph_hi; };
#define KARGS const __attribute__((address_space(4))) Args
__device__ __forceinline__ const float* ain(KARGS& a, int k) { return (const float*)(const GAS float*)a.in[k]; }
struct Ctx { LAS unsigned char* lds; unsigned char* ws; int tid, lane, wave, bid; };

struct ConvItem { const float* src; bf16* dst; int ldw, K; };
__device__ __forceinline__ int src_col(int type, int n0, int ffh) {
    const int pn = n0 >> 8, j = n0 & 255;
    const int t3 = j < 128 ? 128 * pn + j : ffh + 128 * pn + (j - 128);
    return type == 1 ? (n0 < 2048 ? n0 : n0 + 8) : (type == 2 ? (n0 < 1536 ? n0 : n0 + 4) : (type == 3 ? t3 : n0));
}
__device__ __forceinline__ ConvItem conv_decode(KARGS& a, unsigned char* ws, int it) {
    constexpr int I_EIN = 16 * 96, I_EOUT = 16 * 32, I_FGU = 16 * 176, I_FDN = 44 * 32, I_OIN = 16 * 96, I_OOUT = 16 * 32, I_MGU = 16 * 224, I_MDN = 56 * 32;
    constexpr int C1 = I_EIN, C2 = C1 + I_EOUT, C3 = C2 + I_FGU, C4 = C3 + I_FDN, C5 = C4 + I_OIN, C6 = C5 + I_OOUT, C7 = C6 + NEXP * I_MGU;
    const int kind = (it >= C1) + (it >= C2) + (it >= C3) + (it >= C4) + (it >= C5) + (it >= C6) + (it >= C7);
#define SEL8(v0, v1, v2, v3, v4, v5, v6, v7) (kind == 0 ? (v0) : kind == 1 ? (v1) : kind == 2 ? (v2) : kind == 3 ? (v3) : kind == 4 ? (v4) : kind == 5 ? (v5) : kind == 6 ? (v6) : (v7))
    const int base = SEL8(0, C1, C2, C3, C4, C5, C6, C7), per = SEL8(I_EIN, I_EOUT, I_FGU, I_FDN, I_OIN, I_OOUT, I_MGU, I_MDN);
    int r = it - base; const int e = r / per; r -= e * per;
    const int ldw = SEL8(3080, 1024, 2 * FF, 1024, 3076, 1024, 2 * FFE, 1024), K = SEL8(1024, 1024, 1024, FF, 1024, 1024, 1024, FFE), N = SEL8(3072, 1024, 2 * FF, 1024, 3072, 1024, 2 * FFE, 1024);
    const int type = SEL8(1, 0, 3, 0, 2, 0, 3, 0), ffh = SEL8(0, 0, FF, 0, 0, 0, FFE, 0);
    const float* W = SEL8(ain(a, 2), ain(a, 10), ain(a, 12), ain(a, 13), ain(a, 15), ain(a, 19), ain(a, 22), ain(a, 23));
    const size_t wso = SEL8(WS_W_EIN, WS_W_EOUT, WS_W_FGU, WS_W_FDN, WS_W_OIN, WS_W_OOUT, WS_W_MGU, WS_W_MDN);
#undef SEL8
    const int nblk = N / 32, kb = r / nblk, nb = r - kb * nblk, k0 = 64 * kb, n0 = 32 * nb;
    ConvItem c; c.ldw = ldw; c.K = K;
    c.src = W + (size_t)e * K * ldw + (size_t)k0 * ldw + src_col(type, n0, ffh);
    c.dst = (bf16*)(ws + wso) + (size_t)e * N * K + (size_t)n0 * K + k0;
    return c;
}
__device__ __forceinline__ void conv_load(const ConvItem& c, int lane, f32x4 (&v)[8]) {
    const int kl = lane >> 3, n4 = (lane & 7) * 4;
#pragma unroll
    for (int i = 0; i < 8; ++i) v[i] = __builtin_nontemporal_load((const f32x4*)(c.src + (size_t)(8 * kl + i) * c.ldw + n4));
}
__device__ __forceinline__ void conv_finish(const ConvItem& c, int lane, const f32x4 (&v)[8], LAS float*) {
    const int kl = lane >> 3, n4 = (lane & 7) * 4;
#pragma unroll
    for (int e = 0; e < 4; ++e) { u32x4 o; o.x = pk2(v[0][e], v[1][e]); o.y = pk2(v[2][e], v[3][e]); o.z = pk2(v[4][e], v[5][e]); o.w = pk2(v[6][e], v[7][e]);
        *(u32x4*)(c.dst + (size_t)(n4 + e) * c.K + 8 * kl) = o; }
}
constexpr int CONV_FGU_END = 16 * 96 + 16 * 32 + 16 * 176, CONV_DENSE_ITEMS = 16 * 96 + 16 * 32 + 16 * 176 + 44 * 32 + 16 * 96 + 16 * 32, CONV_MGU_END = CONV_DENSE_ITEMS + NEXP * 16 * 224, CONV_ALL_ITEMS = CONV_MGU_END + NEXP * 56 * 32;
template <int LO, int HI, bool REV>
__device__ __forceinline__ void prologue_weights(KARGS& a, const Ctx& c) {
    LAS float* scr = (LAS float*)(c.lds + c.wave * 16384);
    const int gw = c.bid * NWAVES + c.wave, NGW = GRID * NWAVES;
    constexpr int NITEMS = HI - LO;
#define CONV_IT(i) (REV ? HI - 1 - (i) : LO + (i))
    int it = gw; if (it >= NITEMS) return;
    f32x4 va[8], vb[8]; ConvItem d0 = conv_decode(a, c.ws, CONV_IT(it)), d1 = d0; conv_load(d0, c.lane, va);
    for (;;) {
        const int it1 = it + NGW; const bool has1 = it1 < NITEMS;
        if (has1) { d1 = conv_decode(a, c.ws, CONV_IT(it1)); conv_load(d1, c.lane, vb); }
        conv_finish(d0, c.lane, va, scr);
        if (!has1) break;
        it = it1 + NGW; const bool has0 = it < NITEMS;
        if (has0) { d0 = conv_decode(a, c.ws, CONV_IT(it)); conv_load(d0, c.lane, va); }
        conv_finish(d1, c.lane, vb, scr);
        if (!has0) break;
    }
#undef CONV_IT
}
template <int LO, int HI, bool REV>
__device__ __forceinline__ void conv_dynamic(KARGS& a, const Ctx& c, unsigned* q) {
    LAS float* scr = (LAS float*)(c.lds + c.wave * 16384);
    LAS int* slot = (LAS int*)(c.lds + 131072);
    constexpr int NCH = (HI - LO) / 16; static_assert((HI - LO) % 16 == 0, "chunks");
#define CONV_IT(i) (REV ? HI - 1 - (i) : LO + (i))
    if (c.tid == 0) slot[0] = (int)__hip_atomic_fetch_add(q, 1u, RLX_AGENT);
    __syncthreads();
    int ch = slot[0];
    while (ch < NCH) {
        __syncthreads();
        if (c.tid == 0) slot[0] = (int)__hip_atomic_fetch_add(q, 1u, RLX_AGENT);
        const int i0 = ch * 16 + c.wave * 2;
        f32x4 va[8], vb[8]; const ConvItem d0 = conv_decode(a, c.ws, CONV_IT(i0)), d1 = conv_decode(a, c.ws, CONV_IT(i0 + 1));
        conv_load(d0, c.lane, va); conv_load(d1, c.lane, vb);
        conv_finish(d0, c.lane, va, scr); conv_finish(d1, c.lane, vb, scr);
        __syncthreads();
        ch = slot[0];
    }
#undef CONV_IT
}
__device__ __forceinline__ void prologue_tables(KARGS& a, const Ctx& c) {
    const int gt = c.bid * NTHR + c.tid, NGT = GRID * NTHR;
    bf16* sgw = (bf16*)(c.ws + WS_SGW); const float* w = ain(a, 8);
    for (int i = gt; i < 4 * 128 * 128; i += NGT) { const int tt = (i >> 7) & 127, ss = i & 127; sgw[i] = (bf16)(ss <= tt ? f2bf(w[i]) : 0u); }
    if (c.bid == 0 && c.wave == 0) { const float* l = ain(a, 17); const float p0 = wave_sum(l[c.lane] * l[64 + c.lane]), p1 = wave_sum(l[128 + c.lane] * l[192 + c.lane]);
        const float lambda_init = 0.8f - 0.6f * expf(-0.3f);
        if (c.lane == 0) *(float*)(c.ws + WS_MISC + MISC_LAM) = expf(p0) - expf(p1) + lambda_init; }
}

template <int NC> __device__ __forceinline__ void stage_wxt(const Ctx& c, const float* W, int ldw, int col0) {
    LAS float* wxt = (LAS float*)c.lds;
    for (int i = c.tid; i < NC * 1024; i += NTHR) { const int cc = i >> 10, k = i & 1023; wxt[i] = W[(size_t)k * ldw + col0 + cc]; }
    __syncthreads();
}
template <int MODE> __device__ __forceinline__ void row_phase(KARGS& a, const Ctx& c, const void* xin_, const float* gain) {
    constexpr bool XBF = MODE != 0; const float* xin = (const float*)xin_; const bf16* xinb = (const bf16*)xin_; (void)xin; (void)xinb;
    constexpr int NC = (MODE == 0 || MODE == 3) ? 8 : (MODE == 2 ? 4 : 0);
    unsigned char* ws = c.ws;
    LAS float* wxt = (LAS float*)c.lds; LAS int* lcnt = (LAS int*)(c.lds + 32768);
    f32x4 g[4];
#pragma unroll
    for (int j = 0; j < 4; ++j) g[j] = *((const f32x4*)gain + c.lane + 64 * j);
    bf16* XN = (bf16*)(ws + WS_XN);
    int skSL = 2;
    if (MODE == 4) skSL = pg8::hyb_SL(__builtin_amdgcn_readfirstlane(ldi((const int*)(ws + WS_MISC + MISC_TS) + 8)) * 4 - 512);
#define ROW_INDEX(r) ((MODE == 4) ? (r) * (GRID * NWAVES) + c.bid * NWAVES + c.wave : 64 * c.bid + c.wave * 8 + (r))
#define ROW_LOAD(r, V, Y0, Y1, P0, P1) do { const int m_ = ROW_INDEX(r); \
        if (XBF) { const u32x2* xr_ = (const u32x2*)(xinb + (size_t)m_ * DM) + c.lane; _Pragma("unroll") for (int j = 0; j < 4; ++j) vnb[j] = __builtin_nontemporal_load(xr_ + 64 * j); } \
        else { const f32x4* xr_ = (const f32x4*)(xin + (size_t)m_ * DM) + c.lane; _Pragma("unroll") for (int j = 0; j < 4; ++j) V[j] = __builtin_nontemporal_load(xr_ + 64 * j); } \
        if (MODE == 4) { P0 = ldi((const int*)(ws + WS_PPOS) + 2 * m_); P1 = ldi((const int*)(ws + WS_PPOS) + 2 * m_ + 1); \
            const u32x2* y0_ = (const u32x2*)((const bf16*)(ws + WS_Y) + (size_t)P0 * DM) + c.lane; const u32x2* y1_ = (const u32x2*)((const bf16*)(ws + WS_Y) + (size_t)P1 * DM) + c.lane; \
            _Pragma("unroll") for (int j = 0; j < 4; ++j) { Y0[j] = y0_[64 * j]; Y1[j] = y1_[64 * j]; } } } while (0)
    f32x4 vn[4]; u32x2 vnb[4], yn0[4], yn1[4]; int pn0 = 0, pn1 = 0;
    float zk[8] = {0.f, 0.f, 0.f, 0.f, 0.f, 0.f, 0.f, 0.f}; (void)zk; float zk1 = 0.f; (void)zk1;
    ROW_LOAD(0, vn, yn0, yn1, pn0, pn1);
    if (MODE == 0) stage_wxt<8>(c, ain(a, 2), 3080, 2048);
    if (MODE == 2) stage_wxt<4>(c, ain(a, 15), 3076, 1536);
    if (MODE == 3) { if (c.tid < 8) lcnt[c.tid] = 0; stage_wxt<8>(c, ain(a, 21), 8, 0); }
    f32x4 wr[NC > 0 ? NC : 1][4];
    if constexpr (NC > 0) {
#pragma unroll
        for (int cc = 0; cc < NC; ++cc)
#pragma unroll
            for (int j = 0; j < 4; ++j) wr[cc][j] = *((const LAS f32x4*)(wxt + cc * 1024) + c.lane + 64 * j);
    }
#pragma unroll
    for (int r = 0; r < 8; ++r) {
        const int m = ROW_INDEX(r);
        f32x4 v[4]; const int p0 = pn0, p1 = pn1;
#pragma unroll
        for (int j = 0; j < 4; ++j) { if (XBF) { const unsigned w0 = vnb[j].x, w1 = vnb[j].y; v[j] = (f32x4){bflo(w0), bfhi(w0), bflo(w1), bfhi(w1)}; } else v[j] = vn[j];
            if (MODE == 4) { v[j].x += bflo(yn0[j].x) + bflo(yn1[j].x); v[j].y += bfhi(yn0[j].x) + bfhi(yn1[j].x); v[j].z += bflo(yn0[j].y) + bflo(yn1[j].y); v[j].w += bfhi(yn0[j].y) + bfhi(yn1[j].y); } }
        if (r + 1 < 8) ROW_LOAD(r + 1, vn, yn0, yn1, pn0, pn1);
        if (MODE == 4) {
            const bf16* slab = (const bf16*)(ws + WS_XP);
            if (p0 >= 32768 || p1 >= 32768) {
#pragma unroll 1
                for (int q = 0; q < 2; ++q) { const int p = q ? p1 : p0; if (p < 32768) continue;
                    const bf16* sp0 = slab + ((size_t)(((p >> 8) * 4 - 512) * (skSL - 1)) * 256 + (p & 255)) * 256;
#pragma unroll 1
                    for (int s0 = 0; s0 < skSL - 1; s0 += 7) {
                        u32x2 w[4][7];
#pragma unroll
                        for (int j = 0; j < 4; ++j)
#pragma unroll
                            for (int u = 0; u < 7; ++u) { w[j][u] = (u32x2){0u, 0u}; if (s0 + u < skSL - 1) w[j][u] = *((const u32x2*)(sp0 + ((size_t)j * (skSL - 1) + s0 + u) * 65536) + c.lane); }
#pragma unroll
                        for (int j = 0; j < 4; ++j)
#pragma unroll
                            for (int u = 0; u < 7; ++u) { v[j].x += bflo(w[j][u].x); v[j].y += bfhi(w[j][u].x); v[j].z += bflo(w[j][u].y); v[j].w += bfhi(w[j][u].y); } } } } }
        float s = 0.f;
#pragma unroll
        for (int j = 0; j < 4; ++j) s += (v[j].x * v[j].x + v[j].y * v[j].y) + (v[j].z * v[j].z + v[j].w * v[j].w);
#pragma unroll
        for (int j = 0; j < 4; ++j) v[j] = v[j] * g[j];
        float z[NC > 0 ? NC : 1]; float zred = 0.f; (void)zred;
        if constexpr (NC > 0) {
#pragma unroll
            for (int cc = 0; cc < NC; ++cc) { float pp = 0.f;
                f32x2 p2 = {0.f, 0.f};
#pragma unroll
                for (int j = 0; j < 4; ++j) { const f32x4 w = wr[cc][j];
                    p2 = __builtin_elementwise_fma((f32x2){v[j].x, v[j].y}, (f32x2){w.x, w.y}, p2); p2 = __builtin_elementwise_fma((f32x2){v[j].z, v[j].w}, (f32x2){w.z, w.w}, p2); }
                pp = p2.x + p2.y; z[cc] = pp; }
            if constexpr (NC == 8) {
                const bool b1 = (c.lane & 1) != 0, b2 = (c.lane & 2) != 0, b4 = (c.lane & 4) != 0;
                float a4[4], a2[2];
#pragma unroll
                for (int i = 0; i < 4; ++i) { const float keep = b1 ? z[2 * i + 1] : z[2 * i], give = b1 ? z[2 * i] : z[2 * i + 1]; a4[i] = keep + shfl_xor_l(give, 1, c.lane); }
#pragma unroll
                for (int i = 0; i < 2; ++i) { const float keep = b2 ? a4[2 * i + 1] : a4[2 * i], give = b2 ? a4[2 * i] : a4[2 * i + 1]; a2[i] = keep + shfl_xor_l(give, 2, c.lane); }
                { const float keep = b4 ? a2[1] : a2[0], give = b4 ? a2[0] : a2[1]; zred = keep + shfl_xor_l(give, 4, c.lane); }
                zred += shfl_xor_l(zred, 8, c.lane); zred += shfl_xor_l(zred, 16, c.lane); zred += shfl_xor_l(zred, 32, c.lane);
            } else {
                const bool b1 = (c.lane & 1) != 0, b2 = (c.lane & 2) != 0;
                float a2[2];
#pragma unroll
                for (int i = 0; i < 2; ++i) { const float keep = b1 ? z[2 * i + 1] : z[2 * i], give = b1 ? z[2 * i] : z[2 * i + 1]; a2[i] = keep + shfl_xor_l(give, 1, c.lane); }
                { const float keep = b2 ? a2[1] : a2[0], give = b2 ? a2[0] : a2[1]; zred = keep + shfl_xor_l(give, 2, c.lane); }
                zred += shfl_xor_l(zred, 4, c.lane); zred += shfl_xor_l(zred, 8, c.lane); zred += shfl_xor_l(zred, 16, c.lane); zred += shfl_xor_l(zred, 32, c.lane);
            }
        }
        const float rstd = 1.0f / sqrtf(wave_sum(s) * (1.0f / DM) + EPS);
#pragma unroll
        for (int j = 0; j < 4; ++j) v[j] = v[j] * rstd;
        if (MODE == 4) { f32x4* o = (f32x4*)((float*)(GAS float*)a.out + (size_t)m * DM) + c.lane;
#pragma unroll
            for (int j = 0; j < 4; ++j) o[64 * j] = v[j]; }
        else { u32x2* o = (u32x2*)(XN + (size_t)m * DM) + c.lane;
#pragma unroll
            for (int j = 0; j < 4; ++j) { u32x2 w; w.x = pk2(v[j].x, v[j].y); w.y = pk2(v[j].z, v[j].w); o[64 * j] = w; } }
        if constexpr (NC > 0) {
            zred *= rstd;
            if (MODE == 0) zk1 = ((c.lane >> 3) == r) ? zred : zk1;
            if (MODE == 2) zk1 = ((c.lane >> 2) == r) ? zred : zk1;
            if (MODE == 3) {
#pragma unroll
                for (int cc = 0; cc < 8; ++cc) { const float zc = __builtin_bit_cast(float, __builtin_amdgcn_readlane(__builtin_bit_cast(int, zred), cc)); zk[cc] = (c.lane == r) ? zc : zk[cc]; } }
        }
    }
    if (MODE == 0) { const int m = 64 * c.bid + c.wave * 8 + (c.lane >> 3), cc = c.lane & 7;
        const float zb = zk1 + ain(a, 5)[cc];
        if (cc < 4) ((float*)(ws + WS_LI))[m * 4 + cc] = zb; else ((float*)(ws + WS_LF))[m * 4 + cc - 4] = log_sigmoid_acc(zb); }
    if (MODE == 2) { if (c.lane < 32) { const int m = 64 * c.bid + c.wave * 8 + (c.lane >> 2), cc = c.lane & 3;
            ((float*)(ws + WS_LFX))[m * 4 + cc] = log_sigmoid_acc(zk1 + ain(a, 16)[cc]); } }
    if (MODE == 3) { if (c.lane < 8) { const int m = 64 * c.bid + c.wave * 8 + c.lane;
            int e1 = 0; float v1 = zk[0];
#pragma unroll
            for (int cc = 1; cc < 8; ++cc) if (zk[cc] > v1) { v1 = zk[cc]; e1 = cc; }
            int e2 = -1; float v2 = -__builtin_inff();
#pragma unroll
            for (int cc = 0; cc < 8; ++cc) if (cc != e1 && zk[cc] > v2) { v2 = zk[cc]; e2 = cc; }
            const float w2 = 1.0f / (1.0f + expf(v1 - v2)), w1 = 1.0f - w2;
            ((int*)(ws + WS_RTE))[2 * m] = e1; ((int*)(ws + WS_RTE))[2 * m + 1] = e2;
            ((float*)(ws + WS_RTW))[2 * m] = w1; ((float*)(ws + WS_RTW))[2 * m + 1] = w2;
            __hip_atomic_fetch_add(&lcnt[e1], 1, __ATOMIC_RELAXED, __HIP_MEMORY_SCOPE_WORKGROUP); __hip_atomic_fetch_add(&lcnt[e2], 1, __ATOMIC_RELAXED, __HIP_MEMORY_SCOPE_WORKGROUP); } }
#undef ROW_LOAD
#undef ROW_INDEX
    if (MODE == 3) { __syncthreads(); if (c.tid < 8) ((int*)(ws + WS_MISC + MISC_CNT))[c.bid * 8 + c.tid] = lcnt[c.tid]; }
    __syncthreads();
}

__device__ __forceinline__ int crow_(int r, int hi) { return (r & 3) + 8 * (r >> 2) + 4 * hi; }
__device__ __forceinline__ void wg_mma128(f32x16 (&acc)[2], const LAS bf16* A, const LAS bf16* Bt, int wave, int lane) {
    const int r32 = lane & 31, hi = lane >> 5, mblk = (wave >> 1) * 32, nblk = (wave & 1) * 64;
    const LAS bf16* ap = A + (mblk + r32) * TS_ + hi * 8; const LAS bf16* bp0 = Bt + (nblk + r32) * TS_ + hi * 8; const LAS bf16* bp1 = bp0 + 32 * TS_;
#pragma unroll
    for (int ks = 0; ks < 8; ++ks) {
        const bf16x8 av = *(const LAS bf16x8*)(ap + ks * 16), b0 = *(const LAS bf16x8*)(bp0 + ks * 16), b1 = *(const LAS bf16x8*)(bp1 + ks * 16);
        acc[0] = __builtin_amdgcn_mfma_f32_32x32x16_bf16(av, b0, acc[0], 0, 0, 0);
        acc[1] = __builtin_amdgcn_mfma_f32_32x32x16_bf16(av, b1, acc[1], 0, 0, 0);
    }
}
__device__ __forceinline__ void unpack8(const u32x4 w, float (&f)[8]) { f[0] = bflo(w.x); f[1] = bfhi(w.x); f[2] = bflo(w.y); f[3] = bfhi(w.y); f[4] = bflo(w.z); f[5] = bfhi(w.z); f[6] = bflo(w.w); f[7] = bfhi(w.w); }
__device__ __forceinline__ void stage_raw(const Ctx& c, const bf16* Z, int tok0, bool first, int col0, LAS bf16* raw) {
    for (int i = c.tid; i < 131 * 16; i += NTHR) { const int r = i >> 4, ch = i & 15;
        u32x4 v = {0u, 0u, 0u, 0u}; if (!(first && r < 3)) v = *(const u32x4*)(Z + (size_t)(tok0 - 3 + r) * ZP + col0 + ch * 8);
        *(LAS u32x4*)(raw + r * TS_ + ch * 8) = v; }
}
struct ConvW { f32x4 w[4][2]; f32x4 b[2]; };
__device__ __forceinline__ void conv_w_load(const float* cw  , const float* cb, int d0, ConvW& W) {
#pragma unroll
    for (int j = 0; j < 4; ++j) { W.w[j][0] = *(const f32x4*)(cw + j * 1024 + d0); W.w[j][1] = *(const f32x4*)(cw + j * 1024 + d0 + 4); }
    W.b[0] = *(const f32x4*)(cb + d0); W.b[1] = *(const f32x4*)(cb + d0 + 4);
}
template <bool TRANSPOSE> __device__ __forceinline__ void conv_tile(const Ctx& c, const LAS bf16* raw, const float* cw  , const float* cb, float scale, LAS bf16* tile, const ConvW* Wpre = nullptr) {
#pragma unroll 4
    for (int it = 0; it < 4; ++it) {
        const int ch = TRANSPOSE ? (c.tid >> 7) * 4 + it : (c.tid & 15), s = TRANSPOSE ? (c.tid & 127) : (c.tid >> 4) + 32 * it, d0 = ch * 8;
        float acc[8];
#pragma unroll
        for (int i = 0; i < 8; ++i) acc[i] = TRANSPOSE ? cb[d0 + i] : Wpre->b[i >> 2][i & 3];
#pragma unroll
        for (int j = 0; j < 4; ++j) { float x[8]; unpack8(*(const LAS u32x4*)(raw + (s + j) * TS_ + d0), x);
#pragma unroll
            for (int i = 0; i < 8; ++i) acc[i] += (TRANSPOSE ? cw[j * 1024 + d0 + i] : Wpre->w[j][i >> 2][i & 3]) * x[i]; }
#pragma unroll
        for (int i = 0; i < 8; ++i) acc[i] = siluf_(acc[i]) * scale;
        if (TRANSPOSE) {
#pragma unroll
            for (int i = 0; i < 8; ++i) tile[(d0 + i) * TS_ + s] = (bf16)f2bf(acc[i]);
        } else { u32x4 o; o.x = pk2(acc[0], acc[1]); o.y = pk2(acc[2], acc[3]); o.z = pk2(acc[4], acc[5]); o.w = pk2(acc[6], acc[7]); *(LAS u32x4*)(tile + s * TS_ + d0) = o; }
    }
}
struct RawRegs { u32x4 v[5]; };
__device__ __forceinline__ void raw_load(const Ctx& c, const bf16* Z, int tok0, bool first, int col0, RawRegs& R) {
#pragma unroll
    for (int n = 0; n < 5; ++n) { const int i = c.tid + NTHR * n, r = i >> 4, ch = i & 15; R.v[n] = (u32x4){0u, 0u, 0u, 0u};
        if (i < 131 * 16 && !(first && r < 3)) R.v[n] = *(const u32x4*)(Z + (size_t)(tok0 - 3 + r) * ZP + col0 + ch * 8); }
}
__device__ __forceinline__ void raw_store(const Ctx& c, const RawRegs& R, LAS bf16* raw) {
#pragma unroll
    for (int n = 0; n < 5; ++n) { const int i = c.tid + NTHR * n, r = i >> 4, ch = i & 15; if (i < 131 * 16) *(LAS u32x4*)(raw + r * TS_ + ch * 8) = R.v[n]; }
}
struct TRegs { u32x4 v[4]; };
__device__ __forceinline__ void tr_load(const Ctx& c, const bf16* src, TRegs& R) {
    const int s = c.tid & 127, chq = c.tid >> 7;
#pragma unroll
    for (int it = 0; it < 4; ++it) R.v[it] = *(const u32x4*)(src + (size_t)s * ZP + (chq * 4 + it) * 8);
}
template <class F> __device__ __forceinline__ void tr_store(const Ctx& c, const TRegs& R, LAS bf16* tile, const F& f) {
    const int s = c.tid & 127, chq = c.tid >> 7;
#pragma unroll
    for (int it = 0; it < 4; ++it) { const int e0 = (chq * 4 + it) * 8; float x[8]; unpack8(R.v[it], x);
#pragma unroll
        for (int i = 0; i < 8; ++i) tile[(e0 + i) * TS_ + s] = (bf16)f2bf(f(x[i], s, e0 + i)); }
}
struct CRegs { u32x4 v[4]; };
__device__ __forceinline__ void rows_load(const Ctx& c, const bf16* src  , CRegs& R) {
#pragma unroll
    for (int n = 0; n < 4; ++n) { const int i = c.tid + NTHR * n; R.v[n] = *(const u32x4*)(src + (i >> 4) * 128 + (i & 15) * 8); }
}
__device__ __forceinline__ void rows_store(const Ctx& c, const CRegs& R, LAS bf16* tile) {
#pragma unroll
    for (int n = 0; n < 4; ++n) { const int i = c.tid + NTHR * n; *(LAS u32x4*)(tile + (i >> 4) * TS_ + (i & 15) * 8) = R.v[n]; }
}
template <class F> __device__ __forceinline__ void stage_transposed(const Ctx& c, const bf16* src, LAS bf16* tile, const F& f) {
    const int s = c.tid & 127, chq = c.tid >> 7;
#pragma unroll
    for (int it = 0; it < 4; ++it) { const int e0 = (chq * 4 + it) * 8; float x[8]; unpack8(*(const u32x4*)(src + (size_t)s * ZP + e0), x);
#pragma unroll
        for (int i = 0; i < 8; ++i) tile[(e0 + i) * TS_ + s] = (bf16)f2bf(f(x[i], s, e0 + i)); }
}
constexpr int L_T0 = 0, L_T1 = TILE_B, L_T2 = 2 * TILE_B, L_T3 = 3 * TILE_B, L_TAB = 4 * TILE_B + 2048;
static_assert(L_TAB + 4096 <= LDSCTL_OFF, "LDS map");

__device__ __forceinline__ void ml_state_unit(KARGS& a, const Ctx& c0, int bhc) {
    Ctx c = c0; { int t_ = c0.wave * 64 + (int)__builtin_amdgcn_mbcnt_hi(~0u, __builtin_amdgcn_mbcnt_lo(~0u, 0u)); asm volatile("" : "+v"(t_)); c.tid = t_; c.lane = t_ & 63; c.wave = __builtin_amdgcn_readfirstlane(t_ >> 6); }
    unsigned char* ws = c.ws;
    const int bh = bhc >> 6, ck = bhc & 63, b = bh >> 2, h = bh & 3, tok0 = b * SEQ + ck * 128;
    const bf16* Z = (const bf16*)(ws + WS_ARENA);
    LAS bf16* KT = (LAS bf16*)(c.lds + L_T0); LAS bf16* VT = (LAS bf16*)(c.lds + L_T1); LAS bf16* RAW = (LAS bf16*)(c.lds + L_T2);
    LAS float* wt = (LAS float*)(c.lds + L_TAB);
    RawRegs rk; TRegs rv;
    raw_load(c, Z, tok0, ck == 0, 512 + h * 128, rk); tr_load(c, Z + (size_t)tok0 * ZP + 1024 + h * 128, rv);
    if (c.wave == 0) {
        const float* LF = (const float*)(ws + WS_LF); const float* LI = (const float*)(ws + WS_LI);
        const int s0 = 2 * c.lane;
        const float lf0 = ldf(LF + (size_t)(tok0 + s0) * 4 + h), lf1 = ldf(LF + (size_t)(tok0 + s0 + 1) * 4 + h);
        const float li0 = ldf(LI + (size_t)(tok0 + s0) * 4 + h), li1 = ldf(LI + (size_t)(tok0 + s0 + 1) * 4 + h);
        float sc = lf0 + lf1;
#pragma unroll
        for (int o = 1; o < 64; o <<= 1) { const float t = shfl_up_l(sc, o, c.lane); if (c.lane >= o) sc += t; }
        const float b1 = sc, b0 = sc - lf1, blast = shfl_idx_l(sc, 63);
        const float g0 = blast - b0 + li0, g1 = blast - b1 + li1;
        float mg = fmaxf(g0, g1);
#pragma unroll
        for (int o = 1; o < 64; o <<= 1) mg = fmaxf(mg, shfl_xor_l(mg, o, c.lane));
        wt[s0] = fast_exp(g0 - mg); wt[s0 + 1] = fast_exp(g1 - mg);
        if (c.lane == 0) { ((float*)(ws + WS_MISC + MISC_MG))[bhc] = mg; ((float*)(ws + WS_MISC + MISC_BL))[bhc] = blast; }
    }
    raw_store(c, rk, RAW);
    __syncthreads();
    conv_tile<true>(c, RAW, ain(a, 3) + 512 + h * 128, ain(a, 4) + 512 + h * 128, 1.0f, KT);
    tr_store(c, rv, VT, [&](float x, int s, int) { return x * wt[s]; });
    __syncthreads();
    f32x16 acc[2] = {};
    wg_mma128(acc, VT, KT, c.wave, c.lane);
    { const int r32 = c.lane & 31, hi = c.lane >> 5, mblk = (c.wave >> 1) * 32, nblk = (c.wave & 1) * 64; float* CH = (float*)(ws + WS_CH) + (size_t)bhc * 16384;
#pragma unroll
      for (int j = 0; j < 2; ++j)
#pragma unroll
        for (int i = 0; i < 16; ++i) CH[(mblk + crow_(i, hi)) * 128 + nblk + 32 * j + r32] = acc[j][i]; }
    { const int d = c.tid >> 2, part = c.tid & 3; float s = 0.f;
#pragma unroll
      for (int k = 0; k < 4; ++k) { float x[8]; unpack8(*(const LAS u32x4*)(KT + d * TS_ + part * 32 + 8 * k), x);
#pragma unroll
        for (int i = 0; i < 8; ++i) s += wt[part * 32 + 8 * k + i] * x[i]; }
      s = quad_sum(s);
      if (part == 0) ((float*)(ws + WS_NH))[(size_t)bhc * 128 + d] = s; }
    __syncthreads();
}
__device__ __forceinline__ void sg_unit(KARGS& a, const Ctx& c0, int idx) {
    Ctx c = c0; { int t_ = c0.wave * 64 + (int)__builtin_amdgcn_mbcnt_hi(~0u, __builtin_amdgcn_mbcnt_lo(~0u, 0u)); asm volatile("" : "+v"(t_)); c.tid = t_; c.lane = t_ & 63; c.wave = __builtin_amdgcn_readfirstlane(t_ >> 6); }
    unsigned char* ws = c.ws;
    const int bn = idx >> 2, g = idx & 3, tok0 = (bn >> 6) * SEQ + (bn & 63) * 128;
    const bf16* Z = (const bf16*)(ws + WS_ARENA);
    LAS bf16* WG = (LAS bf16*)(c.lds + L_T0); LAS bf16* VN = (LAS bf16*)(c.lds + L_T1); LAS float* rs = (LAS float*)(c.lds + L_TAB);
    const int r32 = c.lane & 31, hi = c.lane >> 5, mblk = (c.wave >> 1) * 32, nblk = (c.wave & 1) * 64, ch = c.tid & 15, c0e = ch * 8, chq = c.tid >> 7;
    TRegs rv; CRegs rw; u32x4 xv[16], uv[4]; f32x4 gv[4][2], bv[4];
    tr_load(c, Z + (size_t)tok0 * ZP + 2560 + g * 128, rv); rows_load(c, (const bf16*)(ws + WS_SGW) + (size_t)g * 16384, rw);
    { const bf16* p = Z + (size_t)(tok0 + (c.tid >> 2)) * ZP + 2560 + (c.tid & 3) * 128;
#pragma unroll
      for (int k = 0; k < 16; ++k) xv[k] = *(const u32x4*)(p + 8 * k); }
#pragma unroll
    for (int it = 0; it < 4; ++it) { uv[it] = *(const u32x4*)(Z + (size_t)(tok0 + (c.tid >> 4) + 32 * it) * ZP + 2048 + g * 128 + c0e);
        const float* gp = ain(a, 7) + g * 128 + (chq * 4 + it) * 8; gv[it][0] = *(const f32x4*)gp; gv[it][1] = *(const f32x4*)(gp + 4);
        bv[it] = *(const f32x4*)(ain(a, 9) + g * 128 + mblk + 8 * it + 4 * hi); }
    { const int s = c.tid >> 2, part = c.tid & 3; float ss = 0.f;
#pragma unroll
      for (int k = 0; k < 16; ++k) { float x[8]; unpack8(xv[k], x);
#pragma unroll
        for (int i = 0; i < 8; ++i) ss += x[i] * x[i]; }
      ss = quad_sum(ss);
      if (part == 0) rs[s] = 1.0f / sqrtf(ss * (1.0f / 512.0f) + EPS); }
    rows_store(c, rw, WG);
    __syncthreads();
    { const int s = c.tid & 127; const float r = rs[s];
#pragma unroll
      for (int it = 0; it < 4; ++it) { const int e0 = (chq * 4 + it) * 8; float x[8]; unpack8(rv.v[it], x);
#pragma unroll
        for (int i = 0; i < 8; ++i) VN[(e0 + i) * TS_ + s] = (bf16)f2bf(x[i] * r * gv[it][i >> 2][i & 3]); } }
    __syncthreads();
    f32x16 acc[2] = {};
    wg_mma128(acc, WG, VN, c.wave, c.lane);
    __syncthreads();
    LAS float* HT = (LAS float*)(c.lds + L_T0);
#pragma unroll
    for (int i = 0; i < 16; ++i) { const int t = mblk + crow_(i, hi); const float bs = bv[i >> 2][i & 3];
        HT[t * 132 + nblk + r32] = acc[0][i] + bs; HT[t * 132 + nblk + 32 + r32] = acc[1][i] + bs; }
    __syncthreads();
    { bf16* CAT = (bf16*)(ws + WS_CAT);
#pragma unroll
      for (int it = 0; it < 4; ++it) { const int t = (c.tid >> 4) + 32 * it; float u[8]; unpack8(uv[it], u);
          const f32x4 x0 = *(const LAS f32x4*)(HT + t * 132 + c0e), x1 = *(const LAS f32x4*)(HT + t * 132 + c0e + 4);
          u32x4 o; o.x = pk2(u[0] * x0.x, u[1] * x0.y); o.y = pk2(u[2] * x0.z, u[3] * x0.w);
          o.z = pk2(u[4] * x1.x, u[5] * x1.y); o.w = pk2(u[6] * x1.z, u[7] * x1.w);
          *(u32x4*)(CAT + (size_t)(tok0 + t) * DM + 512 + g * 128 + c0e) = o; } }
    __syncthreads();
}
__device__ __forceinline__ void ml_scan_phase(const Ctx& c) {
    unsigned char* ws = c.ws;
    int gid_ = c.bid * NTHR + c.tid; asm volatile("" : "+v"(gid_));
    const int gid = gid_, bh = gid >> 14, idx = gid & 16383;
    LAS float* sdec = (LAS float*)c.lds; LAS float* ssc = sdec + 64; LAS float* smp = ssc + 64;
    const float* CH = (const float*)(ws + WS_CH) + (size_t)bh * 64 * 16384 + idx; bf16* CP = (bf16*)(ws + WS_CP) + (size_t)bh * 64 * 16384 + idx;
    float chv[64];
#pragma unroll
    for (int k = 0; k < 64; ++k) chv[k] = __builtin_nontemporal_load(CH + (size_t)k * 16384);
    if (c.wave == 0) {
        const float bl = ldf((const float*)(ws + WS_MISC + MISC_BL) + bh * 64 + c.lane), mg = ldf((const float*)(ws + WS_MISC + MISC_MG) + bh * 64 + c.lane);
        float m = 0.f, mprev = 0.f, mnew = 0.f;
        for (int k = 0; k < 64; ++k) { const float blk = __shfl(bl, k), mgk = __shfl(mg, k); const float mn = fmaxf(blk + m, mgk);
            if (c.lane == k) { mprev = m; mnew = mn; } m = mn; }
        smp[c.lane] = mprev; sdec[c.lane] = fast_exp(bl + mprev - mnew); ssc[c.lane] = fast_exp(mg - mnew);
    }
    __syncthreads();
    float C = 0.f;
#pragma unroll
    for (int k = 0; k < 64; ++k) { CP[(size_t)k * 16384] = (bf16)f2bf(C); C = sdec[k] * C + ssc[k] * chv[k]; }
    if (idx < 128) { const float* NH = (const float*)(ws + WS_NH) + (size_t)bh * 64 * 128 + idx; float* NP = (float*)(ws + WS_NP) + (size_t)bh * 64 * 128 + idx; float n = 0.f;
#pragma unroll 8
        for (int k = 0; k < 64; ++k) { const float nh = NH[k * 128]; NP[k * 128] = n; n = sdec[k] * n + ssc[k] * nh; } }
    if (idx < 64) ((float*)(ws + WS_MISC + MISC_MP))[bh * 64 + idx] = smp[idx];
    __syncthreads();
}
template <int SKIP = 0> __device__ __forceinline__ void ml_out_unit(KARGS& a, const Ctx& c0, int bhc) {
    Ctx c = c0; { int t_ = c0.wave * 64 + (int)__builtin_amdgcn_mbcnt_hi(~0u, __builtin_amdgcn_mbcnt_lo(~0u, 0u)); asm volatile("" : "+v"(t_)); c.tid = t_; c.lane = t_ & 63; c.wave = __builtin_amdgcn_readfirstlane(t_ >> 6); }
    unsigned char* ws = c.ws;
    const int bh = bhc >> 6, ck = bhc & 63, b = bh >> 2, h = bh & 3, tok0 = b * SEQ + ck * 128;
    const bf16* Z = (const bf16*)(ws + WS_ARENA);
    LAS bf16* QT = (LAS bf16*)(c.lds + L_T0); LAS bf16* KT = (LAS bf16*)(c.lds + L_T1); LAS bf16* VT = (LAS bf16*)(c.lds + L_T2); LAS bf16* CT = (LAS bf16*)(c.lds + L_T3);
    LAS bf16* SW = KT; LAS bf16* RAW = (LAS bf16*)(c.lds + L_T3 + 1024); LAS bf16* RAWK = VT;
    RawRegs rq, rk; TRegs rv; CRegs rc;
    raw_load(c, Z, tok0, ck == 0, h * 128, rq); raw_load(c, Z, tok0, ck == 0, 512 + h * 128, rk);
    tr_load(c, Z + (size_t)tok0 * ZP + 1024 + h * 128, rv); rows_load(c, (const bf16*)(ws + WS_CP) + (size_t)bhc * 16384, rc);
    ConvW cwq, cwk; conv_w_load(ain(a, 3) + h * 128, ain(a, 4) + h * 128, (c.tid & 15) * 8, cwq); conv_w_load(ain(a, 3) + 512 + h * 128, ain(a, 4) + 512 + h * 128, (c.tid & 15) * 8, cwk);
    LAS float* t_a = (LAS float*)(c.lds + L_TAB); LAS float* t_mu = t_a + 128; LAS float* t_wi = t_a + 256; LAS float* t_emr = t_a + 384; LAS float* t_rden = t_a + 512; LAS float* t_np = t_a + 640; LAS float* t_ssq = t_a + 768;
    if (c.wave == 0) {
        const float* LF = (const float*)(ws + WS_LF); const float* LI = (const float*)(ws + WS_LI);
        const int s0 = 2 * c.lane;
        const float lf0 = ldf(LF + (size_t)(tok0 + s0) * 4 + h), lf1 = ldf(LF + (size_t)(tok0 + s0 + 1) * 4 + h);
        const float li0 = ldf(LI + (size_t)(tok0 + s0) * 4 + h), li1 = ldf(LI + (size_t)(tok0 + s0 + 1) * 4 + h);
        float sc = lf0 + lf1;
#pragma unroll
        for (int o = 1; o < 64; o <<= 1) { const float t = shfl_up_l(sc, o, c.lane); if (c.lane >= o) sc += t; }
        const float b1 = sc, b0 = sc - lf1;
        const float a0 = li0 - b0, a1 = li1 - b1;
        float pm = fmaxf(a0, a1);
#pragma unroll
        for (int o = 1; o < 64; o <<= 1) { const float t = shfl_up_l(pm, o, c.lane); if (c.lane >= o) pm = fmaxf(pm, t); }
        float pprev = shfl_up_l(pm, 1, c.lane); if (c.lane == 0) pprev = -__builtin_inff();
        const float pm0 = fmaxf(pprev, a0), pm1 = pm;
        const float mprev = ldf((const float*)(ws + WS_MISC + MISC_MP) + bhc);
        const float mu0 = fmaxf(mprev, pm0), mu1 = fmaxf(mprev, pm1);
        t_a[s0] = a0; t_a[s0 + 1] = a1; t_mu[s0] = mu0; t_mu[s0 + 1] = mu1;
        t_wi[s0] = fast_exp(mprev - mu0); t_wi[s0 + 1] = fast_exp(mprev - mu1);
        t_emr[s0] = fast_exp(-b0 - mu0); t_emr[s0 + 1] = fast_exp(-b1 - mu1);
    }
    if (c.wave == 1) { const float* NP = (const float*)(ws + WS_NP) + (size_t)bhc * 128; t_np[c.lane] = ldf(NP + c.lane); t_np[64 + c.lane] = ldf(NP + 64 + c.lane); }
    raw_store(c, rq, RAW); raw_store(c, rk, RAWK);
    __syncthreads();
    if (!(SKIP & 1)) { conv_tile<false>(c, RAW, nullptr, nullptr, 0.08838834764831845f, QT, &cwq);
    conv_tile<false>(c, RAWK, nullptr, nullptr, 1.0f, KT, &cwk); }
    __syncthreads();
    if (!(SKIP & 2)) tr_store(c, rv, VT, [](float x, int, int) { return x; });
    rows_store(c, rc, CT);
    __syncthreads();
    const int r32 = c.lane & 31, hi = c.lane >> 5, mblk = (c.wave >> 1) * 32, nblk = (c.wave & 1) * 64;
    f32x16 sa[2] = {};
    if (!(SKIP & 4)) wg_mma128(sa, QT, KT, c.wave, c.lane);
    __syncthreads();
    { const float as0 = t_a[nblk + r32], as1 = t_a[nblk + 32 + r32];
#pragma unroll
      for (int i = 0; i < 16; ++i) { const int t = mblk + crow_(i, hi); const float mu = t_mu[t];
          const int s0 = nblk + r32, s1 = s0 + 32;
          const float w0 = (s0 <= t) ? fast_exp(as0 - mu) : 0.f, w1 = (s1 <= t) ? fast_exp(as1 - mu) : 0.f;
          SW[t * TS_ + s0] = (bf16)f2bf(sa[0][i] * w0); SW[t * TS_ + s1] = (bf16)f2bf(sa[1][i] * w1); } }
    __syncthreads();
    f32x16 n1[2] = {}, n2[2] = {};
    if (!(SKIP & 4)) { wg_mma128(n1, SW, VT, c.wave, c.lane);
    wg_mma128(n2, QT, CT, c.wave, c.lane); }
    { const int t = c.tid >> 2, part = c.tid & 3; float ds = 0.f, dq = 0.f;
#pragma unroll
      for (int k = 0; k < 4; ++k) { float x[8], q[8]; unpack8(*(const LAS u32x4*)(SW + t * TS_ + part * 32 + 8 * k), x); unpack8(*(const LAS u32x4*)(QT + t * TS_ + part * 32 + 8 * k), q);
#pragma unroll
        for (int i = 0; i < 8; ++i) { ds += x[i]; dq += q[i] * t_np[part * 32 + 8 * k + i]; } }
      ds = quad_sum(ds); dq = quad_sum(dq);
      if (part == 0) { const float den = ds + t_wi[t] * dq; t_rden[t] = 1.0f / fmaxf(fabsf(den), t_emr[t]); } }
    __syncthreads();
    LAS float* HT = (LAS float*)(c.lds + L_T0);
#pragma unroll
    for (int i = 0; i < 16; ++i) { const int t = mblk + crow_(i, hi); const float wi = t_wi[t], rd = t_rden[t];
        HT[t * 132 + nblk + r32] = (n1[0][i] + wi * n2[0][i]) * rd; HT[t * 132 + nblk + 32 + r32] = (n1[1][i] + wi * n2[1][i]) * rd; }
    __syncthreads();
    { const int t = c.tid >> 2, part = c.tid & 3; float q = 0.f;
#pragma unroll
      for (int k = 0; k < 8; ++k) { const f32x4 x = *(const LAS f32x4*)(HT + t * 132 + part * 32 + 4 * k); q += (x.x * x.x + x.y * x.y) + (x.z * x.z + x.w * x.w); }
      q = quad_sum(q);
      if (part == 0) t_ssq[t] = 1.0f / sqrtf(q * (1.0f / 128.0f) + EPS); }
    __syncthreads();
    { int tt = c.tid; asm volatile("" : "+v"(tt));
      bf16* CAT = (bf16*)(ws + WS_CAT); const int ch = tt & 15, e0 = ch * 8; float gn[8];
#pragma unroll
      for (int i = 0; i < 8; ++i) gn[i] = ain(a, 6)[h * 128 + e0 + i];
#pragma unroll
      for (int it = 0; it < 4; ++it) { const int t = (tt >> 4) + 32 * it; float og[8]; unpack8(*(const u32x4*)(Z + (size_t)(tok0 + t) * ZP + 1536 + h * 128 + e0), og);
          const float rstd = t_ssq[t]; const f32x4 x0 = *(const LAS f32x4*)(HT + t * 132 + e0), x1 = *(const LAS f32x4*)(HT + t * 132 + e0 + 4);
          u32x4 o; o.x = pk2(x0.x * rstd * gn[0] * og[0], x0.y * rstd * gn[1] * og[1]); o.y = pk2(x0.z * rstd * gn[2] * og[2], x0.w * rstd * gn[3] * og[3]);
          o.z = pk2(x1.x * rstd * gn[4] * og[4], x1.y * rstd * gn[5] * og[5]); o.w = pk2(x1.z * rstd * gn[6] * og[6], x1.w * rstd * gn[7] * og[7]);
          *(u32x4*)(CAT + (size_t)(tok0 + t) * DM + h * 128 + e0) = o; } }
    __syncthreads();
}

__device__ __forceinline__ void fox_cumsum(const Ctx& c) {
    if (c.bid >= 8) return;
    unsigned char* ws = c.ws; const int bh = c.bid, b = bh >> 2, h = bh & 3;
    const float* LFX = (const float*)(ws + WS_LFX) + (size_t)b * SEQ * 4 + h; u32x2* KB = (u32x2*)(ws + WS_KB) + (size_t)bh * SEQ;
    LAS float* wsum = (LAS float*)c.lds;
    float v[16]; float tot = 0.f;
#pragma unroll
    for (int i = 0; i < 16; ++i) { v[i] = LFX[(size_t)(c.tid * 16 + i) * 4]; tot += v[i]; }
    float sc = tot;
#pragma unroll
    for (int o = 1; o < 64; o <<= 1) { const float t = shfl_up_l(sc, o, c.lane); if (c.lane >= o) sc += t; }
    if (c.lane == 63) wsum[c.wave] = sc;
    __syncthreads();
    float base = 0.f;
    for (int w = 0; w < c.wave; ++w) base += wsum[w];
    float run = base + sc - tot;
#pragma unroll
    for (int i = 0; i < 16; ++i) { run += v[i]; const float x = -run * 11.313708498984761f;
        const unsigned a = f2bf(x); const float r1 = x - bf2f(a); const unsigned b2 = f2bf(r1); const float r2 = r1 - bf2f(b2); const unsigned c2 = f2bf(r2);
        u32x2 w; w.x = a | (b2 << 16); w.y = c2; KB[c.tid * 16 + i] = w; }
}
#ifndef ATT_ONLY
#define ATT_ONLY 0
#endif
template <int ONLY = ATT_ONLY> __device__ __forceinline__ void attn_phase(KARGS& a, const Ctx& c, int qoff) {
    unsigned char* ws = c.ws; char* lds = (char*)c.lds;
    const bf16* Z = (const bf16*)(ws + WS_ARENA);
    LAS int* slot = (LAS int*)(c.lds + att::LDS_BYTES);
    unsigned* q = (unsigned*)(ws + WS_CTL) + CW_QUEUE + qoff;
    if (ONLY != 2) for (;;) {
        if (c.tid == 0) slot[0] = (int)__hip_atomic_fetch_add(q, 1u, RLX_AGENT);
        __syncthreads();
        const int it = slot[0];
        __syncthreads();
        if (it >= 256) break;
        const int qb = 31 - (it >> 3), bh = it & 7, b = bh >> 2, h = bh & 3; const size_t rb = (size_t)b * SEQ;
        att::BlockRef R; R.Q = Z + (rb + (size_t)qb * 256) * ZP + h * 128; R.K = Z + rb * ZP + 512 + h * 128; R.V = Z + rb * ZP + 1024 + h * 128;
        R.KB = (const u32x2*)(ws + WS_KB) + (size_t)bh * SEQ; R.P0 = qb * 256;
        int tl = c.tid; asm volatile("" : "+v"(tl));
        { const int ln = tl & 63, wv = __builtin_amdgcn_readfirstlane(tl >> 6);
          const f32x4* N2 = (const f32x4*)(ws + WS_NORM2) + rb * 8; LAS float* red = (LAS float*)(c.lds + att::LDS_BYTES + 64); LAS int* jl = (LAS int*)(c.lds + att::LDS_BYTES + 32);
          float km = 0.f, qm = 0.f; const int nk = R.P0 + 256;
          { f32x4 pk_[16];
#pragma unroll
            for (int u_ = 0; u_ < 16; ++u_) { const int s = tl + NTHR * u_; pk_[u_] = (f32x4){0.f, 0.f, 0.f, 0.f}; if (s < nk) pk_[u_] = N2[(size_t)s * 8 + 4 + h]; }
#pragma unroll
            for (int u_ = 0; u_ < 16; ++u_) km = fmaxf(km, (pk_[u_].x + pk_[u_].y) + (pk_[u_].z + pk_[u_].w)); }
          if (tl < 256) { const f32x4 pv = N2[(size_t)(R.P0 + tl) * 8 + h]; qm = (pv.x + pv.y) + (pv.z + pv.w); }
          float dmin;
          { const int row = tl >> 1, hf = tl & 1; const u32x4* qp = (const u32x4*)(R.Q + (size_t)row * ZP + hf * 64); const u32x4* kp = (const u32x4*)(R.K + (size_t)(R.P0 + row) * ZP + hf * 64);
            u32x4 qv[8], kv[8];
#pragma unroll
            for (int u_ = 0; u_ < 8; ++u_) { qv[u_] = qp[u_]; kv[u_] = kp[u_]; }
            float d = 0.f;
#pragma unroll
            for (int u_ = 0; u_ < 8; ++u_)
#pragma unroll
                for (int e_ = 0; e_ < 4; ++e_) { const unsigned qa = qv[u_][e_], ka = kv[u_][e_]; d += bflo(qa) * bflo(ka) + bfhi(qa) * bfhi(ka); }
            dmin = d + shfl_xor_l(d, 1, ln); }
#pragma unroll
          for (int o = 1; o < 64; o <<= 1) { km = fmaxf(km, shfl_xor_l(km, o, ln)); qm = fmaxf(qm, shfl_xor_l(qm, o, ln)); dmin = fminf(dmin, shfl_xor_l(dmin, o, ln)); }
          if (ln == 0) { red[wv] = km; red[8 + wv] = qm; red[16 + wv] = dmin; }
          if (tl == 0) jl[0] = qb * 4;
          __syncthreads();
          float K2 = 0.f, Q2 = 0.f, Dm = red[16];
#pragma unroll
          for (int w = 0; w < 8; ++w) { K2 = fmaxf(K2, red[w]); Q2 = fmaxf(Q2, red[8 + w]); Dm = fminf(Dm, red[16 + w]); }
          const float B2 = 1.03f * sqrtf(K2 * Q2) - Dm;
          if (tl < qb * 4) { const u32x2 w1 = R.KB[tl * 64 + 63], w0 = R.KB[R.P0];
              const float kb1 = bflo(w1.x) + bfhi(w1.x) + bflo(w1.y), kb0 = bflo(w0.x) + bfhi(w0.x) + bflo(w0.y);
              if (B2 + (kb1 - kb0) >= -18.0f * 11.313708498984761f) __hip_atomic_fetch_min(jl, tl, __ATOMIC_RELAXED, __HIP_MEMORY_SCOPE_WORKGROUP); }
          __syncthreads();
          R.JLO = jl[0];
          __syncthreads(); }
        att::Seam<128> S;
        att::causal_prime<128, true>(R, lds, S, tl);
        att::causal_block<128, true, 0>(R, R, lds, S, (void*)((bf16*)(ws + WS_CAT) + (rb + (size_t)qb * 256) * DM + h * 128), DM, tl);
    }
    if (ONLY != 1) for (;;) {
        if (c.tid == 0) slot[0] = (int)__hip_atomic_fetch_add(q + 64, 1u, RLX_AGENT);
        __syncthreads();
        const int it = slot[0];
        __syncthreads();
        if (it >= 512) break;
        const int qb = 31 - (it >> 4), d = it & 15, bh = d >> 1, mp = d & 1, b = bh >> 2, h = bh & 3; const size_t rb = (size_t)b * SEQ;
        att::BlockRef R; R.Q = Z + (rb + (size_t)qb * 256) * ZP + 1536 + h * 128 + mp * 64; R.K = Z + rb * ZP + 2048 + h * 128 + mp * 64; R.V = Z + rb * ZP + 2560 + h * 128;
        R.KB = nullptr; R.P0 = qb * 256; R.JLO = 0;
        att::Seam<64> S;
        int tl = c.tid; asm volatile("" : "+v"(tl));
        att::causal_prime<64, false>(R, lds, S, tl);
        att::causal_block<64, false, 1>(R, R, lds, S, (void*)((float*)(ws + WS_DO) + (size_t)mp * T * 512 + (rb + (size_t)qb * 256) * 512 + h * 128), 512, tl);
    }
}
__device__ __forceinline__ void diffnorm_phase(KARGS& a, const Ctx& c) {
    unsigned char* ws = c.ws;
    const float lam = ldf((const float*)(ws + WS_MISC + MISC_LAM)); const float post = 1.0f - (0.8f - 0.6f * expf(-0.3f));
    const float* D0 = (const float*)(ws + WS_DO); const float* D1 = D0 + (size_t)T * 512; bf16* CAT = (bf16*)(ws + WS_CAT);
    const int gw = c.bid * NWAVES + c.wave, NGW = GRID * NWAVES;
    const float g0 = ain(a, 18)[2 * c.lane] * post, g1 = ain(a, 18)[2 * c.lane + 1] * post;
    for (int p0 = gw * 8; p0 < T * 4; p0 += NGW * 8) {
        f32x2 x0[8], x1[8];
#pragma unroll
        for (int k = 0; k < 8; ++k) { const size_t o = (size_t)(p0 + k) * 128 + 2 * c.lane; x0[k] = __builtin_nontemporal_load((const f32x2*)(D0 + o)); x1[k] = __builtin_nontemporal_load((const f32x2*)(D1 + o)); }
#pragma unroll
        for (int k = 0; k < 8; ++k) { const int p = p0 + k, t = p >> 2, h = p & 3; const float y0 = x0[k].x - lam * x1[k].x, y1 = x0[k].y - lam * x1[k].y;
            const float rstd = 1.0f / sqrtf(wave_sum(y0 * y0 + y1 * y1) * (1.0f / 128.0f) + EPS);
            *(unsigned*)(CAT + (size_t)t * DM + 512 + h * 128 + 2 * c.lane) = pk2(y0 * rstd * g0, y1 * rstd * g1); } }
}

__device__ __forceinline__ void moe_scatter_phase(const Ctx& c) {
    unsigned char* ws = c.ws;
    LAS int* soff = (LAS int*)c.lds;
    LAS int* sts = soff + 8;
    LAS int* stot = soff + 32;
    LAS int* spos = soff + 64;
    const int* CNT = (const int*)(ws + WS_MISC + MISC_CNT);
    bf16* XN = (bf16*)(ws + WS_XN); int* ROWTOK = (int*)(ws + WS_ROWTOK);
    if (c.wave == 0) {
        typedef int i32x4 __attribute__((ext_vector_type(4)));
        i32x4 cv[8];
#pragma unroll
        for (int k = 0; k < 8; ++k) cv[k] = *((const i32x4*)(CNT + (size_t)c.lane * 32) + k);
        int tot[8], before[8];
#pragma unroll
        for (int e = 0; e < 8; ++e) { int s = 0, bf = 0;
#pragma unroll
            for (int k = 0; k < 4; ++k) { const int w = 4 * c.lane + k; const int v = cv[2 * k + (e >> 2)][e & 3]; s += v; if (w < c.bid) bf += v; }
            tot[e] = s; before[e] = bf; }
#pragma unroll
        for (int e = 0; e < 8; ++e) {
#pragma unroll
            for (int o = 1; o < 64; o <<= 1) { tot[e] += __shfl_xor(tot[e], o); before[e] += __shfl_xor(before[e], o); } }
        int ts = 0, so[8];
#pragma unroll
        for (int e = 0; e < 8; ++e) { if (c.lane == 0) { sts[e] = ts; stot[e] = tot[e]; } so[e] = ts * 256 + before[e]; ts += (tot[e] + 255) >> 8; }
        if (c.lane == 0) { sts[8] = ts; if (c.bid == 0) { int acc = 0; for (int e = 0; e < 8; ++e) { ((int*)(ws + WS_MISC + MISC_TS))[e] = acc; acc += (tot[e] + 255) >> 8; } ((int*)(ws + WS_MISC + MISC_TS))[8] = acc; } }
        const int m = 64 * c.bid + c.lane; const int e1 = ((const int*)(ws + WS_RTE))[2 * m], e2 = ((const int*)(ws + WS_RTE))[2 * m + 1];
        int p1 = 0, p2 = 0;
#pragma unroll
        for (int e = 0; e < 8; ++e) { const unsigned long long mask = __ballot(e1 == e || e2 == e); const int rank = __builtin_popcountll(mask & ((1ull << c.lane) - 1ull));
            if (e1 == e) p1 = so[e] + rank; if (e2 == e) p2 = so[e] + rank; }
        ROWTOK[p1] = m + 1; ROWTOK[p2] = m + 1;
        ((int*)(ws + WS_PPOS))[2 * m] = p1; ((int*)(ws + WS_PPOS))[2 * m + 1] = p2;
        ((float*)(ws + WS_RW))[p1] = ((const float*)(ws + WS_RTW))[2 * m]; ((float*)(ws + WS_RW))[p2] = ((const float*)(ws + WS_RTW))[2 * m + 1];
    }
    __syncthreads();
    { const int gt = c.bid * NTHR + c.tid;
      for (int e = 0; e < 8; ++e) { const int tot = stot[e], first = sts[e] * 256 + tot, npad = ((tot + 255) & ~255) - tot;
          for (int i = gt; i < npad; i += GRID * NTHR) { ROWTOK[first + i] = 0; ((float*)(ws + WS_RW))[first + i] = 0.f; } }
      if (c.bid == 0 && c.tid < 128) { const u32x4 z = {0u, 0u, 0u, 0u}; *((u32x4*)(XN - DM) + c.tid) = z; } }
    __syncthreads();
}
#ifndef MK_PER_PHASE
#define MK_PER_PHASE 0
#endif
constexpr int NPHASE = 19;
__global__ void __launch_bounds__(NTHR, 2) fwd_kernel(Args args_by_value) {
    (void)args_by_value;
    extern __shared__ __attribute__((aligned(16))) unsigned char lds_raw[];
    KARGS* ap0 = (KARGS*)__builtin_amdgcn_kernarg_segment_ptr();
    Ctx c_; c_.lds = (LAS unsigned char*)lds_raw; c_.ws = (unsigned char*)(GAS unsigned char*)ap0->ws; c_.tid = threadIdx.x; c_.lane = c_.tid & 63; c_.wave = __builtin_amdgcn_readfirstlane(c_.tid >> 6); c_.bid = blockIdx.x;
    unsigned char* const ws0 = c_.ws;
    for (int u = c_.tid; u < (LDS_BYTES - LDSCTL_OFF) / 4; u += NTHR) ((LAS unsigned*)(c_.lds + LDSCTL_OFF))[u] = 0u;
    __syncthreads();
    XcdBarrier bar; bar.bar = (unsigned*)(ws0 + WS_CTL) + CW_BAR; bar.x = 0; bar.st = nullptr;
    if (!MK_PER_PHASE) bar = xcd_barrier_post((unsigned*)(ws0 + WS_CTL) + CW_BAR, (volatile LAS unsigned*)(c_.lds + LDSCTL_OFF));
    const int lo = ap0->ph_lo, hi = ap0->ph_hi; const int wave0 = c_.wave;
#ifndef PHASE_MASK
#define PHASE_MASK 0xFFFFFFFFu
#endif
#define IN(k) (((PHASE_MASK >> (k)) & 1u) && lo <= (k) && (k) < hi)
#define FRESH() Ctx c = c_; { int t_ = wave0 * 64 + (int)__builtin_amdgcn_mbcnt_hi(~0u, __builtin_amdgcn_mbcnt_lo(~0u, 0u)); asm volatile("" : "+v"(t_)); c.tid = t_; c.lane = t_ & 63; c.wave = __builtin_amdgcn_readfirstlane(t_ >> 6); KARGS* ap_ = (KARGS*)__builtin_amdgcn_kernarg_segment_ptr(); asm volatile("" : "+s"(ap_)); GAS unsigned char* w_ = (GAS unsigned char*)ap_->ws; c.ws = (unsigned char*)w_; } \
    KARGS& args = *(KARGS*)__builtin_amdgcn_kernarg_segment_ptr(); \
    unsigned char* const ws = c.ws; bf16* const XN = (bf16*)(ws + WS_XN); bf16* const CAT = (bf16*)(ws + WS_CAT); bf16* const ZA = (bf16*)(ws + WS_ARENA); bf16* const XR = (bf16*)(ws + WS_XR); (void)XN; (void)CAT; (void)ZA; (void)XR;
#define SEAM(k) do { if (IN(k) && IN((k) + 1)) xcd_barrier(bar); } while (0)
    PG8_LAS unsigned char* glds = (PG8_LAS unsigned char*)lds_raw;

#define QOFF 0
    if (IN(0)) { FRESH(); prologue_weights<0, CONV_FGU_END, false>(args, c); prologue_tables(args, c); __syncthreads(); row_phase<0>(args, c, ain(args, 0), ain(args, 1)); }
    SEAM(0);
    if (IN(1)) { FRESH(); pg8::Gemm g{XN, (const bf16*)(ws + WS_W_EIN), T, 3072, 1024}; pg8::StaticOrder S; S.init(T, 3072, GRID, c.bid);
        pg8::EpiBf16 E{ZA, ZP, nullptr, 0, 0, nullptr, 6, 8, 12}; pg8::gemm_phase<pg8::EpiBf16, pg8::StaticOrder, true, true>(glds, g, S, E, c.tid); }
    SEAM(1);
    if (IN(2)) { FRESH(); for (int u = c.bid; u < 1024; u += GRID) { if (u < 512) ml_state_unit(args, c, u); else sg_unit(args, c, u - 512); } }
    SEAM(2);
    if (IN(3)) { FRESH(); ml_scan_phase(c); }
    SEAM(3);
    if (IN(4)) { FRESH(); for (int u = c.bid; u < 512; u += GRID) ml_out_unit(args, c, u); }
    SEAM(4);
    if (IN(5)) { FRESH(); pg8::Gemm g{CAT, (const bf16*)(ws + WS_W_EOUT), T, 1024, 1024}; pg8::StaticOrder S; S.init(T, 1024, GRID, c.bid);
        pg8::EpiResB<float> E{ain(args, 0), XR, DM}; pg8::gemm_phase<pg8::EpiResB<float>, pg8::StaticOrder, false, true>(glds, g, S, E, c.tid); }
    SEAM(5);
    if (IN(6)) { FRESH(); row_phase<1>(args, c, XR, ain(args, 11)); }
    SEAM(6);
    if (IN(7)) { FRESH(); pg8::Gemm g{XN, (const bf16*)(ws + WS_W_FGU), T, 2 * FF, 1024}; pg8::StaticOrder S; S.init(T, 2 * FF, GRID, c.bid);
        pg8::EpiSwiglu E{ZA, FF}; pg8::gemm_phase<pg8::EpiSwiglu, pg8::StaticOrder, true, true>(glds, g, S, E, c.tid);
        __syncthreads(); conv_dynamic<CONV_FGU_END, CONV_DENSE_ITEMS, false>(args, c, (unsigned*)(ws + WS_CTL) + CW_QUEUE + 384 + (QOFF ? 64 : 0)); }
    SEAM(7);
    if (IN(8)) { FRESH(); pg8::Gemm g{ZA, (const bf16*)(ws + WS_W_FDN), T, 1024, FF}; pg8::StaticOrder S; S.init(T, 1024, GRID, c.bid);
        pg8::EpiResB<bf16> E{XR, XR, DM}; pg8::gemm_phase<pg8::EpiResB<bf16>, pg8::StaticOrder, false, true>(glds, g, S, E, c.tid); }
    SEAM(8);
    if (IN(9)) { FRESH(); row_phase<2>(args, c, XR, ain(args, 14)); }
    SEAM(9);
    if (IN(10)) { FRESH(); fox_cumsum(c); __syncthreads();
        pg8::Gemm g{XN, (const bf16*)(ws + WS_W_OIN), T, 3072, 1024}; pg8::StaticOrder S; S.init(T, 3072, GRID, c.bid);
        pg8::EpiBf16 E{ZA, ZP, (const float*)(ws + WS_ROPE), 6, 10, (float*)(ws + WS_NORM2), 99, 99, 99}; pg8::gemm_phase<pg8::EpiBf16, pg8::StaticOrder, true, true>(glds, g, S, E, c.tid); }
    SEAM(10);
    if (IN(11)) { FRESH(); unsigned* cq = (unsigned*)(ws + WS_CTL) + CW_QUEUE + 320 + (QOFF ? 32 : 0);
        if (c.bid >= GRID - 32) { conv_dynamic<CONV_DENSE_ITEMS, CONV_MGU_END, true>(args, c, cq); __syncthreads(); }
        attn_phase(args, c, QOFF);
        __syncthreads(); conv_dynamic<CONV_DENSE_ITEMS, CONV_MGU_END, true>(args, c, cq); }
    SEAM(11);
    if (IN(12)) { FRESH(); diffnorm_phase(args, c); }
    SEAM(12);
    if (IN(13)) { FRESH(); pg8::Gemm g{CAT, (const bf16*)(ws + WS_W_OOUT), T, 1024, 1024}; pg8::StaticOrder S; S.init(T, 1024, GRID, c.bid);
        pg8::EpiResB<bf16> E{XR, XR, DM}; pg8::gemm_phase<pg8::EpiResB<bf16>, pg8::StaticOrder, false, true>(glds, g, S, E, c.tid); }
    SEAM(13);
    if (IN(14)) { FRESH(); row_phase<3>(args, c, XR, ain(args, 20)); }
    SEAM(14);
    if (IN(15)) { FRESH(); moe_scatter_phase(c); }
    SEAM(15);
    if (IN(16)) { FRESH(); pg8::Gemm g{(const bf16*)(ws + WS_XN) - DM, (const bf16*)(ws + WS_W_MGU), 0, 2 * FFE, 1024, (const int*)(ws + WS_ROWTOK)}; pg8::MoeOrder S;
#pragma unroll
        for (int e = 0; e < 9; ++e) S.ts[e] = __builtin_amdgcn_readfirstlane(ldi((const int*)(ws + WS_MISC + MISC_TS) + e));
        S.nM = S.ts[8]; S.nN = 2 * FFE / 256; S.nwg = S.nM * S.nN; S.G = GRID; S.c = c.bid; S.wgm = 4;
        pg8::EpiSwiglu E{ZA, FFE}; pg8::gemm_phase<pg8::EpiSwiglu, pg8::MoeOrder, true, true, true>(glds, g, S, E, c.tid);
        __syncthreads(); conv_dynamic<CONV_MGU_END, CONV_ALL_ITEMS, true>(args, c, (unsigned*)(ws + WS_CTL) + CW_QUEUE + 256 + (QOFF ? 64 : 0)); }
    SEAM(16);
    if (IN(17)) { FRESH(); pg8::Gemm g{ZA, (const bf16*)(ws + WS_W_MDN), 0, 1024, FFE}; pg8::HybridOrder S;
#pragma unroll
        for (int e = 0; e < 9; ++e) S.ts[e] = __builtin_amdgcn_readfirstlane(ldi((const int*)(ws + WS_MISC + MISC_TS) + e));
        S.nN = 4; S.NKT = FFE / 64; S.U = S.ts[8] * 4; S.G = GRID; S.c = c.bid;
        pg8::EpiMoeDownSK E{(bf16*)(ws + WS_Y), DM, (const float*)(ws + WS_RW), (bf16*)(ws + WS_XP), pg8::hyb_SL(S.U - 512)}; pg8::gemm_phase<pg8::EpiMoeDownSK, pg8::HybridOrder, true, true>(glds, g, S, E, c.tid); }
    SEAM(17);
    if (IN(18)) { FRESH(); row_phase<4>(args, c, XR, ain(args, 24)); }
#undef QOFF
#undef IN
#undef SEAM
}

extern "C" void kernel_launch(void* const* d_in, const int* in_sizes, int n_in, void* d_out, int out_size, void* d_ws, size_t ws_size, hipStream_t stream) {
    static int ready = 0;
    if (ready == 0) {
        if (n_in != 25 || in_sizes[0] != T * DM || out_size != T * DM || ws_size < WS_END) {
            fprintf(stderr, "kernel_launch: built for 25 inputs, x/out of %d floats, >= %zu bytes of workspace; got n_in %d in0 %d out %d ws %zu; nothing launched\n", T * DM, (size_t)WS_END, n_in, n_in > 0 ? in_sizes[0] : -1, out_size, ws_size);
            ready = -1; return; }
        if (hipFuncSetAttribute((const void*)fwd_kernel, hipFuncAttributeMaxDynamicSharedMemorySize, LDS_BYTES) != hipSuccess) { fprintf(stderr, "kernel_launch: hipFuncSetAttribute(%d) failed\n", LDS_BYTES); ready = -1; return; }
        int dev = 0, cus = 0, per_cu = 0; (void)hipGetDevice(&dev); (void)hipDeviceGetAttribute(&cus, hipDeviceAttributeMultiprocessorCount, dev);
        if (hipOccupancyMaxActiveBlocksPerMultiprocessor(&per_cu, (const void*)fwd_kernel, NTHR, LDS_BYTES) != hipSuccess) per_cu = -1;
        (void)hipGetLastError();
        if (cus < GRID || per_cu < 1) fprintf(stderr, "kernel_launch: note: %d CUs, occupancy query %d; the kernel needs %d co-resident workgroups (one per CU)\n", cus, per_cu, GRID);
        ready = 1;
    }
    if (ready < 0) return;
    (void)hipMemsetAsync((char*)d_ws + WS_CTL, 0, CTL_ZERO_BYTES, stream);
    Args a{};
    for (int i = 0; i < 25; ++i) a.in[i] = (const float*)d_in[i];
    a.out = (float*)d_out; a.ws = (unsigned char*)d_ws;
#if MK_PER_PHASE
    for (int p = 0; p < NPHASE; ++p) { a.ph_lo = p; a.ph_hi = p + 1; hipLaunchKernelGGL(fwd_kernel, dim3(GRID), dim3(NTHR), LDS_BYTES, stream, a); }
#else
    a.ph_lo = 0; a.ph_hi = NPHASE; hipLaunchKernelGGL(fwd_kernel, dim3(GRID), dim3(NTHR), LDS_BYTES, stream, a);
#endif
    const hipError_t le = hipPeekAtLastError();
    if (le != hipSuccess) fprintf(stderr, "kernel_launch: launch failed: %s\n", hipGetErrorName(le));
}
```
